# Optimizing an MI355X kernel written in HIP

```python
import jax
import jax.numpy as jnp
from jax import lax
import numpy as np

D_MODEL = 1024
BATCH = 8
SEQ = 4096
DEPTH = 2

GRID_W = 64
CTX_LEN = 256
N_EVEN = (DEPTH + 1) // 2
N_ODD = DEPTH // 2

RET_HEADS = 4
RET_DIM = 128
HGRN_HEADS = 4
HGRN_DIM = 128
RET_WIDTH = RET_HEADS * RET_DIM
HGRN_WIDTH = HGRN_HEADS * HGRN_DIM
MIX_IN_SIZES = [RET_WIDTH] * 4 + [HGRN_WIDTH] * 5
MIX_IN_COLS = sum(MIX_IN_SIZES)
MIX_IN_SPLITS = np.cumsum(MIX_IN_SIZES)[:-1].tolist()
RET_CHUNK = 128
HGRN_CHUNK = 64

MLA_HEADS = 8
MLA_NOPE = 128
MLA_ROPE = 64
MLA_V = 128
MLA_Q_RANK = 384
MLA_KV_RANK = 256
MLA_DOWN_COLS = MLA_Q_RANK + MLA_KV_RANK + MLA_ROPE
Q_BLOCK = 128

FFN_DIM = 2816
N_EXPERTS = 8
TOP_K = 2
MOE_DIM = 2816

ROPE_BASE = 10000.0
NORM_EPS = 1e-6

kernel_name = 'hybrid_retention_hgrn2_mla_moe_prefix_dit'


def rmsnorm(x, gain=None):
    xf = x.astype(jnp.float32)
    y = (xf * lax.rsqrt(jnp.mean(xf * xf, axis=-1, keepdims=True) + NORM_EPS)).astype(x.dtype)
    return y if gain is None else y * gain


def axial_rope_tables(n_rows, dim):
    rows = jnp.repeat(jnp.arange(n_rows), GRID_W).astype(jnp.float32)
    cols = jnp.tile(jnp.arange(GRID_W), n_rows).astype(jnp.float32)
    n_freq = dim // 4
    inv = ROPE_BASE ** (-jnp.arange(n_freq, dtype=jnp.float32) / n_freq)
    ang = jnp.concatenate([rows[:, None] * inv, cols[:, None] * inv], axis=-1)
    return jnp.cos(ang), jnp.sin(ang)


def apply_rope(x, cos, sin):
    half = x.shape[-1] // 2
    x1, x2 = x[..., :half], x[..., half:]
    cos = cos.astype(x.dtype)
    sin = sin.astype(x.dtype)
    return jnp.concatenate([x1 * cos - x2 * sin, x1 * sin + x2 * cos], axis=-1)


def _to_chunks(t, size):
    b, h, n, d = t.shape
    return jnp.moveaxis(t.astype(jnp.float32).reshape(b, h, n // size, size, d), 2, 0)


def _from_chunks(t):
    n, b, h, c, d = t.shape
    return jnp.moveaxis(t, 0, 2).reshape(b, h, n * c, d)


def retention_scan(q, k, v, log_gamma, s0):
    cs = RET_CHUNK
    pos = jnp.arange(cs, dtype=jnp.float32)
    lg = log_gamma.astype(jnp.float32)[:, None]
    rel = pos[:, None] - pos[None, :]
    intra = jnp.where(rel >= 0, jnp.exp(lg[:, :, None] * jnp.maximum(rel, 0.0)), 0.0)
    q_dec = jnp.exp(lg * (pos + 1.0))[:, :, None]
    k_dec = jnp.exp(lg * (cs - 1.0 - pos))[:, :, None]
    c_dec = jnp.exp(lg * cs)[:, :, None]

    def step(state, inp):
        qc, kc, vc = inp
        att = jnp.einsum('bhid,bhjd->bhij', qc, kc) * intra
        o = jnp.einsum('bhij,bhje->bhie', att, vc) + jnp.einsum('bhid,bhde->bhie', qc * q_dec, state)
        state = state * c_dec + jnp.einsum('bhjd,bhje->bhde', kc * k_dec, vc)
        return state, o

    state, o = lax.scan(step, s0, (_to_chunks(q, cs), _to_chunks(k, cs), _to_chunks(v, cs)))
    return _from_chunks(o), state


def gated_scan(q, k, v, log_f, s0):
    cs = HGRN_CHUNK
    lower = jnp.tril(jnp.ones((cs, cs), dtype=bool))[:, :, None]

    def step(state, inp):
        qc, kc, vc, gc = inp
        b = jnp.cumsum(gc, axis=2)
        diff = b[:, :, :, None, :] - b[:, :, None, :, :]
        w = jnp.exp(jnp.where(lower, diff, -jnp.inf))
        att = jnp.einsum('bhtsd,bhsd->bhts', qc[:, :, :, None, :] * w, kc)
        o = jnp.einsum('bhts,bhse->bhte', att, vc) + jnp.einsum('bhtd,bhde->bhte', qc * jnp.exp(b), state)
        b_last = b[:, :, -1:, :]
        state = jnp.exp(b_last[:, :, 0, :])[..., None] * state + jnp.einsum(
            'bhsd,bhse->bhde', kc * jnp.exp(b_last - b), vc)
        return state, o

    state, o = lax.scan(step, s0, (_to_chunks(q, cs), _to_chunks(k, cs), _to_chunks(v, cs),
                                   _to_chunks(log_f, cs)))
    return _from_chunks(o), state


def bidirectional_scan(scan_fn, directions, per_token_decay):
    out_c, out_x = 0.0, 0.0
    for reverse, (ctx_args, lat_args) in zip((False, True), directions):
        def orient(args):
            if not reverse:
                return args
            q, k, v, d = args
            fl = lambda t: jnp.flip(t, axis=2)
            return fl(q), fl(k), fl(v), (fl(d) if per_token_decay else d)
        qc, kc, vc, dc = orient(ctx_args)
        s0 = jnp.zeros(qc.shape[:2] + (qc.shape[-1], vc.shape[-1]), jnp.float32)
        o_c, s_c = scan_fn(qc, kc, vc, dc, s0)
        o_x, _ = scan_fn(*orient(lat_args), s_c)
        if reverse:
            o_c, o_x = jnp.flip(o_c, axis=2), jnp.flip(o_x, axis=2)
        out_c = out_c + o_c
        out_x = out_x + o_x
    return out_c, out_x


def _heads(t, d):
    b, n, _ = t.shape
    return t.reshape(b, n, -1, d).transpose(0, 2, 1, 3)


def retention_hgrn_mixer(hx, hc, w_in, ret_decay_logit, hgrn_lb, w_out, rope):
    lb = hgrn_lb.astype(jnp.float32).reshape(HGRN_HEADS, 1, HGRN_DIM)

    def project(h, rope_tab):
        aq, ak, av, ag, bq, bff, bfb, bi, bg = jnp.split(h @ w_in, MIX_IN_SPLITS, axis=-1)
        aq = _heads(aq, RET_DIM)
        ak = _heads(ak, RET_DIM) * (RET_DIM ** -0.5)
        if rope_tab is not None:
            aq = apply_rope(aq, *rope_tab)
            ak = apply_rope(ak, *rope_tab)

        def forget(z):
            f = lb + (1.0 - lb) * jax.nn.sigmoid(_heads(z, HGRN_DIM).astype(jnp.float32))
            return 1.0 - f, jnp.log(f)
        k_f, g_f = forget(bff)
        k_b, g_b = forget(bfb)
        bq = jax.nn.silu(_heads(bq, HGRN_DIM))
        bi = _heads(bi, HGRN_DIM)
        return (aq, ak, _heads(av, RET_DIM)), (bq, k_f, bi, g_f), (bq, k_b, bi, g_b), ag, bg

    c_ret, c_fwd, c_bwd, c_ag, c_bg = project(hc, None)
    x_ret, x_fwd, x_bwd, x_ag, x_bg = project(hx, rope)
    log_gamma = jax.nn.log_sigmoid(ret_decay_logit.astype(jnp.float32))
    ret_c, ret_x = bidirectional_scan(
        retention_scan,
        [((*c_ret, log_gamma[0]), (*x_ret, log_gamma[0])),
         ((*c_ret, log_gamma[1]), (*x_ret, log_gamma[1]))],
        per_token_decay=False)
    hg_c, hg_x = bidirectional_scan(gated_scan, [(c_fwd, x_fwd), (c_bwd, x_bwd)], per_token_decay=True)

    def merge(ret, hg, ag, bg, dtype):
        b, _, n, _ = ret.shape
        flat = lambda t: rmsnorm(t).transpose(0, 2, 1, 3).reshape(b, n, -1).astype(dtype)
        y = jnp.concatenate([flat(ret) * jax.nn.silu(ag), flat(hg) * jax.nn.silu(bg)], axis=-1)
        return y @ w_out

    return merge(ret_x, hg_x, x_ag, x_bg, hx.dtype), merge(ret_c, hg_c, c_ag, c_bg, hc.dtype)


def _mla_queries(down, w_uq, q_norm_g, rope_tab):
    b, n, _ = down.shape
    q = (rmsnorm(down[..., :MLA_Q_RANK], q_norm_g) @ w_uq).reshape(b, n, MLA_HEADS, MLA_NOPE + MLA_ROPE)
    q_nope, q_rope = q[..., :MLA_NOPE], q[..., MLA_NOPE:]
    if rope_tab is not None:
        q_rope = apply_rope(q_rope, rope_tab[0][:, None, :], rope_tab[1][:, None, :])
    return q_nope, q_rope


def _mla_keys_values(down, w_ukv, kv_norm_g, rope_tab):
    b, n, _ = down.shape
    ckv = down[..., MLA_Q_RANK:MLA_Q_RANK + MLA_KV_RANK]
    k_rope = down[..., MLA_Q_RANK + MLA_KV_RANK:]
    kv = (rmsnorm(ckv, kv_norm_g) @ w_ukv).reshape(b, n, MLA_HEADS, MLA_NOPE + MLA_V)
    if rope_tab is not None:
        k_rope = apply_rope(k_rope, *rope_tab)
    return kv[..., :MLA_NOPE], k_rope, kv[..., MLA_NOPE:]


def block_attention(q_nope, q_rope, k_nope, k_rope, v, scale):
    b, n, h, dn = q_nope.shape
    nb = n // Q_BLOCK
    qn = q_nope.reshape(b, nb, Q_BLOCK, h, dn).swapaxes(0, 1)
    qr = q_rope.reshape(b, nb, Q_BLOCK, h, q_rope.shape[-1]).swapaxes(0, 1)

    def one_block(args):
        qn_b, qr_b = args
        s = jnp.einsum('bqhd,bkhd->bhqk', qn_b, k_nope) + jnp.einsum('bqhr,bkr->bhqk', qr_b, k_rope)
        p = jax.nn.softmax(s.astype(jnp.float32) * scale, axis=-1).astype(v.dtype)
        return jnp.einsum('bhqk,bkhd->bqhd', p, v)

    o = lax.map(one_block, (qn, qr))
    return o.swapaxes(0, 1).reshape(b, n, h * v.shape[-1])


def mla_mixer(hx, hc, w_down, q_norm_g, kv_norm_g, w_uq, w_ukv, w_out, rope, need_ctx_out):
    scale = (MLA_NOPE + MLA_ROPE) ** -0.5
    down_c = hc @ w_down
    down_x = hx @ w_down
    c_kn, c_kr, c_v = _mla_keys_values(down_c, w_ukv, kv_norm_g, None)
    x_kn, x_kr, x_v = _mla_keys_values(down_x, w_ukv, kv_norm_g, rope)
    x_qn, x_qr = _mla_queries(down_x, w_uq, q_norm_g, rope)
    k_nope = jnp.concatenate([c_kn, x_kn], axis=1)
    k_rope = jnp.concatenate([c_kr, x_kr], axis=1)
    v = jnp.concatenate([c_v, x_v], axis=1)
    out_x = block_attention(x_qn, x_qr, k_nope, k_rope, v, scale) @ w_out
    out_c = None
    if need_ctx_out:
        c_qn, c_qr = _mla_queries(down_c, w_uq, q_norm_g, None)
        out_c = block_attention(c_qn, c_qr, c_kn, c_kr, c_v, scale) @ w_out
    return out_x, out_c


def swiglu(h, w_in, w_out):
    a, b = jnp.split(h @ w_in, 2, axis=-1)
    return (jax.nn.silu(a) * b) @ w_out


def moe_swiglu(h, router_w, w_in, w_out):
    logits = (h @ router_w).astype(jnp.float32)
    top_v, top_i = lax.top_k(logits, TOP_K)
    weights = jax.nn.softmax(top_v, axis=-1)
    gates = jnp.sum(jax.nn.one_hot(top_i, N_EXPERTS, dtype=jnp.float32) * weights[..., None], axis=-2)
    gates = gates.astype(h.dtype)
    y = 0.0
    for e in range(N_EXPERTS):
        y = y + gates[..., e:e + 1] * swiglu(h, w_in[e], w_out[e])
    return y


def setup_inputs(seed: int = 0) -> dict:
    key = jax.random.key(seed)
    keys = iter(jax.random.split(key, 32))
    f32 = jnp.float32

    def normal(shape, scale=1.0):
        return scale * jax.random.normal(next(keys), shape, f32)

    def weight(shape, fan_in, gain=1.0):
        return normal(shape, gain * fan_in ** -0.5)

    gammas = 1.0 - 2.0 ** (-5.0 - jnp.arange(RET_HEADS, dtype=f32))
    ret_logit = jnp.log(gammas) - jnp.log1p(-gammas)
    mix_w = RET_WIDTH + HGRN_WIDTH
    return {
        'x': normal((BATCH, SEQ, D_MODEL)),
        'c': normal((BATCH, D_MODEL)),
        'ctx': normal((BATCH, CTX_LEN, D_MODEL)),
        'c_ctx': normal((D_MODEL,)),
        'mod_w': weight((DEPTH, D_MODEL, 6 * D_MODEL), D_MODEL, 0.5),
        'mod_b': normal((DEPTH, 6 * D_MODEL), 0.02),
        'norm_g': 1.0 + normal((DEPTH, 4, D_MODEL), 0.05),
        'mix_in_w': weight((N_EVEN, D_MODEL, MIX_IN_COLS), D_MODEL),
        'ret_decay_logit': ret_logit + normal((N_EVEN, 2, RET_HEADS), 0.05),
        'hgrn_lb_logit': normal((N_EVEN + 1, HGRN_WIDTH), 0.5),
        'mix_out_w': weight((N_EVEN, mix_w, D_MODEL), mix_w),
        'ffn_in_w': weight((N_EVEN, D_MODEL, 2 * FFN_DIM), D_MODEL),
        'ffn_out_w': weight((N_EVEN, FFN_DIM, D_MODEL), FFN_DIM),
        'mla_down_w': weight((N_ODD, D_MODEL, MLA_DOWN_COLS), D_MODEL),
        'mla_q_norm_g': 1.0 + normal((N_ODD, MLA_Q_RANK), 0.05),
        'mla_kv_norm_g': 1.0 + normal((N_ODD, MLA_KV_RANK), 0.05),
        'mla_uq_w': weight((N_ODD, MLA_Q_RANK, MLA_HEADS * (MLA_NOPE + MLA_ROPE)), MLA_Q_RANK),
        'mla_ukv_w': weight((N_ODD, MLA_KV_RANK, MLA_HEADS * (MLA_NOPE + MLA_V)), MLA_KV_RANK),
        'mla_out_w': weight((N_ODD, MLA_HEADS * MLA_V, D_MODEL), MLA_HEADS * MLA_V),
        'router_w': weight((N_ODD, D_MODEL, N_EXPERTS), D_MODEL),
        'moe_in_w': weight((N_ODD, N_EXPERTS, D_MODEL, 2 * MOE_DIM), D_MODEL),
        'moe_out_w': weight((N_ODD, N_EXPERTS, MOE_DIM, D_MODEL), MOE_DIM),
    }


def reference(x, c, ctx, c_ctx, mod_w, mod_b, norm_g, mix_in_w, ret_decay_logit, hgrn_lb_logit,
              mix_out_w, ffn_in_w, ffn_out_w, mla_down_w, mla_q_norm_g, mla_kv_norm_g, mla_uq_w,
              mla_ukv_w, mla_out_w, router_w, moe_in_w, moe_out_w):
    n_rows = x.shape[1] // GRID_W
    ret_rope = axial_rope_tables(n_rows, RET_DIM)
    mla_rope = axial_rope_tables(n_rows, MLA_ROPE)
    lb_all = jnp.cumsum(jax.nn.softmax(hgrn_lb_logit.astype(jnp.float32), axis=0), axis=0)
    silu_c = jax.nn.silu(c)
    silu_cc = jax.nn.silu(c_ctx)
    for layer in range(DEPTH):
        last = layer == DEPTH - 1
        j = layer // 2
        g = norm_g[layer]
        mx = [m[:, None, :] for m in jnp.split(silu_c @ mod_w[layer] + mod_b[layer], 6, axis=-1)]
        mc = jnp.split(silu_cc @ mod_w[layer] + mod_b[layer], 6, axis=-1)
        hx = rmsnorm(x, g[0]) * (1.0 + mx[1]) + mx[0]
        hc = rmsnorm(ctx, g[0]) * (1.0 + mc[1]) + mc[0]
        if layer % 2 == 0:
            ox, oc = retention_hgrn_mixer(hx, hc, mix_in_w[j], ret_decay_logit[j], lb_all[j],
                                          mix_out_w[j], ret_rope)
            ffn = lambda h, j=j: swiglu(h, ffn_in_w[j], ffn_out_w[j])
        else:
            ox, oc = mla_mixer(hx, hc, mla_down_w[j], mla_q_norm_g[j], mla_kv_norm_g[j], mla_uq_w[j],
                               mla_ukv_w[j], mla_out_w[j], mla_rope, need_ctx_out=not last)
            ffn = lambda h, j=j: moe_swiglu(h, router_w[j], moe_in_w[j], moe_out_w[j])
        x = x + mx[2] * rmsnorm(ox, g[1])
        if not last:
            ctx = ctx + mc[2] * rmsnorm(oc, g[1])
        hx = rmsnorm(x, g[2]) * (1.0 + mx[4]) + mx[3]
        x = x + mx[5] * rmsnorm(ffn(hx), g[3])
        if not last:
            hc = rmsnorm(ctx, g[2]) * (1.0 + mc[4]) + mc[3]
            ctx = ctx + mc[5] * rmsnorm(ffn(hc), g[3])
    return x
```

```cpp
#include <hip/hip_runtime.h>
#include <cstdint>
#include <cstdio>

constexpr int NB = 8, T = 4096, CT = 256, D = 1024;
constexpr int RL = NB * T;
constexpr int RC = NB * CT;
constexpr int R = RL + RC;
constexpr int KEYS = CT + T;
constexpr int MIXC = 4608, FFN = 2816, NEXP = 8;
constexpr int DOWNC = 704, DOWNP = 768, QRANK = 384, KVRANK = 256;
constexpr float EPS = 1e-6f;
constexpr int SLOTS = 2 * RL;

typedef unsigned short bf16_t;
__host__ __device__ __forceinline__ float bf2f(bf16_t v) { unsigned u = ((unsigned)v) << 16; float f; __builtin_memcpy(&f, &u, 4); return f; }
__host__ __device__ __forceinline__ bf16_t f2bf(float f) { unsigned u; __builtin_memcpy(&u, &f, 4); return (bf16_t)((u + 0x7fffu + ((u >> 16) & 1u)) >> 16); }
__device__ __forceinline__ float siluf(float v) { return v / (1.f + expf(-v)); }
__device__ __forceinline__ float wave_sum(float v) {
#pragma unroll
    for (int o = 1; o < 64; o <<= 1) v += __shfl_xor(v, o);
    return v;
}

constexpr size_t MiB = 1u << 20;
constexpr size_t WS_CTL = 0;
constexpr size_t WS_MODV = 1 * MiB;
constexpr size_t WS_LB = 1 * MiB + 512 * 1024;
constexpr size_t WS_LG = WS_LB + 4096;
constexpr size_t WS_META = WS_LB + 8192;
constexpr size_t WS_ROPE_RC = 2 * MiB;
constexpr size_t WS_ROPE_RS = 3 * MiB;
constexpr size_t WS_ROPE_MC = 4 * MiB;
constexpr size_t WS_ROPE_MS = 4 * MiB + 512 * 1024;
constexpr size_t WS_CX = 5 * MiB;
constexpr size_t WS_TOPE = 5 * MiB;
constexpr size_t WS_TOPG = 5 * MiB + 256 * 1024;
constexpr size_t WS_RANK = 5 * MiB + 512 * 1024;
constexpr size_t WS_TSLOT = 5 * MiB + 768 * 1024;
constexpr size_t WS_WSMALL = 13 * MiB;
constexpr size_t WS_HB = 48 * MiB;
constexpr size_t WS_G0 = 116 * MiB;
constexpr size_t GSZ = 34 * MiB;
constexpr size_t WS_ST = 422 * MiB;
constexpr size_t WS_OX = 116 * MiB;
constexpr size_t WS_ACT = 184 * MiB;
constexpr size_t WS_DOWN = 116 * MiB;
constexpr size_t WS_QN = 404 * MiB;
constexpr size_t WS_QR = 231 * MiB;
constexpr size_t WS_KN = 263 * MiB;
constexpr size_t WS_KR = 331 * MiB;
constexpr size_t WS_V = 336 * MiB;
constexpr size_t WS_AO = 468 * MiB;
constexpr size_t WS_O = 167 * MiB;
constexpr size_t WS_NQ = 532 * MiB;
constexpr size_t WS_NKV = 558 * MiB;
constexpr size_t WS_TMP1 = 575 * MiB;
constexpr size_t WS_H4 = 508 * MiB;
constexpr size_t WS_HS = 13 * MiB;
constexpr size_t WS_ACT2 = 145 * MiB;
constexpr size_t WS_YS = 13 * MiB;
constexpr size_t WS_END = 704 * MiB;

__global__ __launch_bounds__(256) void k_mod(const float* __restrict__ c, const float* __restrict__ cctx, const float* __restrict__ mod_w,
                                             const float* __restrict__ mod_b, float* __restrict__ modv) {
    __shared__ float sc[9 * 1024];
    for (int i = threadIdx.x; i < 9 * 1024; i += 256) { int r = i >> 10, k = i & 1023; float v = r < 8 ? c[r * 1024 + k] : cctx[k]; sc[i] = siluf(v); }
    __syncthreads();
    int gid = blockIdx.x * 256 + threadIdx.x; int l = gid / 6144, n = gid % 6144;
    float acc[9];
#pragma unroll
    for (int r = 0; r < 9; ++r) acc[r] = 0.f;
    const float* w = mod_w + (size_t)l * 1024 * 6144 + n;
    for (int k = 0; k < 1024; ++k) { float wv = w[(size_t)k * 6144];
#pragma unroll
        for (int r = 0; r < 9; ++r) acc[r] += sc[r * 1024 + k] * wv; }
    float bb = mod_b[l * 6144 + n];
#pragma unroll
    for (int r = 0; r < 9; ++r) modv[((size_t)l * 9 + r) * 6144 + n] = acc[r] + bb;
}
__global__ __launch_bounds__(256) void k_tables(const float* __restrict__ lb_logit, const float* __restrict__ decay_logit, float* rc, float* rs, float* mc, float* ms, float* lb, float* lg) {
    int gid = blockIdx.x * 256 + threadIdx.x;
    if (gid < 4096 * 64) { int t = gid >> 6, j = gid & 63, i = j & 31; float pos = (float)(j < 32 ? (t >> 6) : (t & 63));
        float inv = powf(10000.f, -(float)i / 32.f); float a = pos * inv; rc[gid] = cosf(a); rs[gid] = sinf(a); }
    if (gid < 4096 * 32) { int t = gid >> 5, j = gid & 31, i = j & 15; float pos = (float)(j < 16 ? (t >> 6) : (t & 63));
        float inv = powf(10000.f, -(float)i / 16.f); float a = pos * inv; mc[gid] = cosf(a); ms[gid] = sinf(a); }
    if (gid < 512) { float l0 = lb_logit[gid], l1 = lb_logit[512 + gid]; float m = fmaxf(l0, l1); float e0 = expf(l0 - m), e1 = expf(l1 - m); lb[gid] = e0 / (e0 + e1); }
    if (gid < 8) { float x = decay_logit[gid]; lg[gid] = fminf(x, 0.f) - log1pf(expf(-fabsf(x))); }
}

struct RowArgs {
    const float* xin_lat; const float* xin_ctx;
    float* xout_lat; float* xout_ctx;
    const bf16_t* Y;
    const int* tok_slot; const float* tok_g;
    const float* gy;
    const float* gate;
    const float* gh; const float* scale; const float* shift;
    bf16_t* H;
    const float* router_w; int* top_e; float* top_g;
    int nrows;
};
__global__ __launch_bounds__(256) void k_rows(RowArgs a) {
    const int lane = threadIdx.x & 63; const int r = blockIdx.x * 4 + (threadIdx.x >> 6);
    if (r >= a.nrows) return;
    const bool lat = r < RL; const int mr = lat ? (r >> 12) : 8;
    const float* xi = lat ? a.xin_lat + (size_t)r * D : a.xin_ctx + (size_t)(r - RL) * D;
    float x[16];
#pragma unroll
    for (int j = 0; j < 4; ++j) { float4 v = *(const float4*)(xi + j * 256 + lane * 4); x[4 * j] = v.x; x[4 * j + 1] = v.y; x[4 * j + 2] = v.z; x[4 * j + 3] = v.w; }
    if (a.Y) {
        float y[16];
        if (a.tok_slot) {
            const int s0 = a.tok_slot[2 * r], s1 = a.tok_slot[2 * r + 1]; const float g0 = a.tok_g[2 * r], g1 = a.tok_g[2 * r + 1];
#pragma unroll
            for (int j = 0; j < 4; ++j) { const uint2 u0 = *(const uint2*)(a.Y + (size_t)s0 * D + j * 256 + lane * 4); const uint2 u1 = *(const uint2*)(a.Y + (size_t)s1 * D + j * 256 + lane * 4);
                y[4 * j] = g0 * bf2f(u0.x & 0xffff) + g1 * bf2f(u1.x & 0xffff); y[4 * j + 1] = g0 * bf2f(u0.x >> 16) + g1 * bf2f(u1.x >> 16);
                y[4 * j + 2] = g0 * bf2f(u0.y & 0xffff) + g1 * bf2f(u1.y & 0xffff); y[4 * j + 3] = g0 * bf2f(u0.y >> 16) + g1 * bf2f(u1.y >> 16); }
        } else {
#pragma unroll
            for (int j = 0; j < 4; ++j) { const uint2 u = *(const uint2*)(a.Y + (size_t)r * D + j * 256 + lane * 4);
                y[4 * j] = bf2f(u.x & 0xffff); y[4 * j + 1] = bf2f(u.x >> 16); y[4 * j + 2] = bf2f(u.y & 0xffff); y[4 * j + 3] = bf2f(u.y >> 16); }
        }
        float ss = 0.f;
#pragma unroll
        for (int i = 0; i < 16; ++i) ss += y[i] * y[i];
        ss = wave_sum(ss); const float ry = rsqrtf(ss * (1.f / D) + EPS);
        float* xo = lat ? a.xout_lat + (size_t)r * D : a.xout_ctx + (size_t)(r - RL) * D;
#pragma unroll
        for (int j = 0; j < 4; ++j) { const int c = j * 256 + lane * 4; const float4 g = *(const float4*)(a.gy + c); const float4 gt = *(const float4*)(a.gate + (size_t)mr * 6144 + c);
            x[4 * j] += gt.x * (y[4 * j] * ry * g.x); x[4 * j + 1] += gt.y * (y[4 * j + 1] * ry * g.y); x[4 * j + 2] += gt.z * (y[4 * j + 2] * ry * g.z); x[4 * j + 3] += gt.w * (y[4 * j + 3] * ry * g.w);
            *(float4*)(xo + c) = make_float4(x[4 * j], x[4 * j + 1], x[4 * j + 2], x[4 * j + 3]); }
    }
    if (a.gh) {
        float ss = 0.f;
#pragma unroll
        for (int i = 0; i < 16; ++i) ss += x[i] * x[i];
        ss = wave_sum(ss); const float rx = rsqrtf(ss * (1.f / D) + EPS);
        float h[16];
#pragma unroll
        for (int j = 0; j < 4; ++j) { const int c = j * 256 + lane * 4; const float4 g = *(const float4*)(a.gh + c); const float4 sc = *(const float4*)(a.scale + (size_t)mr * 6144 + c); const float4 sh = *(const float4*)(a.shift + (size_t)mr * 6144 + c);
            h[4 * j] = x[4 * j] * rx * g.x * (1.f + sc.x) + sh.x; h[4 * j + 1] = x[4 * j + 1] * rx * g.y * (1.f + sc.y) + sh.y;
            h[4 * j + 2] = x[4 * j + 2] * rx * g.z * (1.f + sc.z) + sh.z; h[4 * j + 3] = x[4 * j + 3] * rx * g.w * (1.f + sc.w) + sh.w;
            uint2 o; o.x = (unsigned)f2bf(h[4 * j]) | ((unsigned)f2bf(h[4 * j + 1]) << 16); o.y = (unsigned)f2bf(h[4 * j + 2]) | ((unsigned)f2bf(h[4 * j + 3]) << 16);
            *(uint2*)(a.H + (size_t)r * D + c) = o; }
        if (a.router_w) {
            float lg[8];
#pragma unroll
            for (int e = 0; e < 8; ++e) lg[e] = 0.f;
#pragma unroll
            for (int j = 0; j < 4; ++j)
#pragma unroll
                for (int i = 0; i < 4; ++i) { const int c = j * 256 + lane * 4 + i; const float4 w0 = *(const float4*)(a.router_w + (size_t)c * 8); const float4 w1 = *(const float4*)(a.router_w + (size_t)c * 8 + 4); const float hv = h[4 * j + i];
                    lg[0] += hv * w0.x; lg[1] += hv * w0.y; lg[2] += hv * w0.z; lg[3] += hv * w0.w; lg[4] += hv * w1.x; lg[5] += hv * w1.y; lg[6] += hv * w1.z; lg[7] += hv * w1.w; }
#pragma unroll
            for (int e = 0; e < 8; ++e) lg[e] = wave_sum(lg[e]);
            if (lane == 0) {
                int e0 = 0; float v0 = lg[0];
#pragma unroll
                for (int e = 1; e < 8; ++e) if (lg[e] > v0) { v0 = lg[e]; e0 = e; }
                int e1 = -1; float v1 = -3.0e38f;
#pragma unroll
                for (int e = 0; e < 8; ++e) if (e != e0 && lg[e] > v1) { v1 = lg[e]; e1 = e; }
                const float g0 = 1.f / (1.f + expf(v1 - v0));
                a.top_e[2 * r] = e0; a.top_e[2 * r + 1] = e1; a.top_g[2 * r] = g0; a.top_g[2 * r + 1] = 1.f - g0;
            }
        }
    }
}

template <int MODE>
__global__ __launch_bounds__(256) void k_sgemm(const bf16_t* __restrict__ A, int lda, const float* __restrict__ W, int ldw, void* __restrict__ Cv, int ldc,
                                               int M, int N, int K, const int* __restrict__ meta, int e, size_t wstride, int row_off, int row_cap) {
    constexpr int NBW = (MODE == 2) ? 2 : 1;
    int arow0 = 0;
    if (meta) { arow0 = meta[e] + row_off; int cnt = meta[8 + e] - row_off; M = cnt < row_cap ? cnt : row_cap; W += (size_t)e * wstride; }
    const int bm = blockIdx.y * 128, bn = blockIdx.x * 64;
    if (bm >= M) return;
    __shared__ float As[16][132]; __shared__ float Bs[NBW][16][68];
    const int tid = threadIdx.x, tx = tid & 15, ty = tid >> 4;
    float acc[NBW][8][4];
#pragma unroll
    for (int w = 0; w < NBW; ++w)
#pragma unroll
        for (int i = 0; i < 8; ++i)
#pragma unroll
            for (int j = 0; j < 4; ++j) acc[w][i][j] = 0.f;
    const int ar = tid >> 1, ak = (tid & 1) * 8; const bool aval = (bm + ar) < M;
    const bf16_t* ap = A + (size_t)(arow0 + bm + (aval ? ar : 0)) * lda + ak;
    const int bk = tid >> 4, bc = (tid & 15) * 4; const bool bval = (bn + bc) < N;
    for (int k0 = 0; k0 < K; k0 += 16) {
        uint4 av = aval ? *(const uint4*)(ap + k0) : make_uint4(0, 0, 0, 0);
        As[ak + 0][ar] = bf2f(av.x & 0xffff); As[ak + 1][ar] = bf2f(av.x >> 16); As[ak + 2][ar] = bf2f(av.y & 0xffff); As[ak + 3][ar] = bf2f(av.y >> 16);
        As[ak + 4][ar] = bf2f(av.z & 0xffff); As[ak + 5][ar] = bf2f(av.z >> 16); As[ak + 6][ar] = bf2f(av.w & 0xffff); As[ak + 7][ar] = bf2f(av.w >> 16);
#pragma unroll
        for (int w = 0; w < NBW; ++w) { float4 bv = bval ? *(const float4*)(W + (size_t)(k0 + bk) * ldw + bn + bc + w * N) : make_float4(0, 0, 0, 0); *(float4*)&Bs[w][bk][bc] = bv; }
        __syncthreads();
#pragma unroll
        for (int kk = 0; kk < 16; ++kk) {
            float a[8]; const float4 a0 = *(const float4*)&As[kk][ty * 8], a1 = *(const float4*)&As[kk][ty * 8 + 4];
            a[0] = a0.x; a[1] = a0.y; a[2] = a0.z; a[3] = a0.w; a[4] = a1.x; a[5] = a1.y; a[6] = a1.z; a[7] = a1.w;
#pragma unroll
            for (int w = 0; w < NBW; ++w) { const float4 b = *(const float4*)&Bs[w][kk][tx * 4];
#pragma unroll
                for (int i = 0; i < 8; ++i) { acc[w][i][0] += a[i] * b.x; acc[w][i][1] += a[i] * b.y; acc[w][i][2] += a[i] * b.z; acc[w][i][3] += a[i] * b.w; } }
        }
        __syncthreads();
    }
#pragma unroll
    for (int i = 0; i < 8; ++i) { const int rr = bm + ty * 8 + i; if (rr >= M) continue;
#pragma unroll
        for (int j = 0; j < 4; ++j) { const int cc = bn + tx * 4 + j; if (cc >= N) continue;
            const size_t o = (size_t)(arow0 + rr) * ldc + cc;
            if (MODE == 0) ((float*)Cv)[o] = acc[0][i][j];
            else if (MODE == 1) ((bf16_t*)Cv)[o] = f2bf(acc[0][i][j]);
            else ((bf16_t*)Cv)[o] = f2bf(siluf(acc[0][i][j]) * acc[NBW - 1][i][j]); } }
}

__global__ __launch_bounds__(256) void k_mixact(const float* __restrict__ tmp, bf16_t* __restrict__ G, int grp, const float* __restrict__ rc, const float* __restrict__ rs, const float* __restrict__ lb) {
    const size_t gid = (size_t)blockIdx.x * 256 + threadIdx.x; if (gid >= (size_t)R * 512) return;
    const int r = (int)(gid >> 9), c = (int)(gid & 511); float v = tmp[gid], o;
    if (grp <= 1) {
        const int j = c & 127, jj = j & 63; const float other = tmp[(size_t)r * 512 + (c ^ 64)];
        float x1 = j < 64 ? v : other, x2 = j < 64 ? other : v;
        if (grp == 1) { x1 *= 0.08838834764831845f; x2 *= 0.08838834764831845f; }
        if (r < RL) { const int t = r & 4095; const float cs = rc[t * 64 + jj], sn = rs[t * 64 + jj]; o = j < 64 ? x1 * cs - x2 * sn : x1 * sn + x2 * cs; }
        else o = j < 64 ? x1 : x2;
    } else if (grp == 2 || grp == 7) o = v;
    else if (grp == 3 || grp == 4 || grp == 8) o = siluf(v);
    else { const float l = lb[c]; o = (1.f - l) / (1.f + expf(v)); }
    G[gid] = f2bf(o);
}
template <int ALGO>
__global__ __launch_bounds__(128) void k_scan_naive(const bf16_t* __restrict__ Q, const bf16_t* __restrict__ Kf, const bf16_t* __restrict__ Kb, const bf16_t* __restrict__ V,
                                                    const float* __restrict__ lg, float* __restrict__ O) {
    const int b = blockIdx.x >> 2, h = blockIdx.x & 3, e = threadIdx.x;
    __shared__ float sq[32][128]; __shared__ float sk[32][128];
    for (int dir = 0; dir < 2; ++dir) {
        const bf16_t* Kp = dir ? Kb : Kf; const float gamma = (ALGO == 0) ? expf(lg[dir * 4 + h]) : 0.f;
        float S[128];
#pragma unroll
        for (int d = 0; d < 128; ++d) S[d] = 0.f;
        for (int p0 = 0; p0 < KEYS; p0 += 32) {
            __syncthreads();
            for (int i = threadIdx.x; i < 32 * 128; i += 128) { const int s = i >> 7, d = i & 127; const int p = p0 + s;
                const int row = p < CT ? (RL + b * CT + (dir ? CT - 1 - p : p)) : (b * T + (dir ? T - 1 - (p - CT) : (p - CT)));
                sq[s][d] = bf2f(Q[(size_t)row * 512 + h * 128 + d]); sk[s][d] = bf2f(Kp[(size_t)row * 512 + h * 128 + d]); }
            __syncthreads();
            for (int s = 0; s < 32; ++s) { const int p = p0 + s;
                const int row = p < CT ? (RL + b * CT + (dir ? CT - 1 - p : p)) : (b * T + (dir ? T - 1 - (p - CT) : (p - CT)));
                const float v = bf2f(V[(size_t)row * 512 + h * 128 + e]); float o = 0.f;
#pragma unroll
                for (int d = 0; d < 128; ++d) { const float kd = sk[s][d]; const float dec = (ALGO == 0) ? gamma : (1.f - kd); S[d] = dec * S[d] + kd * v; o += sq[s][d] * S[d]; }
                float* op = O + (size_t)row * 512 + h * 128 + e; if (dir == 0) *op = o; else *op += o; }
        }
    }
}
__global__ __launch_bounds__(256) void k_merge(const float* __restrict__ Oret, const float* __restrict__ Ohg, const bf16_t* __restrict__ AG, const bf16_t* __restrict__ BG, bf16_t* __restrict__ Y) {
    const int lane = threadIdx.x & 63; const size_t w = (size_t)blockIdx.x * 4 + (threadIdx.x >> 6); if (w >= (size_t)R * 8) return;
    const int r = (int)(w >> 3), part = (int)((w >> 2) & 1), h = (int)(w & 3);
    const float* src = (part ? Ohg : Oret) + (size_t)r * 512 + h * 128; const bf16_t* g = (part ? BG : AG) + (size_t)r * 512 + h * 128;
    const float v0 = src[lane * 2], v1 = src[lane * 2 + 1]; const float ss = wave_sum(v0 * v0 + v1 * v1); const float rr = rsqrtf(ss * (1.f / 128.f) + EPS);
    bf16_t* y = Y + (size_t)r * 1024 + part * 512 + h * 128;
    y[lane * 2] = f2bf(v0 * rr * bf2f(g[lane * 2])); y[lane * 2 + 1] = f2bf(v1 * rr * bf2f(g[lane * 2 + 1]));
}

__global__ __launch_bounds__(256) void k_mla_prep(const bf16_t* __restrict__ DOWN, const float* __restrict__ gq, const float* __restrict__ gkv, const float* __restrict__ mc, const float* __restrict__ ms,
                                                  bf16_t* __restrict__ NQ, bf16_t* __restrict__ NKV, bf16_t* __restrict__ KR) {
    const int lane = threadIdx.x & 63; const int r = blockIdx.x * 4 + (threadIdx.x >> 6); if (r >= R) return;
    const bf16_t* d = DOWN + (size_t)r * DOWNP;
    float q[6]; float ss = 0.f;
#pragma unroll
    for (int i = 0; i < 6; ++i) { q[i] = bf2f(d[lane + 64 * i]); ss += q[i] * q[i]; }
    ss = wave_sum(ss); const float rq = rsqrtf(ss * (1.f / 384.f) + EPS);
#pragma unroll
    for (int i = 0; i < 6; ++i) NQ[(size_t)r * 384 + lane + 64 * i] = f2bf(q[i] * rq * gq[lane + 64 * i]);
    float k[4]; ss = 0.f;
#pragma unroll
    for (int i = 0; i < 4; ++i) { k[i] = bf2f(d[384 + lane + 64 * i]); ss += k[i] * k[i]; }
    ss = wave_sum(ss); const float rk = rsqrtf(ss * (1.f / 256.f) + EPS);
#pragma unroll
    for (int i = 0; i < 4; ++i) NKV[(size_t)r * 256 + lane + 64 * i] = f2bf(k[i] * rk * gkv[lane + 64 * i]);
    const float x1 = bf2f(d[640 + (lane & 31)]), x2 = bf2f(d[672 + (lane & 31)]);
    const bool lat = r < RL; const int b = lat ? (r >> 12) : ((r - RL) >> 8); const int key = lat ? CT + (r & 4095) : ((r - RL) & 255);
    float o;
    if (lat) { const int t = r & 4095; const float cs = mc[t * 32 + (lane & 31)], sn = ms[t * 32 + (lane & 31)]; o = lane < 32 ? x1 * cs - x2 * sn : x1 * sn + x2 * cs; }
    else o = lane < 32 ? x1 : x2;
    KR[((size_t)b * KEYS + key) * 64 + lane] = f2bf(o);
}
__global__ __launch_bounds__(256) void k_qsplit(const float* __restrict__ tmp, int r0, int nrows, const float* __restrict__ mc, const float* __restrict__ ms, bf16_t* __restrict__ QN, bf16_t* __restrict__ QR) {
    const size_t gid = (size_t)blockIdx.x * 256 + threadIdx.x; if (gid >= (size_t)nrows * 1536) return;
    const int rr = (int)(gid / 1536), c = (int)(gid % 1536), h = c / 192, j = c % 192; const int r = r0 + rr, b = r >> 12, t = r & 4095;
    const float v = tmp[gid];
    if (j < 128) QN[(((size_t)b * 8 + h) * T + t) * 128 + j] = f2bf(v);
    else { const int jr = j - 128, jj = jr & 31; const float other = tmp[(size_t)rr * 1536 + h * 192 + 128 + (jr ^ 32)];
        const float x1 = jr < 32 ? v : other, x2 = jr < 32 ? other : v; const float cs = mc[t * 32 + jj], sn = ms[t * 32 + jj];
        QR[(((size_t)b * 8 + h) * T + t) * 64 + jr] = f2bf(jr < 32 ? x1 * cs - x2 * sn : x1 * sn + x2 * cs); }
}
__global__ __launch_bounds__(256) void k_kvsplit(const float* __restrict__ tmp, int r0, int nrows, bf16_t* __restrict__ KN, bf16_t* __restrict__ Vv) {
    const size_t gid = (size_t)blockIdx.x * 256 + threadIdx.x; if (gid >= (size_t)nrows * 2048) return;
    const int rr = (int)(gid >> 11), c = (int)(gid & 2047), h = c >> 8, j = c & 255; const int r = r0 + rr;
    const bool lat = r < RL; const int b = lat ? (r >> 12) : ((r - RL) >> 8); const int key = lat ? CT + (r & 4095) : ((r - RL) & 255);
    bf16_t* dst = (j < 128 ? KN : Vv) + (((size_t)b * 8 + h) * KEYS + key) * 128 + (j & 127);
    *dst = f2bf(tmp[gid]);
}
__global__ __launch_bounds__(256) void k_attn_naive(const bf16_t* __restrict__ QN, const bf16_t* __restrict__ QR, const bf16_t* __restrict__ KN, const bf16_t* __restrict__ KR, const bf16_t* __restrict__ Vv, bf16_t* __restrict__ AO) {
    __shared__ float sq[2][192]; __shared__ float sc[2][KEYS]; __shared__ float red[2][4];
    const int tid = threadIdx.x; const int qb = blockIdx.x % (T / 2), h = (blockIdx.x / (T / 2)) & 7, b = blockIdx.x / (T / 2 * 8);
    const int t0 = qb * 2; const size_t bh = (size_t)b * 8 + h;
    for (int i = tid; i < 2 * 192; i += 256) { const int q = i / 192, j = i % 192; sq[q][j] = j < 128 ? bf2f(QN[(bh * T + t0 + q) * 128 + j]) : bf2f(QR[(bh * T + t0 + q) * 64 + j - 128]); }
    __syncthreads();
    const float scale = 0.07216878364870322f;
    float m0 = -3e38f, m1 = -3e38f;
    for (int key = tid; key < KEYS; key += 256) {
        const uint4* kn = (const uint4*)(KN + (bh * KEYS + key) * 128); const uint4* kr = (const uint4*)(KR + ((size_t)b * KEYS + key) * 64);
        float s0 = 0.f, s1 = 0.f;
        for (int c = 0; c < 24; ++c) { const uint4 u = c < 16 ? kn[c] : kr[c - 16]; const int j = c * 8;
            const float k0 = bf2f(u.x & 0xffff), k1 = bf2f(u.x >> 16), k2 = bf2f(u.y & 0xffff), k3 = bf2f(u.y >> 16), k4 = bf2f(u.z & 0xffff), k5 = bf2f(u.z >> 16), k6 = bf2f(u.w & 0xffff), k7 = bf2f(u.w >> 16);
            s0 += sq[0][j] * k0 + sq[0][j + 1] * k1 + sq[0][j + 2] * k2 + sq[0][j + 3] * k3 + sq[0][j + 4] * k4 + sq[0][j + 5] * k5 + sq[0][j + 6] * k6 + sq[0][j + 7] * k7;
            s1 += sq[1][j] * k0 + sq[1][j + 1] * k1 + sq[1][j + 2] * k2 + sq[1][j + 3] * k3 + sq[1][j + 4] * k4 + sq[1][j + 5] * k5 + sq[1][j + 6] * k6 + sq[1][j + 7] * k7; }
        s0 *= scale; s1 *= scale; sc[0][key] = s0; sc[1][key] = s1; m0 = fmaxf(m0, s0); m1 = fmaxf(m1, s1);
    }
#pragma unroll
    for (int o = 1; o < 64; o <<= 1) { m0 = fmaxf(m0, __shfl_xor(m0, o)); m1 = fmaxf(m1, __shfl_xor(m1, o)); }
    if ((tid & 63) == 0) { red[0][tid >> 6] = m0; red[1][tid >> 6] = m1; }
    __syncthreads();
    m0 = fmaxf(fmaxf(red[0][0], red[0][1]), fmaxf(red[0][2], red[0][3])); m1 = fmaxf(fmaxf(red[1][0], red[1][1]), fmaxf(red[1][2], red[1][3]));
    __syncthreads();
    float l0 = 0.f, l1 = 0.f;
    for (int key = tid; key < KEYS; key += 256) { const float p0 = expf(sc[0][key] - m0), p1 = expf(sc[1][key] - m1); sc[0][key] = p0; sc[1][key] = p1; l0 += p0; l1 += p1; }
    l0 = wave_sum(l0); l1 = wave_sum(l1);
    if ((tid & 63) == 0) { red[0][tid >> 6] = l0; red[1][tid >> 6] = l1; }
    __syncthreads();
    l0 = red[0][0] + red[0][1] + red[0][2] + red[0][3]; l1 = red[1][0] + red[1][1] + red[1][2] + red[1][3];
    const int q = tid >> 7, d = tid & 127; const float* p = sc[q]; float o = 0.f;
    const bf16_t* vp = Vv + bh * KEYS * 128 + d;
    for (int key = 0; key < KEYS; ++key) o += p[key] * bf2f(vp[(size_t)key * 128]);
    AO[((size_t)b * T + t0 + q) * 1024 + h * 128 + d] = f2bf(o / (q ? l1 : l0));
}

__global__ __launch_bounds__(1024) void k_route_rank(const int* __restrict__ top_e, int* __restrict__ rank, int* __restrict__ meta) {
    __shared__ int ws[16]; __shared__ int running;
    const int e = blockIdx.x, tid = threadIdx.x, lane = tid & 63, wid = tid >> 6;
    if (tid == 0) running = 0;
    __syncthreads();
    for (int t0 = 0; t0 < RL; t0 += 1024) { const int t = t0 + tid; const int e0 = top_e[2 * t], e1 = top_e[2 * t + 1]; const int f = (e0 == e || e1 == e) ? 1 : 0;
        const unsigned long long bal = __ballot(f); const int pre = __popcll(bal & ((1ull << lane) - 1ull));
        if (lane == 0) ws[wid] = __popcll(bal);
        __syncthreads();
        int off = 0; for (int w = 0; w < wid; ++w) off += ws[w];
        int tot = 0; for (int w = 0; w < 16; ++w) tot += ws[w];
        const int base = running;
        if (f) rank[2 * t + (e0 == e ? 0 : 1)] = base + off + pre;
        __syncthreads();
        if (tid == 0) running = base + tot;
        __syncthreads();
    }
    if (tid == 0) meta[8 + e] = running;
}
__global__ void k_route_base(int* meta) { if (threadIdx.x == 0) { int s = 0; for (int e = 0; e < 8; ++e) { meta[e] = s; s += meta[8 + e]; } } }
__global__ __launch_bounds__(256) void k_gather(const bf16_t* __restrict__ H4, const int* __restrict__ top_e, const int* __restrict__ rank, const int* __restrict__ meta, bf16_t* __restrict__ HS, int* __restrict__ tok_slot) {
    const int lane = threadIdx.x & 63; const int t = blockIdx.x * 4 + (threadIdx.x >> 6); if (t >= RL) return;
    const uint4 v0 = *(const uint4*)(H4 + (size_t)t * D + lane * 8), v1 = *(const uint4*)(H4 + (size_t)t * D + 512 + lane * 8);
#pragma unroll
    for (int k = 0; k < 2; ++k) { const int e = top_e[2 * t + k]; const int slot = meta[e] + rank[2 * t + k];
        *(uint4*)(HS + (size_t)slot * D + lane * 8) = v0; *(uint4*)(HS + (size_t)slot * D + 512 + lane * 8) = v1;
        if (lane == 0) tok_slot[2 * t + k] = slot; }
}

static inline dim3 g1(size_t n, int per) { return dim3((unsigned)((n + per - 1) / per)); }
extern "C" void kernel_launch(void* const* d_in, const int* in_sizes, int n_in, void* d_out, int out_size, void* d_ws, size_t ws_size, hipStream_t stream) {
    if (n_in != 22 || out_size != RL * D || ws_size < WS_END) { fprintf(stderr, "kernel_launch: unexpected shapes: n_in %d out %d ws %zu (need %zu)\n", n_in, out_size, ws_size, (size_t)WS_END); return; }
    const float* x = (const float*)d_in[0]; const float* c = (const float*)d_in[1]; const float* ctx = (const float*)d_in[2]; const float* cctx = (const float*)d_in[3];
    const float* mod_w = (const float*)d_in[4]; const float* mod_b = (const float*)d_in[5]; const float* norm_g = (const float*)d_in[6]; const float* mix_in_w = (const float*)d_in[7];
    const float* decay_logit = (const float*)d_in[8]; const float* lb_logit = (const float*)d_in[9]; const float* mix_out_w = (const float*)d_in[10]; const float* ffn_in_w = (const float*)d_in[11];
    const float* ffn_out_w = (const float*)d_in[12]; const float* down_w = (const float*)d_in[13]; const float* gq = (const float*)d_in[14]; const float* gkv = (const float*)d_in[15];
    const float* uq_w = (const float*)d_in[16]; const float* ukv_w = (const float*)d_in[17]; const float* mla_out_w = (const float*)d_in[18]; const float* router_w = (const float*)d_in[19];
    const float* moe_in_w = (const float*)d_in[20]; const float* moe_out_w = (const float*)d_in[21];
    char* ws = (char*)d_ws; float* out = (float*)d_out;
    float* modv = (float*)(ws + WS_MODV); float* lb = (float*)(ws + WS_LB); float* lg = (float*)(ws + WS_LG); int* meta = (int*)(ws + WS_META);
    float* rc = (float*)(ws + WS_ROPE_RC); float* rs = (float*)(ws + WS_ROPE_RS); float* mc = (float*)(ws + WS_ROPE_MC); float* ms = (float*)(ws + WS_ROPE_MS);
    float* cx = (float*)(ws + WS_CX); bf16_t* HB = (bf16_t*)(ws + WS_HB);
    bf16_t* G[9]; for (int i = 0; i < 9; ++i) G[i] = (bf16_t*)(ws + WS_G0 + i * GSZ);
    float* tmpS = (float*)(ws + WS_ST); float* oret = (float*)(ws + WS_ST + 72 * MiB); float* ohg = (float*)(ws + WS_ST + 140 * MiB);
    bf16_t* OX = (bf16_t*)(ws + WS_OX); bf16_t* ACT = (bf16_t*)(ws + WS_ACT);
    bf16_t* DOWN = (bf16_t*)(ws + WS_DOWN); bf16_t* QN = (bf16_t*)(ws + WS_QN); bf16_t* QR = (bf16_t*)(ws + WS_QR); bf16_t* KN = (bf16_t*)(ws + WS_KN); bf16_t* KR = (bf16_t*)(ws + WS_KR);
    bf16_t* Vv = (bf16_t*)(ws + WS_V); bf16_t* AO = (bf16_t*)(ws + WS_AO); bf16_t* Ob = (bf16_t*)(ws + WS_O); bf16_t* NQ = (bf16_t*)(ws + WS_NQ); bf16_t* NKV = (bf16_t*)(ws + WS_NKV);
    float* tmp1 = (float*)(ws + WS_TMP1); bf16_t* H4 = (bf16_t*)(ws + WS_H4); bf16_t* HS = (bf16_t*)(ws + WS_HS); bf16_t* ACT2 = (bf16_t*)(ws + WS_ACT2); bf16_t* YS = (bf16_t*)(ws + WS_YS);
    int* top_e = (int*)(ws + WS_TOPE); float* top_g = (float*)(ws + WS_TOPG); int* rank = (int*)(ws + WS_RANK); int* tslot = (int*)(ws + WS_TSLOT);
    const float* mv0 = modv; const float* mv1 = modv + 9 * 6144;
    const float* g0 = norm_g; const float* g1n = norm_g + 4 * 1024;

    hipLaunchKernelGGL(k_mod, dim3(48), dim3(256), 0, stream, c, cctx, mod_w, mod_b, modv);
    hipLaunchKernelGGL(k_tables, dim3(1024), dim3(256), 0, stream, lb_logit, decay_logit, rc, rs, mc, ms, lb, lg);
    { RowArgs a{}; a.xin_lat = x; a.xin_ctx = ctx; a.gh = g0; a.scale = mv0 + 1024; a.shift = mv0; a.H = HB; a.nrows = R;
      hipLaunchKernelGGL(k_rows, dim3(R / 4), dim3(256), 0, stream, a); }
    for (int grp = 0; grp < 9; ++grp) {
        hipLaunchKernelGGL(k_sgemm<0>, dim3(512 / 64, R / 128), dim3(256), 0, stream, HB, D, mix_in_w + grp * 512, MIXC, (void*)tmpS, 512, R, 512, D, (const int*)nullptr, 0, (size_t)0, 0, 0);
        hipLaunchKernelGGL(k_mixact, g1((size_t)R * 512, 256), dim3(256), 0, stream, tmpS, G[grp], grp, rc, rs, lb);
    }
    hipLaunchKernelGGL(k_scan_naive<0>, dim3(32), dim3(128), 0, stream, G[0], G[1], G[1], G[2], lg, oret);
    hipLaunchKernelGGL(k_scan_naive<1>, dim3(32), dim3(128), 0, stream, G[4], G[5], G[6], G[7], lg, ohg);
    hipLaunchKernelGGL(k_merge, g1((size_t)R * 8, 4), dim3(256), 0, stream, oret, ohg, G[3], G[8], HB);
    hipLaunchKernelGGL(k_sgemm<1>, dim3(D / 64, R / 128), dim3(256), 0, stream, HB, D, mix_out_w, D, (void*)OX, D, R, D, D, (const int*)nullptr, 0, (size_t)0, 0, 0);
    { RowArgs a{}; a.xin_lat = x; a.xin_ctx = ctx; a.xout_lat = out; a.xout_ctx = cx; a.Y = OX; a.gy = g0 + 1024; a.gate = mv0 + 2048; a.gh = g0 + 2048; a.scale = mv0 + 4096; a.shift = mv0 + 3072; a.H = HB; a.nrows = R;
      hipLaunchKernelGGL(k_rows, dim3(R / 4), dim3(256), 0, stream, a); }
    hipLaunchKernelGGL(k_sgemm<2>, dim3(FFN / 64, R / 128), dim3(256), 0, stream, HB, D, ffn_in_w, 2 * FFN, (void*)ACT, FFN, R, FFN, D, (const int*)nullptr, 0, (size_t)0, 0, 0);
    hipLaunchKernelGGL(k_sgemm<1>, dim3(D / 64, R / 128), dim3(256), 0, stream, ACT, FFN, ffn_out_w, D, (void*)OX, D, R, D, FFN, (const int*)nullptr, 0, (size_t)0, 0, 0);
    { RowArgs a{}; a.xin_lat = out; a.xin_ctx = cx; a.xout_lat = out; a.xout_ctx = cx; a.Y = OX; a.gy = g0 + 3072; a.gate = mv0 + 5120; a.gh = g1n; a.scale = mv1 + 1024; a.shift = mv1; a.H = HB; a.nrows = R;
      hipLaunchKernelGGL(k_rows, dim3(R / 4), dim3(256), 0, stream, a); }
    hipLaunchKernelGGL(k_sgemm<1>, dim3(DOWNC / 64, R / 128), dim3(256), 0, stream, HB, D, down_w, DOWNC, (void*)DOWN, DOWNP, R, DOWNC, D, (const int*)nullptr, 0, (size_t)0, 0, 0);
    hipLaunchKernelGGL(k_mla_prep, dim3(R / 4), dim3(256), 0, stream, DOWN, gq, gkv, mc, ms, NQ, NKV, KR);
    for (int r0 = 0; r0 < RL; r0 += 8192) {
        hipLaunchKernelGGL(k_sgemm<0>, dim3(1536 / 64, 8192 / 128), dim3(256), 0, stream, NQ + (size_t)r0 * 384, 384, uq_w, 1536, (void*)tmp1, 1536, 8192, 1536, 384, (const int*)nullptr, 0, (size_t)0, 0, 0);
        hipLaunchKernelGGL(k_qsplit, g1((size_t)8192 * 1536, 256), dim3(256), 0, stream, tmp1, r0, 8192, mc, ms, QN, QR);
    }
    for (int r0 = 0; r0 < R; r0 += 8192) { const int nr = (R - r0) < 8192 ? (R - r0) : 8192;
        hipLaunchKernelGGL(k_sgemm<0>, dim3(2048 / 64, (nr + 127) / 128), dim3(256), 0, stream, NKV + (size_t)r0 * 256, 256, ukv_w, 2048, (void*)tmp1, 2048, nr, 2048, 256, (const int*)nullptr, 0, (size_t)0, 0, 0);
        hipLaunchKernelGGL(k_kvsplit, g1((size_t)nr * 2048, 256), dim3(256), 0, stream, tmp1, r0, nr, KN, Vv);
    }
    hipLaunchKernelGGL(k_attn_naive, dim3(NB * 8 * (T / 2)), dim3(256), 0, stream, QN, QR, KN, KR, Vv, AO);
    hipLaunchKernelGGL(k_sgemm<1>, dim3(D / 64, RL / 128), dim3(256), 0, stream, AO, D, mla_out_w, D, (void*)Ob, D, RL, D, D, (const int*)nullptr, 0, (size_t)0, 0, 0);
    { RowArgs a{}; a.xin_lat = out; a.xin_ctx = cx; a.xout_lat = out; a.xout_ctx = cx; a.Y = Ob; a.gy = g1n + 1024; a.gate = mv1 + 2048; a.gh = g1n + 2048; a.scale = mv1 + 4096; a.shift = mv1 + 3072; a.H = H4;
      a.router_w = router_w; a.top_e = top_e; a.top_g = top_g; a.nrows = RL;
      hipLaunchKernelGGL(k_rows, dim3(RL / 4), dim3(256), 0, stream, a); }
    hipLaunchKernelGGL(k_route_rank, dim3(8), dim3(1024), 0, stream, top_e, rank, meta);
    hipLaunchKernelGGL(k_route_base, dim3(1), dim3(64), 0, stream, meta);
    hipLaunchKernelGGL(k_gather, dim3(RL / 4), dim3(256), 0, stream, H4, top_e, rank, meta, HS, tslot);
    for (int e = 0; e < NEXP; ++e)
        hipLaunchKernelGGL(k_sgemm<2>, dim3(FFN / 64, RL / 128), dim3(256), 0, stream, HS, D, moe_in_w, 2 * FFN, (void*)ACT2, FFN, 0, FFN, D, (const int*)meta, e, (size_t)D * 2 * FFN, 0, RL);
    for (int e = 0; e < NEXP; ++e)
        hipLaunchKernelGGL(k_sgemm<1>, dim3(D / 64, RL / 128), dim3(256), 0, stream, ACT2, FFN, moe_out_w, D, (void*)YS, D, 0, D, FFN, (const int*)meta, e, (size_t)FFN * D, 0, RL);
    { RowArgs a{}; a.xin_lat = out; a.xin_ctx = cx; a.xout_lat = out; a.xout_ctx = cx; a.Y = YS; a.tok_slot = tslot; a.tok_g = top_g; a.gy = g1n + 3072; a.gate = mv1 + 5120; a.nrows = RL;
      hipLaunchKernelGGL(k_rows, dim3(RL / 4), dim3(256), 0, stream, a); }
}
```

```cpp
#include <hip/hip_runtime.h>
#include <cstdint>
#include <cstdio>

constexpr int NB = 8, T = 4096, CT = 256, D = 1024;
constexpr int RL = NB * T;
constexpr int RC = NB * CT;
constexpr int R = RL + RC;
constexpr int KEYS = CT + T;
constexpr int MIXC = 4608, FFN = 2816, NEXP = 8;
constexpr int DOWNC = 704, DOWNP = 768, QRANK = 384, KVRANK = 256;
constexpr float EPS = 1e-6f;
constexpr int SLOTS = 2 * RL;

typedef unsigned short bf16_t;
__host__ __device__ __forceinline__ float bf2f(bf16_t v) { unsigned u = ((unsigned)v) << 16; float f; __builtin_memcpy(&f, &u, 4); return f; }
__host__ __device__ __forceinline__ bf16_t f2bf(float f) { unsigned u; __builtin_memcpy(&u, &f, 4); return (bf16_t)((u + 0x7fffu + ((u >> 16) & 1u)) >> 16); }
__device__ __forceinline__ float siluf(float v) { return v / (1.f + expf(-v)); }
__device__ __forceinline__ float wave_sum(float v) {
#pragma unroll
    for (int o = 1; o < 64; o <<= 1) v += __shfl_xor(v, o);
    return v;
}

constexpr size_t MiB = 1u << 20;
constexpr size_t WS_CTL = 0;
constexpr size_t WS_MODV = 512 * 1024;
constexpr size_t WS_LB = 1 * MiB + 512 * 1024;
constexpr size_t WS_LG = WS_LB + 4096;
constexpr size_t WS_META = WS_LB + 8192;
constexpr size_t WS_ROPE_RC = 2 * MiB;
constexpr size_t WS_ROPE_RS = 3 * MiB;
constexpr size_t WS_ROPE_MC = 4 * MiB;
constexpr size_t WS_ROPE_MS = 4 * MiB + 512 * 1024;
constexpr size_t WS_CX = 5 * MiB;
constexpr size_t WS_TOPE = 5 * MiB;
constexpr size_t WS_TOPG = 5 * MiB + 256 * 1024;
constexpr size_t WS_RANK = 5 * MiB + 512 * 1024;
constexpr size_t WS_TSLOT = 5 * MiB + 768 * 1024;
constexpr size_t WS_WSMALL = 13 * MiB;
constexpr size_t WS_HB = 48 * MiB;
constexpr size_t WS_G0 = 116 * MiB;
constexpr size_t GSZ = 34 * MiB;
constexpr size_t WS_ST = 422 * MiB;
constexpr size_t WS_OX = 116 * MiB;
constexpr size_t WS_ACT = 184 * MiB;
constexpr size_t WS_DOWN = 116 * MiB;
constexpr size_t WS_QN = 404 * MiB;
constexpr size_t WS_QR = 231 * MiB;
constexpr size_t WS_KN = 263 * MiB;
constexpr size_t WS_KR = 331 * MiB;
constexpr size_t WS_V = 336 * MiB;
constexpr size_t WS_AO = 468 * MiB;
constexpr size_t WS_O = 167 * MiB;
constexpr size_t WS_NQ = 167 * MiB;
constexpr size_t WS_NKV = 193 * MiB;
constexpr size_t WS_TMP1 = 575 * MiB;
constexpr size_t WS_H4 = 508 * MiB;
constexpr size_t WS_HS = 13 * MiB;
constexpr size_t WS_ACT2 = 145 * MiB;
constexpr size_t WS_YS = 13 * MiB;
constexpr size_t WS_END = 704 * MiB;

__global__ __launch_bounds__(256) void k_mod(const float* __restrict__ c, const float* __restrict__ cctx, const float* __restrict__ mod_w,
                                             const float* __restrict__ mod_b, float* __restrict__ modv) {
    __shared__ float sc[9 * 1024];
    for (int i = threadIdx.x; i < 9 * 1024; i += 256) { int r = i >> 10, k = i & 1023; float v = r < 8 ? c[r * 1024 + k] : cctx[k]; sc[i] = siluf(v); }
    __syncthreads();
    int gid = blockIdx.x * 256 + threadIdx.x; int l = gid / 6144, n = gid % 6144;
    float acc[9];
#pragma unroll
    for (int r = 0; r < 9; ++r) acc[r] = 0.f;
    const float* w = mod_w + (size_t)l * 1024 * 6144 + n;
    for (int k = 0; k < 1024; ++k) { float wv = w[(size_t)k * 6144];
#pragma unroll
        for (int r = 0; r < 9; ++r) acc[r] += sc[r * 1024 + k] * wv; }
    float bb = mod_b[l * 6144 + n];
#pragma unroll
    for (int r = 0; r < 9; ++r) modv[((size_t)l * 9 + r) * 6144 + n] = acc[r] + bb;
}
__device__ __forceinline__ void tables_body(const int gid, const float* __restrict__ lb_logit, const float* __restrict__ decay_logit, float* rc, float* rs, float* mc, float* ms, float* lb, float* lg) {
    if (gid < 4096 * 64) { int t = gid >> 6, j = gid & 63, i = j & 31; float pos = (float)(j < 32 ? (t >> 6) : (t & 63));
        float inv = powf(10000.f, -(float)i / 32.f); float a = pos * inv; rc[gid] = cosf(a); rs[gid] = sinf(a); }
    if (gid < 4096 * 32) { int t = gid >> 5, j = gid & 31, i = j & 15; float pos = (float)(j < 16 ? (t >> 6) : (t & 63));
        float inv = powf(10000.f, -(float)i / 16.f); float a = pos * inv; mc[gid] = cosf(a); ms[gid] = sinf(a); }
    if (gid < 512) { float l0 = lb_logit[gid], l1 = lb_logit[512 + gid]; float m = fmaxf(l0, l1); float e0 = expf(l0 - m), e1 = expf(l1 - m); lb[gid] = e0 / (e0 + e1); }
    if (gid < 8) { float x = decay_logit[gid]; lg[gid] = fminf(x, 0.f) - log1pf(expf(-fabsf(x))); }
}

__global__ __launch_bounds__(256) void k_tables(const float* __restrict__ lb_logit, const float* __restrict__ decay_logit, float* rc, float* rs, float* mc, float* ms, float* lb, float* lg) {
    tables_body(blockIdx.x * 256 + threadIdx.x, lb_logit, decay_logit, rc, rs, mc, ms, lb, lg);
}

struct RowArgs {
    const float* xin_lat; const float* xin_ctx;
    float* xout_lat; float* xout_ctx;
    const bf16_t* Y;
    const int* tok_slot; const float* tok_g;
    const float* gy;
    const float* gate;
    const float* gh; const float* scale; const float* shift;
    bf16_t* H;
    const float* router_w; int* top_e; float* top_g;
    int nrows;
};
__device__ __forceinline__ void rows_body(const RowArgs& a, const int r, const int lane) {
    const bool lat = r < RL; const int mr = lat ? (r >> 12) : 8;
    const float* xi = lat ? a.xin_lat + (size_t)r * D : a.xin_ctx + (size_t)(r - RL) * D;
    float x[16];
#pragma unroll
    for (int j = 0; j < 4; ++j) { float4 v = *(const float4*)(xi + j * 256 + lane * 4); x[4 * j] = v.x; x[4 * j + 1] = v.y; x[4 * j + 2] = v.z; x[4 * j + 3] = v.w; }
    if (a.Y) {
        float y[16];
        if (a.tok_slot) {
            const int s0 = a.tok_slot[2 * r], s1 = a.tok_slot[2 * r + 1]; const float g0 = a.tok_g[2 * r], g1 = a.tok_g[2 * r + 1];
#pragma unroll
            for (int j = 0; j < 4; ++j) { const uint2 u0 = *(const uint2*)(a.Y + (size_t)s0 * D + j * 256 + lane * 4); const uint2 u1 = *(const uint2*)(a.Y + (size_t)s1 * D + j * 256 + lane * 4);
                y[4 * j] = g0 * bf2f(u0.x & 0xffff) + g1 * bf2f(u1.x & 0xffff); y[4 * j + 1] = g0 * bf2f(u0.x >> 16) + g1 * bf2f(u1.x >> 16);
                y[4 * j + 2] = g0 * bf2f(u0.y & 0xffff) + g1 * bf2f(u1.y & 0xffff); y[4 * j + 3] = g0 * bf2f(u0.y >> 16) + g1 * bf2f(u1.y >> 16); }
        } else {
#pragma unroll
            for (int j = 0; j < 4; ++j) { const uint2 u = *(const uint2*)(a.Y + (size_t)r * D + j * 256 + lane * 4);
                y[4 * j] = bf2f(u.x & 0xffff); y[4 * j + 1] = bf2f(u.x >> 16); y[4 * j + 2] = bf2f(u.y & 0xffff); y[4 * j + 3] = bf2f(u.y >> 16); }
        }
        float ss = 0.f;
#pragma unroll
        for (int i = 0; i < 16; ++i) ss += y[i] * y[i];
        ss = wave_sum(ss); const float ry = rsqrtf(ss * (1.f / D) + EPS);
        float* xo = lat ? a.xout_lat + (size_t)r * D : a.xout_ctx + (size_t)(r - RL) * D;
#pragma unroll
        for (int j = 0; j < 4; ++j) { const int c = j * 256 + lane * 4; const float4 g = *(const float4*)(a.gy + c); const float4 gt = *(const float4*)(a.gate + (size_t)mr * 6144 + c);
            x[4 * j] += gt.x * (y[4 * j] * ry * g.x); x[4 * j + 1] += gt.y * (y[4 * j + 1] * ry * g.y); x[4 * j + 2] += gt.z * (y[4 * j + 2] * ry * g.z); x[4 * j + 3] += gt.w * (y[4 * j + 3] * ry * g.w);
            *(float4*)(xo + c) = make_float4(x[4 * j], x[4 * j + 1], x[4 * j + 2], x[4 * j + 3]); }
    }
    if (a.gh) {
        float ss = 0.f;
#pragma unroll
        for (int i = 0; i < 16; ++i) ss += x[i] * x[i];
        ss = wave_sum(ss); const float rx = rsqrtf(ss * (1.f / D) + EPS);
        float h[16];
#pragma unroll
        for (int j = 0; j < 4; ++j) { const int c = j * 256 + lane * 4; const float4 g = *(const float4*)(a.gh + c); const float4 sc = *(const float4*)(a.scale + (size_t)mr * 6144 + c); const float4 sh = *(const float4*)(a.shift + (size_t)mr * 6144 + c);
            h[4 * j] = x[4 * j] * rx * g.x * (1.f + sc.x) + sh.x; h[4 * j + 1] = x[4 * j + 1] * rx * g.y * (1.f + sc.y) + sh.y;
            h[4 * j + 2] = x[4 * j + 2] * rx * g.z * (1.f + sc.z) + sh.z; h[4 * j + 3] = x[4 * j + 3] * rx * g.w * (1.f + sc.w) + sh.w;
            uint2 o; o.x = (unsigned)f2bf(h[4 * j]) | ((unsigned)f2bf(h[4 * j + 1]) << 16); o.y = (unsigned)f2bf(h[4 * j + 2]) | ((unsigned)f2bf(h[4 * j + 3]) << 16);
            *(uint2*)(a.H + (size_t)r * D + c) = o; }
        if (a.router_w) {
            float lg[8];
#pragma unroll
            for (int e = 0; e < 8; ++e) lg[e] = 0.f;
#pragma unroll
            for (int j = 0; j < 4; ++j)
#pragma unroll
                for (int i = 0; i < 4; ++i) { const int c = j * 256 + lane * 4 + i; const float4 w0 = *(const float4*)(a.router_w + (size_t)c * 8); const float4 w1 = *(const float4*)(a.router_w + (size_t)c * 8 + 4); const float hv = h[4 * j + i];
                    lg[0] += hv * w0.x; lg[1] += hv * w0.y; lg[2] += hv * w0.z; lg[3] += hv * w0.w; lg[4] += hv * w1.x; lg[5] += hv * w1.y; lg[6] += hv * w1.z; lg[7] += hv * w1.w; }
#pragma unroll
            for (int e = 0; e < 8; ++e) lg[e] = wave_sum(lg[e]);
            if (lane == 0) {
                int e0 = 0; float v0 = lg[0];
#pragma unroll
                for (int e = 1; e < 8; ++e) if (lg[e] > v0) { v0 = lg[e]; e0 = e; }
                int e1 = -1; float v1 = -3.0e38f;
#pragma unroll
                for (int e = 0; e < 8; ++e) if (e != e0 && lg[e] > v1) { v1 = lg[e]; e1 = e; }
                if (e1 < 0) { e1 = (e0 + 1) & 7; v1 = v0; }
                const float g0 = 1.f / (1.f + expf(v1 - v0));
                a.top_e[2 * r] = e0; a.top_e[2 * r + 1] = e1; a.top_g[2 * r] = g0; a.top_g[2 * r + 1] = 1.f - g0;
            }
        }
    }
}

__global__ __launch_bounds__(256) void k_rows(RowArgs a) {
    const int lane = threadIdx.x & 63; const int r = blockIdx.x * 4 + (threadIdx.x >> 6);
    if (r >= a.nrows) return;
    rows_body(a, r, lane);
}

template <int MODE>
__global__ __launch_bounds__(256) void k_sgemm(const bf16_t* __restrict__ A, int lda, const float* __restrict__ W, int ldw, void* __restrict__ Cv, int ldc,
                                               int M, int N, int K, const int* __restrict__ meta, int e, size_t wstride, int row_off, int row_cap) {
    constexpr int NBW = (MODE == 2) ? 2 : 1;
    int arow0 = 0;
    if (meta) { arow0 = meta[e] + row_off; int cnt = meta[8 + e] - row_off; M = cnt < row_cap ? cnt : row_cap; W += (size_t)e * wstride; }
    const int bm = blockIdx.y * 128, bn = blockIdx.x * 64;
    if (bm >= M) return;
    __shared__ float As[16][132]; __shared__ float Bs[NBW][16][68];
    const int tid = threadIdx.x, tx = tid & 15, ty = tid >> 4;
    float acc[NBW][8][4];
#pragma unroll
    for (int w = 0; w < NBW; ++w)
#pragma unroll
        for (int i = 0; i < 8; ++i)
#pragma unroll
            for (int j = 0; j < 4; ++j) acc[w][i][j] = 0.f;
    const int ar = tid >> 1, ak = (tid & 1) * 8; const bool aval = (bm + ar) < M;
    const bf16_t* ap = A + (size_t)(arow0 + bm + (aval ? ar : 0)) * lda + ak;
    const int bk = tid >> 4, bc = (tid & 15) * 4; const bool bval = (bn + bc) < N;
    for (int k0 = 0; k0 < K; k0 += 16) {
        uint4 av = aval ? *(const uint4*)(ap + k0) : make_uint4(0, 0, 0, 0);
        As[ak + 0][ar] = bf2f(av.x & 0xffff); As[ak + 1][ar] = bf2f(av.x >> 16); As[ak + 2][ar] = bf2f(av.y & 0xffff); As[ak + 3][ar] = bf2f(av.y >> 16);
        As[ak + 4][ar] = bf2f(av.z & 0xffff); As[ak + 5][ar] = bf2f(av.z >> 16); As[ak + 6][ar] = bf2f(av.w & 0xffff); As[ak + 7][ar] = bf2f(av.w >> 16);
#pragma unroll
        for (int w = 0; w < NBW; ++w) { float4 bv = bval ? *(const float4*)(W + (size_t)(k0 + bk) * ldw + bn + bc + w * N) : make_float4(0, 0, 0, 0); *(float4*)&Bs[w][bk][bc] = bv; }
        __syncthreads();
#pragma unroll
        for (int kk = 0; kk < 16; ++kk) {
            float a[8]; const float4 a0 = *(const float4*)&As[kk][ty * 8], a1 = *(const float4*)&As[kk][ty * 8 + 4];
            a[0] = a0.x; a[1] = a0.y; a[2] = a0.z; a[3] = a0.w; a[4] = a1.x; a[5] = a1.y; a[6] = a1.z; a[7] = a1.w;
#pragma unroll
            for (int w = 0; w < NBW; ++w) { const float4 b = *(const float4*)&Bs[w][kk][tx * 4];
#pragma unroll
                for (int i = 0; i < 8; ++i) { acc[w][i][0] += a[i] * b.x; acc[w][i][1] += a[i] * b.y; acc[w][i][2] += a[i] * b.z; acc[w][i][3] += a[i] * b.w; } }
        }
        __syncthreads();
    }
#pragma unroll
    for (int i = 0; i < 8; ++i) { const int rr = bm + ty * 8 + i; if (rr >= M) continue;
#pragma unroll
        for (int j = 0; j < 4; ++j) { const int cc = bn + tx * 4 + j; if (cc >= N) continue;
            const size_t o = (size_t)(arow0 + rr) * ldc + cc;
            if (MODE == 0) ((float*)Cv)[o] = acc[0][i][j];
            else if (MODE == 1) ((bf16_t*)Cv)[o] = f2bf(acc[0][i][j]);
            else ((bf16_t*)Cv)[o] = f2bf(siluf(acc[0][i][j]) * acc[NBW - 1][i][j]); } }
}

__global__ __launch_bounds__(256) void k_mixact(const float* __restrict__ tmp, bf16_t* __restrict__ G, int grp, const float* __restrict__ rc, const float* __restrict__ rs, const float* __restrict__ lb) {
    const size_t gid = (size_t)blockIdx.x * 256 + threadIdx.x; if (gid >= (size_t)R * 512) return;
    const int r = (int)(gid >> 9), c = (int)(gid & 511); float v = tmp[gid], o;
    if (grp <= 1) {
        const int j = c & 127, jj = j & 63; const float other = tmp[(size_t)r * 512 + (c ^ 64)];
        float x1 = j < 64 ? v : other, x2 = j < 64 ? other : v;
        if (grp == 1) { x1 *= 0.08838834764831845f; x2 *= 0.08838834764831845f; }
        if (r < RL) { const int t = r & 4095; const float cs = rc[t * 64 + jj], sn = rs[t * 64 + jj]; o = j < 64 ? x1 * cs - x2 * sn : x1 * sn + x2 * cs; }
        else o = j < 64 ? x1 : x2;
    } else if (grp == 2 || grp == 7) o = v;
    else if (grp == 3 || grp == 4 || grp == 8) o = siluf(v);
    else { const float l = lb[c]; o = (1.f - l) / (1.f + expf(v)); }
    G[gid] = f2bf(o);
}
template <int ALGO>
__global__ __launch_bounds__(128) void k_scan_naive(const bf16_t* __restrict__ Q, const bf16_t* __restrict__ Kf, const bf16_t* __restrict__ Kb, const bf16_t* __restrict__ V,
                                                    const float* __restrict__ lg, float* __restrict__ O) {
    const int b = blockIdx.x >> 2, h = blockIdx.x & 3, e = threadIdx.x;
    __shared__ float sq[32][128]; __shared__ float sk[32][128];
    for (int dir = 0; dir < 2; ++dir) {
        const bf16_t* Kp = dir ? Kb : Kf; const float gamma = (ALGO == 0) ? expf(lg[dir * 4 + h]) : 0.f;
        float S[128];
#pragma unroll
        for (int d = 0; d < 128; ++d) S[d] = 0.f;
        for (int p0 = 0; p0 < KEYS; p0 += 32) {
            __syncthreads();
            for (int i = threadIdx.x; i < 32 * 128; i += 128) { const int s = i >> 7, d = i & 127; const int p = p0 + s;
                const int row = p < CT ? (RL + b * CT + (dir ? CT - 1 - p : p)) : (b * T + (dir ? T - 1 - (p - CT) : (p - CT)));
                sq[s][d] = bf2f(Q[(size_t)row * 512 + h * 128 + d]); sk[s][d] = bf2f(Kp[(size_t)row * 512 + h * 128 + d]); }
            __syncthreads();
            for (int s = 0; s < 32; ++s) { const int p = p0 + s;
                const int row = p < CT ? (RL + b * CT + (dir ? CT - 1 - p : p)) : (b * T + (dir ? T - 1 - (p - CT) : (p - CT)));
                const float v = bf2f(V[(size_t)row * 512 + h * 128 + e]); float o = 0.f;
#pragma unroll
                for (int d = 0; d < 128; ++d) { const float kd = sk[s][d]; const float dec = (ALGO == 0) ? gamma : (1.f - kd); S[d] = dec * S[d] + kd * v; o += sq[s][d] * S[d]; }
                float* op = O + (size_t)row * 512 + h * 128 + e; if (dir == 0) *op = o; else *op += o; }
        }
    }
}
__global__ __launch_bounds__(256) void k_merge(const float* __restrict__ Oret, const float* __restrict__ Ohg, const bf16_t* __restrict__ AG, const bf16_t* __restrict__ BG, bf16_t* __restrict__ Y, int part_sel) {
    const int lane = threadIdx.x & 63; const size_t w = (size_t)blockIdx.x * 4 + (threadIdx.x >> 6); if (w >= (size_t)R * 8) return;
    const int r = (int)(w >> 3), part = (int)((w >> 2) & 1), h = (int)(w & 3);
    if (part_sel >= 0 && part != part_sel) return;
    const float* src = (part ? Ohg : Oret) + (size_t)r * 512 + h * 128; const bf16_t* g = (part ? BG : AG) + (size_t)r * 512 + h * 128;
    const float v0 = src[lane * 2], v1 = src[lane * 2 + 1]; const float ss = wave_sum(v0 * v0 + v1 * v1); const float rr = rsqrtf(ss * (1.f / 128.f) + EPS);
    bf16_t* y = Y + (size_t)r * 1024 + part * 512 + h * 128;
    y[lane * 2] = f2bf(v0 * rr * bf2f(g[lane * 2])); y[lane * 2 + 1] = f2bf(v1 * rr * bf2f(g[lane * 2 + 1]));
}

__device__ __forceinline__ void mla_prep_body(const int r, const int lane, const bf16_t* __restrict__ DOWN, const float* __restrict__ gq, const float* __restrict__ gkv, const float* __restrict__ mc, const float* __restrict__ ms,
                                                  bf16_t* __restrict__ NQ, bf16_t* __restrict__ NKV, bf16_t* __restrict__ KR) {
    const bf16_t* d = DOWN + (size_t)r * DOWNP;
    float q[6]; float ss = 0.f;
#pragma unroll
    for (int i = 0; i < 6; ++i) { q[i] = bf2f(d[lane + 64 * i]); ss += q[i] * q[i]; }
    ss = wave_sum(ss); const float rq = rsqrtf(ss * (1.f / 384.f) + EPS);
#pragma unroll
    for (int i = 0; i < 6; ++i) NQ[(size_t)r * 384 + lane + 64 * i] = f2bf(q[i] * rq * gq[lane + 64 * i]);
    float k[4]; ss = 0.f;
#pragma unroll
    for (int i = 0; i < 4; ++i) { k[i] = bf2f(d[384 + lane + 64 * i]); ss += k[i] * k[i]; }
    ss = wave_sum(ss); const float rk = rsqrtf(ss * (1.f / 256.f) + EPS);
#pragma unroll
    for (int i = 0; i < 4; ++i) NKV[(size_t)r * 256 + lane + 64 * i] = f2bf(k[i] * rk * gkv[lane + 64 * i]);
    const float x1 = bf2f(d[640 + (lane & 31)]), x2 = bf2f(d[672 + (lane & 31)]);
    const bool lat = r < RL; const int b = lat ? (r >> 12) : ((r - RL) >> 8); const int key = lat ? CT + (r & 4095) : ((r - RL) & 255);
    float o;
    if (lat) { const int t = r & 4095; const float cs = mc[t * 32 + (lane & 31)], sn = ms[t * 32 + (lane & 31)]; o = lane < 32 ? x1 * cs - x2 * sn : x1 * sn + x2 * cs; }
    else o = lane < 32 ? x1 : x2;
    KR[((size_t)b * KEYS + key) * 64 + lane] = f2bf(o);
}
__global__ __launch_bounds__(256) void k_mla_prep(const bf16_t* __restrict__ DOWN, const float* __restrict__ gq, const float* __restrict__ gkv, const float* __restrict__ mc, const float* __restrict__ ms,
                                                  bf16_t* __restrict__ NQ, bf16_t* __restrict__ NKV, bf16_t* __restrict__ KR) {
    const int lane = threadIdx.x & 63; const int r = blockIdx.x * 4 + (threadIdx.x >> 6); if (r >= R) return;
    mla_prep_body(r, lane, DOWN, gq, gkv, mc, ms, NQ, NKV, KR);
}
__global__ __launch_bounds__(256) void k_qsplit(const float* __restrict__ tmp, int r0, int nrows, const float* __restrict__ mc, const float* __restrict__ ms, bf16_t* __restrict__ QN, bf16_t* __restrict__ QR) {
    const size_t gid = (size_t)blockIdx.x * 256 + threadIdx.x; if (gid >= (size_t)nrows * 1536) return;
    const int rr = (int)(gid / 1536), c = (int)(gid % 1536), h = c / 192, j = c % 192; const int r = r0 + rr, b = r >> 12, t = r & 4095;
    const float v = tmp[gid];
    if (j < 128) QN[(((size_t)b * 8 + h) * T + t) * 128 + j] = f2bf(v);
    else { const int jr = j - 128, jj = jr & 31; const float other = tmp[(size_t)rr * 1536 + h * 192 + 128 + (jr ^ 32)];
        const float x1 = jr < 32 ? v : other, x2 = jr < 32 ? other : v; const float cs = mc[t * 32 + jj], sn = ms[t * 32 + jj];
        QR[(((size_t)b * 8 + h) * T + t) * 64 + jr] = f2bf(jr < 32 ? x1 * cs - x2 * sn : x1 * sn + x2 * cs); }
}
__global__ __launch_bounds__(256) void k_kvsplit(const float* __restrict__ tmp, int r0, int nrows, bf16_t* __restrict__ KN, bf16_t* __restrict__ Vv) {
    const size_t gid = (size_t)blockIdx.x * 256 + threadIdx.x; if (gid >= (size_t)nrows * 2048) return;
    const int rr = (int)(gid >> 11), c = (int)(gid & 2047), h = c >> 8, j = c & 255; const int r = r0 + rr;
    const bool lat = r < RL; const int b = lat ? (r >> 12) : ((r - RL) >> 8); const int key = lat ? CT + (r & 4095) : ((r - RL) & 255);
    bf16_t* dst = (j < 128 ? KN : Vv) + (((size_t)b * 8 + h) * KEYS + key) * 128 + (j & 127);
    *dst = f2bf(tmp[gid]);
}
__global__ __launch_bounds__(256) void k_attn_naive(const bf16_t* __restrict__ QN, const bf16_t* __restrict__ QR, const bf16_t* __restrict__ KN, const bf16_t* __restrict__ KR, const bf16_t* __restrict__ Vv, bf16_t* __restrict__ AO) {
    __shared__ float sq[2][192]; __shared__ float sc[2][KEYS]; __shared__ float red[2][4];
    const int tid = threadIdx.x; const int qb = blockIdx.x % (T / 2), h = (blockIdx.x / (T / 2)) & 7, b = blockIdx.x / (T / 2 * 8);
    const int t0 = qb * 2; const size_t bh = (size_t)b * 8 + h;
    for (int i = tid; i < 2 * 192; i += 256) { const int q = i / 192, j = i % 192; sq[q][j] = j < 128 ? bf2f(QN[(bh * T + t0 + q) * 128 + j]) : bf2f(QR[(bh * T + t0 + q) * 64 + j - 128]); }
    __syncthreads();
    const float scale = 0.07216878364870322f;
    float m0 = -3e38f, m1 = -3e38f;
    for (int key = tid; key < KEYS; key += 256) {
        const uint4* kn = (const uint4*)(KN + (bh * KEYS + key) * 128); const uint4* kr = (const uint4*)(KR + ((size_t)b * KEYS + key) * 64);
        float s0 = 0.f, s1 = 0.f;
        for (int c = 0; c < 24; ++c) { const uint4 u = c < 16 ? kn[c] : kr[c - 16]; const int j = c * 8;
            const float k0 = bf2f(u.x & 0xffff), k1 = bf2f(u.x >> 16), k2 = bf2f(u.y & 0xffff), k3 = bf2f(u.y >> 16), k4 = bf2f(u.z & 0xffff), k5 = bf2f(u.z >> 16), k6 = bf2f(u.w & 0xffff), k7 = bf2f(u.w >> 16);
            s0 += sq[0][j] * k0 + sq[0][j + 1] * k1 + sq[0][j + 2] * k2 + sq[0][j + 3] * k3 + sq[0][j + 4] * k4 + sq[0][j + 5] * k5 + sq[0][j + 6] * k6 + sq[0][j + 7] * k7;
            s1 += sq[1][j] * k0 + sq[1][j + 1] * k1 + sq[1][j + 2] * k2 + sq[1][j + 3] * k3 + sq[1][j + 4] * k4 + sq[1][j + 5] * k5 + sq[1][j + 6] * k6 + sq[1][j + 7] * k7; }
        s0 *= scale; s1 *= scale; sc[0][key] = s0; sc[1][key] = s1; m0 = fmaxf(m0, s0); m1 = fmaxf(m1, s1);
    }
#pragma unroll
    for (int o = 1; o < 64; o <<= 1) { m0 = fmaxf(m0, __shfl_xor(m0, o)); m1 = fmaxf(m1, __shfl_xor(m1, o)); }
    if ((tid & 63) == 0) { red[0][tid >> 6] = m0; red[1][tid >> 6] = m1; }
    __syncthreads();
    m0 = fmaxf(fmaxf(red[0][0], red[0][1]), fmaxf(red[0][2], red[0][3])); m1 = fmaxf(fmaxf(red[1][0], red[1][1]), fmaxf(red[1][2], red[1][3]));
    __syncthreads();
    float l0 = 0.f, l1 = 0.f;
    for (int key = tid; key < KEYS; key += 256) { const float p0 = expf(sc[0][key] - m0), p1 = expf(sc[1][key] - m1); sc[0][key] = p0; sc[1][key] = p1; l0 += p0; l1 += p1; }
    l0 = wave_sum(l0); l1 = wave_sum(l1);
    if ((tid & 63) == 0) { red[0][tid >> 6] = l0; red[1][tid >> 6] = l1; }
    __syncthreads();
    l0 = red[0][0] + red[0][1] + red[0][2] + red[0][3]; l1 = red[1][0] + red[1][1] + red[1][2] + red[1][3];
    const int q = tid >> 7, d = tid & 127; const float* p = sc[q]; float o = 0.f;
    const bf16_t* vp = Vv + bh * KEYS * 128 + d;
    for (int key = 0; key < KEYS; ++key) o += p[key] * bf2f(vp[(size_t)key * 128]);
    AO[((size_t)b * T + t0 + q) * 1024 + h * 128 + d] = f2bf(o / (q ? l1 : l0));
}

__global__ __launch_bounds__(1024) void k_route_rank(const int* __restrict__ top_e, int* __restrict__ rank, int* __restrict__ meta) {
    __shared__ int ws[16]; __shared__ int running;
    const int e = blockIdx.x, tid = threadIdx.x, lane = tid & 63, wid = tid >> 6;
    if (tid == 0) running = 0;
    __syncthreads();
    for (int t0 = 0; t0 < RL; t0 += 1024) { const int t = t0 + tid; const int e0 = top_e[2 * t], e1 = top_e[2 * t + 1]; const int f = (e0 == e || e1 == e) ? 1 : 0;
        const unsigned long long bal = __ballot(f); const int pre = __popcll(bal & ((1ull << lane) - 1ull));
        if (lane == 0) ws[wid] = __popcll(bal);
        __syncthreads();
        int off = 0; for (int w = 0; w < wid; ++w) off += ws[w];
        int tot = 0; for (int w = 0; w < 16; ++w) tot += ws[w];
        const int base = running;
        if (f) rank[2 * t + (e0 == e ? 0 : 1)] = base + off + pre;
        __syncthreads();
        if (tid == 0) running = base + tot;
        __syncthreads();
    }
    if (tid == 0) meta[8 + e] = running;
}
__global__ void k_route_base(int* meta) { if (threadIdx.x == 0) { int s = 0; for (int e = 0; e < 8; ++e) { meta[e] = s; s += meta[8 + e]; } } }
__global__ __launch_bounds__(256) void k_gather(const bf16_t* __restrict__ H4, const int* __restrict__ top_e, const int* __restrict__ rank, const int* __restrict__ meta, bf16_t* __restrict__ HS, int* __restrict__ tok_slot) {
    const int lane = threadIdx.x & 63; const int t = blockIdx.x * 4 + (threadIdx.x >> 6); if (t >= RL) return;
    const uint4 v0 = *(const uint4*)(H4 + (size_t)t * D + lane * 8), v1 = *(const uint4*)(H4 + (size_t)t * D + 512 + lane * 8);
#pragma unroll
    for (int k = 0; k < 2; ++k) { const int e = top_e[2 * t + k]; const int slot = meta[e] + rank[2 * t + k];
        *(uint4*)(HS + (size_t)slot * D + lane * 8) = v0; *(uint4*)(HS + (size_t)slot * D + 512 + lane * 8) = v1;
        if (lane == 0) tok_slot[2 * t + k] = slot; }
}


#define LAS __attribute__((address_space(3)))
#define GAS __attribute__((address_space(1)))
typedef short bf16x8 __attribute__((ext_vector_type(8)));
typedef float f32x4 __attribute__((ext_vector_type(4)));
typedef float f32x2 __attribute__((ext_vector_type(2)));
typedef unsigned u32x4 __attribute__((ext_vector_type(4)));
typedef unsigned u32x2 __attribute__((ext_vector_type(2)));
constexpr size_t WS_WMI = 572 * MiB;
constexpr size_t WS_WMO = 660 * MiB;
constexpr size_t WS_W_MIXIN = WS_WSMALL;
constexpr size_t WS_W_MIXOUT = WS_W_MIXIN + 9 * MiB;
constexpr size_t WS_W_FFNIN = WS_W_MIXOUT + 2 * MiB;
constexpr size_t WS_W_FFNOUT = WS_W_FFNIN + 11 * MiB;
constexpr size_t WS_W_DOWN = WS_W_FFNOUT + 5632 * 1024;
constexpr size_t WS_W_UQ = WS_W_DOWN + 1536 * 1024;
constexpr size_t WS_W_UKV = WS_W_UQ + 1152 * 1024;
constexpr size_t WS_W_MLAOUT = WS_W_UKV + 1 * MiB;
static_assert(WS_W_MLAOUT + 2 * MiB <= WS_HB, "small weights fit");

typedef float f32x2_cv __attribute__((ext_vector_type(2))); typedef __bf16 bf16x2_cv __attribute__((ext_vector_type(2)));
__device__ __forceinline__ unsigned cvt_pk_bf16(float lo, float hi) { const f32x2_cv v = {lo, hi}; const bf16x2_cv b = __builtin_convertvector(v, bf16x2_cv); return __builtin_bit_cast(unsigned, b); }
__device__ __forceinline__ float fast_silu(float v) { return v * __builtin_amdgcn_rcpf(1.f + __expf(-v)); }

namespace pg8 {
constexpr int BM = 256, BK = 64, HALF = 128, HTB = HALF * BK * 2  , STAGE_BYTES = 8 * HTB, NXCD = 8, WGM = 8;
__host__ __device__ __forceinline__ int lds_byte(int r, int c) { const int st = (r >> 4) * 2 + (c >> 5), rr = r & 15, cc = c & 31, ob = rr * 64 + cc * 2; return st * 1024 + (ob ^ (((ob >> 9) & 1) << 5)); }
__host__ __device__ __forceinline__ void stage_rc(int b, int& R_, int& C_) { const int st = b / 1024, sb = b % 1024, swz = sb ^ (((sb >> 9) & 1) << 5); R_ = (st >> 1) * 16 + swz / 64; C_ = (st & 1) * 32 + (swz % 64) / 2; }
__host__ __device__ __forceinline__ int perm32(int rho) { const int n = rho >> 4, i = rho & 15; return 8 * (i >> 2) + 4 * n + (i & 3); }

struct Unit { int arow, brow, pm, pn, rend; };
struct Gemm { const bf16_t* A; const bf16_t* Bt; int lda, ldb, K; };

struct DenseOrder {
    int nM, nN, nwg, G, c;
    __device__ void init(int nM_, int nN_, int G_, int c_) { nM = nM_; nN = nN_; nwg = nM * nN; G = G_; c = c_; }
    __device__ bool next(int i, Unit& u) const {
        const long L = (long)i * G + c; if (L >= nwg) return false;
        int wgid = (int)L; { const int q = nwg / NXCD, r = nwg % NXCD, xcd = wgid % NXCD, off = wgid / NXCD; wgid = (xcd < r ? xcd * (q + 1) : r * (q + 1) + (xcd - r) * q) + off; }
        const int nig = WGM * nN, gid = wgid / nig, fm = gid * WGM, gsz = (nM - fm) < WGM ? (nM - fm) : WGM;
        u.pm = fm + ((wgid % nig) % gsz); u.pn = (wgid % nig) / gsz; u.arow = u.pm * BM; u.brow = u.pn * BM; u.rend = 0x7fffffff; return true;
    }
    __device__ __forceinline__ void a_ready(const Unit&) const {}
    __device__ __forceinline__ void done(const Unit&) const {}
};
struct MoeOrder {
    const LAS int* meta; int nN, G, c, nwg;
    __device__ void init(const LAS int* meta_, int nN_, int G_, int c_) { meta = meta_; nN = nN_; G = G_; c = c_; int s = 0;
#pragma unroll
        for (int e = 0; e < 8; ++e) s += ((meta[8 + e] + 255) >> 8) * nN; nwg = s; }
    __device__ bool next(int i, Unit& u) const {
        const long L = (long)i * G + c; if (L >= nwg) return false;
        int wgid = (int)L; { const int q = nwg / NXCD, r = nwg % NXCD, xcd = wgid % NXCD, off = wgid / NXCD; wgid = (xcd < r ? xcd * (q + 1) : r * (q + 1) + (xcd - r) * q) + off; }
        int e = -1, nM = 1, base = 0, cnt = 0;
#pragma unroll
        for (int k = 0; k < 8; ++k) { const int ck = meta[8 + k], tk = (ck + 255) >> 8, uk = tk * nN; if (e < 0) { if (wgid < uk) { e = k; nM = tk; base = meta[k]; cnt = ck; } else wgid -= uk; } }
        if (e < 0) return false;
        const int nig = WGM * nN, gid = wgid / nig, fm = gid * WGM, gsz = (nM - fm) < WGM ? (nM - fm) : WGM;
        u.pm = fm + ((wgid % nig) % gsz); u.pn = (wgid % nig) / gsz; u.arow = base + u.pm * BM; u.brow = (e * nN + u.pn) * BM; u.rend = base + cnt; return true;
    }
    __device__ __forceinline__ void a_ready(const Unit&) const {}
    __device__ __forceinline__ void done(const Unit&) const {}
};

#define EPI_ROWS(...) _Pragma("unroll") for (int ai = 0; ai < 2; ++ai) _Pragma("unroll") for (int m = 0; m < 4; ++m) { const int row = u.arow + ai * HALF + wr * 64 + m * 16 + fr; __VA_ARGS__ }
__device__ __forceinline__ u32x4 pack8(const f32x4 a, const f32x4 b) { u32x4 w; w.x = cvt_pk_bf16(a[0], a[1]); w.y = cvt_pk_bf16(a[2], a[3]); w.z = cvt_pk_bf16(b[0], b[1]); w.w = cvt_pk_bf16(b[2], b[3]); return w; }

struct EpiPlain {
    static constexpr bool PERM = true, AFTER_DRAIN = false;
    bf16_t* O; int ldc;
    __device__ __forceinline__ void operator()(const f32x4 (&acc)[2][2][4][2], const Unit& u, int wr, int wc, int fr, int fq) const {
        const int col0 = u.pn * BM + wc * 32 + fq * 8;
        EPI_ROWS( if (row < u.rend) { bf16_t* rowp = O + (size_t)row * ldc + col0;
            _Pragma("unroll") for (int bj = 0; bj < 2; ++bj) *(u32x4*)(rowp + bj * HALF) = pack8(acc[ai][bj][m][0], acc[ai][bj][m][1]); } )
    }
};
struct EpiSwiglu {
    static constexpr bool PERM = true, AFTER_DRAIN = false;
    bf16_t* O;
    __device__ __forceinline__ void operator()(const f32x4 (&acc)[2][2][4][2], const Unit& u, int wr, int wc, int fr, int fq) const {
        const int col0 = u.pn * HALF + wc * 32 + fq * 8;
        EPI_ROWS( if (row < u.rend) { f32x4 o0, o1;
            _Pragma("unroll") for (int i = 0; i < 4; ++i) { o0[i] = fast_silu(acc[ai][0][m][0][i]) * acc[ai][1][m][0][i]; o1[i] = fast_silu(acc[ai][0][m][1][i]) * acc[ai][1][m][1][i]; }
            *(u32x4*)(O + (size_t)row * FFN + col0) = pack8(o0, o1); } )
    }
};
struct EpiMix {
    static constexpr bool PERM = true, AFTER_DRAIN = false;
    bf16_t* G0; const float* rc; const float* rs; const float* lb;
    __device__ __forceinline__ void operator()(const f32x4 (&acc)[2][2][4][2], const Unit& u, int wr, int wc, int fr, int fq) const {
        const int grp = u.pn >> 1, half = u.pn & 1; bf16_t* Gp = G0 + (size_t)grp * (GSZ / 2);
        if (grp <= 1) {
            const int head = half * 2 + (wc >> 1), jb = (wc & 1) * 32 + fq * 8; const float sc = grp == 1 ? 0.08838834764831845f : 1.f;
            EPI_ROWS( f32x4 a0 = acc[ai][0][m][0] * sc, a1 = acc[ai][0][m][1] * sc, b0 = acc[ai][1][m][0] * sc, b1 = acc[ai][1][m][1] * sc; f32x4 o0, o1, p0, p1;
                if (row < RL) { const int t = row & 4095; const f32x4 c0 = *(const f32x4*)(rc + t * 64 + jb), c1 = *(const f32x4*)(rc + t * 64 + jb + 4), s0 = *(const f32x4*)(rs + t * 64 + jb), s1 = *(const f32x4*)(rs + t * 64 + jb + 4);
                    o0 = a0 * c0 - b0 * s0; o1 = a1 * c1 - b1 * s1; p0 = a0 * s0 + b0 * c0; p1 = a1 * s1 + b1 * c1; }
                else { o0 = a0; o1 = a1; p0 = b0; p1 = b1; }
                bf16_t* dst = Gp + (size_t)row * 512 + head * 128 + jb; *(u32x4*)dst = pack8(o0, o1); *(u32x4*)(dst + 64) = pack8(p0, p1); )
        } else {
            const int cb = half * 256 + wc * 32 + fq * 8;
            EPI_ROWS( _Pragma("unroll") for (int bj = 0; bj < 2; ++bj) { f32x4 v0 = acc[ai][bj][m][0], v1 = acc[ai][bj][m][1]; const int c = cb + bj * HALF;
                if (grp == 3 || grp == 4 || grp == 8) { _Pragma("unroll") for (int i = 0; i < 4; ++i) { v0[i] = fast_silu(v0[i]); v1[i] = fast_silu(v1[i]); } }
                else if (grp == 5 || grp == 6) { const f32x4 l0 = *(const f32x4*)(lb + c), l1 = *(const f32x4*)(lb + c + 4);
                    _Pragma("unroll") for (int i = 0; i < 4; ++i) { v0[i] = (1.f - l0[i]) * __builtin_amdgcn_rcpf(1.f + __expf(v0[i])); v1[i] = (1.f - l1[i]) * __builtin_amdgcn_rcpf(1.f + __expf(v1[i])); } }
                *(u32x4*)(Gp + (size_t)row * 512 + c) = pack8(v0, v1); } )
        }
    }
};
struct EpiUQ {
    static constexpr bool PERM = true, AFTER_DRAIN = false;
    bf16_t* QN; bf16_t* QR; const float* mc; const float* ms;
    __device__ __forceinline__ void operator()(const f32x4 (&acc)[2][2][4][2], const Unit& u, int wr, int wc, int fr, int fq) const {
        if (u.pn < 4) {
            EPI_ROWS( const int b = row >> 12, t = row & 4095;
                _Pragma("unroll") for (int bj = 0; bj < 2; ++bj) { const int h = 2 * u.pn + bj; *(u32x4*)(QN + (((size_t)b * 8 + h) * T + t) * 128 + wc * 32 + fq * 8) = pack8(acc[ai][bj][m][0], acc[ai][bj][m][1]); } )
        } else {
            const int h = 4 * (u.pn - 4) + wc, jb = fq * 8;
            EPI_ROWS( const int b = row >> 12, t = row & 4095; const f32x4 a0 = acc[ai][0][m][0], a1 = acc[ai][0][m][1], b0 = acc[ai][1][m][0], b1 = acc[ai][1][m][1];
                const f32x4 c0 = *(const f32x4*)(mc + t * 32 + jb), c1 = *(const f32x4*)(mc + t * 32 + jb + 4), s0 = *(const f32x4*)(ms + t * 32 + jb), s1 = *(const f32x4*)(ms + t * 32 + jb + 4);
                bf16_t* dst = QR + (((size_t)b * 8 + h) * T + t) * 64 + jb; *(u32x4*)dst = pack8(a0 * c0 - b0 * s0, a1 * c1 - b1 * s1); *(u32x4*)(dst + 32) = pack8(a0 * s0 + b0 * c0, a1 * s1 + b1 * c1); )
        }
    }
};
struct EpiUKV {
    static constexpr bool PERM = true, AFTER_DRAIN = false;
    bf16_t* KN; bf16_t* V;
    __device__ __forceinline__ void operator()(const f32x4 (&acc)[2][2][4][2], const Unit& u, int wr, int wc, int fr, int fq) const {
        EPI_ROWS( const bool lat = row < RL; const int b = lat ? (row >> 12) : ((row - RL) >> 8); const int key = lat ? CT + (row & 4095) : ((row - RL) & 255);
            const size_t off = (((size_t)b * 8 + u.pn) * KEYS + key) * 128 + wc * 32 + fq * 8;
            *(u32x4*)(KN + off) = pack8(acc[ai][0][m][0], acc[ai][0][m][1]); *(u32x4*)(V + off) = pack8(acc[ai][1][m][0], acc[ai][1][m][1]); )
    }
};

template <class Epi, class Sched, bool ALIGN_EPI>
__device__ __forceinline__ void gemm_phase(LAS unsigned char* lds, const Gemm g, const Sched& S, const Epi& E) {
    const int tid = threadIdx.x, wid = __builtin_amdgcn_readfirstlane(tid >> 6), lane = tid & 63, wr = wid >> 2, wc = wid & 3, fr = lane & 15, fq = lane >> 4;
    const int K = g.K, nt = K / BK;
    unsigned voffA[2], voffB[2];
#pragma unroll
    for (int i = 0; i < 2; ++i) { int R_, C_; stage_rc(tid * 16 + i * 8192, R_, C_); const int Rb = Epi::PERM ? ((R_ & ~31) + perm32(R_ & 31)) : R_;
        voffA[i] = (unsigned)(R_ * g.lda + C_) * 2u; voffB[i] = (unsigned)(Rb * g.ldb + C_) * 2u; }
    const size_t kstep = (size_t)(BK * 2);
    const size_t hstepA = (size_t)HALF * g.lda * 2, hstepB = (size_t)HALF * g.ldb * 2;
    const unsigned ldsw = (unsigned)wid * 1024u;
    const int aoff = lds_byte(wr * 64 + fr, fq * 8), boff = lds_byte(wc * 32 + fr, fq * 8);
#define PG8_SA(b, h) (((b) * 2 + (h)) * HTB)
#define PG8_SB(b, h) ((4 + (b) * 2 + (h)) * HTB)
#define PG8_STAGE(bufoff, gbase, voff) do { _Pragma("unroll") for (int _i = 0; _i < 2; ++_i) \
        __builtin_amdgcn_global_load_lds((const unsigned*)((const char*)(gbase) + (voff)[_i]), (LAS unsigned*)(lds + (bufoff) + ldsw + _i * 8192), 16, 0, 0); } while (0)
#define PG8_LDA(dst, b, h) do { _Pragma("unroll") for (int m = 0; m < 4; ++m) _Pragma("unroll") for (int k = 0; k < 2; ++k) dst[m][k] = *(const LAS bf16x8*)(lds + PG8_SA(b, h) + aoff + m * 2048 + k * 1024); } while (0)
#define PG8_LDB(dst, b, h) do { _Pragma("unroll") for (int n = 0; n < 2; ++n) _Pragma("unroll") for (int k = 0; k < 2; ++k) dst[n][k] = *(const LAS bf16x8*)(lds + PG8_SB(b, h) + boff + n * 2048 + k * 1024); } while (0)
#define PG8_MMA(ai, bj, At, Bt) do { __builtin_amdgcn_s_setprio(1); _Pragma("unroll") for (int m = 0; m < 4; ++m) _Pragma("unroll") for (int n = 0; n < 2; ++n) _Pragma("unroll") for (int k = 0; k < 2; ++k) \
        acc[ai][bj][m][n] = __builtin_amdgcn_mfma_f32_16x16x32_bf16(Bt[n][k], At[m][k], acc[ai][bj][m][n], 0, 0, 0); __builtin_amdgcn_s_setprio(0); } while (0)
#define PG8_WAIT_V(n) asm volatile("s_waitcnt vmcnt(" #n ")" ::: "memory")
#define PG8_WAIT_L(n) asm volatile("s_waitcnt lgkmcnt(" #n ")" ::: "memory")
#define PG8_BAR __builtin_amdgcn_s_barrier()
#define PG8_SCHED __builtin_amdgcn_sched_barrier(0)
    Unit cur, nxt; int ui = 0;
    if (!S.next(0, cur)) return;
    f32x4 acc[2][2][4][2];
#pragma unroll
    for (int a = 0; a < 2; ++a)
#pragma unroll
        for (int b = 0; b < 2; ++b)
#pragma unroll
            for (int m = 0; m < 4; ++m)
#pragma unroll
                for (int n = 0; n < 2; ++n) acc[a][b][m][n] = (f32x4){0.f, 0.f, 0.f, 0.f};
    bf16x8 At[4][2], B0[2][2], B1[2][2];
    const char* cA = (const char*)g.A + (size_t)cur.arow * g.lda * 2; const char* cB = (const char*)g.Bt + (size_t)cur.brow * g.ldb * 2;
    S.a_ready(cur);
    PG8_STAGE(PG8_SB(0, 0), cB, voffB); PG8_STAGE(PG8_SB(0, 1), cB + hstepB, voffB); PG8_STAGE(PG8_SA(0, 0), cA, voffA); PG8_STAGE(PG8_SA(0, 1), cA + hstepA, voffA);
    if (wr == 1) PG8_BAR;
    PG8_WAIT_V(2); PG8_BAR;
    PG8_STAGE(PG8_SB(1, 0), cB + kstep, voffB); PG8_STAGE(PG8_SA(1, 0), cA + kstep, voffA); PG8_STAGE(PG8_SB(1, 1), cB + hstepB + kstep, voffB);
    PG8_WAIT_V(6); PG8_BAR;
    for (;;) {
        const bool has_next = S.next(ui + 1, nxt);
        const char* nA = has_next ? (const char*)g.A + (size_t)nxt.arow * g.lda * 2 : cA; const char* nB = has_next ? (const char*)g.Bt + (size_t)nxt.brow * g.ldb * 2 : cB;
#pragma unroll 1
        for (int t = 0; t < nt; t += 2) {
            const bool last = (t == nt - 2);
            const char* a1 = cA + (size_t)(t + 1) * kstep;
            const char* a2 = last ? nA : cA + (size_t)(t + 2) * kstep; const char* b2 = last ? nB : cB + (size_t)(t + 2) * kstep;
            const char* a3 = a2 + kstep; const char* b3 = b2 + kstep;
            if (last && has_next) S.a_ready(nxt);
            PG8_LDB(B0, 0, 0); PG8_LDB(B1, 0, 1); PG8_SCHED; PG8_LDA(At, 0, 0); PG8_STAGE(PG8_SA(1, 1), a1 + hstepA, voffA);
            PG8_WAIT_V(8); PG8_WAIT_L(0); PG8_BAR; PG8_MMA(0, 0, At, B0); PG8_MMA(0, 1, At, B1); PG8_BAR; PG8_SCHED;
            PG8_LDA(At, 0, 1); PG8_STAGE(PG8_SB(0, 0), b2, voffB); PG8_STAGE(PG8_SB(0, 1), b2 + hstepB, voffB); PG8_STAGE(PG8_SA(0, 0), a2, voffA);
            PG8_WAIT_V(8); PG8_WAIT_L(0); PG8_BAR; PG8_MMA(1, 0, At, B0); PG8_MMA(1, 1, At, B1); PG8_BAR; PG8_SCHED;
            PG8_LDB(B0, 1, 0); PG8_LDB(B1, 1, 1); PG8_SCHED; PG8_LDA(At, 1, 0); PG8_STAGE(PG8_SA(0, 1), a2 + hstepA, voffA);
            PG8_WAIT_V(8); PG8_WAIT_L(0); PG8_BAR; PG8_MMA(0, 0, At, B0); PG8_MMA(0, 1, At, B1); PG8_BAR; PG8_SCHED;
            PG8_LDA(At, 1, 1); PG8_STAGE(PG8_SB(1, 0), b3, voffB); PG8_STAGE(PG8_SB(1, 1), b3 + hstepB, voffB); PG8_STAGE(PG8_SA(1, 0), a3, voffA);
            PG8_WAIT_V(8); PG8_WAIT_L(0); PG8_BAR; PG8_MMA(1, 0, At, B0); PG8_MMA(1, 1, At, B1); PG8_BAR; PG8_SCHED;
        }
        if constexpr (ALIGN_EPI) { if (wr == 0) PG8_BAR; }
        E(acc, cur, wr, wc, fr, fq); S.done(cur);
        if (!has_next) break;
#pragma unroll
        for (int a = 0; a < 2; ++a)
#pragma unroll
            for (int b = 0; b < 2; ++b)
#pragma unroll
                for (int m = 0; m < 4; ++m)
#pragma unroll
                    for (int n = 0; n < 2; ++n) acc[a][b][m][n] = (f32x4){0.f, 0.f, 0.f, 0.f};
        cur = nxt; cA = nA; cB = nB; ++ui;
        if constexpr (ALIGN_EPI) { if (wr == 1) PG8_BAR; }
    }
    PG8_WAIT_V(0);
    if constexpr (!ALIGN_EPI) { if (wr == 0) PG8_BAR; }
    PG8_BAR;
#undef PG8_SA
#undef PG8_SB
#undef PG8_STAGE
#undef PG8_LDA
#undef PG8_LDB
#undef PG8_MMA
#undef PG8_WAIT_V
#undef PG8_WAIT_L
#undef PG8_BAR
#undef PG8_SCHED
}
}


namespace attn {
using s16x4 = __attribute__((ext_vector_type(4))) short;
using f32x16 = __attribute__((ext_vector_type(16))) float;
constexpr int NW = 8, QBLK = 32, KVBLK = 64;
constexpr float SCALE = 0.07216878364870322f;
constexpr float THR = 8.f;
constexpr int SHM_V = KVBLK * 128 * 2, SHM_K = KVBLK * 128 * 2, SHM_R = KVBLK * 128 * 2;
constexpr int OFF_V = 0, OFF_K = 2 * SHM_V, OFF_R = OFF_K + 2 * SHM_K, OFF_W = OFF_R + 2 * SHM_R, OFF_Q = OFF_W + NW * 64 * 4, LDS_NEED = OFF_Q + 256 * 64 * 2;
#define KSWZ(row, colB) ((row) * 256 + ((colB) ^ (((row) & 7) << 4)))
#define RSWZ(row, colB) KSWZ(row, colB)
#define SBAR() __builtin_amdgcn_sched_barrier(0)
__device__ __forceinline__ int crow(int r, int hi) { return (r & 3) + 8 * (r >> 2) + 4 * hi; }
__device__ __forceinline__ unsigned cvtpk(float lo, float hi) { return cvt_pk_bf16(lo, hi); }

__device__ __forceinline__ void partialSM(f32x16& p0, f32x16& p1, float& m_reg, float& mn, float& alpha) {
    constexpr float C = SCALE * 1.4426950408889634f;
    float pmax = p0[0];
#pragma unroll
    for (int r = 1; r < 16; ++r) pmax = fmaxf(pmax, p0[r]);
#pragma unroll
    for (int r = 0; r < 16; ++r) pmax = fmaxf(pmax, p1[r]);
    { auto rr = __builtin_amdgcn_permlane32_swap(__float_as_uint(pmax), __float_as_uint(pmax), false, false);
      pmax = fmaxf(__uint_as_float(rr[0]), __uint_as_float(rr[1])); }
    if (__builtin_expect(__all(pmax - m_reg <= THR / SCALE), 1)) { mn = m_reg; alpha = 1.f; }
    else { mn = fmaxf(m_reg, pmax); alpha = __builtin_amdgcn_exp2f((m_reg - mn) * C); m_reg = mn; }
    const float mnC = -mn * C;
#pragma unroll
    for (int r = 0; r < 16; ++r) p0[r] = fmaf(p0[r], C, mnC);
#pragma unroll
    for (int r = 0; r < 16; ++r) p1[r] = fmaf(p1[r], C, mnC);
#pragma unroll
    for (int r = 0; r < 16; ++r) p0[r] = __builtin_amdgcn_exp2f(p0[r]);
}
__device__ __forceinline__ void finishSM(f32x16& p0, f32x16& p1, float alpha, float& l_reg, bf16x8& pa0, bf16x8& pa1, bf16x8& pa2, bf16x8& pa3) {
#pragma unroll
    for (int r = 0; r < 16; ++r) p1[r] = __builtin_amdgcn_exp2f(p1[r]);
    float ps = 0;
#pragma unroll
    for (int r = 0; r < 16; ++r) ps += p0[r];
#pragma unroll
    for (int r = 0; r < 16; ++r) ps += p1[r];
    { auto rr = __builtin_amdgcn_permlane32_swap(__float_as_uint(ps), __float_as_uint(ps), false, false);
      ps = __uint_as_float(rr[0]) + __uint_as_float(rr[1]); }
    l_reg = l_reg * alpha + ps;
#define PK4(P, BASE, OUT) do { unsigned a0 = cvtpk(P[BASE + 0], P[BASE + 1]), a1 = cvtpk(P[BASE + 2], P[BASE + 3]);   \
    unsigned b0 = cvtpk(P[BASE + 4], P[BASE + 5]), b1 = cvtpk(P[BASE + 6], P[BASE + 7]);                              \
    auto r0 = __builtin_amdgcn_permlane32_swap(a0, b0, false, false); auto r1 = __builtin_amdgcn_permlane32_swap(a1, b1, false, false); \
    u32x4 w = {r0[0], r1[0], r0[1], r1[1]}; OUT = *reinterpret_cast<bf16x8*>(&w); } while (0)
    PK4(p0, 0, pa0); PK4(p0, 8, pa1); PK4(p1, 0, pa2); PK4(p1, 8, pa3);
#undef PK4
}
__device__ __forceinline__ void qkt(f32x16& p0, f32x16& p1, const LAS char* Ks, const LAS char* Rs, const bf16x8* qr, const bf16x8* qrr, int r32, int hi) {
    p0 = f32x16{}; p1 = f32x16{};
#pragma unroll
    for (int d0 = 0; d0 < 8; ++d0) { const int cb = (d0 * 16 + hi * 8) * 2;
        const bf16x8 b0 = *reinterpret_cast<const LAS bf16x8*>(Ks + KSWZ(r32, cb));
        const bf16x8 b1 = *reinterpret_cast<const LAS bf16x8*>(Ks + KSWZ(32 + r32, cb));
        p0 = __builtin_amdgcn_mfma_f32_32x32x16_bf16(b0, qr[d0], p0, 0, 0, 0);
        p1 = __builtin_amdgcn_mfma_f32_32x32x16_bf16(b1, qr[d0], p1, 0, 0, 0); if ((d0 & 3) == 3) SBAR(); }
#pragma unroll
    for (int d0 = 0; d0 < 4; ++d0) { const int cb = (d0 * 16 + hi * 8) * 2;
        const bf16x8 b0 = *reinterpret_cast<const LAS bf16x8*>(Rs + RSWZ(r32, cb));
        const bf16x8 b1 = *reinterpret_cast<const LAS bf16x8*>(Rs + RSWZ(32 + r32, cb));
        p0 = __builtin_amdgcn_mfma_f32_32x32x16_bf16(b0, qrr[d0], p0, 0, 0, 0);
        p1 = __builtin_amdgcn_mfma_f32_32x32x16_bf16(b1, qrr[d0], p1, 0, 0, 0); }
}
__device__ __forceinline__ int v_st(int k, int c) { const int kk = (k & ~0xC) | ((k & 4) << 1) | ((k & 8) >> 1); return ((kk >> 3) * 4 + (c >> 5)) * 512 + ((kk & 7) * 32 + (c & 31)) * 2; }
__device__ __forceinline__ int v_rd_base(int lane) { return ((lane & 3) << 3) | (((lane >> 2) & 3) << 6) | (((lane >> 4) & 1) << 5) | (((lane >> 5) & 1) << 8); }
constexpr int v_rd_off(int d0, int ks, int half) { return d0 * 512 + ks * 4096 + half * 2048; }
template <int OFF> __device__ __forceinline__ s16x4 tr_read(int vb) {
    s16x4 r; asm volatile("ds_read_b64_tr_b16 %0, %1 offset:%2" : "=&v"(r) : "v"(vb), "i"(OFF) : "memory"); return r;
}
template <int D0> __device__ __forceinline__ void pv_one(f32x16& od, int vb, bf16x8 pa0, bf16x8 pa1, bf16x8 pa2, bf16x8 pa3) {
    const s16x4 l0 = tr_read<v_rd_off(D0, 0, 0)>(vb), h0 = tr_read<v_rd_off(D0, 0, 1)>(vb), l1 = tr_read<v_rd_off(D0, 1, 0)>(vb), h1 = tr_read<v_rd_off(D0, 1, 1)>(vb);
    const s16x4 l2 = tr_read<v_rd_off(D0, 2, 0)>(vb), h2 = tr_read<v_rd_off(D0, 2, 1)>(vb), l3 = tr_read<v_rd_off(D0, 3, 0)>(vb), h3 = tr_read<v_rd_off(D0, 3, 1)>(vb);
    asm volatile("s_waitcnt lgkmcnt(0)" ::: "memory"); SBAR();
#define PK(L, H) (bf16x8){L[0], L[1], L[2], L[3], H[0], H[1], H[2], H[3]}
    od = __builtin_amdgcn_mfma_f32_32x32x16_bf16(pa0, PK(l0, h0), od, 0, 0, 0);
    od = __builtin_amdgcn_mfma_f32_32x32x16_bf16(pa1, PK(l1, h1), od, 0, 0, 0);
    od = __builtin_amdgcn_mfma_f32_32x32x16_bf16(pa2, PK(l2, h2), od, 0, 0, 0);
    od = __builtin_amdgcn_mfma_f32_32x32x16_bf16(pa3, PK(l3, h3), od, 0, 0, 0);
#undef PK
}
__device__ __forceinline__ void pv_d0(f32x16* o, int vb, bf16x8 pa0, bf16x8 pa1, bf16x8 pa2, bf16x8 pa3) {
    pv_one<0>(o[0], vb, pa0, pa1, pa2, pa3); pv_one<1>(o[1], vb, pa0, pa1, pa2, pa3); pv_one<2>(o[2], vb, pa0, pa1, pa2, pa3); pv_one<3>(o[3], vb, pa0, pa1, pa2, pa3);
}

__device__ __forceinline__ void attn_unit(const bf16_t* __restrict__ Qn, const bf16_t* __restrict__ Qr, const bf16_t* __restrict__ Kn, const bf16_t* __restrict__ Kr, const bf16_t* __restrict__ Vh,
                                          bf16_t* __restrict__ Ob, int seq, LAS char* lds) {
    const int tid = threadIdx.x, wid = tid >> 6, lane = tid & 63, r32 = lane & 31, hi = lane >> 5;
    LAS char* V_lds = lds + OFF_V; LAS char* K_lds = lds + OFF_K; LAS char* R_lds = lds + OFF_R;
    LAS float* wsl = (LAS float*)(lds + OFF_W) + wid * 64; LAS float* li_l = wsl; LAS float* al_l = wsl + 32;
    float m_reg = -1e30f, l_reg = 0; f32x16 o[4] = {}; bf16x8 qr[8], qrr[4];
    { unsigned qo = (unsigned)((wid * QBLK + r32) * 128 + hi * 8) * 2u, qo2 = (unsigned)((wid * QBLK + r32) * 64 + hi * 8) * 2u;
      asm volatile("" : "+v"(qo), "+v"(qo2));
#pragma unroll
      for (int d0 = 0; d0 < 8; ++d0) qr[d0] = *reinterpret_cast<const bf16x8*>((const char*)Qn + qo + d0 * 32);
#pragma unroll
      for (int d0 = 0; d0 < 4; ++d0) qrr[d0] = *reinterpret_cast<const bf16x8*>((const char*)Qr + qo2 + d0 * 32); }
    const int sr = tid >> 4, sc = (tid & 15) * 8, vst0 = v_st(sr, sc), vst1 = v_st(32 + sr, sc);
    const int rr_ = tid >> 3, rc_ = (tid & 7) * 8;
    const int vb0 = (int)(unsigned)(uintptr_t)V_lds + v_rd_base(lane);
    bf16x8 vs0, vs1, ks0, ks1, rs0;
    const unsigned vo = (unsigned)(sr * 128 + sc) * 2u, ro = (unsigned)(rr_ * 64 + rc_) * 2u;
#define SLOAD(k0) do { const char* vt = (const char*)Vh + (size_t)(k0) * 256; const char* kt = (const char*)Kn + (size_t)(k0) * 256; const char* rt = (const char*)Kr + (size_t)(k0) * 128; \
    vs0 = *reinterpret_cast<const bf16x8*>(vt + vo); vs1 = *reinterpret_cast<const bf16x8*>(vt + 8192 + vo); \
    ks0 = *reinterpret_cast<const bf16x8*>(kt + vo); ks1 = *reinterpret_cast<const bf16x8*>(kt + 8192 + vo); \
    rs0 = *reinterpret_cast<const bf16x8*>(rt + ro); } while (0)
#define SWRITE(b) do { *(LAS bf16x8*)(V_lds + (b) * SHM_V + vst0) = vs0; *(LAS bf16x8*)(V_lds + (b) * SHM_V + vst1) = vs1; const int kc = sc * 2; \
    *(LAS bf16x8*)(K_lds + (b) * SHM_K + KSWZ(sr, kc)) = ks0; *(LAS bf16x8*)(K_lds + (b) * SHM_K + KSWZ(32 + sr, kc)) = ks1; \
    *(LAS bf16x8*)(R_lds + (b) * SHM_R + RSWZ(rr_, rc_ * 2)) = rs0; } while (0)
#define SWAIT() asm volatile("s_waitcnt vmcnt(0)" ::: "memory")
#define RESC(a) do { if (__any((a) < 1.f)) { if (hi == 0) al_l[r32] = (a); asm volatile("s_waitcnt lgkmcnt(0)" ::: "memory"); \
    _Pragma("unroll") for (int d = 0; d < 4; ++d) _Pragma("unroll") for (int r = 0; r < 16; ++r) o[d][r] *= al_l[crow(r, hi)]; } } while (0)
#define TILE(b, jj) do { f32x16 p0, p1; float mn, al; bf16x8 pa0, pa1, pa2, pa3; \
    if ((jj) + 2 < NT) SLOAD(((jj) + 2) * KVBLK); SBAR(); \
    qkt(p0, p1, K_lds + (b) * SHM_K, R_lds + (b) * SHM_R, qr, qrr, r32, hi); partialSM(p0, p1, m_reg, mn, al); RESC(al); \
    finishSM(p0, p1, al, l_reg, pa0, pa1, pa2, pa3); SBAR(); \
    pv_d0(o, vb0 + (b) * SHM_V, pa0, pa1, pa2, pa3); \
    __syncthreads(); if ((jj) + 2 < NT) { SWAIT(); SWRITE(b); } } while (0)
    const int NT = seq / KVBLK;
    SLOAD(0); SWAIT(); SWRITE(0); SLOAD(KVBLK); SWAIT(); SWRITE(1); __syncthreads();
    for (int j = 0; j < NT; j += 2) { TILE(0, j); TILE(1, j + 1); }
    if (hi == 0) li_l[r32] = l_reg; asm volatile("s_waitcnt lgkmcnt(0)" ::: "memory");
    unsigned oo0 = (unsigned)((wid * QBLK) * 1024 + r32) * 2u; asm volatile("" : "+v"(oo0));
#pragma unroll
    for (int r = 0; r < 16; ++r) { const int orow = crow(r, hi); const float rl = __builtin_amdgcn_rcpf(li_l[orow]); const unsigned oo = oo0 + (unsigned)orow * 2048u;
#pragma unroll
        for (int d0 = 0; d0 < 4; ++d0) *(bf16_t*)((char*)Ob + oo + d0 * 64) = (bf16_t)(cvtpk(o[d0][r] * rl, 0.f) & 0xffffu); }
    __syncthreads();
#undef SLOAD
#undef SWRITE
#undef SWAIT
#undef RESC
#undef TILE
}
}


namespace scan {
using attn::s16x4; using attn::f32x16; using attn::v_st; using attn::v_rd_base; using attn::crow; using attn::cvtpk;
constexpr int NCH = KEYS / 64;
constexpr size_t WS_STATE = 422 * MiB;
constexpr size_t WS_DEC = 694 * MiB;
__device__ __forceinline__ int seq_row(int b, int p) { return p < CT ? RL + b * CT + p : b * T + (p - CT); }
__device__ __forceinline__ s16x4 trr(int addr) { s16x4 r; asm volatile("ds_read_b64_tr_b16 %0, %1" : "=&v"(r) : "v"(addr) : "memory"); return r; }
template <int OFF> __device__ __forceinline__ s16x4 tri(int addr) { s16x4 r; asm volatile("ds_read_b64_tr_b16 %0, %1 offset:%2" : "=&v"(r) : "v"(addr), "i"(OFF) : "memory"); return r; }
#define SC_PK(L, H) (bf16x8){L[0], L[1], L[2], L[3], H[0], H[1], H[2], H[3]}
#define SC_LWAIT() do { asm volatile("s_waitcnt lgkmcnt(0)" ::: "memory"); __builtin_amdgcn_sched_barrier(0); } while (0)
__device__ __forceinline__ float2 bf2x(unsigned u) { return make_float2(bf2f((bf16_t)(u & 0xffffu)), bf2f((bf16_t)(u >> 16))); }

struct Prep {
    float2 kf[8], kb[8];
    float2 bf[8], cb[8];
    float2 totf, totb, reff, refb;
};
__device__ __forceinline__ void prep_decay(Prep& P, const bf16_t* __restrict__ KF, const bf16_t* __restrict__ KB, int row0, int h, int a, float lgf, float lgb, LAS float* tot, int tid) {
    const int cp = tid & 63, tg = tid >> 6;
    float2 gf[8], gb[8];
#pragma unroll
    for (int i = 0; i < 8; ++i) { const size_t off = (size_t)(row0 + 8 * tg + i) * 512 + h * 128 + 2 * cp;
        P.kf[i] = bf2x(*(const unsigned*)(KF + off)); P.kb[i] = bf2x(*(const unsigned*)(KB + off));
        if (a) { gf[i] = make_float2(__logf(fmaxf(1.f - P.kf[i].x, 1e-30f)), __logf(fmaxf(1.f - P.kf[i].y, 1e-30f))); gb[i] = make_float2(__logf(fmaxf(1.f - P.kb[i].x, 1e-30f)), __logf(fmaxf(1.f - P.kb[i].y, 1e-30f))); }
        else { gf[i] = make_float2(lgf, lgf); gb[i] = make_float2(lgb, lgb); } }
    P.bf[0] = gf[0];
#pragma unroll
    for (int i = 1; i < 8; ++i) P.bf[i] = make_float2(P.bf[i - 1].x + gf[i].x, P.bf[i - 1].y + gf[i].y);
    P.cb[0] = gb[0];
#pragma unroll
    for (int i = 1; i < 8; ++i) P.cb[i] = make_float2(P.cb[i - 1].x + gb[i].x, P.cb[i - 1].y + gb[i].y);
    *(LAS f32x2*)(tot + (0 * 8 + tg) * 128 + 2 * cp) = (f32x2){P.bf[7].x, P.bf[7].y}; *(LAS f32x2*)(tot + (1 * 8 + tg) * 128 + 2 * cp) = (f32x2){P.cb[7].x, P.cb[7].y};
    __syncthreads();
    float2 offf = make_float2(0.f, 0.f), offb = make_float2(0.f, 0.f); P.totf = offf; P.totb = offf; P.reff = offf; P.refb = offf;
#pragma unroll
    for (int g = 0; g < 8; ++g) { const f32x2 tf = *(const LAS f32x2*)(tot + (0 * 8 + g) * 128 + 2 * cp), tb = *(const LAS f32x2*)(tot + (1 * 8 + g) * 128 + 2 * cp);
        P.totf.x += tf.x; P.totf.y += tf.y; P.totb.x += tb.x; P.totb.y += tb.y;
        if (g < 4) { P.reff.x += tf.x; P.reff.y += tf.y; } else { P.refb.x += tb.x; P.refb.y += tb.y; }
        if (g < tg) { offf.x += tf.x; offf.y += tf.y; offb.x += tb.x; offb.y += tb.y; } }
#pragma unroll
    for (int i = 0; i < 8; ++i) { P.bf[i].x += offf.x; P.bf[i].y += offf.y;
        P.cb[i].x = P.totb.x - (P.cb[i].x + offb.x) + gb[i].x; P.cb[i].y = P.totb.y - (P.cb[i].y + offb.y) + gb[i].y; }
}
__device__ __forceinline__ unsigned pk2f(float a, float b) { return cvtpk(a, b); }

__device__ __forceinline__ void s1_item(int item, const bf16_t* G0p, const float* lg, bf16_t* ST, float* DEC, LAS char* lds) {
    const int tid = threadIdx.x, lane = tid & 63, wid = tid >> 6, cp = tid & 63, tg = tid >> 6, r32 = lane & 31, hi = lane >> 5;
    const int c = item % NCH, h = (item / NCH) & 3, b = (item / (NCH * 4)) & 7, a = item / (NCH * 32);
    const bf16_t* KF = G0p + (size_t)(a ? 5 : 1) * (GSZ / 2); const bf16_t* KB = G0p + (size_t)(a ? 6 : 1) * (GSZ / 2); const bf16_t* Vg = G0p + (size_t)(a ? 7 : 2) * (GSZ / 2);
    const int row0 = seq_row(b, 64 * c);
    LAS char* KFi = lds; LAS char* KBi = lds + 16384; LAS char* Vi = lds + 32768; LAS float* tot = (LAS float*)(lds + 49152);
    bf16x8 vv[2];
#pragma unroll
    for (int n = 0; n < 2; ++n) { const int q = tid + 512 * n, k = q >> 4, c0 = (q & 15) * 8; vv[n] = *(const bf16x8*)(Vg + (size_t)(row0 + k) * 512 + h * 128 + c0); }
    Prep P; prep_decay(P, KF, KB, row0, h, a, lg[h], lg[4 + h], tot, tid);
#pragma unroll
    for (int i = 0; i < 8; ++i) { const int k = 8 * tg + i; const int o = v_st(k, 2 * cp);
        *(LAS unsigned*)(KFi + o) = pk2f(P.kf[i].x * __expf(P.totf.x - P.bf[i].x), P.kf[i].y * __expf(P.totf.y - P.bf[i].y));
        *(LAS unsigned*)(KBi + o) = pk2f(P.kb[i].x * __expf(P.totb.x - P.cb[i].x), P.kb[i].y * __expf(P.totb.y - P.cb[i].y)); }
#pragma unroll
    for (int n = 0; n < 2; ++n) { const int q = tid + 512 * n, k = q >> 4, c0 = (q & 15) * 8; *(LAS bf16x8*)(Vi + v_st(k, c0)) = vv[n]; }
    const size_t sidx = ((((size_t)a * 8 + b) * 4 + h) * 2) * NCH;
    if (tg == 0) { *(float2*)(DEC + (sidx + c) * 128 + 2 * cp) = make_float2(__expf(P.totf.x), __expf(P.totf.y)); *(float2*)(DEC + (sidx + NCH + c) * 128 + 2 * cp) = make_float2(__expf(P.totb.x), __expf(P.totb.y)); }
    __syncthreads();
    const int dkb = wid & 3, dvb0 = 2 * (wid >> 2);
    const int aKF = (int)(unsigned)(uintptr_t)KFi + v_rd_base(lane) + dkb * 512, aKB = (int)(unsigned)(uintptr_t)KBi + v_rd_base(lane) + dkb * 512, aV = (int)(unsigned)(uintptr_t)Vi + v_rd_base(lane) + dvb0 * 512;
    f32x16 uf0 = {}, uf1 = {}, ub0 = {}, ub1 = {};
    asm volatile("" : "+v"(uf0), "+v"(uf1), "+v"(ub0), "+v"(ub1));
#define S1_STEP(KS) do { const s16x4 fl = tri<(KS) * 4096>(aKF), fh = tri<(KS) * 4096 + 2048>(aKF), bl = tri<(KS) * 4096>(aKB), bh = tri<(KS) * 4096 + 2048>(aKB); \
        const s16x4 v0l = tri<(KS) * 4096>(aV), v0h = tri<(KS) * 4096 + 2048>(aV), v1l = tri<(KS) * 4096 + 512>(aV), v1h = tri<(KS) * 4096 + 2048 + 512>(aV); SC_LWAIT(); \
        const bf16x8 kff = SC_PK(fl, fh), kbf = SC_PK(bl, bh), vf0 = SC_PK(v0l, v0h), vf1 = SC_PK(v1l, v1h); \
        uf0 = __builtin_amdgcn_mfma_f32_32x32x16_bf16(vf0, kff, uf0, 0, 0, 0); uf1 = __builtin_amdgcn_mfma_f32_32x32x16_bf16(vf1, kff, uf1, 0, 0, 0); \
        ub0 = __builtin_amdgcn_mfma_f32_32x32x16_bf16(vf0, kbf, ub0, 0, 0, 0); ub1 = __builtin_amdgcn_mfma_f32_32x32x16_bf16(vf1, kbf, ub1, 0, 0, 0); } while (0)
    S1_STEP(0); S1_STEP(1); S1_STEP(2); S1_STEP(3);
#undef S1_STEP
    bf16_t* Uf = ST + (sidx + c) * 16384 + (size_t)(32 * dkb + r32) * 128; bf16_t* Ub = ST + (sidx + NCH + c) * 16384 + (size_t)(32 * dkb + r32) * 128;
#pragma unroll
    for (int g = 0; g < 4; ++g) { const int dv = 8 * g + 4 * hi;
        *(u32x2*)(Uf + 32 * dvb0 + dv) = (u32x2){cvtpk(uf0[4 * g], uf0[4 * g + 1]), cvtpk(uf0[4 * g + 2], uf0[4 * g + 3])}; *(u32x2*)(Uf + 32 * (dvb0 + 1) + dv) = (u32x2){cvtpk(uf1[4 * g], uf1[4 * g + 1]), cvtpk(uf1[4 * g + 2], uf1[4 * g + 3])};
        *(u32x2*)(Ub + 32 * dvb0 + dv) = (u32x2){cvtpk(ub0[4 * g], ub0[4 * g + 1]), cvtpk(ub0[4 * g + 2], ub0[4 * g + 3])}; *(u32x2*)(Ub + 32 * (dvb0 + 1) + dv) = (u32x2){cvtpk(ub1[4 * g], ub1[4 * g + 1]), cvtpk(ub1[4 * g + 2], ub1[4 * g + 3])}; }
    __syncthreads();
}

__device__ __forceinline__ void s2_vec(size_t v, bf16_t* ST, const float* DEC) {
    const int chain = (int)(v >> 11), e8 = (int)(v & 2047), dk = e8 >> 4, dir = chain & 1;
    bf16_t* base = ST + (size_t)chain * NCH * 16384 + (size_t)e8 * 8; const float* dec = DEC + (size_t)chain * NCH * 128 + dk;
    float S[8];
#pragma unroll
    for (int i = 0; i < 8; ++i) S[i] = 0.f;
    u32x4 u_next = *(const u32x4*)(base + (size_t)(dir ? 3 : 0) * 16384);
    for (int q = 0; q < NCH; ++q) {
        const int c = dir ? (q < 4 ? 3 - q : 71 - q) : q;
        const u32x4 u = u_next; const float d = dec[c * 128];
        if (q + 1 < NCH) { const int cn = dir ? (q + 1 < 4 ? 3 - (q + 1) : 71 - (q + 1)) : q + 1; u_next = *(const u32x4*)(base + (size_t)cn * 16384); }
        u32x4 w; w.x = cvtpk(S[0], S[1]); w.y = cvtpk(S[2], S[3]); w.z = cvtpk(S[4], S[5]); w.w = cvtpk(S[6], S[7]);
        *(u32x4*)(base + (size_t)c * 16384) = w;
        const float2 u0 = bf2x(u.x), u1 = bf2x(u.y), u2 = bf2x(u.z), u3 = bf2x(u.w);
        S[0] = d * S[0] + u0.x; S[1] = d * S[1] + u0.y; S[2] = d * S[2] + u1.x; S[3] = d * S[3] + u1.y; S[4] = d * S[4] + u2.x; S[5] = d * S[5] + u2.y; S[6] = d * S[6] + u3.x; S[7] = d * S[7] + u3.y;
    }
}

__device__ __forceinline__ void s3_item(int item, const bf16_t* G0p, const float* lg, const bf16_t* ST, bf16_t* Y, LAS char* lds) {
    const int tid = threadIdx.x, lane = tid & 63, wid = tid >> 6, cp = tid & 63, tg = tid >> 6, r32 = lane & 31, hi = lane >> 5;
    const int c = item % NCH, h = (item / NCH) & 3, b = (item / (NCH * 4)) & 7, a = item / (NCH * 32);
    const bf16_t* Qg = G0p + (size_t)(a ? 4 : 0) * (GSZ / 2); const bf16_t* KF = G0p + (size_t)(a ? 5 : 1) * (GSZ / 2); const bf16_t* KB = G0p + (size_t)(a ? 6 : 1) * (GSZ / 2);
    const bf16_t* Vg = G0p + (size_t)(a ? 7 : 2) * (GSZ / 2); const bf16_t* Gt = G0p + (size_t)(a ? 8 : 3) * (GSZ / 2);
    const int row0 = seq_row(b, 64 * c);
    LAS char* QFi = lds; LAS char* KFi = lds + 16384; LAS char* Vi = lds + 32768; LAS float* tot = (LAS float*)(lds + 49152);
    LAS char* QBi = lds + 65536; LAS char* KBi = lds + 81920; LAS char* QF2 = lds + 98304; LAS char* QB2 = lds + 114688; LAS float* red = (LAS float*)(lds + 65536);
    const size_t sidx = ((((size_t)a * 8 + b) * 4 + h) * 2) * NCH;
    bf16x8 vv[2], sf[4], sb[4];
#pragma unroll
    for (int n = 0; n < 2; ++n) { const int q = tid + 512 * n, k = q >> 4, c0 = (q & 15) * 8; vv[n] = *(const bf16x8*)(Vg + (size_t)(row0 + k) * 512 + h * 128 + c0); }
    float2 qv[8];
#pragma unroll
    for (int i = 0; i < 8; ++i) qv[i] = bf2x(*(const unsigned*)(Qg + (size_t)(row0 + 8 * tg + i) * 512 + h * 128 + 2 * cp));
    Prep P; prep_decay(P, KF, KB, row0, h, a, lg[h], lg[4 + h], tot, tid);
#pragma unroll
    for (int i = 0; i < 8; ++i) { const int k = 8 * tg + i; const int o = KSWZ(k, 4 * cp);
        const float2 ef = make_float2(__expf(P.bf[i].x - P.reff.x), __expf(P.bf[i].y - P.reff.y)), eb = make_float2(__expf(P.cb[i].x - P.refb.x), __expf(P.cb[i].y - P.refb.y));
        *(LAS unsigned*)(QFi + o) = pk2f(qv[i].x * ef.x, qv[i].y * ef.y); *(LAS unsigned*)(KFi + o) = pk2f(P.kf[i].x * __builtin_amdgcn_rcpf(ef.x), P.kf[i].y * __builtin_amdgcn_rcpf(ef.y));
        *(LAS unsigned*)(QBi + o) = pk2f(qv[i].x * eb.x, qv[i].y * eb.y); *(LAS unsigned*)(KBi + o) = pk2f(P.kb[i].x * __builtin_amdgcn_rcpf(eb.x), P.kb[i].y * __builtin_amdgcn_rcpf(eb.y));
        *(LAS unsigned*)(QF2 + o) = pk2f(qv[i].x * __expf(P.bf[i].x), qv[i].y * __expf(P.bf[i].y)); *(LAS unsigned*)(QB2 + o) = pk2f(qv[i].x * __expf(P.cb[i].x), qv[i].y * __expf(P.cb[i].y)); }
#pragma unroll
    for (int n = 0; n < 2; ++n) { const int q = tid + 512 * n, k = q >> 4, c0 = (q & 15) * 8; *(LAS bf16x8*)(Vi + v_st(k, c0)) = vv[n]; }
#pragma unroll
    for (int n = 0; n < 4; ++n) { const int q = tid + 512 * n; sf[n] = *(const bf16x8*)(ST + (sidx + c) * 16384 + (size_t)q * 8); sb[n] = *(const bf16x8*)(ST + (sidx + NCH + c) * 16384 + (size_t)q * 8); }
    __syncthreads();
    const int rb = wid >> 2, d0 = wid & 3, qrow = 32 * rb + r32;
    f32x16 pf0 = {}, pf1 = {}, pb0 = {}, pb1 = {};
    asm volatile("" : "+v"(pf0), "+v"(pf1), "+v"(pb0), "+v"(pb1));
#pragma unroll
    for (int ks = 0; ks < 8; ++ks) { const int cb_ = (ks * 16 + hi * 8) * 2;
        const bf16x8 qf = *(const LAS bf16x8*)(QFi + KSWZ(qrow, cb_)), qb = *(const LAS bf16x8*)(QBi + KSWZ(qrow, cb_));
        const bf16x8 kf0 = *(const LAS bf16x8*)(KFi + KSWZ(r32, cb_)), kf1 = *(const LAS bf16x8*)(KFi + KSWZ(32 + r32, cb_)), kb0 = *(const LAS bf16x8*)(KBi + KSWZ(r32, cb_)), kb1 = *(const LAS bf16x8*)(KBi + KSWZ(32 + r32, cb_));
        pf0 = __builtin_amdgcn_mfma_f32_32x32x16_bf16(kf0, qf, pf0, 0, 0, 0); pf1 = __builtin_amdgcn_mfma_f32_32x32x16_bf16(kf1, qf, pf1, 0, 0, 0);
        pb0 = __builtin_amdgcn_mfma_f32_32x32x16_bf16(kb0, qb, pb0, 0, 0, 0); pb1 = __builtin_amdgcn_mfma_f32_32x32x16_bf16(kb1, qb, pb1, 0, 0, 0); }
#pragma unroll
    for (int r = 0; r < 16; ++r) { const int j0 = crow(r, hi), j1 = 32 + j0;
        pf0[r] = (j0 <= qrow ? pf0[r] : 0.f) + (j0 >= qrow ? pb0[r] : 0.f); pf1[r] = (j1 <= qrow ? pf1[r] : 0.f) + (j1 >= qrow ? pb1[r] : 0.f); }
    bf16x8 pa0, pa1, pa2, pa3;
#define PK4(Pv, BASE, OUT) do { unsigned a0 = cvtpk(Pv[BASE + 0], Pv[BASE + 1]), a1 = cvtpk(Pv[BASE + 2], Pv[BASE + 3]);   \
    unsigned b0 = cvtpk(Pv[BASE + 4], Pv[BASE + 5]), b1 = cvtpk(Pv[BASE + 6], Pv[BASE + 7]);                              \
    auto r0 = __builtin_amdgcn_permlane32_swap(a0, b0, false, false); auto r1 = __builtin_amdgcn_permlane32_swap(a1, b1, false, false); \
    u32x4 w = {r0[0], r1[0], r0[1], r1[1]}; OUT = *reinterpret_cast<bf16x8*>(&w); } while (0)
    PK4(pf0, 0, pa0); PK4(pf0, 8, pa1); PK4(pf1, 0, pa2); PK4(pf1, 8, pa3);
#undef PK4
    f32x16 o = {}; asm volatile("" : "+v"(o));
    { const int aV = (int)(unsigned)(uintptr_t)Vi + v_rd_base(lane) + d0 * 512;
      const s16x4 l0 = tri<0>(aV), h0 = tri<2048>(aV), l1 = tri<4096>(aV), h1 = tri<4096 + 2048>(aV), l2 = tri<8192>(aV), h2 = tri<8192 + 2048>(aV), l3 = tri<12288>(aV), h3 = tri<12288 + 2048>(aV); SC_LWAIT();
      o = __builtin_amdgcn_mfma_f32_32x32x16_bf16(pa0, SC_PK(l0, h0), o, 0, 0, 0); o = __builtin_amdgcn_mfma_f32_32x32x16_bf16(pa1, SC_PK(l1, h1), o, 0, 0, 0);
      o = __builtin_amdgcn_mfma_f32_32x32x16_bf16(pa2, SC_PK(l2, h2), o, 0, 0, 0); o = __builtin_amdgcn_mfma_f32_32x32x16_bf16(pa3, SC_PK(l3, h3), o, 0, 0, 0); }
    __syncthreads();
    LAS char* SFi = lds; LAS char* SBi = lds + 32768;
#pragma unroll
    for (int n = 0; n < 4; ++n) { const int q = tid + 512 * n, dk = q >> 4, c0 = (q & 15) * 8; const int oo = (dk >> 6) * 16384 + v_st(dk & 63, c0); *(LAS bf16x8*)(SFi + oo) = sf[n]; *(LAS bf16x8*)(SBi + oo) = sb[n]; }
    __syncthreads();
    { const int aSF = (int)(unsigned)(uintptr_t)SFi + v_rd_base(lane) + d0 * 512, aSB = (int)(unsigned)(uintptr_t)SBi + v_rd_base(lane) + d0 * 512;
#define S3_STEP(KS) do { const int cb_ = ((KS) * 16 + hi * 8) * 2; const bf16x8 q1 = *(const LAS bf16x8*)(QF2 + KSWZ(qrow, cb_)), q2 = *(const LAS bf16x8*)(QB2 + KSWZ(qrow, cb_)); \
        const s16x4 fl = tri<(KS) * 4096>(aSF), fh = tri<(KS) * 4096 + 2048>(aSF), bl = tri<(KS) * 4096>(aSB), bh = tri<(KS) * 4096 + 2048>(aSB); SC_LWAIT(); \
        o = __builtin_amdgcn_mfma_f32_32x32x16_bf16(q1, SC_PK(fl, fh), o, 0, 0, 0); o = __builtin_amdgcn_mfma_f32_32x32x16_bf16(q2, SC_PK(bl, bh), o, 0, 0, 0); } while (0)
      S3_STEP(0); S3_STEP(1); S3_STEP(2); S3_STEP(3); S3_STEP(4); S3_STEP(5); S3_STEP(6); S3_STEP(7);
#undef S3_STEP
    }
#pragma unroll
    for (int r = 0; r < 16; ++r) { float s = o[r] * o[r];
        s += __shfl_xor(s, 1); s += __shfl_xor(s, 2); s += __shfl_xor(s, 4); s += __shfl_xor(s, 8); s += __shfl_xor(s, 16);
        if (r32 == 0) red[(rb * 4 + d0) * 32 + crow(r, hi)] = s; }
    __syncthreads();
#pragma unroll
    for (int r = 0; r < 16; ++r) { const int lr = crow(r, hi); const float ss = red[(rb * 4 + 0) * 32 + lr] + red[(rb * 4 + 1) * 32 + lr] + red[(rb * 4 + 2) * 32 + lr] + red[(rb * 4 + 3) * 32 + lr];
        const float rs = rsqrtf(ss * (1.f / 128.f) + EPS); const int row = row0 + 32 * rb + lr; const int col = h * 128 + 32 * d0 + r32;
        const float g = bf2f(Gt[(size_t)row * 512 + col]);
        Y[(size_t)row * 1024 + a * 512 + col] = (bf16_t)(cvtpk(o[r] * rs * g, 0.f) & 0xffffu); }
    __syncthreads();
}
#undef SC_PK
#undef SC_LWAIT
}

constexpr int RING_OFF = 0, RING_BYTES = 131072;
constexpr int MISC_OFF = RING_BYTES;
constexpr int LDS_BYTES = 147456;
constexpr int NWAVES = 8, NTHREADS = 512;

#define XB_TMO      128
#define XB_XCNT(j)  (256  + 64 * (j))
#define XB_XSUB(j)  (1280 + 64 * (j))
#define XB_XGEN(j)  (2304 + 64 * (j))
#define XB_TOP      3328
#define XB_TOPGEN   3392
#define XCD_BAR_WORDS 3456
#define XB_SPIN_CAP (1u << 18)
__device__ __forceinline__ unsigned xb_ld(unsigned* p)              { return __hip_atomic_load(p, __ATOMIC_RELAXED, __HIP_MEMORY_SCOPE_AGENT); }
__device__ __forceinline__ unsigned xb_add(unsigned* p, unsigned v) { return __hip_atomic_fetch_add(p, v, __ATOMIC_RELAXED, __HIP_MEMORY_SCOPE_AGENT); }
__device__ __forceinline__ unsigned xb_xcc_id() { return (unsigned)__builtin_amdgcn_s_getreg((3 << 11) | 20) & 0xFu; }
#define XB_SPIN(cond, bar) do { unsigned _sp = 0; while (cond) { __builtin_amdgcn_s_sleep(1); \
    if ((++_sp & 255u) == 0u) { if (xb_ld(&(bar)[XB_TMO])) break; if (_sp > XB_SPIN_CAP) { atomicAdd(&(bar)[XB_TMO], 1u); break; } } } } while (0)
struct XcdBarrier { unsigned* bar; unsigned x; volatile LAS unsigned* st; };
__device__ __forceinline__ XcdBarrier xcd_barrier_post(unsigned* bar, volatile LAS unsigned* st) {
    XcdBarrier b; b.bar = bar; b.x = xb_xcc_id(); b.st = st;
    if (threadIdx.x == 0) (void)xb_add(&bar[XB_XCNT(b.x)], 1u);
    return b;
}
__device__ __forceinline__ void xcd_barrier_complete(unsigned* bar, unsigned x, unsigned& nloc, unsigned& nx) {
    const unsigned Gt = gridDim.x * gridDim.y * gridDim.z;
    unsigned sum, cnt, mine, sp = 0u;
    for (;;) {
        sum = 0u; cnt = 0u; mine = 0u;
#pragma unroll
        for (unsigned j = 0; j < 16; ++j) { const unsigned c = xb_ld(&bar[XB_XCNT(j)]); sum += c; cnt += (c > 0u) ? 1u : 0u; mine = (j == x) ? c : mine; }
        if (sum == Gt) break;
        __builtin_amdgcn_s_sleep(1);
        if ((++sp & 255u) == 0u) { if (xb_ld(&bar[XB_TMO])) break; if (sp > XB_SPIN_CAP) { atomicAdd(&bar[XB_TMO], 1u); break; } }
    }
    nloc = mine > 0u ? mine : 1u; nx = cnt > 0u ? cnt : 1u;
}
__device__ __forceinline__ void xcd_barrier(const XcdBarrier& b) {
    asm volatile("s_waitcnt vmcnt(0)" ::: "memory");
    __syncthreads();
    if (threadIdx.x == 0) {
        unsigned* bar = b.bar;
        __builtin_amdgcn_s_waitcnt(0);
        unsigned nloc = b.st[0], nx = b.st[1];
        if (nloc == 0u) { xcd_barrier_complete(bar, b.x, nloc, nx); b.st[0] = nloc; b.st[1] = nx; }
        const unsigned old = xb_add(&bar[XB_XSUB(b.x)], 1u);
        const unsigned gen = old / nloc;
        if (old + 1u == (gen + 1u) * nloc) {
            __builtin_amdgcn_fence(__ATOMIC_RELEASE, "agent");
            asm volatile("s_waitcnt vmcnt(0)" ::: "memory");
            const unsigned og = xb_add(&bar[XB_TOP], 1u);
            const unsigned tg = og / nx;
            if (og + 1u == (tg + 1u) * nx) xb_add(&bar[XB_TOPGEN], 1u);
            else XB_SPIN(xb_ld(&bar[XB_TOPGEN]) == tg, bar);
            __builtin_amdgcn_fence(__ATOMIC_ACQUIRE, "agent");
            xb_add(&bar[XB_XGEN(b.x)], 1u);
            asm volatile("s_waitcnt vmcnt(0)" ::: "memory");
        } else {
            XB_SPIN(xb_ld(&bar[XB_XGEN(b.x)]) == gen, bar);
            __builtin_amdgcn_fence(__ATOMIC_ACQUIRE, "agent");
            asm volatile("s_waitcnt vmcnt(0)" ::: "memory");
        }
    }
    __syncthreads();
}

__device__ __forceinline__ void transpose_item(const float* __restrict__ W, int ldw, int K, int src0, bf16_t* __restrict__ WT, int n0, int k0, LAS float* scr, int lane) {
    if (src0 >= 0) {
#pragma unroll 8
        for (int i = 0; i < 32; ++i) { const int kk = 2 * i + (lane >> 5); scr[kk * 33 + (lane & 31)] = W[(size_t)(k0 + kk) * ldw + src0 + (lane & 31)]; }
    } else {
#pragma unroll 8
        for (int i = 0; i < 32; ++i) { const int kk = 2 * i + (lane >> 5); scr[kk * 33 + (lane & 31)] = 0.f; }
    }
    asm volatile("s_waitcnt lgkmcnt(0)" ::: "memory");
    const int c = lane & 7;
#pragma unroll
    for (int j = 0; j < 4; ++j) { const int n = (lane >> 3) + 8 * j; const LAS float* s = scr + (8 * c) * 33 + n;
        u32x4 o; o.x = cvt_pk_bf16(s[0 * 33], s[1 * 33]); o.y = cvt_pk_bf16(s[2 * 33], s[3 * 33]); o.z = cvt_pk_bf16(s[4 * 33], s[5 * 33]); o.w = cvt_pk_bf16(s[6 * 33], s[7 * 33]);
        *(u32x4*)(WT + (size_t)(n0 + n) * K + k0 + 8 * c) = o; }
    asm volatile("s_waitcnt lgkmcnt(0)" ::: "memory");
}
__device__ __forceinline__ int src_mixin(int n0) { const int pn = n0 >> 8, q = n0 & 255, grp = pn >> 1, half = pn & 1; if (grp > 1) return n0; const int bj = q >> 7, rr = q & 127, hl = rr >> 6, j = rr & 63; return grp * 512 + (half * 2 + hl) * 128 + bj * 64 + j; }
__device__ __forceinline__ int src_swiglu(int n0) { const int pn = n0 >> 8, q = n0 & 255, bj = q >> 7, rr = q & 127; return bj * FFN + pn * 128 + rr; }
__device__ __forceinline__ int src_uq(int n0) { const int pn = n0 >> 8, q = n0 & 255, bj = q >> 7, rr = q & 127; if (pn < 4) return (2 * pn + bj) * 192 + rr; const int hl = rr >> 5; return (4 * (pn - 4) + hl) * 192 + 128 + bj * 32 + (rr & 31); }

struct Args { const float* in[22]; float* out; unsigned char* ws; int ph_lo, ph_hi; };
enum Phase { PH_SETUP = 0, PH_ROWS1, PH_MIXIN, PH_SCAN1, PH_SCAN2, PH_SCAN3, PH_MIXOUT, PH_ROWS5, PH_FFNIN, PH_FFNOUT, PH_ROWS8, PH_DOWN, PH_PREP, PH_UQ, PH_UKV, PH_ATTN, PH_MLAOUT, PH_ROWS13, PH_ROUTE, PH_MOEIN, PH_MOEOUT, PH_ROWS17, PH_COUNT };

__global__ void __launch_bounds__(NTHREADS, 2) mega(Args args) {
    extern __shared__ __attribute__((aligned(16))) unsigned char lds_raw[];
    LAS unsigned char* lds = (LAS unsigned char*)lds_raw;
    volatile LAS unsigned* MISC = (volatile LAS unsigned*)(lds + MISC_OFF);
    const int tid = threadIdx.x, lane = tid & 63, wave = __builtin_amdgcn_readfirstlane(tid >> 6);
    const int G = gridDim.x, blk = blockIdx.x;
    unsigned char* ws = args.ws;
    for (int u = tid; u < (LDS_BYTES - MISC_OFF) / 4; u += NTHREADS) ((LAS unsigned*)(lds + MISC_OFF))[u] = 0u;
    __syncthreads();
    const int lo = args.ph_lo, hi = args.ph_hi;
    XcdBarrier bar; bar.bar = (unsigned*)(ws + WS_CTL) + 4096; bar.x = 0; bar.st = nullptr;
    if (hi - lo > 1) bar = xcd_barrier_post((unsigned*)(ws + WS_CTL) + 4096, MISC + 8);
#ifndef PHMASK
#define PHMASK 0xffffffffu
#endif
#define IN(k) (((PHMASK >> (k)) & 1u) && lo <= (k) && (k) < hi)
#define SEAM(k) do { if (IN(k) && IN((k) + 1)) xcd_barrier(bar); } while (0)
    const float* x = args.in[0]; const float* cvec = args.in[1]; const float* ctx = args.in[2]; const float* cctx = args.in[3];
    const float* mod_w = args.in[4]; const float* mod_b = args.in[5]; const float* norm_g = args.in[6]; const float* mix_in_w = args.in[7];
    const float* decay_logit = args.in[8]; const float* lb_logit = args.in[9]; const float* mix_out_w = args.in[10]; const float* ffn_in_w = args.in[11];
    const float* ffn_out_w = args.in[12]; const float* down_w = args.in[13]; const float* gq = args.in[14]; const float* gkv = args.in[15];
    const float* uq_w = args.in[16]; const float* ukv_w = args.in[17]; const float* mla_out_w = args.in[18]; const float* router_w = args.in[19];
    const float* moe_in_w = args.in[20]; const float* moe_out_w = args.in[21];
    float* out = args.out;
    float* modv = (float*)(ws + WS_MODV); float* lbv = (float*)(ws + WS_LB); float* lg = (float*)(ws + WS_LG); int* meta = (int*)(ws + WS_META);
    float* rc = (float*)(ws + WS_ROPE_RC); float* rs = (float*)(ws + WS_ROPE_RS); float* mc = (float*)(ws + WS_ROPE_MC); float* ms = (float*)(ws + WS_ROPE_MS);
    float* cx = (float*)(ws + WS_CX); bf16_t* HB = (bf16_t*)(ws + WS_HB); bf16_t* G0 = (bf16_t*)(ws + WS_G0);
    bf16_t* OX = (bf16_t*)(ws + WS_OX); bf16_t* ACT = (bf16_t*)(ws + WS_ACT);
    bf16_t* DOWN = (bf16_t*)(ws + WS_DOWN); bf16_t* QN = (bf16_t*)(ws + WS_QN); bf16_t* QR = (bf16_t*)(ws + WS_QR); bf16_t* KN = (bf16_t*)(ws + WS_KN); bf16_t* KR = (bf16_t*)(ws + WS_KR);
    bf16_t* Vv = (bf16_t*)(ws + WS_V); bf16_t* AO = (bf16_t*)(ws + WS_AO); bf16_t* Ob = (bf16_t*)(ws + WS_O); bf16_t* NQ = (bf16_t*)(ws + WS_NQ); bf16_t* NKV = (bf16_t*)(ws + WS_NKV);
    bf16_t* H4 = (bf16_t*)(ws + WS_H4); bf16_t* HS = (bf16_t*)(ws + WS_HS); bf16_t* ACT2 = (bf16_t*)(ws + WS_ACT2); bf16_t* YS = (bf16_t*)(ws + WS_YS);
    int* top_e = (int*)(ws + WS_TOPE); float* top_g = (float*)(ws + WS_TOPG); int* tslot = (int*)(ws + WS_TSLOT);
    bf16_t* Wmixin = (bf16_t*)(ws + WS_W_MIXIN); bf16_t* Wmixout = (bf16_t*)(ws + WS_W_MIXOUT); bf16_t* Wffnin = (bf16_t*)(ws + WS_W_FFNIN); bf16_t* Wffnout = (bf16_t*)(ws + WS_W_FFNOUT);
    bf16_t* Wdown = (bf16_t*)(ws + WS_W_DOWN); bf16_t* Wuq = (bf16_t*)(ws + WS_W_UQ); bf16_t* Wukv = (bf16_t*)(ws + WS_W_UKV); bf16_t* Wmlaout = (bf16_t*)(ws + WS_W_MLAOUT);
    bf16_t* Wmi = (bf16_t*)(ws + WS_WMI); bf16_t* Wmo = (bf16_t*)(ws + WS_WMO);
    const float* mv0 = modv; const float* mv1 = modv + 9 * 6144; const float* g0 = norm_g; const float* g1n = norm_g + 4 * 1024;
    const int gw = blk * NWAVES + wave, NGW = G * NWAVES;

    if (IN(PH_SETUP)) {
        for (int gid = blk * NTHREADS + tid; gid < 4096 * 64; gid += G * NTHREADS) tables_body(gid, lb_logit, decay_logit, rc, rs, mc, ms, lbv, lg);
        LAS float* sc = (LAS float*)(lds + RING_OFF);
        for (int i = tid; i < 9 * 1024; i += NTHREADS) { const int r = i >> 10, k = i & 1023; const float v = r < 8 ? cvec[r * 1024 + k] : cctx[k]; sc[i] = siluf(v); }
        __syncthreads();
        for (int col = blk * NTHREADS + tid; col < 12288; col += G * NTHREADS) {
            const int l = col / 6144, n = col % 6144;
            float acc[9];
#pragma unroll
            for (int r = 0; r < 9; ++r) acc[r] = 0.f;
            const float* w = mod_w + (size_t)l * 1024 * 6144 + n;
#pragma unroll 8
            for (int k = 0; k < 1024; ++k) { const float wv = w[(size_t)k * 6144];
#pragma unroll
                for (int r = 0; r < 9; ++r) acc[r] += sc[r * 1024 + k] * wv; }
            const float bb = mod_b[l * 6144 + n];
#pragma unroll
            for (int r = 0; r < 9; ++r) modv[((size_t)l * 9 + r) * 6144 + n] = acc[r] + bb;
        }
        __syncthreads();
        LAS float* scr = (LAS float*)(lds + RING_OFF + 40960 + wave * 8448);
        constexpr int I0 = 16 * 144, I1 = 16 * 32, I2 = 16 * 176, I3 = 44 * 32, I4 = 16 * 24, I5 = 6 * 48, I6 = 4 * 64, I7 = 16 * 32;
        for (int it = gw; it < I0 + I1 + I2 + I3 + I4 + I5 + I6 + I7; it += NGW) {
            int r = it;
            if (r < I0) { const int kb = r / 144, nb = r % 144; transpose_item(mix_in_w, MIXC, 1024, src_mixin(nb * 32), Wmixin, nb * 32, kb * 64, scr, lane); continue; } r -= I0;
            if (r < I1) { const int kb = r / 32, nb = r % 32; transpose_item(mix_out_w, 1024, 1024, nb * 32, Wmixout, nb * 32, kb * 64, scr, lane); continue; } r -= I1;
            if (r < I2) { const int kb = r / 176, nb = r % 176; transpose_item(ffn_in_w, 2 * FFN, 1024, src_swiglu(nb * 32), Wffnin, nb * 32, kb * 64, scr, lane); continue; } r -= I2;
            if (r < I3) { const int kb = r / 32, nb = r % 32; transpose_item(ffn_out_w, 1024, FFN, nb * 32, Wffnout, nb * 32, kb * 64, scr, lane); continue; } r -= I3;
            if (r < I4) { const int kb = r / 24, nb = r % 24; transpose_item(down_w, DOWNC, 1024, nb < 22 ? nb * 32 : -1, Wdown, nb * 32, kb * 64, scr, lane); continue; } r -= I4;
            if (r < I5) { const int kb = r / 48, nb = r % 48; transpose_item(uq_w, 1536, QRANK, src_uq(nb * 32), Wuq, nb * 32, kb * 64, scr, lane); continue; } r -= I5;
            if (r < I6) { const int kb = r / 64, nb = r % 64; transpose_item(ukv_w, 2048, KVRANK, nb * 32, Wukv, nb * 32, kb * 64, scr, lane); continue; } r -= I6;
            { const int kb = r / 32, nb = r % 32; transpose_item(mla_out_w, 1024, 1024, nb * 32, Wmlaout, nb * 32, kb * 64, scr, lane); }
        }
    }
    SEAM(PH_SETUP);
    if (IN(PH_ROWS1)) { RowArgs a{}; a.xin_lat = x; a.xin_ctx = ctx; a.gh = g0; a.scale = mv0 + 1024; a.shift = mv0; a.H = HB; a.nrows = R;
        for (int r = gw; r < R; r += NGW) rows_body(a, r, lane); }
    SEAM(PH_ROWS1);
    if (IN(PH_MIXIN)) { pg8::Gemm g{HB, Wmixin, D, D, D}; pg8::DenseOrder S; S.init(R / 256, MIXC / 256, G, blk); pg8::EpiMix E{G0, rc, rs, lbv};
        pg8::gemm_phase<pg8::EpiMix, pg8::DenseOrder, true>(lds + RING_OFF, g, S, E); }
    SEAM(PH_MIXIN);
    bf16_t* ST = (bf16_t*)(ws + scan::WS_STATE); float* DEC = (float*)(ws + scan::WS_DEC);
    if (IN(PH_SCAN1)) { for (int item = blk; item < 2 * NB * 4 * scan::NCH; item += G) scan::s1_item(item, G0, lg, ST, DEC, (LAS char*)(lds + RING_OFF)); }
    SEAM(PH_SCAN1);
    if (IN(PH_SCAN2)) { for (size_t v = (size_t)blk * NTHREADS + tid; v < (size_t)2 * NB * 4 * 2 * 2048; v += (size_t)G * NTHREADS) scan::s2_vec(v, ST, DEC); }
    SEAM(PH_SCAN2);
    if (IN(PH_SCAN3)) { for (int item = blk; item < 2 * NB * 4 * scan::NCH; item += G) scan::s3_item(item, G0, lg, ST, HB, (LAS char*)(lds + RING_OFF)); }
    SEAM(PH_SCAN3);
    if (IN(PH_MIXOUT)) { pg8::Gemm g{HB, Wmixout, D, D, D}; pg8::DenseOrder S; S.init(R / 256, D / 256, G, blk); pg8::EpiPlain E{OX, D};
        pg8::gemm_phase<pg8::EpiPlain, pg8::DenseOrder, true>(lds + RING_OFF, g, S, E); }
    SEAM(PH_MIXOUT);
    if (IN(PH_ROWS5)) { RowArgs a{}; a.xin_lat = x; a.xin_ctx = ctx; a.xout_lat = out; a.xout_ctx = cx; a.Y = OX; a.gy = g0 + 1024; a.gate = mv0 + 2048; a.gh = g0 + 2048; a.scale = mv0 + 4096; a.shift = mv0 + 3072; a.H = HB; a.nrows = R;
        for (int r = gw; r < R; r += NGW) rows_body(a, r, lane); }
    SEAM(PH_ROWS5);
    if (IN(PH_FFNIN)) { pg8::Gemm g{HB, Wffnin, D, D, D}; pg8::DenseOrder S; S.init(R / 256, 2 * FFN / 256, G, blk); pg8::EpiSwiglu E{ACT};
        pg8::gemm_phase<pg8::EpiSwiglu, pg8::DenseOrder, true>(lds + RING_OFF, g, S, E); }
    SEAM(PH_FFNIN);
    if (IN(PH_FFNOUT)) { pg8::Gemm g{ACT, Wffnout, FFN, FFN, FFN}; pg8::DenseOrder S; S.init(R / 256, D / 256, G, blk); pg8::EpiPlain E{OX, D};
        pg8::gemm_phase<pg8::EpiPlain, pg8::DenseOrder, true>(lds + RING_OFF, g, S, E); }
    SEAM(PH_FFNOUT);
    if (IN(PH_ROWS8)) { RowArgs a{}; a.xin_lat = out; a.xin_ctx = cx; a.xout_lat = out; a.xout_ctx = cx; a.Y = OX; a.gy = g0 + 3072; a.gate = mv0 + 5120; a.gh = g1n; a.scale = mv1 + 1024; a.shift = mv1; a.H = HB; a.nrows = R;
        for (int r = gw; r < R; r += NGW) rows_body(a, r, lane);
        LAS float* scr = (LAS float*)(lds + RING_OFF + wave * 8448);
        constexpr int J0 = 16 * 176, J1 = 44 * 32;
        for (int it = gw; it < 8 * (J0 + J1); it += NGW) {
            if (it < 8 * J0) { const int e = it / J0, r = it % J0, kb = r / 176, nb = r % 176; transpose_item(moe_in_w + (size_t)e * 1024 * 2 * FFN, 2 * FFN, 1024, src_swiglu(nb * 32), Wmi + (size_t)e * 2 * FFN * 1024, nb * 32, kb * 64, scr, lane); }
            else { const int q = it - 8 * J0, e = q / J1, r = q % J1, kb = r / 32, nb = r % 32; transpose_item(moe_out_w + (size_t)e * FFN * 1024, 1024, FFN, nb * 32, Wmo + (size_t)e * 1024 * FFN, nb * 32, kb * 64, scr, lane); }
        }
    }
    SEAM(PH_ROWS8);
    if (IN(PH_DOWN)) { pg8::Gemm g{HB, Wdown, D, D, D}; pg8::DenseOrder S; S.init(R / 256, DOWNP / 256, G, blk); pg8::EpiPlain E{DOWN, DOWNP};
        pg8::gemm_phase<pg8::EpiPlain, pg8::DenseOrder, true>(lds + RING_OFF, g, S, E); }
    SEAM(PH_DOWN);
    if (IN(PH_PREP)) { for (int r = gw; r < R; r += NGW) mla_prep_body(r, lane, DOWN, gq, gkv, mc, ms, NQ, NKV, KR); }
    SEAM(PH_PREP);
    if (IN(PH_UQ)) { pg8::Gemm g{NQ, Wuq, QRANK, QRANK, QRANK}; pg8::DenseOrder S; S.init(RL / 256, 1536 / 256, G, blk); pg8::EpiUQ E{QN, QR, mc, ms};
          pg8::gemm_phase<pg8::EpiUQ, pg8::DenseOrder, true>(lds + RING_OFF, g, S, E); }
    if (IN(PH_UKV)) { pg8::Gemm g{NKV, Wukv, KVRANK, KVRANK, KVRANK}; pg8::DenseOrder S; S.init(R / 256, 2048 / 256, G, blk); pg8::EpiUKV E{KN, Vv};
          pg8::gemm_phase<pg8::EpiUKV, pg8::DenseOrder, true>(lds + RING_OFF, g, S, E); }
    SEAM(PH_UKV);
    if (IN(PH_ATTN)) {
        for (int L = blk; L < NB * 8 * (T / 256); L += G) { const int xg = L & 7, jj = L >> 3, pair = xg * 8 + (jj >> 4), qb = jj & 15, b = pair >> 3, h = pair & 7;
            const size_t bh = (size_t)b * 8 + h;
            attn::attn_unit(QN + (bh * T + qb * 256) * 128, QR + (bh * T + qb * 256) * 64, KN + bh * KEYS * 128, KR + (size_t)b * KEYS * 64, Vv + bh * KEYS * 128,
                            AO + ((size_t)b * T + qb * 256) * 1024 + h * 128, KEYS, (LAS char*)(lds + RING_OFF)); }
    }
    SEAM(PH_ATTN);
    if (IN(PH_MLAOUT)) { pg8::Gemm g{AO, Wmlaout, D, D, D}; pg8::DenseOrder S; S.init(RL / 256, D / 256, G, blk); pg8::EpiPlain E{Ob, D};
        pg8::gemm_phase<pg8::EpiPlain, pg8::DenseOrder, true>(lds + RING_OFF, g, S, E); }
    SEAM(PH_MLAOUT);
    if (IN(PH_ROWS13)) { RowArgs a{}; a.xin_lat = out; a.xin_ctx = cx; a.xout_lat = out; a.xout_ctx = cx; a.Y = Ob; a.gy = g1n + 1024; a.gate = mv1 + 2048; a.gh = g1n + 2048; a.scale = mv1 + 4096; a.shift = mv1 + 3072; a.H = H4;
        a.router_w = router_w; a.top_e = top_e; a.top_g = top_g; a.nrows = RL;
        for (int r = gw; r < RL; r += NGW) rows_body(a, r, lane); }
    SEAM(PH_ROWS13);
    if (IN(PH_MOEIN)) {
        if (tid < 16) MISC[16 + tid] = (unsigned)meta[tid];
        __syncthreads();
        pg8::Gemm g{HS, Wmi, D, D, D}; pg8::MoeOrder S; S.init((const LAS int*)(lds + MISC_OFF + 64), 2 * FFN / 256, G, blk); pg8::EpiSwiglu E{ACT2};
        pg8::gemm_phase<pg8::EpiSwiglu, pg8::MoeOrder, true>(lds + RING_OFF, g, S, E); }
    SEAM(PH_MOEIN);
    if (IN(PH_MOEOUT)) {
        if (tid < 16) MISC[16 + tid] = (unsigned)meta[tid];
        __syncthreads();
        pg8::Gemm g{ACT2, Wmo, FFN, FFN, FFN}; pg8::MoeOrder S; S.init((const LAS int*)(lds + MISC_OFF + 64), D / 256, G, blk); pg8::EpiPlain E{YS, D};
        pg8::gemm_phase<pg8::EpiPlain, pg8::MoeOrder, true>(lds + RING_OFF, g, S, E); }
    SEAM(PH_MOEOUT);
    if (IN(PH_ROWS17)) { RowArgs a{}; a.xin_lat = out; a.xin_ctx = cx; a.xout_lat = out; a.xout_ctx = cx; a.Y = YS; a.tok_slot = tslot; a.tok_g = top_g; a.gy = g1n + 3072; a.gate = mv1 + 5120; a.nrows = RL;
        for (int r = gw; r < RL; r += NGW) rows_body(a, r, lane); }
#undef IN
#undef SEAM
}

static inline dim3 g1(size_t n, int per) { return dim3((unsigned)((n + per - 1) / per)); }
extern "C" void kernel_launch(void* const* d_in, const int* in_sizes, int n_in, void* d_out, int out_size, void* d_ws, size_t ws_size, hipStream_t stream) {
    if (n_in != 22 || out_size != RL * D || ws_size < WS_END) { fprintf(stderr, "kernel_launch: unexpected shapes: n_in %d out %d ws %zu (need %zu)\n", n_in, out_size, ws_size, (size_t)WS_END); return; }
    static int grid = 0;
    if (grid == 0) {
        int dev = 0, cus = 0;
        if (hipGetDevice(&dev) != hipSuccess || hipDeviceGetAttribute(&cus, hipDeviceAttributeMultiprocessorCount, dev) != hipSuccess) { grid = -1; return; }
        if (hipFuncSetAttribute((const void*)mega, hipFuncAttributeMaxDynamicSharedMemorySize, LDS_BYTES) != hipSuccess) { fprintf(stderr, "hipFuncSetAttribute failed\n"); grid = -1; return; }
        int per_cu = 0; (void)hipOccupancyMaxActiveBlocksPerMultiprocessor(&per_cu, (const void*)mega, NTHREADS, LDS_BYTES); (void)hipGetLastError();
        if (per_cu < 1) fprintf(stderr, "occupancy query says %d\n", per_cu);
        grid = cus;
    }
    if (grid < 0) return;
    char* ws = (char*)d_ws; float* out = (float*)d_out;
    float* lg = (float*)(ws + WS_LG); int* meta = (int*)(ws + WS_META);
    bf16_t* HB = (bf16_t*)(ws + WS_HB);
    bf16_t* G[9]; for (int i = 0; i < 9; ++i) G[i] = (bf16_t*)(ws + WS_G0 + i * GSZ);
    float* oret = (float*)(ws + WS_ST + 72 * MiB); float* ohg = (float*)(ws + WS_ST + 140 * MiB);
    bf16_t* QN = (bf16_t*)(ws + WS_QN); bf16_t* QR = (bf16_t*)(ws + WS_QR); bf16_t* KN = (bf16_t*)(ws + WS_KN); bf16_t* KR = (bf16_t*)(ws + WS_KR);
    bf16_t* Vv = (bf16_t*)(ws + WS_V); bf16_t* AO = (bf16_t*)(ws + WS_AO);
    bf16_t* H4 = (bf16_t*)(ws + WS_H4); bf16_t* HS = (bf16_t*)(ws + WS_HS);
    int* top_e = (int*)(ws + WS_TOPE); int* rank = (int*)(ws + WS_RANK); int* tslot = (int*)(ws + WS_TSLOT);
    (void)hipMemsetAsync(ws + WS_CTL, 0, 1 * MiB, stream);
    Args a{}; for (int i = 0; i < 22; ++i) a.in[i] = (const float*)d_in[i]; a.out = out; a.ws = (unsigned char*)d_ws;
    auto run = [&](int lo, int hi) { a.ph_lo = lo; a.ph_hi = hi; hipLaunchKernelGGL(mega, dim3(grid), dim3(NTHREADS), LDS_BYTES, stream, a); };
    for (int p = PH_SETUP; p <= PH_ROWS13; ++p) run(p, p + 1);
    hipLaunchKernelGGL(k_route_rank, dim3(8), dim3(1024), 0, stream, top_e, rank, meta);
    hipLaunchKernelGGL(k_route_base, dim3(1), dim3(64), 0, stream, meta);
    hipLaunchKernelGGL(k_gather, dim3(RL / 4), dim3(256), 0, stream, H4, top_e, rank, meta, HS, tslot);
    for (int p = PH_MOEIN; p <= PH_ROWS17; ++p) run(p, p + 1);
}
```

```cpp
#include <hip/hip_runtime.h>
#include <cstdint>
#include <cstdio>

constexpr int NB = 8, T = 4096, CT = 256, D = 1024;
constexpr int RL = NB * T;
constexpr int RC = NB * CT;
constexpr int R = RL + RC;
constexpr int KEYS = CT + T;
constexpr int MIXC = 4608, FFN = 2816, NEXP = 8;
constexpr int DOWNC = 704, DOWNP = 768, QRANK = 384, KVRANK = 256;
constexpr float EPS = 1e-6f;
constexpr int SLOTS = 2 * RL;

typedef unsigned short bf16_t;
__host__ __device__ __forceinline__ float bf2f(bf16_t v) { unsigned u = ((unsigned)v) << 16; float f; __builtin_memcpy(&f, &u, 4); return f; }
__host__ __device__ __forceinline__ bf16_t f2bf(float f) { unsigned u; __builtin_memcpy(&u, &f, 4); return (bf16_t)((u + 0x7fffu + ((u >> 16) & 1u)) >> 16); }
__device__ __forceinline__ float siluf(float v) { return v / (1.f + expf(-v)); }
__device__ __forceinline__ float wave_sum(float v) {
#pragma unroll
    for (int o = 1; o < 64; o <<= 1) v += __shfl_xor(v, o);
    return v;
}

constexpr size_t MiB = 1u << 20;
constexpr size_t WS_CTL = 0;
constexpr size_t WS_MODV = 512 * 1024;
constexpr size_t WS_LB = 1 * MiB + 512 * 1024;
constexpr size_t WS_LG = WS_LB + 4096;
constexpr size_t WS_META = WS_LB + 8192;
constexpr size_t WS_ROPE_RC = 2 * MiB;
constexpr size_t WS_ROPE_RS = 3 * MiB;
constexpr size_t WS_ROPE_MC = 4 * MiB;
constexpr size_t WS_ROPE_MS = 4 * MiB + 512 * 1024;
constexpr size_t WS_CX = 5 * MiB;
constexpr size_t WS_TOPE = 5 * MiB;
constexpr size_t WS_TOPG = 5 * MiB + 256 * 1024;
constexpr size_t WS_RANK = 5 * MiB + 512 * 1024;
constexpr size_t WS_TSLOT = 5 * MiB + 768 * 1024;
constexpr size_t WS_WSMALL = 13 * MiB;
constexpr size_t WS_HB = 48 * MiB;
constexpr size_t WS_G0 = 116 * MiB;
constexpr size_t GSZ = 34 * MiB;
constexpr size_t WS_ST = 422 * MiB;
constexpr size_t WS_OX = 116 * MiB;
constexpr size_t WS_ACT = 184 * MiB;
constexpr size_t WS_DOWN = 116 * MiB;
constexpr size_t WS_QN = 404 * MiB;
constexpr size_t WS_QR = 231 * MiB;
constexpr size_t WS_KN = 263 * MiB;
constexpr size_t WS_KR = 331 * MiB;
constexpr size_t WS_V = 336 * MiB;
constexpr size_t WS_AO = 468 * MiB;
constexpr size_t WS_O = 167 * MiB;
constexpr size_t WS_NQ = 167 * MiB;
constexpr size_t WS_NKV = 193 * MiB;
constexpr size_t WS_TMP1 = 575 * MiB;
constexpr size_t WS_H4 = 508 * MiB;
constexpr size_t WS_HS = 13 * MiB;
constexpr size_t WS_ACT2 = 145 * MiB;
constexpr size_t WS_YS = 13 * MiB;
constexpr size_t WS_END = 704 * MiB;

__global__ __launch_bounds__(256) void k_mod(const float* __restrict__ c, const float* __restrict__ cctx, const float* __restrict__ mod_w,
                                             const float* __restrict__ mod_b, float* __restrict__ modv) {
    __shared__ float sc[9 * 1024];
    for (int i = threadIdx.x; i < 9 * 1024; i += 256) { int r = i >> 10, k = i & 1023; float v = r < 8 ? c[r * 1024 + k] : cctx[k]; sc[i] = siluf(v); }
    __syncthreads();
    int gid = blockIdx.x * 256 + threadIdx.x; int l = gid / 6144, n = gid % 6144;
    float acc[9];
#pragma unroll
    for (int r = 0; r < 9; ++r) acc[r] = 0.f;
    const float* w = mod_w + (size_t)l * 1024 * 6144 + n;
    for (int k = 0; k < 1024; ++k) { float wv = w[(size_t)k * 6144];
#pragma unroll
        for (int r = 0; r < 9; ++r) acc[r] += sc[r * 1024 + k] * wv; }
    float bb = mod_b[l * 6144 + n];
#pragma unroll
    for (int r = 0; r < 9; ++r) modv[((size_t)l * 9 + r) * 6144 + n] = acc[r] + bb;
}
__device__ __forceinline__ void tables_body(const int gid, const float* __restrict__ lb_logit, const float* __restrict__ decay_logit, float* rc, float* rs, float* mc, float* ms, float* lb, float* lg) {
    if (gid < 4096 * 64) { int t = gid >> 6, j = gid & 63, i = j & 31; float pos = (float)(j < 32 ? (t >> 6) : (t & 63));
        float inv = powf(10000.f, -(float)i / 32.f); float a = pos * inv; rc[gid] = cosf(a); rs[gid] = sinf(a); }
    if (gid < 4096 * 32) { int t = gid >> 5, j = gid & 31, i = j & 15; float pos = (float)(j < 16 ? (t >> 6) : (t & 63));
        float inv = powf(10000.f, -(float)i / 16.f); float a = pos * inv; mc[gid] = cosf(a); ms[gid] = sinf(a); }
    if (gid < 512) { float l0 = lb_logit[gid], l1 = lb_logit[512 + gid]; float m = fmaxf(l0, l1); float e0 = expf(l0 - m), e1 = expf(l1 - m); lb[gid] = e0 / (e0 + e1); }
    if (gid < 8) { float x = decay_logit[gid]; lg[gid] = fminf(x, 0.f) - log1pf(expf(-fabsf(x))); }
}

__global__ __launch_bounds__(256) void k_tables(const float* __restrict__ lb_logit, const float* __restrict__ decay_logit, float* rc, float* rs, float* mc, float* ms, float* lb, float* lg) {
    tables_body(blockIdx.x * 256 + threadIdx.x, lb_logit, decay_logit, rc, rs, mc, ms, lb, lg);
}

struct RowArgs {
    const float* xin_lat; const float* xin_ctx;
    float* xout_lat; float* xout_ctx;
    const bf16_t* Y;
    const int* tok_slot; const float* tok_g;
    const float* gy;
    const float* gate;
    const float* gh; const float* scale; const float* shift;
    bf16_t* H;
    const float* router_w; int* top_e; float* top_g;
    int nrows;
};
__device__ __forceinline__ void rows_body(const RowArgs& a, const int r, const int lane) {
    const bool lat = r < RL; const int mr = lat ? (r >> 12) : 8;
    const float* xi = lat ? a.xin_lat + (size_t)r * D : a.xin_ctx + (size_t)(r - RL) * D;
    float x[16];
#pragma unroll
    for (int j = 0; j < 4; ++j) { float4 v = *(const float4*)(xi + j * 256 + lane * 4); x[4 * j] = v.x; x[4 * j + 1] = v.y; x[4 * j + 2] = v.z; x[4 * j + 3] = v.w; }
    if (a.Y) {
        float y[16];
        if (a.tok_slot) {
            const int s0 = a.tok_slot[2 * r], s1 = a.tok_slot[2 * r + 1]; const float g0 = a.tok_g[2 * r], g1 = a.tok_g[2 * r + 1];
#pragma unroll
            for (int j = 0; j < 4; ++j) { const uint2 u0 = *(const uint2*)(a.Y + (size_t)s0 * D + j * 256 + lane * 4); const uint2 u1 = *(const uint2*)(a.Y + (size_t)s1 * D + j * 256 + lane * 4);
                y[4 * j] = g0 * bf2f(u0.x & 0xffff) + g1 * bf2f(u1.x & 0xffff); y[4 * j + 1] = g0 * bf2f(u0.x >> 16) + g1 * bf2f(u1.x >> 16);
                y[4 * j + 2] = g0 * bf2f(u0.y & 0xffff) + g1 * bf2f(u1.y & 0xffff); y[4 * j + 3] = g0 * bf2f(u0.y >> 16) + g1 * bf2f(u1.y >> 16); }
        } else {
#pragma unroll
            for (int j = 0; j < 4; ++j) { const uint2 u = *(const uint2*)(a.Y + (size_t)r * D + j * 256 + lane * 4);
                y[4 * j] = bf2f(u.x & 0xffff); y[4 * j + 1] = bf2f(u.x >> 16); y[4 * j + 2] = bf2f(u.y & 0xffff); y[4 * j + 3] = bf2f(u.y >> 16); }
        }
        float ss = 0.f;
#pragma unroll
        for (int i = 0; i < 16; ++i) ss += y[i] * y[i];
        ss = wave_sum(ss); const float ry = rsqrtf(ss * (1.f / D) + EPS);
        float* xo = lat ? a.xout_lat + (size_t)r * D : a.xout_ctx + (size_t)(r - RL) * D;
#pragma unroll
        for (int j = 0; j < 4; ++j) { const int c = j * 256 + lane * 4; const float4 g = *(const float4*)(a.gy + c); const float4 gt = *(const float4*)(a.gate + (size_t)mr * 6144 + c);
            x[4 * j] += gt.x * (y[4 * j] * ry * g.x); x[4 * j + 1] += gt.y * (y[4 * j + 1] * ry * g.y); x[4 * j + 2] += gt.z * (y[4 * j + 2] * ry * g.z); x[4 * j + 3] += gt.w * (y[4 * j + 3] * ry * g.w);
            *(float4*)(xo + c) = make_float4(x[4 * j], x[4 * j + 1], x[4 * j + 2], x[4 * j + 3]); }
    }
    if (a.gh) {
        float ss = 0.f;
#pragma unroll
        for (int i = 0; i < 16; ++i) ss += x[i] * x[i];
        ss = wave_sum(ss); const float rx = rsqrtf(ss * (1.f / D) + EPS);
        float h[16];
#pragma unroll
        for (int j = 0; j < 4; ++j) { const int c = j * 256 + lane * 4; const float4 g = *(const float4*)(a.gh + c); const float4 sc = *(const float4*)(a.scale + (size_t)mr * 6144 + c); const float4 sh = *(const float4*)(a.shift + (size_t)mr * 6144 + c);
            h[4 * j] = x[4 * j] * rx * g.x * (1.f + sc.x) + sh.x; h[4 * j + 1] = x[4 * j + 1] * rx * g.y * (1.f + sc.y) + sh.y;
            h[4 * j + 2] = x[4 * j + 2] * rx * g.z * (1.f + sc.z) + sh.z; h[4 * j + 3] = x[4 * j + 3] * rx * g.w * (1.f + sc.w) + sh.w;
            uint2 o; o.x = (unsigned)f2bf(h[4 * j]) | ((unsigned)f2bf(h[4 * j + 1]) << 16); o.y = (unsigned)f2bf(h[4 * j + 2]) | ((unsigned)f2bf(h[4 * j + 3]) << 16);
            *(uint2*)(a.H + (size_t)r * D + c) = o; }
        if (a.router_w) {
            float lg[8];
#pragma unroll
            for (int e = 0; e < 8; ++e) lg[e] = 0.f;
#pragma unroll
            for (int j = 0; j < 4; ++j)
#pragma unroll
                for (int i = 0; i < 4; ++i) { const int c = j * 256 + lane * 4 + i; const float4 w0 = *(const float4*)(a.router_w + (size_t)c * 8); const float4 w1 = *(const float4*)(a.router_w + (size_t)c * 8 + 4); const float hv = h[4 * j + i];
                    lg[0] += hv * w0.x; lg[1] += hv * w0.y; lg[2] += hv * w0.z; lg[3] += hv * w0.w; lg[4] += hv * w1.x; lg[5] += hv * w1.y; lg[6] += hv * w1.z; lg[7] += hv * w1.w; }
#pragma unroll
            for (int e = 0; e < 8; ++e) lg[e] = wave_sum(lg[e]);
            if (lane == 0) {
                int e0 = 0; float v0 = lg[0];
#pragma unroll
                for (int e = 1; e < 8; ++e) if (lg[e] > v0) { v0 = lg[e]; e0 = e; }
                int e1 = -1; float v1 = -3.0e38f;
#pragma unroll
                for (int e = 0; e < 8; ++e) if (e != e0 && lg[e] > v1) { v1 = lg[e]; e1 = e; }
                if (e1 < 0) { e1 = (e0 + 1) & 7; v1 = v0; }
                const float g0 = 1.f / (1.f + expf(v1 - v0));
                a.top_e[2 * r] = e0; a.top_e[2 * r + 1] = e1; a.top_g[2 * r] = g0; a.top_g[2 * r + 1] = 1.f - g0;
            }
        }
    }
}

__global__ __launch_bounds__(256) void k_rows(RowArgs a) {
    const int lane = threadIdx.x & 63; const int r = blockIdx.x * 4 + (threadIdx.x >> 6);
    if (r >= a.nrows) return;
    rows_body(a, r, lane);
}

template <int MODE>
__global__ __launch_bounds__(256) void k_sgemm(const bf16_t* __restrict__ A, int lda, const float* __restrict__ W, int ldw, void* __restrict__ Cv, int ldc,
                                               int M, int N, int K, const int* __restrict__ meta, int e, size_t wstride, int row_off, int row_cap) {
    constexpr int NBW = (MODE == 2) ? 2 : 1;
    int arow0 = 0;
    if (meta) { arow0 = meta[e] + row_off; int cnt = meta[8 + e] - row_off; M = cnt < row_cap ? cnt : row_cap; W += (size_t)e * wstride; }
    const int bm = blockIdx.y * 128, bn = blockIdx.x * 64;
    if (bm >= M) return;
    __shared__ float As[16][132]; __shared__ float Bs[NBW][16][68];
    const int tid = threadIdx.x, tx = tid & 15, ty = tid >> 4;
    float acc[NBW][8][4];
#pragma unroll
    for (int w = 0; w < NBW; ++w)
#pragma unroll
        for (int i = 0; i < 8; ++i)
#pragma unroll
            for (int j = 0; j < 4; ++j) acc[w][i][j] = 0.f;
    const int ar = tid >> 1, ak = (tid & 1) * 8; const bool aval = (bm + ar) < M;
    const bf16_t* ap = A + (size_t)(arow0 + bm + (aval ? ar : 0)) * lda + ak;
    const int bk = tid >> 4, bc = (tid & 15) * 4; const bool bval = (bn + bc) < N;
    for (int k0 = 0; k0 < K; k0 += 16) {
        uint4 av = aval ? *(const uint4*)(ap + k0) : make_uint4(0, 0, 0, 0);
        As[ak + 0][ar] = bf2f(av.x & 0xffff); As[ak + 1][ar] = bf2f(av.x >> 16); As[ak + 2][ar] = bf2f(av.y & 0xffff); As[ak + 3][ar] = bf2f(av.y >> 16);
        As[ak + 4][ar] = bf2f(av.z & 0xffff); As[ak + 5][ar] = bf2f(av.z >> 16); As[ak + 6][ar] = bf2f(av.w & 0xffff); As[ak + 7][ar] = bf2f(av.w >> 16);
#pragma unroll
        for (int w = 0; w < NBW; ++w) { float4 bv = bval ? *(const float4*)(W + (size_t)(k0 + bk) * ldw + bn + bc + w * N) : make_float4(0, 0, 0, 0); *(float4*)&Bs[w][bk][bc] = bv; }
        __syncthreads();
#pragma unroll
        for (int kk = 0; kk < 16; ++kk) {
            float a[8]; const float4 a0 = *(const float4*)&As[kk][ty * 8], a1 = *(const float4*)&As[kk][ty * 8 + 4];
            a[0] = a0.x; a[1] = a0.y; a[2] = a0.z; a[3] = a0.w; a[4] = a1.x; a[5] = a1.y; a[6] = a1.z; a[7] = a1.w;
#pragma unroll
            for (int w = 0; w < NBW; ++w) { const float4 b = *(const float4*)&Bs[w][kk][tx * 4];
#pragma unroll
                for (int i = 0; i < 8; ++i) { acc[w][i][0] += a[i] * b.x; acc[w][i][1] += a[i] * b.y; acc[w][i][2] += a[i] * b.z; acc[w][i][3] += a[i] * b.w; } }
        }
        __syncthreads();
    }
#pragma unroll
    for (int i = 0; i < 8; ++i) { const int rr = bm + ty * 8 + i; if (rr >= M) continue;
#pragma unroll
        for (int j = 0; j < 4; ++j) { const int cc = bn + tx * 4 + j; if (cc >= N) continue;
            const size_t o = (size_t)(arow0 + rr) * ldc + cc;
            if (MODE == 0) ((float*)Cv)[o] = acc[0][i][j];
            else if (MODE == 1) ((bf16_t*)Cv)[o] = f2bf(acc[0][i][j]);
            else ((bf16_t*)Cv)[o] = f2bf(siluf(acc[0][i][j]) * acc[NBW - 1][i][j]); } }
}

__global__ __launch_bounds__(256) void k_mixact(const float* __restrict__ tmp, bf16_t* __restrict__ G, int grp, const float* __restrict__ rc, const float* __restrict__ rs, const float* __restrict__ lb) {
    const size_t gid = (size_t)blockIdx.x * 256 + threadIdx.x; if (gid >= (size_t)R * 512) return;
    const int r = (int)(gid >> 9), c = (int)(gid & 511); float v = tmp[gid], o;
    if (grp <= 1) {
        const int j = c & 127, jj = j & 63; const float other = tmp[(size_t)r * 512 + (c ^ 64)];
        float x1 = j < 64 ? v : other, x2 = j < 64 ? other : v;
        if (grp == 1) { x1 *= 0.08838834764831845f; x2 *= 0.08838834764831845f; }
        if (r < RL) { const int t = r & 4095; const float cs = rc[t * 64 + jj], sn = rs[t * 64 + jj]; o = j < 64 ? x1 * cs - x2 * sn : x1 * sn + x2 * cs; }
        else o = j < 64 ? x1 : x2;
    } else if (grp == 2 || grp == 7) o = v;
    else if (grp == 3 || grp == 4 || grp == 8) o = siluf(v);
    else { const float l = lb[c]; o = (1.f - l) / (1.f + expf(v)); }
    G[gid] = f2bf(o);
}
template <int ALGO>
__global__ __launch_bounds__(128) void k_scan_naive(const bf16_t* __restrict__ Q, const bf16_t* __restrict__ Kf, const bf16_t* __restrict__ Kb, const bf16_t* __restrict__ V,
                                                    const float* __restrict__ lg, float* __restrict__ O) {
    const int b = blockIdx.x >> 2, h = blockIdx.x & 3, e = threadIdx.x;
    __shared__ float sq[32][128]; __shared__ float sk[32][128];
    for (int dir = 0; dir < 2; ++dir) {
        const bf16_t* Kp = dir ? Kb : Kf; const float gamma = (ALGO == 0) ? expf(lg[dir * 4 + h]) : 0.f;
        float S[128];
#pragma unroll
        for (int d = 0; d < 128; ++d) S[d] = 0.f;
        for (int p0 = 0; p0 < KEYS; p0 += 32) {
            __syncthreads();
            for (int i = threadIdx.x; i < 32 * 128; i += 128) { const int s = i >> 7, d = i & 127; const int p = p0 + s;
                const int row = p < CT ? (RL + b * CT + (dir ? CT - 1 - p : p)) : (b * T + (dir ? T - 1 - (p - CT) : (p - CT)));
                sq[s][d] = bf2f(Q[(size_t)row * 512 + h * 128 + d]); sk[s][d] = bf2f(Kp[(size_t)row * 512 + h * 128 + d]); }
            __syncthreads();
            for (int s = 0; s < 32; ++s) { const int p = p0 + s;
                const int row = p < CT ? (RL + b * CT + (dir ? CT - 1 - p : p)) : (b * T + (dir ? T - 1 - (p - CT) : (p - CT)));
                const float v = bf2f(V[(size_t)row * 512 + h * 128 + e]); float o = 0.f;
#pragma unroll
                for (int d = 0; d < 128; ++d) { const float kd = sk[s][d]; const float dec = (ALGO == 0) ? gamma : (1.f - kd); S[d] = dec * S[d] + kd * v; o += sq[s][d] * S[d]; }
                float* op = O + (size_t)row * 512 + h * 128 + e; if (dir == 0) *op = o; else *op += o; }
        }
    }
}
__global__ __launch_bounds__(256) void k_merge(const float* __restrict__ Oret, const float* __restrict__ Ohg, const bf16_t* __restrict__ AG, const bf16_t* __restrict__ BG, bf16_t* __restrict__ Y, int part_sel) {
    const int lane = threadIdx.x & 63; const size_t w = (size_t)blockIdx.x * 4 + (threadIdx.x >> 6); if (w >= (size_t)R * 8) return;
    const int r = (int)(w >> 3), part = (int)((w >> 2) & 1), h = (int)(w & 3);
    if (part_sel >= 0 && part != part_sel) return;
    const float* src = (part ? Ohg : Oret) + (size_t)r * 512 + h * 128; const bf16_t* g = (part ? BG : AG) + (size_t)r * 512 + h * 128;
    const float v0 = src[lane * 2], v1 = src[lane * 2 + 1]; const float ss = wave_sum(v0 * v0 + v1 * v1); const float rr = rsqrtf(ss * (1.f / 128.f) + EPS);
    bf16_t* y = Y + (size_t)r * 1024 + part * 512 + h * 128;
    y[lane * 2] = f2bf(v0 * rr * bf2f(g[lane * 2])); y[lane * 2 + 1] = f2bf(v1 * rr * bf2f(g[lane * 2 + 1]));
}

__device__ __forceinline__ void mla_prep_body(const int r, const int lane, const bf16_t* __restrict__ DOWN, const float* __restrict__ gq, const float* __restrict__ gkv, const float* __restrict__ mc, const float* __restrict__ ms,
                                                  bf16_t* __restrict__ NQ, bf16_t* __restrict__ NKV, bf16_t* __restrict__ KR) {
    const bf16_t* d = DOWN + (size_t)r * DOWNP;
    float q[6]; float ss = 0.f;
#pragma unroll
    for (int i = 0; i < 6; ++i) { q[i] = bf2f(d[lane + 64 * i]); ss += q[i] * q[i]; }
    ss = wave_sum(ss); const float rq = rsqrtf(ss * (1.f / 384.f) + EPS);
#pragma unroll
    for (int i = 0; i < 6; ++i) NQ[(size_t)r * 384 + lane + 64 * i] = f2bf(q[i] * rq * gq[lane + 64 * i]);
    float k[4]; ss = 0.f;
#pragma unroll
    for (int i = 0; i < 4; ++i) { k[i] = bf2f(d[384 + lane + 64 * i]); ss += k[i] * k[i]; }
    ss = wave_sum(ss); const float rk = rsqrtf(ss * (1.f / 256.f) + EPS);
#pragma unroll
    for (int i = 0; i < 4; ++i) NKV[(size_t)r * 256 + lane + 64 * i] = f2bf(k[i] * rk * gkv[lane + 64 * i]);
    const float x1 = bf2f(d[640 + (lane & 31)]), x2 = bf2f(d[672 + (lane & 31)]);
    const bool lat = r < RL; const int b = lat ? (r >> 12) : ((r - RL) >> 8); const int key = lat ? CT + (r & 4095) : ((r - RL) & 255);
    float o;
    if (lat) { const int t = r & 4095; const float cs = mc[t * 32 + (lane & 31)], sn = ms[t * 32 + (lane & 31)]; o = lane < 32 ? x1 * cs - x2 * sn : x1 * sn + x2 * cs; }
    else o = lane < 32 ? x1 : x2;
    KR[((size_t)b * KEYS + key) * 64 + lane] = f2bf(o);
}
__global__ __launch_bounds__(256) void k_mla_prep(const bf16_t* __restrict__ DOWN, const float* __restrict__ gq, const float* __restrict__ gkv, const float* __restrict__ mc, const float* __restrict__ ms,
                                                  bf16_t* __restrict__ NQ, bf16_t* __restrict__ NKV, bf16_t* __restrict__ KR) {
    const int lane = threadIdx.x & 63; const int r = blockIdx.x * 4 + (threadIdx.x >> 6); if (r >= R) return;
    mla_prep_body(r, lane, DOWN, gq, gkv, mc, ms, NQ, NKV, KR);
}
__global__ __launch_bounds__(256) void k_qsplit(const float* __restrict__ tmp, int r0, int nrows, const float* __restrict__ mc, const float* __restrict__ ms, bf16_t* __restrict__ QN, bf16_t* __restrict__ QR) {
    const size_t gid = (size_t)blockIdx.x * 256 + threadIdx.x; if (gid >= (size_t)nrows * 1536) return;
    const int rr = (int)(gid / 1536), c = (int)(gid % 1536), h = c / 192, j = c % 192; const int r = r0 + rr, b = r >> 12, t = r & 4095;
    const float v = tmp[gid];
    if (j < 128) QN[(((size_t)b * 8 + h) * T + t) * 128 + j] = f2bf(v);
    else { const int jr = j - 128, jj = jr & 31; const float other = tmp[(size_t)rr * 1536 + h * 192 + 128 + (jr ^ 32)];
        const float x1 = jr < 32 ? v : other, x2 = jr < 32 ? other : v; const float cs = mc[t * 32 + jj], sn = ms[t * 32 + jj];
        QR[(((size_t)b * 8 + h) * T + t) * 64 + jr] = f2bf(jr < 32 ? x1 * cs - x2 * sn : x1 * sn + x2 * cs); }
}
__global__ __launch_bounds__(256) void k_kvsplit(const float* __restrict__ tmp, int r0, int nrows, bf16_t* __restrict__ KN, bf16_t* __restrict__ Vv) {
    const size_t gid = (size_t)blockIdx.x * 256 + threadIdx.x; if (gid >= (size_t)nrows * 2048) return;
    const int rr = (int)(gid >> 11), c = (int)(gid & 2047), h = c >> 8, j = c & 255; const int r = r0 + rr;
    const bool lat = r < RL; const int b = lat ? (r >> 12) : ((r - RL) >> 8); const int key = lat ? CT + (r & 4095) : ((r - RL) & 255);
    bf16_t* dst = (j < 128 ? KN : Vv) + (((size_t)b * 8 + h) * KEYS + key) * 128 + (j & 127);
    *dst = f2bf(tmp[gid]);
}
__global__ __launch_bounds__(256) void k_attn_naive(const bf16_t* __restrict__ QN, const bf16_t* __restrict__ QR, const bf16_t* __restrict__ KN, const bf16_t* __restrict__ KR, const bf16_t* __restrict__ Vv, bf16_t* __restrict__ AO) {
    __shared__ float sq[2][192]; __shared__ float sc[2][KEYS]; __shared__ float red[2][4];
    const int tid = threadIdx.x; const int qb = blockIdx.x % (T / 2), h = (blockIdx.x / (T / 2)) & 7, b = blockIdx.x / (T / 2 * 8);
    const int t0 = qb * 2; const size_t bh = (size_t)b * 8 + h;
    for (int i = tid; i < 2 * 192; i += 256) { const int q = i / 192, j = i % 192; sq[q][j] = j < 128 ? bf2f(QN[(bh * T + t0 + q) * 128 + j]) : bf2f(QR[(bh * T + t0 + q) * 64 + j - 128]); }
    __syncthreads();
    const float scale = 0.07216878364870322f;
    float m0 = -3e38f, m1 = -3e38f;
    for (int key = tid; key < KEYS; key += 256) {
        const uint4* kn = (const uint4*)(KN + (bh * KEYS + key) * 128); const uint4* kr = (const uint4*)(KR + ((size_t)b * KEYS + key) * 64);
        float s0 = 0.f, s1 = 0.f;
        for (int c = 0; c < 24; ++c) { const uint4 u = c < 16 ? kn[c] : kr[c - 16]; const int j = c * 8;
            const float k0 = bf2f(u.x & 0xffff), k1 = bf2f(u.x >> 16), k2 = bf2f(u.y & 0xffff), k3 = bf2f(u.y >> 16), k4 = bf2f(u.z & 0xffff), k5 = bf2f(u.z >> 16), k6 = bf2f(u.w & 0xffff), k7 = bf2f(u.w >> 16);
            s0 += sq[0][j] * k0 + sq[0][j + 1] * k1 + sq[0][j + 2] * k2 + sq[0][j + 3] * k3 + sq[0][j + 4] * k4 + sq[0][j + 5] * k5 + sq[0][j + 6] * k6 + sq[0][j + 7] * k7;
            s1 += sq[1][j] * k0 + sq[1][j + 1] * k1 + sq[1][j + 2] * k2 + sq[1][j + 3] * k3 + sq[1][j + 4] * k4 + sq[1][j + 5] * k5 + sq[1][j + 6] * k6 + sq[1][j + 7] * k7; }
        s0 *= scale; s1 *= scale; sc[0][key] = s0; sc[1][key] = s1; m0 = fmaxf(m0, s0); m1 = fmaxf(m1, s1);
    }
#pragma unroll
    for (int o = 1; o < 64; o <<= 1) { m0 = fmaxf(m0, __shfl_xor(m0, o)); m1 = fmaxf(m1, __shfl_xor(m1, o)); }
    if ((tid & 63) == 0) { red[0][tid >> 6] = m0; red[1][tid >> 6] = m1; }
    __syncthreads();
    m0 = fmaxf(fmaxf(red[0][0], red[0][1]), fmaxf(red[0][2], red[0][3])); m1 = fmaxf(fmaxf(red[1][0], red[1][1]), fmaxf(red[1][2], red[1][3]));
    __syncthreads();
    float l0 = 0.f, l1 = 0.f;
    for (int key = tid; key < KEYS; key += 256) { const float p0 = expf(sc[0][key] - m0), p1 = expf(sc[1][key] - m1); sc[0][key] = p0; sc[1][key] = p1; l0 += p0; l1 += p1; }
    l0 = wave_sum(l0); l1 = wave_sum(l1);
    if ((tid & 63) == 0) { red[0][tid >> 6] = l0; red[1][tid >> 6] = l1; }
    __syncthreads();
    l0 = red[0][0] + red[0][1] + red[0][2] + red[0][3]; l1 = red[1][0] + red[1][1] + red[1][2] + red[1][3];
    const int q = tid >> 7, d = tid & 127; const float* p = sc[q]; float o = 0.f;
    const bf16_t* vp = Vv + bh * KEYS * 128 + d;
    for (int key = 0; key < KEYS; ++key) o += p[key] * bf2f(vp[(size_t)key * 128]);
    AO[((size_t)b * T + t0 + q) * 1024 + h * 128 + d] = f2bf(o / (q ? l1 : l0));
}

__global__ __launch_bounds__(1024) void k_route_rank(const int* __restrict__ top_e, int* __restrict__ rank, int* __restrict__ meta) {
    __shared__ int ws[16]; __shared__ int running;
    const int e = blockIdx.x, tid = threadIdx.x, lane = tid & 63, wid = tid >> 6;
    if (tid == 0) running = 0;
    __syncthreads();
    for (int t0 = 0; t0 < RL; t0 += 1024) { const int t = t0 + tid; const int e0 = top_e[2 * t], e1 = top_e[2 * t + 1]; const int f = (e0 == e || e1 == e) ? 1 : 0;
        const unsigned long long bal = __ballot(f); const int pre = __popcll(bal & ((1ull << lane) - 1ull));
        if (lane == 0) ws[wid] = __popcll(bal);
        __syncthreads();
        int off = 0; for (int w = 0; w < wid; ++w) off += ws[w];
        int tot = 0; for (int w = 0; w < 16; ++w) tot += ws[w];
        const int base = running;
        if (f) rank[2 * t + (e0 == e ? 0 : 1)] = base + off + pre;
        __syncthreads();
        if (tid == 0) running = base + tot;
        __syncthreads();
    }
    if (tid == 0) meta[8 + e] = running;
}
__global__ void k_route_base(int* meta) { if (threadIdx.x == 0) { int s = 0; for (int e = 0; e < 8; ++e) { meta[e] = s; s += meta[8 + e]; } } }
__global__ __launch_bounds__(256) void k_gather(const bf16_t* __restrict__ H4, const int* __restrict__ top_e, const int* __restrict__ rank, const int* __restrict__ meta, bf16_t* __restrict__ HS, int* __restrict__ tok_slot) {
    const int lane = threadIdx.x & 63; const int t = blockIdx.x * 4 + (threadIdx.x >> 6); if (t >= RL) return;
    const uint4 v0 = *(const uint4*)(H4 + (size_t)t * D + lane * 8), v1 = *(const uint4*)(H4 + (size_t)t * D + 512 + lane * 8);
#pragma unroll
    for (int k = 0; k < 2; ++k) { const int e = top_e[2 * t + k]; const int slot = meta[e] + rank[2 * t + k];
        *(uint4*)(HS + (size_t)slot * D + lane * 8) = v0; *(uint4*)(HS + (size_t)slot * D + 512 + lane * 8) = v1;
        if (lane == 0) tok_slot[2 * t + k] = slot; }
}


#define LAS __attribute__((address_space(3)))
#define GAS __attribute__((address_space(1)))
typedef short bf16x8 __attribute__((ext_vector_type(8)));
typedef float f32x4 __attribute__((ext_vector_type(4)));
typedef float f32x2 __attribute__((ext_vector_type(2)));
typedef unsigned u32x4 __attribute__((ext_vector_type(4)));
typedef unsigned u32x2 __attribute__((ext_vector_type(2)));
constexpr size_t WS_WMI = 572 * MiB;
constexpr size_t WS_WMO = 660 * MiB;
constexpr size_t WS_W_MIXIN = WS_WSMALL;
constexpr size_t WS_W_MIXOUT = WS_W_MIXIN + 9 * MiB;
constexpr size_t WS_W_FFNIN = WS_W_MIXOUT + 2 * MiB;
constexpr size_t WS_W_FFNOUT = WS_W_FFNIN + 11 * MiB;
constexpr size_t WS_W_DOWN = WS_W_FFNOUT + 5632 * 1024;
constexpr size_t WS_W_UQ = WS_W_DOWN + 1536 * 1024;
constexpr size_t WS_W_UKV = WS_W_UQ + 1152 * 1024;
constexpr size_t WS_W_MLAOUT = WS_W_UKV + 1 * MiB;
static_assert(WS_W_MLAOUT + 2 * MiB <= WS_HB, "small weights fit");

typedef float f32x2_cv __attribute__((ext_vector_type(2))); typedef __bf16 bf16x2_cv __attribute__((ext_vector_type(2)));
__device__ __forceinline__ unsigned cvt_pk_bf16(float lo, float hi) { const f32x2_cv v = {lo, hi}; const bf16x2_cv b = __builtin_convertvector(v, bf16x2_cv); return __builtin_bit_cast(unsigned, b); }
__device__ __forceinline__ float fast_silu(float v) { return v * __builtin_amdgcn_rcpf(1.f + __expf(-v)); }

namespace pg8 {
constexpr int BM = 256, BK = 64, HALF = 128, HTB = HALF * BK * 2  , STAGE_BYTES = 8 * HTB, NXCD = 8, WGM = 8;
__host__ __device__ __forceinline__ int lds_byte(int r, int c) { const int st = (r >> 4) * 2 + (c >> 5), rr = r & 15, cc = c & 31, ob = rr * 64 + cc * 2; return st * 1024 + (ob ^ (((ob >> 9) & 1) << 5)); }
__host__ __device__ __forceinline__ void stage_rc(int b, int& R_, int& C_) { const int st = b / 1024, sb = b % 1024, swz = sb ^ (((sb >> 9) & 1) << 5); R_ = (st >> 1) * 16 + swz / 64; C_ = (st & 1) * 32 + (swz % 64) / 2; }
__host__ __device__ __forceinline__ int perm32(int rho) { const int n = rho >> 4, i = rho & 15; return 8 * (i >> 2) + 4 * n + (i & 3); }

struct Unit { int arow, brow, pm, pn, rend; };
struct Gemm { const bf16_t* A; const bf16_t* Bt; int lda, ldb, K; };

struct DenseOrder {
    int nM, nN, nwg, G, c;
    __device__ void init(int nM_, int nN_, int G_, int c_) { nM = nM_; nN = nN_; nwg = nM * nN; G = G_; c = c_; }
    __device__ bool next(int i, Unit& u) const {
        const long L = (long)i * G + c; if (L >= nwg) return false;
        int wgid = (int)L; { const int q = nwg / NXCD, r = nwg % NXCD, xcd = wgid % NXCD, off = wgid / NXCD; wgid = (xcd < r ? xcd * (q + 1) : r * (q + 1) + (xcd - r) * q) + off; }
        const int nig = WGM * nN, gid = wgid / nig, fm = gid * WGM, gsz = (nM - fm) < WGM ? (nM - fm) : WGM;
        u.pm = fm + ((wgid % nig) % gsz); u.pn = (wgid % nig) / gsz; u.arow = u.pm * BM; u.brow = u.pn * BM; u.rend = 0x7fffffff; return true;
    }
    __device__ __forceinline__ void a_ready(const Unit&) const {}
    __device__ __forceinline__ void done(const Unit&) const {}
};
struct MoeOrder {
    const LAS int* meta; int nN, G, c, nwg;
    __device__ void init(const LAS int* meta_, int nN_, int G_, int c_) { meta = meta_; nN = nN_; G = G_; c = c_; int s = 0;
#pragma unroll
        for (int e = 0; e < 8; ++e) s += ((meta[8 + e] + 255) >> 8) * nN; nwg = s; }
    __device__ bool next(int i, Unit& u) const {
        const long L = (long)i * G + c; if (L >= nwg) return false;
        int wgid = (int)L; { const int q = nwg / NXCD, r = nwg % NXCD, xcd = wgid % NXCD, off = wgid / NXCD; wgid = (xcd < r ? xcd * (q + 1) : r * (q + 1) + (xcd - r) * q) + off; }
        int e = -1, nM = 1, base = 0, cnt = 0;
#pragma unroll
        for (int k = 0; k < 8; ++k) { const int ck = meta[8 + k], tk = (ck + 255) >> 8, uk = tk * nN; if (e < 0) { if (wgid < uk) { e = k; nM = tk; base = meta[k]; cnt = ck; } else wgid -= uk; } }
        if (e < 0) return false;
        const int nig = WGM * nN, gid = wgid / nig, fm = gid * WGM, gsz = (nM - fm) < WGM ? (nM - fm) : WGM;
        u.pm = fm + ((wgid % nig) % gsz); u.pn = (wgid % nig) / gsz; u.arow = base + u.pm * BM; u.brow = (e * nN + u.pn) * BM; u.rend = base + cnt; return true;
    }
    __device__ __forceinline__ void a_ready(const Unit&) const {}
    __device__ __forceinline__ void done(const Unit&) const {}
};

#define EPI_ROWS(...) _Pragma("unroll") for (int ai = 0; ai < 2; ++ai) _Pragma("unroll") for (int m = 0; m < 4; ++m) { const int row = u.arow + ai * HALF + wr * 64 + m * 16 + fr; __VA_ARGS__ }
__device__ __forceinline__ u32x4 pack8(const f32x4 a, const f32x4 b) { u32x4 w; w.x = cvt_pk_bf16(a[0], a[1]); w.y = cvt_pk_bf16(a[2], a[3]); w.z = cvt_pk_bf16(b[0], b[1]); w.w = cvt_pk_bf16(b[2], b[3]); return w; }

struct EpiPlain {
    static constexpr bool PERM = true, AFTER_DRAIN = false;
    bf16_t* O; int ldc;
    __device__ __forceinline__ void operator()(const f32x4 (&acc)[2][2][4][2], const Unit& u, int wr, int wc, int fr, int fq) const {
        const int col0 = u.pn * BM + wc * 32 + fq * 8;
        EPI_ROWS( if (row < u.rend) { bf16_t* rowp = O + (size_t)row * ldc + col0;
            _Pragma("unroll") for (int bj = 0; bj < 2; ++bj) *(u32x4*)(rowp + bj * HALF) = pack8(acc[ai][bj][m][0], acc[ai][bj][m][1]); } )
    }
};
struct EpiSwiglu {
    static constexpr bool PERM = true, AFTER_DRAIN = false;
    bf16_t* O;
    __device__ __forceinline__ void operator()(const f32x4 (&acc)[2][2][4][2], const Unit& u, int wr, int wc, int fr, int fq) const {
        const int col0 = u.pn * HALF + wc * 32 + fq * 8;
        EPI_ROWS( if (row < u.rend) { f32x4 o0, o1;
            _Pragma("unroll") for (int i = 0; i < 4; ++i) { o0[i] = fast_silu(acc[ai][0][m][0][i]) * acc[ai][1][m][0][i]; o1[i] = fast_silu(acc[ai][0][m][1][i]) * acc[ai][1][m][1][i]; }
            *(u32x4*)(O + (size_t)row * FFN + col0) = pack8(o0, o1); } )
    }
};
struct EpiMix {
    static constexpr bool PERM = true, AFTER_DRAIN = false;
    bf16_t* G0; const float* rc; const float* rs; const float* lb;
    __device__ __forceinline__ void operator()(const f32x4 (&acc)[2][2][4][2], const Unit& u, int wr, int wc, int fr, int fq) const {
        const int grp = u.pn >> 1, half = u.pn & 1; bf16_t* Gp = G0 + (size_t)grp * (GSZ / 2);
        if (grp <= 1) {
            const int head = half * 2 + (wc >> 1), jb = (wc & 1) * 32 + fq * 8; const float sc = grp == 1 ? 0.08838834764831845f : 1.f;
            EPI_ROWS( f32x4 a0 = acc[ai][0][m][0] * sc, a1 = acc[ai][0][m][1] * sc, b0 = acc[ai][1][m][0] * sc, b1 = acc[ai][1][m][1] * sc; f32x4 o0, o1, p0, p1;
                if (row < RL) { const int t = row & 4095; const f32x4 c0 = *(const f32x4*)(rc + t * 64 + jb), c1 = *(const f32x4*)(rc + t * 64 + jb + 4), s0 = *(const f32x4*)(rs + t * 64 + jb), s1 = *(const f32x4*)(rs + t * 64 + jb + 4);
                    o0 = a0 * c0 - b0 * s0; o1 = a1 * c1 - b1 * s1; p0 = a0 * s0 + b0 * c0; p1 = a1 * s1 + b1 * c1; }
                else { o0 = a0; o1 = a1; p0 = b0; p1 = b1; }
                bf16_t* dst = Gp + (size_t)row * 512 + head * 128 + jb; *(u32x4*)dst = pack8(o0, o1); *(u32x4*)(dst + 64) = pack8(p0, p1); )
        } else {
            const int cb = half * 256 + wc * 32 + fq * 8;
            EPI_ROWS( _Pragma("unroll") for (int bj = 0; bj < 2; ++bj) { f32x4 v0 = acc[ai][bj][m][0], v1 = acc[ai][bj][m][1]; const int c = cb + bj * HALF;
                if (grp == 3 || grp == 4 || grp == 8) { _Pragma("unroll") for (int i = 0; i < 4; ++i) { v0[i] = fast_silu(v0[i]); v1[i] = fast_silu(v1[i]); } }
                else if (grp == 5 || grp == 6) { const f32x4 l0 = *(const f32x4*)(lb + c), l1 = *(const f32x4*)(lb + c + 4);
                    _Pragma("unroll") for (int i = 0; i < 4; ++i) { v0[i] = (1.f - l0[i]) * __builtin_amdgcn_rcpf(1.f + __expf(v0[i])); v1[i] = (1.f - l1[i]) * __builtin_amdgcn_rcpf(1.f + __expf(v1[i])); } }
                *(u32x4*)(Gp + (size_t)row * 512 + c) = pack8(v0, v1); } )
        }
    }
};
struct EpiUQ {
    static constexpr bool PERM = true, AFTER_DRAIN = false;
    bf16_t* QN; bf16_t* QR; const float* mc; const float* ms;
    __device__ __forceinline__ void operator()(const f32x4 (&acc)[2][2][4][2], const Unit& u, int wr, int wc, int fr, int fq) const {
        if (u.pn < 4) {
            EPI_ROWS( const int b = row >> 12, t = row & 4095;
                _Pragma("unroll") for (int bj = 0; bj < 2; ++bj) { const int h = 2 * u.pn + bj; *(u32x4*)(QN + (((size_t)b * 8 + h) * T + t) * 128 + wc * 32 + fq * 8) = pack8(acc[ai][bj][m][0], acc[ai][bj][m][1]); } )
        } else {
            const int h = 4 * (u.pn - 4) + wc, jb = fq * 8;
            EPI_ROWS( const int b = row >> 12, t = row & 4095; const f32x4 a0 = acc[ai][0][m][0], a1 = acc[ai][0][m][1], b0 = acc[ai][1][m][0], b1 = acc[ai][1][m][1];
                const f32x4 c0 = *(const f32x4*)(mc + t * 32 + jb), c1 = *(const f32x4*)(mc + t * 32 + jb + 4), s0 = *(const f32x4*)(ms + t * 32 + jb), s1 = *(const f32x4*)(ms + t * 32 + jb + 4);
                bf16_t* dst = QR + (((size_t)b * 8 + h) * T + t) * 64 + jb; *(u32x4*)dst = pack8(a0 * c0 - b0 * s0, a1 * c1 - b1 * s1); *(u32x4*)(dst + 32) = pack8(a0 * s0 + b0 * c0, a1 * s1 + b1 * c1); )
        }
    }
};
struct EpiUKV {
    static constexpr bool PERM = true, AFTER_DRAIN = false;
    bf16_t* KN; bf16_t* V;
    __device__ __forceinline__ void operator()(const f32x4 (&acc)[2][2][4][2], const Unit& u, int wr, int wc, int fr, int fq) const {
        EPI_ROWS( const bool lat = row < RL; const int b = lat ? (row >> 12) : ((row - RL) >> 8); const int key = lat ? CT + (row & 4095) : ((row - RL) & 255);
            const size_t off = (((size_t)b * 8 + u.pn) * KEYS + key) * 128 + wc * 32 + fq * 8;
            *(u32x4*)(KN + off) = pack8(acc[ai][0][m][0], acc[ai][0][m][1]); *(u32x4*)(V + off) = pack8(acc[ai][1][m][0], acc[ai][1][m][1]); )
    }
};

template <class Epi, class Sched, bool ALIGN_EPI>
__device__ __forceinline__ void gemm_phase(LAS unsigned char* lds, const Gemm g, const Sched& S, const Epi& E) {
    const int tid = threadIdx.x, wid = __builtin_amdgcn_readfirstlane(tid >> 6), lane = tid & 63, wr = wid >> 2, wc = wid & 3, fr = lane & 15, fq = lane >> 4;
    const int K = g.K, nt = K / BK;
    unsigned voffA[2], voffB[2];
#pragma unroll
    for (int i = 0; i < 2; ++i) { int R_, C_; stage_rc(tid * 16 + i * 8192, R_, C_); const int Rb = Epi::PERM ? ((R_ & ~31) + perm32(R_ & 31)) : R_;
        voffA[i] = (unsigned)(R_ * g.lda + C_) * 2u; voffB[i] = (unsigned)(Rb * g.ldb + C_) * 2u; }
    const size_t kstep = (size_t)(BK * 2);
    const size_t hstepA = (size_t)HALF * g.lda * 2, hstepB = (size_t)HALF * g.ldb * 2;
    const unsigned ldsw = (unsigned)wid * 1024u;
    const int aoff = lds_byte(wr * 64 + fr, fq * 8), boff = lds_byte(wc * 32 + fr, fq * 8);
#define PG8_SA(b, h) (((b) * 2 + (h)) * HTB)
#define PG8_SB(b, h) ((4 + (b) * 2 + (h)) * HTB)
#define PG8_STAGE(bufoff, gbase, voff) do { _Pragma("unroll") for (int _i = 0; _i < 2; ++_i) \
        __builtin_amdgcn_global_load_lds((const unsigned*)((const char*)(gbase) + (voff)[_i]), (LAS unsigned*)(lds + (bufoff) + ldsw + _i * 8192), 16, 0, 0); } while (0)
#define PG8_LDA(dst, b, h) do { _Pragma("unroll") for (int m = 0; m < 4; ++m) _Pragma("unroll") for (int k = 0; k < 2; ++k) dst[m][k] = *(const LAS bf16x8*)(lds + PG8_SA(b, h) + aoff + m * 2048 + k * 1024); } while (0)
#define PG8_LDB(dst, b, h) do { _Pragma("unroll") for (int n = 0; n < 2; ++n) _Pragma("unroll") for (int k = 0; k < 2; ++k) dst[n][k] = *(const LAS bf16x8*)(lds + PG8_SB(b, h) + boff + n * 2048 + k * 1024); } while (0)
#define PG8_MMA(ai, bj, At, Bt) do { __builtin_amdgcn_s_setprio(1); _Pragma("unroll") for (int m = 0; m < 4; ++m) _Pragma("unroll") for (int n = 0; n < 2; ++n) _Pragma("unroll") for (int k = 0; k < 2; ++k) \
        acc[ai][bj][m][n] = __builtin_amdgcn_mfma_f32_16x16x32_bf16(Bt[n][k], At[m][k], acc[ai][bj][m][n], 0, 0, 0); __builtin_amdgcn_s_setprio(0); } while (0)
#define PG8_WAIT_V(n) asm volatile("s_waitcnt vmcnt(" #n ")" ::: "memory")
#define PG8_WAIT_L(n) asm volatile("s_waitcnt lgkmcnt(" #n ")" ::: "memory")
#define PG8_BAR __builtin_amdgcn_s_barrier()
#define PG8_SCHED __builtin_amdgcn_sched_barrier(0)
    Unit cur, nxt; int ui = 0;
    if (!S.next(0, cur)) return;
    f32x4 acc[2][2][4][2];
#pragma unroll
    for (int a = 0; a < 2; ++a)
#pragma unroll
        for (int b = 0; b < 2; ++b)
#pragma unroll
            for (int m = 0; m < 4; ++m)
#pragma unroll
                for (int n = 0; n < 2; ++n) acc[a][b][m][n] = (f32x4){0.f, 0.f, 0.f, 0.f};
    bf16x8 At[4][2], B0[2][2], B1[2][2];
    const char* cA = (const char*)g.A + (size_t)cur.arow * g.lda * 2; const char* cB = (const char*)g.Bt + (size_t)cur.brow * g.ldb * 2;
    S.a_ready(cur);
    PG8_STAGE(PG8_SB(0, 0), cB, voffB); PG8_STAGE(PG8_SB(0, 1), cB + hstepB, voffB); PG8_STAGE(PG8_SA(0, 0), cA, voffA); PG8_STAGE(PG8_SA(0, 1), cA + hstepA, voffA);
    if (wr == 1) PG8_BAR;
    PG8_WAIT_V(2); PG8_BAR;
    PG8_STAGE(PG8_SB(1, 0), cB + kstep, voffB); PG8_STAGE(PG8_SA(1, 0), cA + kstep, voffA); PG8_STAGE(PG8_SB(1, 1), cB + hstepB + kstep, voffB);
    PG8_WAIT_V(6); PG8_BAR;
    for (;;) {
        const bool has_next = S.next(ui + 1, nxt);
        const char* nA = has_next ? (const char*)g.A + (size_t)nxt.arow * g.lda * 2 : cA; const char* nB = has_next ? (const char*)g.Bt + (size_t)nxt.brow * g.ldb * 2 : cB;
#pragma unroll 1
        for (int t = 0; t < nt; t += 2) {
            const bool last = (t == nt - 2);
            const char* a1 = cA + (size_t)(t + 1) * kstep;
            const char* a2 = last ? nA : cA + (size_t)(t + 2) * kstep; const char* b2 = last ? nB : cB + (size_t)(t + 2) * kstep;
            const char* a3 = a2 + kstep; const char* b3 = b2 + kstep;
            if (last && has_next) S.a_ready(nxt);
            PG8_LDB(B0, 0, 0); PG8_LDB(B1, 0, 1); PG8_SCHED; PG8_LDA(At, 0, 0); PG8_STAGE(PG8_SA(1, 1), a1 + hstepA, voffA);
            PG8_WAIT_V(8); PG8_WAIT_L(0); PG8_BAR; PG8_MMA(0, 0, At, B0); PG8_MMA(0, 1, At, B1); PG8_BAR; PG8_SCHED;
            PG8_LDA(At, 0, 1); PG8_STAGE(PG8_SB(0, 0), b2, voffB); PG8_STAGE(PG8_SB(0, 1), b2 + hstepB, voffB); PG8_STAGE(PG8_SA(0, 0), a2, voffA);
            PG8_WAIT_V(8); PG8_WAIT_L(0); PG8_BAR; PG8_MMA(1, 0, At, B0); PG8_MMA(1, 1, At, B1); PG8_BAR; PG8_SCHED;
            PG8_LDB(B0, 1, 0); PG8_LDB(B1, 1, 1); PG8_SCHED; PG8_LDA(At, 1, 0); PG8_STAGE(PG8_SA(0, 1), a2 + hstepA, voffA);
            PG8_WAIT_V(8); PG8_WAIT_L(0); PG8_BAR; PG8_MMA(0, 0, At, B0); PG8_MMA(0, 1, At, B1); PG8_BAR; PG8_SCHED;
            PG8_LDA(At, 1, 1); PG8_STAGE(PG8_SB(1, 0), b3, voffB); PG8_STAGE(PG8_SB(1, 1), b3 + hstepB, voffB); PG8_STAGE(PG8_SA(1, 0), a3, voffA);
            PG8_WAIT_V(8); PG8_WAIT_L(0); PG8_BAR; PG8_MMA(1, 0, At, B0); PG8_MMA(1, 1, At, B1); PG8_BAR; PG8_SCHED;
        }
        if constexpr (ALIGN_EPI) { if (wr == 0) PG8_BAR; }
        E(acc, cur, wr, wc, fr, fq); S.done(cur);
        if (!has_next) break;
#pragma unroll
        for (int a = 0; a < 2; ++a)
#pragma unroll
            for (int b = 0; b < 2; ++b)
#pragma unroll
                for (int m = 0; m < 4; ++m)
#pragma unroll
                    for (int n = 0; n < 2; ++n) acc[a][b][m][n] = (f32x4){0.f, 0.f, 0.f, 0.f};
        cur = nxt; cA = nA; cB = nB; ++ui;
        if constexpr (ALIGN_EPI) { if (wr == 1) PG8_BAR; }
    }
    PG8_WAIT_V(0);
    if constexpr (!ALIGN_EPI) { if (wr == 0) PG8_BAR; }
    PG8_BAR;
#undef PG8_SA
#undef PG8_SB
#undef PG8_STAGE
#undef PG8_LDA
#undef PG8_LDB
#undef PG8_MMA
#undef PG8_WAIT_V
#undef PG8_WAIT_L
#undef PG8_BAR
#undef PG8_SCHED
}
}


namespace attn {
using s16x4 = __attribute__((ext_vector_type(4))) short;
using f32x16 = __attribute__((ext_vector_type(16))) float;
constexpr int NW = 8, QBLK = 32, KVBLK = 64;
constexpr float SCALE = 0.07216878364870322f;
constexpr float THR = 8.f;
constexpr int SHM_V = KVBLK * 128 * 2, SHM_K = KVBLK * 128 * 2, SHM_R = KVBLK * 128 * 2;
constexpr int OFF_V = 0, OFF_K = 2 * SHM_V, OFF_R = OFF_K + 2 * SHM_K, OFF_W = OFF_R + 2 * SHM_R, OFF_Q = OFF_W + NW * 64 * 4, LDS_NEED = OFF_Q + 256 * 64 * 2;
#define KSWZ(row, colB) ((row) * 256 + ((colB) ^ (((row) & 7) << 4)))
#define RSWZ(row, colB) KSWZ(row, colB)
#define SBAR() __builtin_amdgcn_sched_barrier(0)
__device__ __forceinline__ int crow(int r, int hi) { return (r & 3) + 8 * (r >> 2) + 4 * hi; }
__device__ __forceinline__ unsigned cvtpk(float lo, float hi) { return cvt_pk_bf16(lo, hi); }

__device__ __forceinline__ void partialSM(f32x16& p0, f32x16& p1, float& m_reg, float& mn, float& alpha) {
    constexpr float C = SCALE * 1.4426950408889634f;
    float pmax = p0[0];
#pragma unroll
    for (int r = 1; r < 16; ++r) pmax = fmaxf(pmax, p0[r]);
#pragma unroll
    for (int r = 0; r < 16; ++r) pmax = fmaxf(pmax, p1[r]);
    { auto rr = __builtin_amdgcn_permlane32_swap(__float_as_uint(pmax), __float_as_uint(pmax), false, false);
      pmax = fmaxf(__uint_as_float(rr[0]), __uint_as_float(rr[1])); }
    if (__builtin_expect(__all(pmax - m_reg <= THR / SCALE), 1)) { mn = m_reg; alpha = 1.f; }
    else { mn = fmaxf(m_reg, pmax); alpha = __builtin_amdgcn_exp2f((m_reg - mn) * C); m_reg = mn; }
    const float mnC = -mn * C;
#pragma unroll
    for (int r = 0; r < 16; ++r) p0[r] = fmaf(p0[r], C, mnC);
#pragma unroll
    for (int r = 0; r < 16; ++r) p1[r] = fmaf(p1[r], C, mnC);
#pragma unroll
    for (int r = 0; r < 16; ++r) p0[r] = __builtin_amdgcn_exp2f(p0[r]);
}
__device__ __forceinline__ void finishSM(f32x16& p0, f32x16& p1, float alpha, float& l_reg, bf16x8& pa0, bf16x8& pa1, bf16x8& pa2, bf16x8& pa3) {
#pragma unroll
    for (int r = 0; r < 16; ++r) p1[r] = __builtin_amdgcn_exp2f(p1[r]);
    float ps = 0;
#pragma unroll
    for (int r = 0; r < 16; ++r) ps += p0[r];
#pragma unroll
    for (int r = 0; r < 16; ++r) ps += p1[r];
    { auto rr = __builtin_amdgcn_permlane32_swap(__float_as_uint(ps), __float_as_uint(ps), false, false);
      ps = __uint_as_float(rr[0]) + __uint_as_float(rr[1]); }
    l_reg = l_reg * alpha + ps;
#define PK4(P, BASE, OUT) do { unsigned a0 = cvtpk(P[BASE + 0], P[BASE + 1]), a1 = cvtpk(P[BASE + 2], P[BASE + 3]);   \
    unsigned b0 = cvtpk(P[BASE + 4], P[BASE + 5]), b1 = cvtpk(P[BASE + 6], P[BASE + 7]);                              \
    auto r0 = __builtin_amdgcn_permlane32_swap(a0, b0, false, false); auto r1 = __builtin_amdgcn_permlane32_swap(a1, b1, false, false); \
    u32x4 w = {r0[0], r1[0], r0[1], r1[1]}; OUT = *reinterpret_cast<bf16x8*>(&w); } while (0)
    PK4(p0, 0, pa0); PK4(p0, 8, pa1); PK4(p1, 0, pa2); PK4(p1, 8, pa3);
#undef PK4
}
__device__ __forceinline__ void qkt(f32x16& p0, f32x16& p1, const LAS char* Ks, const LAS char* Rs, const bf16x8* qr, const bf16x8* qrr, int r32, int hi) {
    p0 = f32x16{}; p1 = f32x16{};
#pragma unroll
    for (int d0 = 0; d0 < 8; ++d0) { const int cb = (d0 * 16 + hi * 8) * 2;
        const bf16x8 b0 = *reinterpret_cast<const LAS bf16x8*>(Ks + KSWZ(r32, cb));
        const bf16x8 b1 = *reinterpret_cast<const LAS bf16x8*>(Ks + KSWZ(32 + r32, cb));
        p0 = __builtin_amdgcn_mfma_f32_32x32x16_bf16(b0, qr[d0], p0, 0, 0, 0);
        p1 = __builtin_amdgcn_mfma_f32_32x32x16_bf16(b1, qr[d0], p1, 0, 0, 0); if ((d0 & 3) == 3) SBAR(); }
#pragma unroll
    for (int d0 = 0; d0 < 4; ++d0) { const int cb = (d0 * 16 + hi * 8) * 2;
        const bf16x8 b0 = *reinterpret_cast<const LAS bf16x8*>(Rs + RSWZ(r32, cb));
        const bf16x8 b1 = *reinterpret_cast<const LAS bf16x8*>(Rs + RSWZ(32 + r32, cb));
        p0 = __builtin_amdgcn_mfma_f32_32x32x16_bf16(b0, qrr[d0], p0, 0, 0, 0);
        p1 = __builtin_amdgcn_mfma_f32_32x32x16_bf16(b1, qrr[d0], p1, 0, 0, 0); }
}
__device__ __forceinline__ int v_st(int k, int c) { const int kk = (k & ~0xC) | ((k & 4) << 1) | ((k & 8) >> 1); return ((kk >> 3) * 4 + (c >> 5)) * 512 + ((kk & 7) * 32 + (c & 31)) * 2; }
__device__ __forceinline__ int v_rd_base(int lane) { return ((lane & 3) << 3) | (((lane >> 2) & 3) << 6) | (((lane >> 4) & 1) << 5) | (((lane >> 5) & 1) << 8); }
constexpr int v_rd_off(int d0, int ks, int half) { return d0 * 512 + ks * 4096 + half * 2048; }
template <int OFF> __device__ __forceinline__ s16x4 tr_read(int vb) {
    s16x4 r; asm volatile("ds_read_b64_tr_b16 %0, %1 offset:%2" : "=&v"(r) : "v"(vb), "i"(OFF) : "memory"); return r;
}
template <int D0> __device__ __forceinline__ void pv_one(f32x16& od, int vb, bf16x8 pa0, bf16x8 pa1, bf16x8 pa2, bf16x8 pa3) {
    const s16x4 l0 = tr_read<v_rd_off(D0, 0, 0)>(vb), h0 = tr_read<v_rd_off(D0, 0, 1)>(vb), l1 = tr_read<v_rd_off(D0, 1, 0)>(vb), h1 = tr_read<v_rd_off(D0, 1, 1)>(vb);
    const s16x4 l2 = tr_read<v_rd_off(D0, 2, 0)>(vb), h2 = tr_read<v_rd_off(D0, 2, 1)>(vb), l3 = tr_read<v_rd_off(D0, 3, 0)>(vb), h3 = tr_read<v_rd_off(D0, 3, 1)>(vb);
    asm volatile("s_waitcnt lgkmcnt(0)" ::: "memory"); SBAR();
#define PK(L, H) (bf16x8){L[0], L[1], L[2], L[3], H[0], H[1], H[2], H[3]}
    od = __builtin_amdgcn_mfma_f32_32x32x16_bf16(pa0, PK(l0, h0), od, 0, 0, 0);
    od = __builtin_amdgcn_mfma_f32_32x32x16_bf16(pa1, PK(l1, h1), od, 0, 0, 0);
    od = __builtin_amdgcn_mfma_f32_32x32x16_bf16(pa2, PK(l2, h2), od, 0, 0, 0);
    od = __builtin_amdgcn_mfma_f32_32x32x16_bf16(pa3, PK(l3, h3), od, 0, 0, 0);
#undef PK
}
__device__ __forceinline__ void pv_d0(f32x16* o, int vb, bf16x8 pa0, bf16x8 pa1, bf16x8 pa2, bf16x8 pa3) {
    pv_one<0>(o[0], vb, pa0, pa1, pa2, pa3); pv_one<1>(o[1], vb, pa0, pa1, pa2, pa3); pv_one<2>(o[2], vb, pa0, pa1, pa2, pa3); pv_one<3>(o[3], vb, pa0, pa1, pa2, pa3);
}

__device__ __forceinline__ void attn_unit(const bf16_t* __restrict__ Qn, const bf16_t* __restrict__ Qr, const bf16_t* __restrict__ Kn, const bf16_t* __restrict__ Kr, const bf16_t* __restrict__ Vh,
                                          bf16_t* __restrict__ Ob, int seq, LAS char* lds) {
    const int tid = threadIdx.x, wid = tid >> 6, lane = tid & 63, r32 = lane & 31, hi = lane >> 5;
    LAS char* V_lds = lds + OFF_V; LAS char* K_lds = lds + OFF_K; LAS char* R_lds = lds + OFF_R;
    LAS float* wsl = (LAS float*)(lds + OFF_W) + wid * 64; LAS float* li_l = wsl; LAS float* al_l = wsl + 32;
    float m_reg = -1e30f, l_reg = 0; f32x16 o[4] = {}; bf16x8 qr[8], qrr[4];
    { unsigned qo = (unsigned)((wid * QBLK + r32) * 128 + hi * 8) * 2u, qo2 = (unsigned)((wid * QBLK + r32) * 64 + hi * 8) * 2u;
      asm volatile("" : "+v"(qo), "+v"(qo2));
#pragma unroll
      for (int d0 = 0; d0 < 8; ++d0) qr[d0] = *reinterpret_cast<const bf16x8*>((const char*)Qn + qo + d0 * 32);
#pragma unroll
      for (int d0 = 0; d0 < 4; ++d0) qrr[d0] = *reinterpret_cast<const bf16x8*>((const char*)Qr + qo2 + d0 * 32); }
    const int sr = tid >> 4, sc = (tid & 15) * 8, vst0 = v_st(sr, sc), vst1 = v_st(32 + sr, sc);
    const int rr_ = tid >> 3, rc_ = (tid & 7) * 8;
    const int vb0 = (int)(unsigned)(uintptr_t)V_lds + v_rd_base(lane);
    bf16x8 vs0, vs1, ks0, ks1, rs0;
    const unsigned vo = (unsigned)(sr * 128 + sc) * 2u, ro = (unsigned)(rr_ * 64 + rc_) * 2u;
#define SLOAD(k0) do { const char* vt = (const char*)Vh + (size_t)(k0) * 256; const char* kt = (const char*)Kn + (size_t)(k0) * 256; const char* rt = (const char*)Kr + (size_t)(k0) * 128; \
    vs0 = *reinterpret_cast<const bf16x8*>(vt + vo); vs1 = *reinterpret_cast<const bf16x8*>(vt + 8192 + vo); \
    ks0 = *reinterpret_cast<const bf16x8*>(kt + vo); ks1 = *reinterpret_cast<const bf16x8*>(kt + 8192 + vo); \
    rs0 = *reinterpret_cast<const bf16x8*>(rt + ro); } while (0)
#define SWRITE(b) do { *(LAS bf16x8*)(V_lds + (b) * SHM_V + vst0) = vs0; *(LAS bf16x8*)(V_lds + (b) * SHM_V + vst1) = vs1; const int kc = sc * 2; \
    *(LAS bf16x8*)(K_lds + (b) * SHM_K + KSWZ(sr, kc)) = ks0; *(LAS bf16x8*)(K_lds + (b) * SHM_K + KSWZ(32 + sr, kc)) = ks1; \
    *(LAS bf16x8*)(R_lds + (b) * SHM_R + RSWZ(rr_, rc_ * 2)) = rs0; } while (0)
#define SWAIT() asm volatile("s_waitcnt vmcnt(0)" ::: "memory")
#define RESC(a) do { if (__any((a) < 1.f)) { if (hi == 0) al_l[r32] = (a); asm volatile("s_waitcnt lgkmcnt(0)" ::: "memory"); \
    _Pragma("unroll") for (int d = 0; d < 4; ++d) _Pragma("unroll") for (int r = 0; r < 16; ++r) o[d][r] *= al_l[crow(r, hi)]; } } while (0)
#define TILE(b, jj) do { f32x16 p0, p1; float mn, al; bf16x8 pa0, pa1, pa2, pa3; \
    if ((jj) + 2 < NT) SLOAD(((jj) + 2) * KVBLK); SBAR(); \
    qkt(p0, p1, K_lds + (b) * SHM_K, R_lds + (b) * SHM_R, qr, qrr, r32, hi); partialSM(p0, p1, m_reg, mn, al); RESC(al); \
    finishSM(p0, p1, al, l_reg, pa0, pa1, pa2, pa3); SBAR(); \
    pv_d0(o, vb0 + (b) * SHM_V, pa0, pa1, pa2, pa3); \
    __syncthreads(); if ((jj) + 2 < NT) { SWAIT(); SWRITE(b); } } while (0)
    const int NT = seq / KVBLK;
    SLOAD(0); SWAIT(); SWRITE(0); SLOAD(KVBLK); SWAIT(); SWRITE(1); __syncthreads();
    for (int j = 0; j < NT; j += 2) { TILE(0, j); TILE(1, j + 1); }
    if (hi == 0) li_l[r32] = l_reg; asm volatile("s_waitcnt lgkmcnt(0)" ::: "memory");
    unsigned oo0 = (unsigned)((wid * QBLK) * 1024 + r32) * 2u; asm volatile("" : "+v"(oo0));
#pragma unroll
    for (int r = 0; r < 16; ++r) { const int orow = crow(r, hi); const float rl = __builtin_amdgcn_rcpf(li_l[orow]); const unsigned oo = oo0 + (unsigned)orow * 2048u;
#pragma unroll
        for (int d0 = 0; d0 < 4; ++d0) *(bf16_t*)((char*)Ob + oo + d0 * 64) = (bf16_t)(cvtpk(o[d0][r] * rl, 0.f) & 0xffffu); }
    __syncthreads();
#undef SLOAD
#undef SWRITE
#undef SWAIT
#undef RESC
#undef TILE
}
}


namespace scan {
using attn::s16x4; using attn::f32x16; using attn::v_st; using attn::v_rd_base; using attn::crow; using attn::cvtpk;
constexpr int NCH = KEYS / 64;
constexpr size_t WS_STATE = 422 * MiB;
constexpr size_t WS_DEC = 694 * MiB;
__device__ __forceinline__ int seq_row(int b, int p) { return p < CT ? RL + b * CT + p : b * T + (p - CT); }
__device__ __forceinline__ s16x4 trr(int addr) { s16x4 r; asm volatile("ds_read_b64_tr_b16 %0, %1" : "=&v"(r) : "v"(addr) : "memory"); return r; }
template <int OFF> __device__ __forceinline__ s16x4 tri(int addr) { s16x4 r; asm volatile("ds_read_b64_tr_b16 %0, %1 offset:%2" : "=&v"(r) : "v"(addr), "i"(OFF) : "memory"); return r; }
#define SC_PK(L, H) (bf16x8){L[0], L[1], L[2], L[3], H[0], H[1], H[2], H[3]}
#define SC_LWAIT() do { asm volatile("s_waitcnt lgkmcnt(0)" ::: "memory"); __builtin_amdgcn_sched_barrier(0); } while (0)
__device__ __forceinline__ float2 bf2x(unsigned u) { return make_float2(bf2f((bf16_t)(u & 0xffffu)), bf2f((bf16_t)(u >> 16))); }

struct Prep {
    float2 kf[8], kb[8];
    float2 bf[8], cb[8];
    float2 totf, totb, reff, refb;
};
__device__ __forceinline__ void prep_decay(Prep& P, const bf16_t* __restrict__ KF, const bf16_t* __restrict__ KB, int row0, int h, int a, float lgf, float lgb, LAS float* tot, int tid) {
    const int cp = tid & 63, tg = tid >> 6;
    float2 gf[8], gb[8];
#pragma unroll
    for (int i = 0; i < 8; ++i) { const size_t off = (size_t)(row0 + 8 * tg + i) * 512 + h * 128 + 2 * cp;
        P.kf[i] = bf2x(*(const unsigned*)(KF + off)); P.kb[i] = bf2x(*(const unsigned*)(KB + off));
        if (a) { gf[i] = make_float2(__logf(fmaxf(1.f - P.kf[i].x, 1e-30f)), __logf(fmaxf(1.f - P.kf[i].y, 1e-30f))); gb[i] = make_float2(__logf(fmaxf(1.f - P.kb[i].x, 1e-30f)), __logf(fmaxf(1.f - P.kb[i].y, 1e-30f))); }
        else { gf[i] = make_float2(lgf, lgf); gb[i] = make_float2(lgb, lgb); } }
    P.bf[0] = gf[0];
#pragma unroll
    for (int i = 1; i < 8; ++i) P.bf[i] = make_float2(P.bf[i - 1].x + gf[i].x, P.bf[i - 1].y + gf[i].y);
    P.cb[0] = gb[0];
#pragma unroll
    for (int i = 1; i < 8; ++i) P.cb[i] = make_float2(P.cb[i - 1].x + gb[i].x, P.cb[i - 1].y + gb[i].y);
    *(LAS f32x2*)(tot + (0 * 8 + tg) * 128 + 2 * cp) = (f32x2){P.bf[7].x, P.bf[7].y}; *(LAS f32x2*)(tot + (1 * 8 + tg) * 128 + 2 * cp) = (f32x2){P.cb[7].x, P.cb[7].y};
    __syncthreads();
    float2 offf = make_float2(0.f, 0.f), offb = make_float2(0.f, 0.f); P.totf = offf; P.totb = offf; P.reff = offf; P.refb = offf;
#pragma unroll
    for (int g = 0; g < 8; ++g) { const f32x2 tf = *(const LAS f32x2*)(tot + (0 * 8 + g) * 128 + 2 * cp), tb = *(const LAS f32x2*)(tot + (1 * 8 + g) * 128 + 2 * cp);
        P.totf.x += tf.x; P.totf.y += tf.y; P.totb.x += tb.x; P.totb.y += tb.y;
        if (g < 4) { P.reff.x += tf.x; P.reff.y += tf.y; } else { P.refb.x += tb.x; P.refb.y += tb.y; }
        if (g < tg) { offf.x += tf.x; offf.y += tf.y; offb.x += tb.x; offb.y += tb.y; } }
#pragma unroll
    for (int i = 0; i < 8; ++i) { P.bf[i].x += offf.x; P.bf[i].y += offf.y;
        P.cb[i].x = P.totb.x - (P.cb[i].x + offb.x) + gb[i].x; P.cb[i].y = P.totb.y - (P.cb[i].y + offb.y) + gb[i].y; }
}
__device__ __forceinline__ unsigned pk2f(float a, float b) { return cvtpk(a, b); }

__device__ __forceinline__ void s1_item(int item, const bf16_t* G0p, const float* lg, bf16_t* ST, float* DEC, LAS char* lds) {
    const int tid = threadIdx.x, lane = tid & 63, wid = tid >> 6, cp = tid & 63, tg = tid >> 6, r32 = lane & 31, hi = lane >> 5;
    const int c = item % NCH, h = (item / NCH) & 3, b = (item / (NCH * 4)) & 7, a = item / (NCH * 32);
    const bf16_t* KF = G0p + (size_t)(a ? 5 : 1) * (GSZ / 2); const bf16_t* KB = G0p + (size_t)(a ? 6 : 1) * (GSZ / 2); const bf16_t* Vg = G0p + (size_t)(a ? 7 : 2) * (GSZ / 2);
    const int row0 = seq_row(b, 64 * c);
    LAS char* KFi = lds; LAS char* KBi = lds + 16384; LAS char* Vi = lds + 32768; LAS float* tot = (LAS float*)(lds + 49152);
    bf16x8 vv[2];
#pragma unroll
    for (int n = 0; n < 2; ++n) { const int q = tid + 512 * n, k = q >> 4, c0 = (q & 15) * 8; vv[n] = *(const bf16x8*)(Vg + (size_t)(row0 + k) * 512 + h * 128 + c0); }
    Prep P; prep_decay(P, KF, KB, row0, h, a, lg[h], lg[4 + h], tot, tid);
#pragma unroll
    for (int i = 0; i < 8; ++i) { const int k = 8 * tg + i; const int o = v_st(k, 2 * cp);
        *(LAS unsigned*)(KFi + o) = pk2f(P.kf[i].x * __expf(P.totf.x - P.bf[i].x), P.kf[i].y * __expf(P.totf.y - P.bf[i].y));
        *(LAS unsigned*)(KBi + o) = pk2f(P.kb[i].x * __expf(P.totb.x - P.cb[i].x), P.kb[i].y * __expf(P.totb.y - P.cb[i].y)); }
#pragma unroll
    for (int n = 0; n < 2; ++n) { const int q = tid + 512 * n, k = q >> 4, c0 = (q & 15) * 8; *(LAS bf16x8*)(Vi + v_st(k, c0)) = vv[n]; }
    const size_t sidx = ((((size_t)a * 8 + b) * 4 + h) * 2) * NCH;
    if (tg == 0) { *(float2*)(DEC + (sidx + c) * 128 + 2 * cp) = make_float2(__expf(P.totf.x), __expf(P.totf.y)); *(float2*)(DEC + (sidx + NCH + c) * 128 + 2 * cp) = make_float2(__expf(P.totb.x), __expf(P.totb.y)); }
    __syncthreads();
    const int dkb = wid & 3, dvb0 = 2 * (wid >> 2);
    const int aKF = (int)(unsigned)(uintptr_t)KFi + v_rd_base(lane) + dkb * 512, aKB = (int)(unsigned)(uintptr_t)KBi + v_rd_base(lane) + dkb * 512, aV = (int)(unsigned)(uintptr_t)Vi + v_rd_base(lane) + dvb0 * 512;
    f32x16 uf0 = {}, uf1 = {}, ub0 = {}, ub1 = {};
    asm volatile("" : "+v"(uf0), "+v"(uf1), "+v"(ub0), "+v"(ub1));
#define S1_STEP(KS) do { const s16x4 fl = tri<(KS) * 4096>(aKF), fh = tri<(KS) * 4096 + 2048>(aKF), bl = tri<(KS) * 4096>(aKB), bh = tri<(KS) * 4096 + 2048>(aKB); \
        const s16x4 v0l = tri<(KS) * 4096>(aV), v0h = tri<(KS) * 4096 + 2048>(aV), v1l = tri<(KS) * 4096 + 512>(aV), v1h = tri<(KS) * 4096 + 2048 + 512>(aV); SC_LWAIT(); \
        const bf16x8 kff = SC_PK(fl, fh), kbf = SC_PK(bl, bh), vf0 = SC_PK(v0l, v0h), vf1 = SC_PK(v1l, v1h); \
        uf0 = __builtin_amdgcn_mfma_f32_32x32x16_bf16(vf0, kff, uf0, 0, 0, 0); uf1 = __builtin_amdgcn_mfma_f32_32x32x16_bf16(vf1, kff, uf1, 0, 0, 0); \
        ub0 = __builtin_amdgcn_mfma_f32_32x32x16_bf16(vf0, kbf, ub0, 0, 0, 0); ub1 = __builtin_amdgcn_mfma_f32_32x32x16_bf16(vf1, kbf, ub1, 0, 0, 0); } while (0)
    S1_STEP(0); S1_STEP(1); S1_STEP(2); S1_STEP(3);
#undef S1_STEP
    bf16_t* Uf = ST + (sidx + c) * 16384 + (size_t)(32 * dkb + r32) * 128; bf16_t* Ub = ST + (sidx + NCH + c) * 16384 + (size_t)(32 * dkb + r32) * 128;
#pragma unroll
    for (int g = 0; g < 4; ++g) { const int dv = 8 * g + 4 * hi;
        *(u32x2*)(Uf + 32 * dvb0 + dv) = (u32x2){cvtpk(uf0[4 * g], uf0[4 * g + 1]), cvtpk(uf0[4 * g + 2], uf0[4 * g + 3])}; *(u32x2*)(Uf + 32 * (dvb0 + 1) + dv) = (u32x2){cvtpk(uf1[4 * g], uf1[4 * g + 1]), cvtpk(uf1[4 * g + 2], uf1[4 * g + 3])};
        *(u32x2*)(Ub + 32 * dvb0 + dv) = (u32x2){cvtpk(ub0[4 * g], ub0[4 * g + 1]), cvtpk(ub0[4 * g + 2], ub0[4 * g + 3])}; *(u32x2*)(Ub + 32 * (dvb0 + 1) + dv) = (u32x2){cvtpk(ub1[4 * g], ub1[4 * g + 1]), cvtpk(ub1[4 * g + 2], ub1[4 * g + 3])}; }
    __syncthreads();
}

__device__ __forceinline__ void s2_vec(size_t v, bf16_t* ST, const float* DEC) {
    const int chain = (int)(v >> 11), e8 = (int)(v & 2047), dk = e8 >> 4, dir = chain & 1;
    bf16_t* base = ST + (size_t)chain * NCH * 16384 + (size_t)e8 * 8; const float* dec = DEC + (size_t)chain * NCH * 128 + dk;
    float S[8];
#pragma unroll
    for (int i = 0; i < 8; ++i) S[i] = 0.f;
    u32x4 u_next = *(const u32x4*)(base + (size_t)(dir ? 3 : 0) * 16384);
    for (int q = 0; q < NCH; ++q) {
        const int c = dir ? (q < 4 ? 3 - q : 71 - q) : q;
        const u32x4 u = u_next; const float d = dec[c * 128];
        if (q + 1 < NCH) { const int cn = dir ? (q + 1 < 4 ? 3 - (q + 1) : 71 - (q + 1)) : q + 1; u_next = *(const u32x4*)(base + (size_t)cn * 16384); }
        u32x4 w; w.x = cvtpk(S[0], S[1]); w.y = cvtpk(S[2], S[3]); w.z = cvtpk(S[4], S[5]); w.w = cvtpk(S[6], S[7]);
        *(u32x4*)(base + (size_t)c * 16384) = w;
        const float2 u0 = bf2x(u.x), u1 = bf2x(u.y), u2 = bf2x(u.z), u3 = bf2x(u.w);
        S[0] = d * S[0] + u0.x; S[1] = d * S[1] + u0.y; S[2] = d * S[2] + u1.x; S[3] = d * S[3] + u1.y; S[4] = d * S[4] + u2.x; S[5] = d * S[5] + u2.y; S[6] = d * S[6] + u3.x; S[7] = d * S[7] + u3.y;
    }
}

__device__ __forceinline__ void s3_item(int item, const bf16_t* G0p, const float* lg, const bf16_t* ST, bf16_t* Y, LAS char* lds) {
    const int tid = threadIdx.x, lane = tid & 63, wid = tid >> 6, cp = tid & 63, tg = tid >> 6, r32 = lane & 31, hi = lane >> 5;
    const int c = item % NCH, h = (item / NCH) & 3, b = (item / (NCH * 4)) & 7, a = item / (NCH * 32);
    const bf16_t* Qg = G0p + (size_t)(a ? 4 : 0) * (GSZ / 2); const bf16_t* KF = G0p + (size_t)(a ? 5 : 1) * (GSZ / 2); const bf16_t* KB = G0p + (size_t)(a ? 6 : 1) * (GSZ / 2);
    const bf16_t* Vg = G0p + (size_t)(a ? 7 : 2) * (GSZ / 2); const bf16_t* Gt = G0p + (size_t)(a ? 8 : 3) * (GSZ / 2);
    const int row0 = seq_row(b, 64 * c);
    LAS char* QFi = lds; LAS char* KFi = lds + 16384; LAS char* Vi = lds + 32768; LAS float* tot = (LAS float*)(lds + 49152);
    LAS char* QBi = lds + 65536; LAS char* KBi = lds + 81920; LAS char* QF2 = lds + 98304; LAS char* QB2 = lds + 114688; LAS float* red = (LAS float*)(lds + 65536);
    const size_t sidx = ((((size_t)a * 8 + b) * 4 + h) * 2) * NCH;
    bf16x8 vv[2], sf[4], sb[4];
#pragma unroll
    for (int n = 0; n < 2; ++n) { const int q = tid + 512 * n, k = q >> 4, c0 = (q & 15) * 8; vv[n] = *(const bf16x8*)(Vg + (size_t)(row0 + k) * 512 + h * 128 + c0); }
    float2 qv[8];
#pragma unroll
    for (int i = 0; i < 8; ++i) qv[i] = bf2x(*(const unsigned*)(Qg + (size_t)(row0 + 8 * tg + i) * 512 + h * 128 + 2 * cp));
    Prep P; prep_decay(P, KF, KB, row0, h, a, lg[h], lg[4 + h], tot, tid);
#pragma unroll
    for (int i = 0; i < 8; ++i) { const int k = 8 * tg + i; const int o = KSWZ(k, 4 * cp);
        const float2 ef = make_float2(__expf(P.bf[i].x - P.reff.x), __expf(P.bf[i].y - P.reff.y)), eb = make_float2(__expf(P.cb[i].x - P.refb.x), __expf(P.cb[i].y - P.refb.y));
        *(LAS unsigned*)(QFi + o) = pk2f(qv[i].x * ef.x, qv[i].y * ef.y); *(LAS unsigned*)(KFi + o) = pk2f(P.kf[i].x * __builtin_amdgcn_rcpf(ef.x), P.kf[i].y * __builtin_amdgcn_rcpf(ef.y));
        *(LAS unsigned*)(QBi + o) = pk2f(qv[i].x * eb.x, qv[i].y * eb.y); *(LAS unsigned*)(KBi + o) = pk2f(P.kb[i].x * __builtin_amdgcn_rcpf(eb.x), P.kb[i].y * __builtin_amdgcn_rcpf(eb.y));
        *(LAS unsigned*)(QF2 + o) = pk2f(qv[i].x * __expf(P.bf[i].x), qv[i].y * __expf(P.bf[i].y)); *(LAS unsigned*)(QB2 + o) = pk2f(qv[i].x * __expf(P.cb[i].x), qv[i].y * __expf(P.cb[i].y)); }
#pragma unroll
    for (int n = 0; n < 2; ++n) { const int q = tid + 512 * n, k = q >> 4, c0 = (q & 15) * 8; *(LAS bf16x8*)(Vi + v_st(k, c0)) = vv[n]; }
#pragma unroll
    for (int n = 0; n < 4; ++n) { const int q = tid + 512 * n; sf[n] = *(const bf16x8*)(ST + (sidx + c) * 16384 + (size_t)q * 8); sb[n] = *(const bf16x8*)(ST + (sidx + NCH + c) * 16384 + (size_t)q * 8); }
    __syncthreads();
    const int rb = wid >> 2, d0 = wid & 3, qrow = 32 * rb + r32;
    f32x16 pf0 = {}, pf1 = {}, pb0 = {}, pb1 = {};
    asm volatile("" : "+v"(pf0), "+v"(pf1), "+v"(pb0), "+v"(pb1));
#pragma unroll
    for (int ks = 0; ks < 8; ++ks) { const int cb_ = (ks * 16 + hi * 8) * 2;
        const bf16x8 qf = *(const LAS bf16x8*)(QFi + KSWZ(qrow, cb_)), qb = *(const LAS bf16x8*)(QBi + KSWZ(qrow, cb_));
        const bf16x8 kf0 = *(const LAS bf16x8*)(KFi + KSWZ(r32, cb_)), kf1 = *(const LAS bf16x8*)(KFi + KSWZ(32 + r32, cb_)), kb0 = *(const LAS bf16x8*)(KBi + KSWZ(r32, cb_)), kb1 = *(const LAS bf16x8*)(KBi + KSWZ(32 + r32, cb_));
        pf0 = __builtin_amdgcn_mfma_f32_32x32x16_bf16(kf0, qf, pf0, 0, 0, 0); pf1 = __builtin_amdgcn_mfma_f32_32x32x16_bf16(kf1, qf, pf1, 0, 0, 0);
        pb0 = __builtin_amdgcn_mfma_f32_32x32x16_bf16(kb0, qb, pb0, 0, 0, 0); pb1 = __builtin_amdgcn_mfma_f32_32x32x16_bf16(kb1, qb, pb1, 0, 0, 0); }
#pragma unroll
    for (int r = 0; r < 16; ++r) { const int j0 = crow(r, hi), j1 = 32 + j0;
        pf0[r] = (j0 <= qrow ? pf0[r] : 0.f) + (j0 >= qrow ? pb0[r] : 0.f); pf1[r] = (j1 <= qrow ? pf1[r] : 0.f) + (j1 >= qrow ? pb1[r] : 0.f); }
    bf16x8 pa0, pa1, pa2, pa3;
#define PK4(Pv, BASE, OUT) do { unsigned a0 = cvtpk(Pv[BASE + 0], Pv[BASE + 1]), a1 = cvtpk(Pv[BASE + 2], Pv[BASE + 3]);   \
    unsigned b0 = cvtpk(Pv[BASE + 4], Pv[BASE + 5]), b1 = cvtpk(Pv[BASE + 6], Pv[BASE + 7]);                              \
    auto r0 = __builtin_amdgcn_permlane32_swap(a0, b0, false, false); auto r1 = __builtin_amdgcn_permlane32_swap(a1, b1, false, false); \
    u32x4 w = {r0[0], r1[0], r0[1], r1[1]}; OUT = *reinterpret_cast<bf16x8*>(&w); } while (0)
    PK4(pf0, 0, pa0); PK4(pf0, 8, pa1); PK4(pf1, 0, pa2); PK4(pf1, 8, pa3);
#undef PK4
    f32x16 o = {}; asm volatile("" : "+v"(o));
    { const int aV = (int)(unsigned)(uintptr_t)Vi + v_rd_base(lane) + d0 * 512;
      const s16x4 l0 = tri<0>(aV), h0 = tri<2048>(aV), l1 = tri<4096>(aV), h1 = tri<4096 + 2048>(aV), l2 = tri<8192>(aV), h2 = tri<8192 + 2048>(aV), l3 = tri<12288>(aV), h3 = tri<12288 + 2048>(aV); SC_LWAIT();
      o = __builtin_amdgcn_mfma_f32_32x32x16_bf16(pa0, SC_PK(l0, h0), o, 0, 0, 0); o = __builtin_amdgcn_mfma_f32_32x32x16_bf16(pa1, SC_PK(l1, h1), o, 0, 0, 0);
      o = __builtin_amdgcn_mfma_f32_32x32x16_bf16(pa2, SC_PK(l2, h2), o, 0, 0, 0); o = __builtin_amdgcn_mfma_f32_32x32x16_bf16(pa3, SC_PK(l3, h3), o, 0, 0, 0); }
    __syncthreads();
    LAS char* SFi = lds; LAS char* SBi = lds + 32768;
#pragma unroll
    for (int n = 0; n < 4; ++n) { const int q = tid + 512 * n, dk = q >> 4, c0 = (q & 15) * 8; const int oo = (dk >> 6) * 16384 + v_st(dk & 63, c0); *(LAS bf16x8*)(SFi + oo) = sf[n]; *(LAS bf16x8*)(SBi + oo) = sb[n]; }
    __syncthreads();
    { const int aSF = (int)(unsigned)(uintptr_t)SFi + v_rd_base(lane) + d0 * 512, aSB = (int)(unsigned)(uintptr_t)SBi + v_rd_base(lane) + d0 * 512;
#define S3_STEP(KS) do { const int cb_ = ((KS) * 16 + hi * 8) * 2; const bf16x8 q1 = *(const LAS bf16x8*)(QF2 + KSWZ(qrow, cb_)), q2 = *(const LAS bf16x8*)(QB2 + KSWZ(qrow, cb_)); \
        const s16x4 fl = tri<(KS) * 4096>(aSF), fh = tri<(KS) * 4096 + 2048>(aSF), bl = tri<(KS) * 4096>(aSB), bh = tri<(KS) * 4096 + 2048>(aSB); SC_LWAIT(); \
        o = __builtin_amdgcn_mfma_f32_32x32x16_bf16(q1, SC_PK(fl, fh), o, 0, 0, 0); o = __builtin_amdgcn_mfma_f32_32x32x16_bf16(q2, SC_PK(bl, bh), o, 0, 0, 0); } while (0)
      S3_STEP(0); S3_STEP(1); S3_STEP(2); S3_STEP(3); S3_STEP(4); S3_STEP(5); S3_STEP(6); S3_STEP(7);
#undef S3_STEP
    }
#pragma unroll
    for (int r = 0; r < 16; ++r) { float s = o[r] * o[r];
        s += __shfl_xor(s, 1); s += __shfl_xor(s, 2); s += __shfl_xor(s, 4); s += __shfl_xor(s, 8); s += __shfl_xor(s, 16);
        if (r32 == 0) red[(rb * 4 + d0) * 32 + crow(r, hi)] = s; }
    __syncthreads();
#pragma unroll
    for (int r = 0; r < 16; ++r) { const int lr = crow(r, hi); const float ss = red[(rb * 4 + 0) * 32 + lr] + red[(rb * 4 + 1) * 32 + lr] + red[(rb * 4 + 2) * 32 + lr] + red[(rb * 4 + 3) * 32 + lr];
        const float rs = rsqrtf(ss * (1.f / 128.f) + EPS); const int row = row0 + 32 * rb + lr; const int col = h * 128 + 32 * d0 + r32;
        const float g = bf2f(Gt[(size_t)row * 512 + col]);
        Y[(size_t)row * 1024 + a * 512 + col] = (bf16_t)(cvtpk(o[r] * rs * g, 0.f) & 0xffffu); }
    __syncthreads();
}
#undef SC_PK
#undef SC_LWAIT
}

constexpr int RING_OFF = 0, RING_BYTES = 131072;
constexpr int MISC_OFF = RING_BYTES;
constexpr int LDS_BYTES = 147456;
constexpr int NWAVES = 8, NTHREADS = 512;

#define XB_TMO      128
#define XB_XCNT(j)  (256  + 64 * (j))
#define XB_XSUB(j)  (1280 + 64 * (j))
#define XB_XGEN(j)  (2304 + 64 * (j))
#define XB_TOP      3328
#define XB_TOPGEN   3392
#define XCD_BAR_WORDS 3456
#define XB_SPIN_CAP (1u << 18)
__device__ __forceinline__ unsigned xb_ld(unsigned* p)              { return __hip_atomic_load(p, __ATOMIC_RELAXED, __HIP_MEMORY_SCOPE_AGENT); }
__device__ __forceinline__ unsigned xb_add(unsigned* p, unsigned v) { return __hip_atomic_fetch_add(p, v, __ATOMIC_RELAXED, __HIP_MEMORY_SCOPE_AGENT); }
__device__ __forceinline__ unsigned xb_xcc_id() { return (unsigned)__builtin_amdgcn_s_getreg((3 << 11) | 20) & 0xFu; }
#define XB_SPIN(cond, bar) do { unsigned _sp = 0; while (cond) { __builtin_amdgcn_s_sleep(1); \
    if ((++_sp & 255u) == 0u) { if (xb_ld(&(bar)[XB_TMO])) break; if (_sp > XB_SPIN_CAP) { atomicAdd(&(bar)[XB_TMO], 1u); break; } } } } while (0)
struct XcdBarrier { unsigned* bar; unsigned x; volatile LAS unsigned* st; };
__device__ __forceinline__ XcdBarrier xcd_barrier_post(unsigned* bar, volatile LAS unsigned* st) {
    XcdBarrier b; b.bar = bar; b.x = xb_xcc_id(); b.st = st;
    if (threadIdx.x == 0) (void)xb_add(&bar[XB_XCNT(b.x)], 1u);
    return b;
}
__device__ __forceinline__ void xcd_barrier_complete(unsigned* bar, unsigned x, unsigned& nloc, unsigned& nx) {
    const unsigned Gt = gridDim.x * gridDim.y * gridDim.z;
    unsigned sum, cnt, mine, sp = 0u;
    for (;;) {
        sum = 0u; cnt = 0u; mine = 0u;
#pragma unroll
        for (unsigned j = 0; j < 16; ++j) { const unsigned c = xb_ld(&bar[XB_XCNT(j)]); sum += c; cnt += (c > 0u) ? 1u : 0u; mine = (j == x) ? c : mine; }
        if (sum == Gt) break;
        __builtin_amdgcn_s_sleep(1);
        if ((++sp & 255u) == 0u) { if (xb_ld(&bar[XB_TMO])) break; if (sp > XB_SPIN_CAP) { atomicAdd(&bar[XB_TMO], 1u); break; } }
    }
    nloc = mine > 0u ? mine : 1u; nx = cnt > 0u ? cnt : 1u;
}
__device__ __forceinline__ void xcd_barrier(const XcdBarrier& b) {
    asm volatile("s_waitcnt vmcnt(0)" ::: "memory");
    __syncthreads();
    if (threadIdx.x == 0) {
        unsigned* bar = b.bar;
        __builtin_amdgcn_s_waitcnt(0);
        unsigned nloc = b.st[0], nx = b.st[1];
        if (nloc == 0u) { xcd_barrier_complete(bar, b.x, nloc, nx); b.st[0] = nloc; b.st[1] = nx; }
        const unsigned old = xb_add(&bar[XB_XSUB(b.x)], 1u);
        const unsigned gen = old / nloc;
        if (old + 1u == (gen + 1u) * nloc) {
            __builtin_amdgcn_fence(__ATOMIC_RELEASE, "agent");
            asm volatile("s_waitcnt vmcnt(0)" ::: "memory");
            const unsigned og = xb_add(&bar[XB_TOP], 1u);
            const unsigned tg = og / nx;
            if (og + 1u == (tg + 1u) * nx) xb_add(&bar[XB_TOPGEN], 1u);
            else XB_SPIN(xb_ld(&bar[XB_TOPGEN]) == tg, bar);
            __builtin_amdgcn_fence(__ATOMIC_ACQUIRE, "agent");
            xb_add(&bar[XB_XGEN(b.x)], 1u);
            asm volatile("s_waitcnt vmcnt(0)" ::: "memory");
        } else {
            XB_SPIN(xb_ld(&bar[XB_XGEN(b.x)]) == gen, bar);
            __builtin_amdgcn_fence(__ATOMIC_ACQUIRE, "agent");
            asm volatile("s_waitcnt vmcnt(0)" ::: "memory");
        }
    }
    __syncthreads();
}

__device__ __forceinline__ void transpose_item(const float* __restrict__ W, int ldw, int K, int src0, bf16_t* __restrict__ WT, int n0, int k0, LAS float* scr, int lane) {
    if (src0 >= 0) {
#pragma unroll 8
        for (int i = 0; i < 32; ++i) { const int kk = 2 * i + (lane >> 5); scr[kk * 33 + (lane & 31)] = W[(size_t)(k0 + kk) * ldw + src0 + (lane & 31)]; }
    } else {
#pragma unroll 8
        for (int i = 0; i < 32; ++i) { const int kk = 2 * i + (lane >> 5); scr[kk * 33 + (lane & 31)] = 0.f; }
    }
    asm volatile("s_waitcnt lgkmcnt(0)" ::: "memory");
    const int c = lane & 7;
#pragma unroll
    for (int j = 0; j < 4; ++j) { const int n = (lane >> 3) + 8 * j; const LAS float* s = scr + (8 * c) * 33 + n;
        u32x4 o; o.x = cvt_pk_bf16(s[0 * 33], s[1 * 33]); o.y = cvt_pk_bf16(s[2 * 33], s[3 * 33]); o.z = cvt_pk_bf16(s[4 * 33], s[5 * 33]); o.w = cvt_pk_bf16(s[6 * 33], s[7 * 33]);
        *(u32x4*)(WT + (size_t)(n0 + n) * K + k0 + 8 * c) = o; }
    asm volatile("s_waitcnt lgkmcnt(0)" ::: "memory");
}
__device__ __forceinline__ int src_mixin(int n0) { const int pn = n0 >> 8, q = n0 & 255, grp = pn >> 1, half = pn & 1; if (grp > 1) return n0; const int bj = q >> 7, rr = q & 127, hl = rr >> 6, j = rr & 63; return grp * 512 + (half * 2 + hl) * 128 + bj * 64 + j; }
__device__ __forceinline__ int src_swiglu(int n0) { const int pn = n0 >> 8, q = n0 & 255, bj = q >> 7, rr = q & 127; return bj * FFN + pn * 128 + rr; }
__device__ __forceinline__ int src_uq(int n0) { const int pn = n0 >> 8, q = n0 & 255, bj = q >> 7, rr = q & 127; if (pn < 4) return (2 * pn + bj) * 192 + rr; const int hl = rr >> 5; return (4 * (pn - 4) + hl) * 192 + 128 + bj * 32 + (rr & 31); }

struct Args { const float* in[22]; float* out; unsigned char* ws; int ph_lo, ph_hi; };
enum Phase { PH_SETUP = 0, PH_ROWS1, PH_MIXIN, PH_SCAN1, PH_SCAN2, PH_SCAN3, PH_MIXOUT, PH_ROWS5, PH_FFNIN, PH_FFNOUT, PH_ROWS8, PH_DOWN, PH_PREP, PH_UQ, PH_UKV, PH_ATTN, PH_MLAOUT, PH_ROWS13, PH_ROUTE, PH_MOEIN, PH_MOEOUT, PH_ROWS17, PH_COUNT };

__global__ void __launch_bounds__(NTHREADS, 2) mega(Args args) {
    extern __shared__ __attribute__((aligned(16))) unsigned char lds_raw[];
    LAS unsigned char* lds = (LAS unsigned char*)lds_raw;
    volatile LAS unsigned* MISC = (volatile LAS unsigned*)(lds + MISC_OFF);
    const int tid = threadIdx.x, lane = tid & 63, wave = __builtin_amdgcn_readfirstlane(tid >> 6);
    const int G = gridDim.x, blk = blockIdx.x;
    unsigned char* ws = args.ws;
    for (int u = tid; u < (LDS_BYTES - MISC_OFF) / 4; u += NTHREADS) ((LAS unsigned*)(lds + MISC_OFF))[u] = 0u;
    __syncthreads();
    const int lo = args.ph_lo, hi = args.ph_hi;
    XcdBarrier bar; bar.bar = (unsigned*)(ws + WS_CTL) + 4096; bar.x = 0; bar.st = nullptr;
    if (hi - lo > 1) bar = xcd_barrier_post((unsigned*)(ws + WS_CTL) + 4096, MISC + 8);
#ifndef PHMASK
#define PHMASK 0xffffffffu
#endif
#define IN(k) (((PHMASK >> (k)) & 1u) && lo <= (k) && (k) < hi)
#define SEAM(k) do { if (IN(k) && IN((k) + 1)) xcd_barrier(bar); } while (0)
    const float* x = args.in[0]; const float* cvec = args.in[1]; const float* ctx = args.in[2]; const float* cctx = args.in[3];
    const float* mod_w = args.in[4]; const float* mod_b = args.in[5]; const float* norm_g = args.in[6]; const float* mix_in_w = args.in[7];
    const float* decay_logit = args.in[8]; const float* lb_logit = args.in[9]; const float* mix_out_w = args.in[10]; const float* ffn_in_w = args.in[11];
    const float* ffn_out_w = args.in[12]; const float* down_w = args.in[13]; const float* gq = args.in[14]; const float* gkv = args.in[15];
    const float* uq_w = args.in[16]; const float* ukv_w = args.in[17]; const float* mla_out_w = args.in[18]; const float* router_w = args.in[19];
    const float* moe_in_w = args.in[20]; const float* moe_out_w = args.in[21];
    float* out = args.out;
    float* modv = (float*)(ws + WS_MODV); float* lbv = (float*)(ws + WS_LB); float* lg = (float*)(ws + WS_LG); int* meta = (int*)(ws + WS_META);
    float* rc = (float*)(ws + WS_ROPE_RC); float* rs = (float*)(ws + WS_ROPE_RS); float* mc = (float*)(ws + WS_ROPE_MC); float* ms = (float*)(ws + WS_ROPE_MS);
    float* cx = (float*)(ws + WS_CX); bf16_t* HB = (bf16_t*)(ws + WS_HB); bf16_t* G0 = (bf16_t*)(ws + WS_G0);
    bf16_t* OX = (bf16_t*)(ws + WS_OX); bf16_t* ACT = (bf16_t*)(ws + WS_ACT);
    bf16_t* DOWN = (bf16_t*)(ws + WS_DOWN); bf16_t* QN = (bf16_t*)(ws + WS_QN); bf16_t* QR = (bf16_t*)(ws + WS_QR); bf16_t* KN = (bf16_t*)(ws + WS_KN); bf16_t* KR = (bf16_t*)(ws + WS_KR);
    bf16_t* Vv = (bf16_t*)(ws + WS_V); bf16_t* AO = (bf16_t*)(ws + WS_AO); bf16_t* Ob = (bf16_t*)(ws + WS_O); bf16_t* NQ = (bf16_t*)(ws + WS_NQ); bf16_t* NKV = (bf16_t*)(ws + WS_NKV);
    bf16_t* H4 = (bf16_t*)(ws + WS_H4); bf16_t* HS = (bf16_t*)(ws + WS_HS); bf16_t* ACT2 = (bf16_t*)(ws + WS_ACT2); bf16_t* YS = (bf16_t*)(ws + WS_YS);
    int* top_e = (int*)(ws + WS_TOPE); float* top_g = (float*)(ws + WS_TOPG); int* tslot = (int*)(ws + WS_TSLOT);
    bf16_t* Wmixin = (bf16_t*)(ws + WS_W_MIXIN); bf16_t* Wmixout = (bf16_t*)(ws + WS_W_MIXOUT); bf16_t* Wffnin = (bf16_t*)(ws + WS_W_FFNIN); bf16_t* Wffnout = (bf16_t*)(ws + WS_W_FFNOUT);
    bf16_t* Wdown = (bf16_t*)(ws + WS_W_DOWN); bf16_t* Wuq = (bf16_t*)(ws + WS_W_UQ); bf16_t* Wukv = (bf16_t*)(ws + WS_W_UKV); bf16_t* Wmlaout = (bf16_t*)(ws + WS_W_MLAOUT);
    bf16_t* Wmi = (bf16_t*)(ws + WS_WMI); bf16_t* Wmo = (bf16_t*)(ws + WS_WMO);
    const float* mv0 = modv; const float* mv1 = modv + 9 * 6144; const float* g0 = norm_g; const float* g1n = norm_g + 4 * 1024;
    const int gw = blk * NWAVES + wave, NGW = G * NWAVES;

    if (IN(PH_SETUP)) {
        for (int gid = blk * NTHREADS + tid; gid < 4096 * 64; gid += G * NTHREADS) tables_body(gid, lb_logit, decay_logit, rc, rs, mc, ms, lbv, lg);
        LAS float* sc = (LAS float*)(lds + RING_OFF);
        for (int i = tid; i < 9 * 1024; i += NTHREADS) { const int r = i >> 10, k = i & 1023; const float v = r < 8 ? cvec[r * 1024 + k] : cctx[k]; sc[i] = siluf(v); }
        __syncthreads();
        for (int col = blk * NTHREADS + tid; col < 12288; col += G * NTHREADS) {
            const int l = col / 6144, n = col % 6144;
            float acc[9];
#pragma unroll
            for (int r = 0; r < 9; ++r) acc[r] = 0.f;
            const float* w = mod_w + (size_t)l * 1024 * 6144 + n;
#pragma unroll 8
            for (int k = 0; k < 1024; ++k) { const float wv = w[(size_t)k * 6144];
#pragma unroll
                for (int r = 0; r < 9; ++r) acc[r] += sc[r * 1024 + k] * wv; }
            const float bb = mod_b[l * 6144 + n];
#pragma unroll
            for (int r = 0; r < 9; ++r) modv[((size_t)l * 9 + r) * 6144 + n] = acc[r] + bb;
        }
        __syncthreads();
        LAS float* scr = (LAS float*)(lds + RING_OFF + 40960 + wave * 8448);
        constexpr int I0 = 16 * 144, I1 = 16 * 32, I2 = 16 * 176, I3 = 44 * 32, I4 = 16 * 24, I5 = 6 * 48, I6 = 4 * 64, I7 = 16 * 32;
        for (int it = gw; it < I0 + I1 + I2 + I3 + I4 + I5 + I6 + I7; it += NGW) {
            int r = it;
            if (r < I0) { const int kb = r / 144, nb = r % 144; transpose_item(mix_in_w, MIXC, 1024, src_mixin(nb * 32), Wmixin, nb * 32, kb * 64, scr, lane); continue; } r -= I0;
            if (r < I1) { const int kb = r / 32, nb = r % 32; transpose_item(mix_out_w, 1024, 1024, nb * 32, Wmixout, nb * 32, kb * 64, scr, lane); continue; } r -= I1;
            if (r < I2) { const int kb = r / 176, nb = r % 176; transpose_item(ffn_in_w, 2 * FFN, 1024, src_swiglu(nb * 32), Wffnin, nb * 32, kb * 64, scr, lane); continue; } r -= I2;
            if (r < I3) { const int kb = r / 32, nb = r % 32; transpose_item(ffn_out_w, 1024, FFN, nb * 32, Wffnout, nb * 32, kb * 64, scr, lane); continue; } r -= I3;
            if (r < I4) { const int kb = r / 24, nb = r % 24; transpose_item(down_w, DOWNC, 1024, nb < 22 ? nb * 32 : -1, Wdown, nb * 32, kb * 64, scr, lane); continue; } r -= I4;
            if (r < I5) { const int kb = r / 48, nb = r % 48; transpose_item(uq_w, 1536, QRANK, src_uq(nb * 32), Wuq, nb * 32, kb * 64, scr, lane); continue; } r -= I5;
            if (r < I6) { const int kb = r / 64, nb = r % 64; transpose_item(ukv_w, 2048, KVRANK, nb * 32, Wukv, nb * 32, kb * 64, scr, lane); continue; } r -= I6;
            { const int kb = r / 32, nb = r % 32; transpose_item(mla_out_w, 1024, 1024, nb * 32, Wmlaout, nb * 32, kb * 64, scr, lane); }
        }
    }
    SEAM(PH_SETUP);
    if (IN(PH_ROWS1)) { RowArgs a{}; a.xin_lat = x; a.xin_ctx = ctx; a.gh = g0; a.scale = mv0 + 1024; a.shift = mv0; a.H = HB; a.nrows = R;
        for (int r = gw; r < R; r += NGW) rows_body(a, r, lane); }
    SEAM(PH_ROWS1);
    if (IN(PH_MIXIN)) { pg8::Gemm g{HB, Wmixin, D, D, D}; pg8::DenseOrder S; S.init(R / 256, MIXC / 256, G, blk); pg8::EpiMix E{G0, rc, rs, lbv};
        pg8::gemm_phase<pg8::EpiMix, pg8::DenseOrder, true>(lds + RING_OFF, g, S, E); }
    SEAM(PH_MIXIN);
    bf16_t* ST = (bf16_t*)(ws + scan::WS_STATE); float* DEC = (float*)(ws + scan::WS_DEC);
    if (IN(PH_SCAN1)) { for (int item = blk; item < 2 * NB * 4 * scan::NCH; item += G) scan::s1_item(item, G0, lg, ST, DEC, (LAS char*)(lds + RING_OFF)); }
    SEAM(PH_SCAN1);
    if (IN(PH_SCAN2)) { for (size_t v = (size_t)blk * NTHREADS + tid; v < (size_t)2 * NB * 4 * 2 * 2048; v += (size_t)G * NTHREADS) scan::s2_vec(v, ST, DEC); }
    SEAM(PH_SCAN2);
    if (IN(PH_SCAN3)) { for (int item = blk; item < 2 * NB * 4 * scan::NCH; item += G) scan::s3_item(item, G0, lg, ST, HB, (LAS char*)(lds + RING_OFF)); }
    SEAM(PH_SCAN3);
    if (IN(PH_MIXOUT)) { pg8::Gemm g{HB, Wmixout, D, D, D}; pg8::DenseOrder S; S.init(R / 256, D / 256, G, blk); pg8::EpiPlain E{OX, D};
        pg8::gemm_phase<pg8::EpiPlain, pg8::DenseOrder, true>(lds + RING_OFF, g, S, E); }
    SEAM(PH_MIXOUT);
    if (IN(PH_ROWS5)) { RowArgs a{}; a.xin_lat = x; a.xin_ctx = ctx; a.xout_lat = out; a.xout_ctx = cx; a.Y = OX; a.gy = g0 + 1024; a.gate = mv0 + 2048; a.gh = g0 + 2048; a.scale = mv0 + 4096; a.shift = mv0 + 3072; a.H = HB; a.nrows = R;
        for (int r = gw; r < R; r += NGW) rows_body(a, r, lane); }
    SEAM(PH_ROWS5);
    if (IN(PH_FFNIN)) { pg8::Gemm g{HB, Wffnin, D, D, D}; pg8::DenseOrder S; S.init(R / 256, 2 * FFN / 256, G, blk); pg8::EpiSwiglu E{ACT};
        pg8::gemm_phase<pg8::EpiSwiglu, pg8::DenseOrder, true>(lds + RING_OFF, g, S, E); }
    SEAM(PH_FFNIN);
    if (IN(PH_FFNOUT)) { pg8::Gemm g{ACT, Wffnout, FFN, FFN, FFN}; pg8::DenseOrder S; S.init(R / 256, D / 256, G, blk); pg8::EpiPlain E{OX, D};
        pg8::gemm_phase<pg8::EpiPlain, pg8::DenseOrder, true>(lds + RING_OFF, g, S, E); }
    SEAM(PH_FFNOUT);
    if (IN(PH_ROWS8)) { RowArgs a{}; a.xin_lat = out; a.xin_ctx = cx; a.xout_lat = out; a.xout_ctx = cx; a.Y = OX; a.gy = g0 + 3072; a.gate = mv0 + 5120; a.gh = g1n; a.scale = mv1 + 1024; a.shift = mv1; a.H = HB; a.nrows = R;
        for (int r = gw; r < R; r += NGW) rows_body(a, r, lane);
        LAS float* scr = (LAS float*)(lds + RING_OFF + wave * 8448);
        constexpr int J0 = 16 * 176, J1 = 44 * 32;
        for (int it = gw; it < 8 * (J0 + J1); it += NGW) {
            if (it < 8 * J0) { const int e = it / J0, r = it % J0, kb = r / 176, nb = r % 176; transpose_item(moe_in_w + (size_t)e * 1024 * 2 * FFN, 2 * FFN, 1024, src_swiglu(nb * 32), Wmi + (size_t)e * 2 * FFN * 1024, nb * 32, kb * 64, scr, lane); }
            else { const int q = it - 8 * J0, e = q / J1, r = q % J1, kb = r / 32, nb = r % 32; transpose_item(moe_out_w + (size_t)e * FFN * 1024, 1024, FFN, nb * 32, Wmo + (size_t)e * 1024 * FFN, nb * 32, kb * 64, scr, lane); }
        }
    }
    SEAM(PH_ROWS8);
    if (IN(PH_DOWN)) { pg8::Gemm g{HB, Wdown, D, D, D}; pg8::DenseOrder S; S.init(R / 256, DOWNP / 256, G, blk); pg8::EpiPlain E{DOWN, DOWNP};
        pg8::gemm_phase<pg8::EpiPlain, pg8::DenseOrder, true>(lds + RING_OFF, g, S, E); }
    SEAM(PH_DOWN);
    if (IN(PH_PREP)) { for (int r = gw; r < R; r += NGW) mla_prep_body(r, lane, DOWN, gq, gkv, mc, ms, NQ, NKV, KR); }
    SEAM(PH_PREP);
    if (IN(PH_UQ)) { pg8::Gemm g{NQ, Wuq, QRANK, QRANK, QRANK}; pg8::DenseOrder S; S.init(RL / 256, 1536 / 256, G, blk); pg8::EpiUQ E{QN, QR, mc, ms};
          pg8::gemm_phase<pg8::EpiUQ, pg8::DenseOrder, true>(lds + RING_OFF, g, S, E); }
    if (IN(PH_UKV)) { pg8::Gemm g{NKV, Wukv, KVRANK, KVRANK, KVRANK}; pg8::DenseOrder S; S.init(R / 256, 2048 / 256, G, blk); pg8::EpiUKV E{KN, Vv};
          pg8::gemm_phase<pg8::EpiUKV, pg8::DenseOrder, true>(lds + RING_OFF, g, S, E); }
    SEAM(PH_UKV);
    if (IN(PH_ATTN)) {
        for (int L = blk; L < NB * 8 * (T / 256); L += G) { const int xg = L & 7, jj = L >> 3, pair = xg * 8 + (jj >> 4), qb = jj & 15, b = pair >> 3, h = pair & 7;
            const size_t bh = (size_t)b * 8 + h;
            attn::attn_unit(QN + (bh * T + qb * 256) * 128, QR + (bh * T + qb * 256) * 64, KN + bh * KEYS * 128, KR + (size_t)b * KEYS * 64, Vv + bh * KEYS * 128,
                            AO + ((size_t)b * T + qb * 256) * 1024 + h * 128, KEYS, (LAS char*)(lds + RING_OFF)); }
    }
    SEAM(PH_ATTN);
    if (IN(PH_MLAOUT)) { pg8::Gemm g{AO, Wmlaout, D, D, D}; pg8::DenseOrder S; S.init(RL / 256, D / 256, G, blk); pg8::EpiPlain E{Ob, D};
        pg8::gemm_phase<pg8::EpiPlain, pg8::DenseOrder, true>(lds + RING_OFF, g, S, E); }
    SEAM(PH_MLAOUT);
    if (IN(PH_ROWS13)) { RowArgs a{}; a.xin_lat = out; a.xin_ctx = cx; a.xout_lat = out; a.xout_ctx = cx; a.Y = Ob; a.gy = g1n + 1024; a.gate = mv1 + 2048; a.gh = g1n + 2048; a.scale = mv1 + 4096; a.shift = mv1 + 3072; a.H = H4;
        a.router_w = router_w; a.top_e = top_e; a.top_g = top_g; a.nrows = RL;
        for (int r = gw; r < RL; r += NGW) rows_body(a, r, lane); }
    SEAM(PH_ROWS13);
    if (IN(PH_ROUTE)) {
        LAS int* sh = (LAS int*)(lds + RING_OFF);
        const int TPB = RL / G, t0 = blk * TPB;
        if (tid < 32) sh[tid] = 0;
        __syncthreads();
        unsigned long long ctot = 0ull, cpre = 0ull;
        for (int t = tid; t < RL; t += NTHREADS) { const int2 e = *(const int2*)(top_e + 2 * t); const unsigned long long inc = (1ull << (8 * e.x)) + (1ull << (8 * e.y)); ctot += inc; if (t < t0) cpre += inc; }
#pragma unroll
        for (int e = 0; e < 8; ++e) { int a = (int)((ctot >> (8 * e)) & 255ull), b2 = (int)((cpre >> (8 * e)) & 255ull);
#pragma unroll
            for (int o = 1; o < 64; o <<= 1) { a += __shfl_xor(a, o); b2 += __shfl_xor(b2, o); }
            if (lane == 0) { __hip_atomic_fetch_add(&sh[e], a, __ATOMIC_RELAXED, __HIP_MEMORY_SCOPE_WORKGROUP); __hip_atomic_fetch_add(&sh[8 + e], b2, __ATOMIC_RELAXED, __HIP_MEMORY_SCOPE_WORKGROUP); } }
        __syncthreads();
        int base_e[8]; { int acc = 0;
#pragma unroll
            for (int e = 0; e < 8; ++e) { base_e[e] = acc; acc += sh[e]; } }
        if (tid < 8) { MISC[16 + tid] = (unsigned)base_e[tid]; MISC[24 + tid] = (unsigned)sh[tid]; if (blk == 0) { meta[tid] = base_e[tid]; meta[8 + tid] = sh[tid]; } }
        int e0 = 0, e1 = 0; const bool act = tid < TPB;
        if (act) { const int2 e = *(const int2*)(top_e + 2 * (t0 + tid)); e0 = e.x; e1 = e.y; }
        int r0 = 0, r1 = 0;
#pragma unroll
        for (int e = 0; e < 8; ++e) { const bool f = act && (e0 == e || e1 == e); const unsigned long long bal = __ballot(f); const int pre = __popcll(bal & ((1ull << lane) - 1ull));
            if (wave == 0 && lane == 0) sh[16 + e] = __popcll(bal);
            if (e0 == e) r0 = pre; if (e1 == e) r1 = pre; }
        __syncthreads();
        if (act) { if (wave == 1) { r0 += sh[16 + e0]; r1 += sh[16 + e1]; }
            int s0 = 0, s1 = 0;
#pragma unroll
            for (int e = 0; e < 8; ++e) { if (e0 == e) s0 = base_e[e] + sh[8 + e] + r0; if (e1 == e) s1 = base_e[e] + sh[8 + e] + r1; }
            sh[32 + 2 * tid] = s0; sh[33 + 2 * tid] = s1; *(int2*)(tslot + 2 * (t0 + tid)) = make_int2(s0, s1); }
        __syncthreads();
        for (int i = wave; i < TPB; i += NWAVES) { const int t = t0 + i; const int s0 = sh[32 + 2 * i], s1 = sh[33 + 2 * i];
            const uint4 v0 = *(const uint4*)(H4 + (size_t)t * D + lane * 8), v1 = *(const uint4*)(H4 + (size_t)t * D + 512 + lane * 8);
            *(uint4*)(HS + (size_t)s0 * D + lane * 8) = v0; *(uint4*)(HS + (size_t)s0 * D + 512 + lane * 8) = v1;
            *(uint4*)(HS + (size_t)s1 * D + lane * 8) = v0; *(uint4*)(HS + (size_t)s1 * D + 512 + lane * 8) = v1; }
    }
    SEAM(PH_ROUTE);
    if (IN(PH_MOEIN)) {
        if (tid < 16) MISC[16 + tid] = (unsigned)meta[tid];
        __syncthreads();
        pg8::Gemm g{HS, Wmi, D, D, D}; pg8::MoeOrder S; S.init((const LAS int*)(lds + MISC_OFF + 64), 2 * FFN / 256, G, blk); pg8::EpiSwiglu E{ACT2};
        pg8::gemm_phase<pg8::EpiSwiglu, pg8::MoeOrder, true>(lds + RING_OFF, g, S, E); }
    SEAM(PH_MOEIN);
    if (IN(PH_MOEOUT)) {
        if (tid < 16) MISC[16 + tid] = (unsigned)meta[tid];
        __syncthreads();
        pg8::Gemm g{ACT2, Wmo, FFN, FFN, FFN}; pg8::MoeOrder S; S.init((const LAS int*)(lds + MISC_OFF + 64), D / 256, G, blk); pg8::EpiPlain E{YS, D};
        pg8::gemm_phase<pg8::EpiPlain, pg8::MoeOrder, true>(lds + RING_OFF, g, S, E); }
    SEAM(PH_MOEOUT);
    if (IN(PH_ROWS17)) { RowArgs a{}; a.xin_lat = out; a.xin_ctx = cx; a.xout_lat = out; a.xout_ctx = cx; a.Y = YS; a.tok_slot = tslot; a.tok_g = top_g; a.gy = g1n + 3072; a.gate = mv1 + 5120; a.nrows = RL;
        for (int r = gw; r < RL; r += NGW) rows_body(a, r, lane); }
#undef IN
#undef SEAM
}
#ifndef N_LAUNCH_MODE
#define N_LAUNCH_MODE 1
#endif

static inline dim3 g1(size_t n, int per) { return dim3((unsigned)((n + per - 1) / per)); }
extern "C" void kernel_launch(void* const* d_in, const int* in_sizes, int n_in, void* d_out, int out_size, void* d_ws, size_t ws_size, hipStream_t stream) {
    if (n_in != 22 || out_size != RL * D || ws_size < WS_END) { fprintf(stderr, "kernel_launch: unexpected shapes: n_in %d out %d ws %zu (need %zu)\n", n_in, out_size, ws_size, (size_t)WS_END); return; }
    static int grid = 0;
    if (grid == 0) {
        int dev = 0, cus = 0;
        if (hipGetDevice(&dev) != hipSuccess || hipDeviceGetAttribute(&cus, hipDeviceAttributeMultiprocessorCount, dev) != hipSuccess) { grid = -1; return; }
        if (hipFuncSetAttribute((const void*)mega, hipFuncAttributeMaxDynamicSharedMemorySize, LDS_BYTES) != hipSuccess) { fprintf(stderr, "hipFuncSetAttribute failed\n"); grid = -1; return; }
        int per_cu = 0; (void)hipOccupancyMaxActiveBlocksPerMultiprocessor(&per_cu, (const void*)mega, NTHREADS, LDS_BYTES); (void)hipGetLastError();
        if (per_cu < 1) fprintf(stderr, "occupancy query says %d\n", per_cu);
        grid = cus;
    }
    if (grid < 0) return;
    char* ws = (char*)d_ws; float* out = (float*)d_out;
    float* lg = (float*)(ws + WS_LG); int* meta = (int*)(ws + WS_META);
    bf16_t* HB = (bf16_t*)(ws + WS_HB);
    bf16_t* G[9]; for (int i = 0; i < 9; ++i) G[i] = (bf16_t*)(ws + WS_G0 + i * GSZ);
    float* oret = (float*)(ws + WS_ST + 72 * MiB); float* ohg = (float*)(ws + WS_ST + 140 * MiB);
    bf16_t* QN = (bf16_t*)(ws + WS_QN); bf16_t* QR = (bf16_t*)(ws + WS_QR); bf16_t* KN = (bf16_t*)(ws + WS_KN); bf16_t* KR = (bf16_t*)(ws + WS_KR);
    bf16_t* Vv = (bf16_t*)(ws + WS_V); bf16_t* AO = (bf16_t*)(ws + WS_AO);
    bf16_t* H4 = (bf16_t*)(ws + WS_H4); bf16_t* HS = (bf16_t*)(ws + WS_HS);
    int* top_e = (int*)(ws + WS_TOPE); int* rank = (int*)(ws + WS_RANK); int* tslot = (int*)(ws + WS_TSLOT);
    (void)hipMemsetAsync(ws + WS_CTL, 0, 1 * MiB, stream);
    Args a{}; for (int i = 0; i < 22; ++i) a.in[i] = (const float*)d_in[i]; a.out = out; a.ws = (unsigned char*)d_ws;
    auto run = [&](int lo, int hi) { a.ph_lo = lo; a.ph_hi = hi; hipLaunchKernelGGL(mega, dim3(grid), dim3(NTHREADS), LDS_BYTES, stream, a); };
#if N_LAUNCH_MODE == 1
    run(0, PH_COUNT);
#else
    for (int p = PH_SETUP; p < PH_COUNT; ++p) run(p, p + 1);
#endif
}
```

```cpp
#include <hip/hip_runtime.h>
#include <cstdint>
#include <cstdio>

constexpr int NB = 8, T = 4096, CT = 256, D = 1024;
constexpr int RL = NB * T;
constexpr int RC = NB * CT;
constexpr int R = RL + RC;
constexpr int KEYS = CT + T;
constexpr int MIXC = 4608, FFN = 2816, NEXP = 8;
constexpr int DOWNC = 704, DOWNP = 768, QRANK = 384, KVRANK = 256;
constexpr float EPS = 1e-6f;
constexpr int SLOTS = 2 * RL;

typedef unsigned short bf16_t;
__host__ __device__ __forceinline__ float bf2f(bf16_t v) { unsigned u = ((unsigned)v) << 16; float f; __builtin_memcpy(&f, &u, 4); return f; }
__host__ __device__ __forceinline__ bf16_t f2bf(float f) { unsigned u; __builtin_memcpy(&u, &f, 4); return (bf16_t)((u + 0x7fffu + ((u >> 16) & 1u)) >> 16); }
__device__ __forceinline__ float siluf(float v) { return v / (1.f + expf(-v)); }
__device__ __forceinline__ float wave_sum(float v) {
#define WS_DPP(x, ctrl, rm, bc) __builtin_bit_cast(float, __builtin_amdgcn_update_dpp(0, __builtin_bit_cast(int, (x)), (ctrl), (rm), 0xf, (bc)))
    v += WS_DPP(v, 0x111, 0xf, true); v += WS_DPP(v, 0x112, 0xf, true); v += WS_DPP(v, 0x114, 0xf, true); v += WS_DPP(v, 0x118, 0xf, true);
    v += WS_DPP(v, 0x142, 0xa, false); v += WS_DPP(v, 0x143, 0xc, false);
#undef WS_DPP
    return __builtin_bit_cast(float, __builtin_amdgcn_readlane(__builtin_bit_cast(int, v), 63));
}

constexpr size_t MiB = 1u << 20;
constexpr size_t WS_CTL = 0;
constexpr size_t WS_MODV = 512 * 1024;
constexpr size_t WS_LB = 1 * MiB + 512 * 1024;
constexpr size_t WS_LG = WS_LB + 4096;
constexpr size_t WS_META = WS_LB + 8192;
constexpr size_t WS_ROPE_RC = 2 * MiB;
constexpr size_t WS_ROPE_RS = 3 * MiB;
constexpr size_t WS_ROPE_MC = 4 * MiB;
constexpr size_t WS_ROPE_MS = 4 * MiB + 512 * 1024;
constexpr size_t WS_CX = 5 * MiB;
constexpr size_t WS_TOPE = 5 * MiB;
constexpr size_t WS_TOPG = 5 * MiB + 256 * 1024;
constexpr size_t WS_RANK = 5 * MiB + 512 * 1024;
constexpr size_t WS_TSLOT = 5 * MiB + 768 * 1024;
constexpr size_t WS_WSMALL = 13 * MiB;
constexpr size_t WS_HB = 48 * MiB;
constexpr size_t WS_G0 = 116 * MiB;
constexpr size_t GSZ = 34 * MiB;
constexpr size_t WS_ST = 422 * MiB;
constexpr size_t WS_OX = 116 * MiB;
constexpr size_t WS_ACT = 184 * MiB;
constexpr size_t WS_DOWN = 116 * MiB;
constexpr size_t WS_QN = 404 * MiB;
constexpr size_t WS_QR = 231 * MiB;
constexpr size_t WS_KN = 263 * MiB;
constexpr size_t WS_KR = 331 * MiB;
constexpr size_t WS_V = 336 * MiB;
constexpr size_t WS_AO = 468 * MiB;
constexpr size_t WS_O = 167 * MiB;
constexpr size_t WS_NQ = 167 * MiB;
constexpr size_t WS_NKV = 193 * MiB;
constexpr size_t WS_TMP1 = 575 * MiB;
constexpr size_t WS_H4 = 508 * MiB;
constexpr size_t WS_HS = 13 * MiB;
constexpr size_t WS_ACT2 = 145 * MiB;
constexpr size_t WS_YS = 13 * MiB;
constexpr size_t WS_END = 704 * MiB;

__global__ __launch_bounds__(256) void k_mod(const float* __restrict__ c, const float* __restrict__ cctx, const float* __restrict__ mod_w,
                                             const float* __restrict__ mod_b, float* __restrict__ modv) {
    __shared__ float sc[9 * 1024];
    for (int i = threadIdx.x; i < 9 * 1024; i += 256) { int r = i >> 10, k = i & 1023; float v = r < 8 ? c[r * 1024 + k] : cctx[k]; sc[i] = siluf(v); }
    __syncthreads();
    int gid = blockIdx.x * 256 + threadIdx.x; int l = gid / 6144, n = gid % 6144;
    float acc[9];
#pragma unroll
    for (int r = 0; r < 9; ++r) acc[r] = 0.f;
    const float* w = mod_w + (size_t)l * 1024 * 6144 + n;
    for (int k = 0; k < 1024; ++k) { float wv = w[(size_t)k * 6144];
#pragma unroll
        for (int r = 0; r < 9; ++r) acc[r] += sc[r * 1024 + k] * wv; }
    float bb = mod_b[l * 6144 + n];
#pragma unroll
    for (int r = 0; r < 9; ++r) modv[((size_t)l * 9 + r) * 6144 + n] = acc[r] + bb;
}
__device__ __forceinline__ void tables_body(const int gid, const float* __restrict__ lb_logit, const float* __restrict__ decay_logit, float* rc, float* rs, float* mc, float* ms, float* lb, float* lg) {
    if (gid < 4096 * 64) { int t = gid >> 6, j = gid & 63, i = j & 31; float pos = (float)(j < 32 ? (t >> 6) : (t & 63));
        float inv = powf(10000.f, -(float)i / 32.f); float a = pos * inv; rc[gid] = cosf(a); rs[gid] = sinf(a); }
    if (gid < 4096 * 32) { int t = gid >> 5, j = gid & 31, i = j & 15; float pos = (float)(j < 16 ? (t >> 6) : (t & 63));
        float inv = powf(10000.f, -(float)i / 16.f); float a = pos * inv; mc[gid] = cosf(a); ms[gid] = sinf(a); }
    if (gid < 512) { float l0 = lb_logit[gid], l1 = lb_logit[512 + gid]; float m = fmaxf(l0, l1); float e0 = expf(l0 - m), e1 = expf(l1 - m); lb[gid] = e0 / (e0 + e1); }
    if (gid < 8) { float x = decay_logit[gid]; lg[gid] = fminf(x, 0.f) - log1pf(expf(-fabsf(x))); }
}

__global__ __launch_bounds__(256) void k_tables(const float* __restrict__ lb_logit, const float* __restrict__ decay_logit, float* rc, float* rs, float* mc, float* ms, float* lb, float* lg) {
    tables_body(blockIdx.x * 256 + threadIdx.x, lb_logit, decay_logit, rc, rs, mc, ms, lb, lg);
}

struct RowArgs {
    const float* xin_lat; const float* xin_ctx;
    float* xout_lat; float* xout_ctx;
    const bf16_t* Y;
    const int* tok_slot; const float* tok_g;
    const float* gy;
    const float* gate;
    const float* gh; const float* scale; const float* shift;
    bf16_t* H;
    unsigned char* H8;
    const float* router_w; int* top_e; float* top_g;
    int nrows; float oscale; int xin_bf, xout_bf;
};
__device__ __forceinline__ void rows_body(const RowArgs& a, const int r, const int lane) {
    const bool lat = r < RL; const int mr = lat ? (r >> 12) : 8;
    const float* xi = lat ? a.xin_lat + (size_t)r * D : a.xin_ctx + (size_t)(r - RL) * D;
    float x[16];
    if (a.xin_bf) { const bf16_t* xb = lat ? (const bf16_t*)a.xin_lat + (size_t)r * D : (const bf16_t*)a.xin_ctx + (size_t)(r - RL) * D;
#pragma unroll
        for (int j = 0; j < 4; ++j) { const uint2 u = *(const uint2*)(xb + j * 256 + lane * 4); x[4 * j] = bf2f(u.x & 0xffff); x[4 * j + 1] = bf2f(u.x >> 16); x[4 * j + 2] = bf2f(u.y & 0xffff); x[4 * j + 3] = bf2f(u.y >> 16); }
    } else {
#pragma unroll
        for (int j = 0; j < 4; ++j) { float4 v = *(const float4*)(xi + j * 256 + lane * 4); x[4 * j] = v.x; x[4 * j + 1] = v.y; x[4 * j + 2] = v.z; x[4 * j + 3] = v.w; }
    }
    if (a.Y) {
        float y[16];
        if (a.tok_slot) {
            const int s0 = a.tok_slot[2 * r], s1 = a.tok_slot[2 * r + 1]; const float g0 = a.tok_g[2 * r], g1 = a.tok_g[2 * r + 1];
#pragma unroll
            for (int j = 0; j < 4; ++j) { const uint2 u0 = *(const uint2*)(a.Y + (size_t)s0 * D + j * 256 + lane * 4); const uint2 u1 = *(const uint2*)(a.Y + (size_t)s1 * D + j * 256 + lane * 4);
                y[4 * j] = g0 * bf2f(u0.x & 0xffff) + g1 * bf2f(u1.x & 0xffff); y[4 * j + 1] = g0 * bf2f(u0.x >> 16) + g1 * bf2f(u1.x >> 16);
                y[4 * j + 2] = g0 * bf2f(u0.y & 0xffff) + g1 * bf2f(u1.y & 0xffff); y[4 * j + 3] = g0 * bf2f(u0.y >> 16) + g1 * bf2f(u1.y >> 16); }
        } else {
#pragma unroll
            for (int j = 0; j < 4; ++j) { const uint2 u = *(const uint2*)(a.Y + (size_t)r * D + j * 256 + lane * 4);
                y[4 * j] = bf2f(u.x & 0xffff); y[4 * j + 1] = bf2f(u.x >> 16); y[4 * j + 2] = bf2f(u.y & 0xffff); y[4 * j + 3] = bf2f(u.y >> 16); }
        }
        float ss = 0.f;
#pragma unroll
        for (int i = 0; i < 16; ++i) ss += y[i] * y[i];
        ss = wave_sum(ss); const float ry = rsqrtf(ss * (1.f / D) + EPS);
        float* xo = lat ? a.xout_lat + (size_t)r * D : a.xout_ctx + (size_t)(r - RL) * D;
#pragma unroll
        for (int j = 0; j < 4; ++j) { const int c = j * 256 + lane * 4; const float4 g = *(const float4*)(a.gy + c); const float4 gt = *(const float4*)(a.gate + (size_t)mr * 6144 + c);
            x[4 * j] += gt.x * (y[4 * j] * ry * g.x); x[4 * j + 1] += gt.y * (y[4 * j + 1] * ry * g.y); x[4 * j + 2] += gt.z * (y[4 * j + 2] * ry * g.z); x[4 * j + 3] += gt.w * (y[4 * j + 3] * ry * g.w);
            if (a.oscale != 0.f) { x[4 * j] *= a.oscale; x[4 * j + 1] *= a.oscale; x[4 * j + 2] *= a.oscale; x[4 * j + 3] *= a.oscale; }
            if (a.xout_bf) { bf16_t* xob = lat ? (bf16_t*)a.xout_lat + (size_t)r * D : (bf16_t*)a.xout_ctx + (size_t)(r - RL) * D;
                uint2 o; o.x = (unsigned)f2bf(x[4 * j]) | ((unsigned)f2bf(x[4 * j + 1]) << 16); o.y = (unsigned)f2bf(x[4 * j + 2]) | ((unsigned)f2bf(x[4 * j + 3]) << 16); *(uint2*)(xob + c) = o;
                x[4 * j] = bf2f((bf16_t)(o.x & 0xffff)); x[4 * j + 1] = bf2f((bf16_t)(o.x >> 16)); x[4 * j + 2] = bf2f((bf16_t)(o.y & 0xffff)); x[4 * j + 3] = bf2f((bf16_t)(o.y >> 16)); }
            else *(float4*)(xo + c) = make_float4(x[4 * j], x[4 * j + 1], x[4 * j + 2], x[4 * j + 3]); }
    }
    if (a.gh) {
        float ss = 0.f;
#pragma unroll
        for (int i = 0; i < 16; ++i) ss += x[i] * x[i];
        ss = wave_sum(ss); const float rx = rsqrtf(ss * (1.f / D) + EPS);
        float h[16];
#pragma unroll
        for (int j = 0; j < 4; ++j) { const int c = j * 256 + lane * 4; const float4 g = *(const float4*)(a.gh + c); const float4 sc = *(const float4*)(a.scale + (size_t)mr * 6144 + c); const float4 sh = *(const float4*)(a.shift + (size_t)mr * 6144 + c);
            h[4 * j] = x[4 * j] * rx * g.x * (1.f + sc.x) + sh.x; h[4 * j + 1] = x[4 * j + 1] * rx * g.y * (1.f + sc.y) + sh.y;
            h[4 * j + 2] = x[4 * j + 2] * rx * g.z * (1.f + sc.z) + sh.z; h[4 * j + 3] = x[4 * j + 3] * rx * g.w * (1.f + sc.w) + sh.w;
            if (a.H8) { unsigned w = 0u; w = (unsigned)__builtin_amdgcn_cvt_pk_fp8_f32(fminf(fmaxf(h[4 * j], -448.f), 448.f), fminf(fmaxf(h[4 * j + 1], -448.f), 448.f), (int)w, false);
                w = (unsigned)__builtin_amdgcn_cvt_pk_fp8_f32(fminf(fmaxf(h[4 * j + 2], -448.f), 448.f), fminf(fmaxf(h[4 * j + 3], -448.f), 448.f), (int)w, true); *(unsigned*)(a.H8 + (size_t)r * D + c) = w; }
            else { uint2 o; o.x = (unsigned)f2bf(h[4 * j]) | ((unsigned)f2bf(h[4 * j + 1]) << 16); o.y = (unsigned)f2bf(h[4 * j + 2]) | ((unsigned)f2bf(h[4 * j + 3]) << 16);
            *(uint2*)(a.H + (size_t)r * D + c) = o; } }
        if (a.router_w) {
            float lg[8];
#pragma unroll
            for (int e = 0; e < 8; ++e) lg[e] = 0.f;
#pragma unroll
            for (int j = 0; j < 4; ++j)
#pragma unroll
                for (int i = 0; i < 4; ++i) { const int c = j * 256 + lane * 4 + i; const float4 w0 = *(const float4*)(a.router_w + (size_t)c * 8); const float4 w1 = *(const float4*)(a.router_w + (size_t)c * 8 + 4); const float hv = h[4 * j + i];
                    lg[0] += hv * w0.x; lg[1] += hv * w0.y; lg[2] += hv * w0.z; lg[3] += hv * w0.w; lg[4] += hv * w1.x; lg[5] += hv * w1.y; lg[6] += hv * w1.z; lg[7] += hv * w1.w; }
#pragma unroll
            for (int e = 0; e < 8; ++e) lg[e] = wave_sum(lg[e]);
            if (lane == 0) {
                int e0 = 0; float v0 = lg[0];
#pragma unroll
                for (int e = 1; e < 8; ++e) if (lg[e] > v0) { v0 = lg[e]; e0 = e; }
                int e1 = -1; float v1 = -3.0e38f;
#pragma unroll
                for (int e = 0; e < 8; ++e) if (e != e0 && lg[e] > v1) { v1 = lg[e]; e1 = e; }
                if (e1 < 0) { e1 = (e0 + 1) & 7; v1 = v0; }
                const float g0 = 1.f / (1.f + expf(v1 - v0));
                a.top_e[2 * r] = e0; a.top_e[2 * r + 1] = e1; a.top_g[2 * r] = g0; a.top_g[2 * r + 1] = 1.f - g0;
            }
        }
    }
}

__global__ __launch_bounds__(256) void k_rows(RowArgs a) {
    const int lane = threadIdx.x & 63; const int r = blockIdx.x * 4 + (threadIdx.x >> 6);
    if (r >= a.nrows) return;
    rows_body(a, r, lane);
}

template <int MODE>
__global__ __launch_bounds__(256) void k_sgemm(const bf16_t* __restrict__ A, int lda, const float* __restrict__ W, int ldw, void* __restrict__ Cv, int ldc,
                                               int M, int N, int K, const int* __restrict__ meta, int e, size_t wstride, int row_off, int row_cap) {
    constexpr int NBW = (MODE == 2) ? 2 : 1;
    int arow0 = 0;
    if (meta) { arow0 = meta[e] + row_off; int cnt = meta[8 + e] - row_off; M = cnt < row_cap ? cnt : row_cap; W += (size_t)e * wstride; }
    const int bm = blockIdx.y * 128, bn = blockIdx.x * 64;
    if (bm >= M) return;
    __shared__ float As[16][132]; __shared__ float Bs[NBW][16][68];
    const int tid = threadIdx.x, tx = tid & 15, ty = tid >> 4;
    float acc[NBW][8][4];
#pragma unroll
    for (int w = 0; w < NBW; ++w)
#pragma unroll
        for (int i = 0; i < 8; ++i)
#pragma unroll
            for (int j = 0; j < 4; ++j) acc[w][i][j] = 0.f;
    const int ar = tid >> 1, ak = (tid & 1) * 8; const bool aval = (bm + ar) < M;
    const bf16_t* ap = A + (size_t)(arow0 + bm + (aval ? ar : 0)) * lda + ak;
    const int bk = tid >> 4, bc = (tid & 15) * 4; const bool bval = (bn + bc) < N;
    for (int k0 = 0; k0 < K; k0 += 16) {
        uint4 av = aval ? *(const uint4*)(ap + k0) : make_uint4(0, 0, 0, 0);
        As[ak + 0][ar] = bf2f(av.x & 0xffff); As[ak + 1][ar] = bf2f(av.x >> 16); As[ak + 2][ar] = bf2f(av.y & 0xffff); As[ak + 3][ar] = bf2f(av.y >> 16);
        As[ak + 4][ar] = bf2f(av.z & 0xffff); As[ak + 5][ar] = bf2f(av.z >> 16); As[ak + 6][ar] = bf2f(av.w & 0xffff); As[ak + 7][ar] = bf2f(av.w >> 16);
#pragma unroll
        for (int w = 0; w < NBW; ++w) { float4 bv = bval ? *(const float4*)(W + (size_t)(k0 + bk) * ldw + bn + bc + w * N) : make_float4(0, 0, 0, 0); *(float4*)&Bs[w][bk][bc] = bv; }
        __syncthreads();
#pragma unroll
        for (int kk = 0; kk < 16; ++kk) {
            float a[8]; const float4 a0 = *(const float4*)&As[kk][ty * 8], a1 = *(const float4*)&As[kk][ty * 8 + 4];
            a[0] = a0.x; a[1] = a0.y; a[2] = a0.z; a[3] = a0.w; a[4] = a1.x; a[5] = a1.y; a[6] = a1.z; a[7] = a1.w;
#pragma unroll
            for (int w = 0; w < NBW; ++w) { const float4 b = *(const float4*)&Bs[w][kk][tx * 4];
#pragma unroll
                for (int i = 0; i < 8; ++i) { acc[w][i][0] += a[i] * b.x; acc[w][i][1] += a[i] * b.y; acc[w][i][2] += a[i] * b.z; acc[w][i][3] += a[i] * b.w; } }
        }
        __syncthreads();
    }
#pragma unroll
    for (int i = 0; i < 8; ++i) { const int rr = bm + ty * 8 + i; if (rr >= M) continue;
#pragma unroll
        for (int j = 0; j < 4; ++j) { const int cc = bn + tx * 4 + j; if (cc >= N) continue;
            const size_t o = (size_t)(arow0 + rr) * ldc + cc;
            if (MODE == 0) ((float*)Cv)[o] = acc[0][i][j];
            else if (MODE == 1) ((bf16_t*)Cv)[o] = f2bf(acc[0][i][j]);
            else ((bf16_t*)Cv)[o] = f2bf(siluf(acc[0][i][j]) * acc[NBW - 1][i][j]); } }
}

__global__ __launch_bounds__(256) void k_mixact(const float* __restrict__ tmp, bf16_t* __restrict__ G, int grp, const float* __restrict__ rc, const float* __restrict__ rs, const float* __restrict__ lb) {
    const size_t gid = (size_t)blockIdx.x * 256 + threadIdx.x; if (gid >= (size_t)R * 512) return;
    const int r = (int)(gid >> 9), c = (int)(gid & 511); float v = tmp[gid], o;
    if (grp <= 1) {
        const int j = c & 127, jj = j & 63; const float other = tmp[(size_t)r * 512 + (c ^ 64)];
        float x1 = j < 64 ? v : other, x2 = j < 64 ? other : v;
        if (grp == 1) { x1 *= 0.08838834764831845f; x2 *= 0.08838834764831845f; }
        if (r < RL) { const int t = r & 4095; const float cs = rc[t * 64 + jj], sn = rs[t * 64 + jj]; o = j < 64 ? x1 * cs - x2 * sn : x1 * sn + x2 * cs; }
        else o = j < 64 ? x1 : x2;
    } else if (grp == 2 || grp == 7) o = v;
    else if (grp == 3 || grp == 4 || grp == 8) o = siluf(v);
    else { const float l = lb[c]; o = (1.f - l) / (1.f + expf(v)); }
    G[gid] = f2bf(o);
}
template <int ALGO>
__global__ __launch_bounds__(128) void k_scan_naive(const bf16_t* __restrict__ Q, const bf16_t* __restrict__ Kf, const bf16_t* __restrict__ Kb, const bf16_t* __restrict__ V,
                                                    const float* __restrict__ lg, float* __restrict__ O) {
    const int b = blockIdx.x >> 2, h = blockIdx.x & 3, e = threadIdx.x;
    __shared__ float sq[32][128]; __shared__ float sk[32][128];
    for (int dir = 0; dir < 2; ++dir) {
        const bf16_t* Kp = dir ? Kb : Kf; const float gamma = (ALGO == 0) ? expf(lg[dir * 4 + h]) : 0.f;
        float S[128];
#pragma unroll
        for (int d = 0; d < 128; ++d) S[d] = 0.f;
        for (int p0 = 0; p0 < KEYS; p0 += 32) {
            __syncthreads();
            for (int i = threadIdx.x; i < 32 * 128; i += 128) { const int s = i >> 7, d = i & 127; const int p = p0 + s;
                const int row = p < CT ? (RL + b * CT + (dir ? CT - 1 - p : p)) : (b * T + (dir ? T - 1 - (p - CT) : (p - CT)));
                sq[s][d] = bf2f(Q[(size_t)row * 512 + h * 128 + d]); sk[s][d] = bf2f(Kp[(size_t)row * 512 + h * 128 + d]); }
            __syncthreads();
            for (int s = 0; s < 32; ++s) { const int p = p0 + s;
                const int row = p < CT ? (RL + b * CT + (dir ? CT - 1 - p : p)) : (b * T + (dir ? T - 1 - (p - CT) : (p - CT)));
                const float v = bf2f(V[(size_t)row * 512 + h * 128 + e]); float o = 0.f;
#pragma unroll
                for (int d = 0; d < 128; ++d) { const float kd = sk[s][d]; const float dec = (ALGO == 0) ? gamma : (1.f - kd); S[d] = dec * S[d] + kd * v; o += sq[s][d] * S[d]; }
                float* op = O + (size_t)row * 512 + h * 128 + e; if (dir == 0) *op = o; else *op += o; }
        }
    }
}
__global__ __launch_bounds__(256) void k_merge(const float* __restrict__ Oret, const float* __restrict__ Ohg, const bf16_t* __restrict__ AG, const bf16_t* __restrict__ BG, bf16_t* __restrict__ Y, int part_sel) {
    const int lane = threadIdx.x & 63; const size_t w = (size_t)blockIdx.x * 4 + (threadIdx.x >> 6); if (w >= (size_t)R * 8) return;
    const int r = (int)(w >> 3), part = (int)((w >> 2) & 1), h = (int)(w & 3);
    if (part_sel >= 0 && part != part_sel) return;
    const float* src = (part ? Ohg : Oret) + (size_t)r * 512 + h * 128; const bf16_t* g = (part ? BG : AG) + (size_t)r * 512 + h * 128;
    const float v0 = src[lane * 2], v1 = src[lane * 2 + 1]; const float ss = wave_sum(v0 * v0 + v1 * v1); const float rr = rsqrtf(ss * (1.f / 128.f) + EPS);
    bf16_t* y = Y + (size_t)r * 1024 + part * 512 + h * 128;
    y[lane * 2] = f2bf(v0 * rr * bf2f(g[lane * 2])); y[lane * 2 + 1] = f2bf(v1 * rr * bf2f(g[lane * 2 + 1]));
}

__device__ __forceinline__ void mla_prep_body(const int r, const int lane, const bf16_t* __restrict__ DOWN, const float* __restrict__ gq, const float* __restrict__ gkv, const float* __restrict__ mc, const float* __restrict__ ms,
                                                  bf16_t* __restrict__ NQ, bf16_t* __restrict__ NKV, bf16_t* __restrict__ KR) {
    const bf16_t* d = DOWN + (size_t)r * DOWNP;
    float q[6]; float ss = 0.f;
#pragma unroll
    for (int i = 0; i < 6; ++i) { q[i] = bf2f(d[lane + 64 * i]); ss += q[i] * q[i]; }
    ss = wave_sum(ss); const float rq = rsqrtf(ss * (1.f / 384.f) + EPS);
#pragma unroll
    for (int i = 0; i < 6; ++i) NQ[(size_t)r * 384 + lane + 64 * i] = f2bf(q[i] * rq * gq[lane + 64 * i]);
    float k[4]; ss = 0.f;
#pragma unroll
    for (int i = 0; i < 4; ++i) { k[i] = bf2f(d[384 + lane + 64 * i]); ss += k[i] * k[i]; }
    ss = wave_sum(ss); const float rk = rsqrtf(ss * (1.f / 256.f) + EPS);
#pragma unroll
    for (int i = 0; i < 4; ++i) NKV[(size_t)r * 256 + lane + 64 * i] = f2bf(k[i] * rk * gkv[lane + 64 * i]);
    const float x1 = bf2f(d[640 + (lane & 31)]), x2 = bf2f(d[672 + (lane & 31)]);
    const bool lat = r < RL; const int b = lat ? (r >> 12) : ((r - RL) >> 8); const int key = lat ? CT + (r & 4095) : ((r - RL) & 255);
    float o;
    if (lat) { const int t = r & 4095; const float cs = mc[t * 32 + (lane & 31)], sn = ms[t * 32 + (lane & 31)]; o = lane < 32 ? x1 * cs - x2 * sn : x1 * sn + x2 * cs; }
    else o = lane < 32 ? x1 : x2;
    KR[((size_t)b * KEYS + key) * 64 + lane] = f2bf(o);
}
__global__ __launch_bounds__(256) void k_mla_prep(const bf16_t* __restrict__ DOWN, const float* __restrict__ gq, const float* __restrict__ gkv, const float* __restrict__ mc, const float* __restrict__ ms,
                                                  bf16_t* __restrict__ NQ, bf16_t* __restrict__ NKV, bf16_t* __restrict__ KR) {
    const int lane = threadIdx.x & 63; const int r = blockIdx.x * 4 + (threadIdx.x >> 6); if (r >= R) return;
    mla_prep_body(r, lane, DOWN, gq, gkv, mc, ms, NQ, NKV, KR);
}
__global__ __launch_bounds__(256) void k_qsplit(const float* __restrict__ tmp, int r0, int nrows, const float* __restrict__ mc, const float* __restrict__ ms, bf16_t* __restrict__ QN, bf16_t* __restrict__ QR) {
    const size_t gid = (size_t)blockIdx.x * 256 + threadIdx.x; if (gid >= (size_t)nrows * 1536) return;
    const int rr = (int)(gid / 1536), c = (int)(gid % 1536), h = c / 192, j = c % 192; const int r = r0 + rr, b = r >> 12, t = r & 4095;
    const float v = tmp[gid];
    if (j < 128) QN[(((size_t)b * 8 + h) * T + t) * 128 + j] = f2bf(v);
    else { const int jr = j - 128, jj = jr & 31; const float other = tmp[(size_t)rr * 1536 + h * 192 + 128 + (jr ^ 32)];
        const float x1 = jr < 32 ? v : other, x2 = jr < 32 ? other : v; const float cs = mc[t * 32 + jj], sn = ms[t * 32 + jj];
        QR[(((size_t)b * 8 + h) * T + t) * 64 + jr] = f2bf(jr < 32 ? x1 * cs - x2 * sn : x1 * sn + x2 * cs); }
}
__global__ __launch_bounds__(256) void k_kvsplit(const float* __restrict__ tmp, int r0, int nrows, bf16_t* __restrict__ KN, bf16_t* __restrict__ Vv) {
    const size_t gid = (size_t)blockIdx.x * 256 + threadIdx.x; if (gid >= (size_t)nrows * 2048) return;
    const int rr = (int)(gid >> 11), c = (int)(gid & 2047), h = c >> 8, j = c & 255; const int r = r0 + rr;
    const bool lat = r < RL; const int b = lat ? (r >> 12) : ((r - RL) >> 8); const int key = lat ? CT + (r & 4095) : ((r - RL) & 255);
    bf16_t* dst = (j < 128 ? KN : Vv) + (((size_t)b * 8 + h) * KEYS + key) * 128 + (j & 127);
    *dst = f2bf(tmp[gid]);
}
__global__ __launch_bounds__(256) void k_attn_naive(const bf16_t* __restrict__ QN, const bf16_t* __restrict__ QR, const bf16_t* __restrict__ KN, const bf16_t* __restrict__ KR, const bf16_t* __restrict__ Vv, bf16_t* __restrict__ AO) {
    __shared__ float sq[2][192]; __shared__ float sc[2][KEYS]; __shared__ float red[2][4];
    const int tid = threadIdx.x; const int qb = blockIdx.x % (T / 2), h = (blockIdx.x / (T / 2)) & 7, b = blockIdx.x / (T / 2 * 8);
    const int t0 = qb * 2; const size_t bh = (size_t)b * 8 + h;
    for (int i = tid; i < 2 * 192; i += 256) { const int q = i / 192, j = i % 192; sq[q][j] = j < 128 ? bf2f(QN[(bh * T + t0 + q) * 128 + j]) : bf2f(QR[(bh * T + t0 + q) * 64 + j - 128]); }
    __syncthreads();
    const float scale = 0.07216878364870322f;
    float m0 = -3e38f, m1 = -3e38f;
    for (int key = tid; key < KEYS; key += 256) {
        const uint4* kn = (const uint4*)(KN + (bh * KEYS + key) * 128); const uint4* kr = (const uint4*)(KR + ((size_t)b * KEYS + key) * 64);
        float s0 = 0.f, s1 = 0.f;
        for (int c = 0; c < 24; ++c) { const uint4 u = c < 16 ? kn[c] : kr[c - 16]; const int j = c * 8;
            const float k0 = bf2f(u.x & 0xffff), k1 = bf2f(u.x >> 16), k2 = bf2f(u.y & 0xffff), k3 = bf2f(u.y >> 16), k4 = bf2f(u.z & 0xffff), k5 = bf2f(u.z >> 16), k6 = bf2f(u.w & 0xffff), k7 = bf2f(u.w >> 16);
            s0 += sq[0][j] * k0 + sq[0][j + 1] * k1 + sq[0][j + 2] * k2 + sq[0][j + 3] * k3 + sq[0][j + 4] * k4 + sq[0][j + 5] * k5 + sq[0][j + 6] * k6 + sq[0][j + 7] * k7;
            s1 += sq[1][j] * k0 + sq[1][j + 1] * k1 + sq[1][j + 2] * k2 + sq[1][j + 3] * k3 + sq[1][j + 4] * k4 + sq[1][j + 5] * k5 + sq[1][j + 6] * k6 + sq[1][j + 7] * k7; }
        s0 *= scale; s1 *= scale; sc[0][key] = s0; sc[1][key] = s1; m0 = fmaxf(m0, s0); m1 = fmaxf(m1, s1);
    }
#pragma unroll
    for (int o = 1; o < 64; o <<= 1) { m0 = fmaxf(m0, __shfl_xor(m0, o)); m1 = fmaxf(m1, __shfl_xor(m1, o)); }
    if ((tid & 63) == 0) { red[0][tid >> 6] = m0; red[1][tid >> 6] = m1; }
    __syncthreads();
    m0 = fmaxf(fmaxf(red[0][0], red[0][1]), fmaxf(red[0][2], red[0][3])); m1 = fmaxf(fmaxf(red[1][0], red[1][1]), fmaxf(red[1][2], red[1][3]));
    __syncthreads();
    float l0 = 0.f, l1 = 0.f;
    for (int key = tid; key < KEYS; key += 256) { const float p0 = expf(sc[0][key] - m0), p1 = expf(sc[1][key] - m1); sc[0][key] = p0; sc[1][key] = p1; l0 += p0; l1 += p1; }
    l0 = wave_sum(l0); l1 = wave_sum(l1);
    if ((tid & 63) == 0) { red[0][tid >> 6] = l0; red[1][tid >> 6] = l1; }
    __syncthreads();
    l0 = red[0][0] + red[0][1] + red[0][2] + red[0][3]; l1 = red[1][0] + red[1][1] + red[1][2] + red[1][3];
    const int q = tid >> 7, d = tid & 127; const float* p = sc[q]; float o = 0.f;
    const bf16_t* vp = Vv + bh * KEYS * 128 + d;
    for (int key = 0; key < KEYS; ++key) o += p[key] * bf2f(vp[(size_t)key * 128]);
    AO[((size_t)b * T + t0 + q) * 1024 + h * 128 + d] = f2bf(o / (q ? l1 : l0));
}

__global__ __launch_bounds__(1024) void k_route_rank(const int* __restrict__ top_e, int* __restrict__ rank, int* __restrict__ meta) {
    __shared__ int ws[16]; __shared__ int running;
    const int e = blockIdx.x, tid = threadIdx.x, lane = tid & 63, wid = tid >> 6;
    if (tid == 0) running = 0;
    __syncthreads();
    for (int t0 = 0; t0 < RL; t0 += 1024) { const int t = t0 + tid; const int e0 = top_e[2 * t], e1 = top_e[2 * t + 1]; const int f = (e0 == e || e1 == e) ? 1 : 0;
        const unsigned long long bal = __ballot(f); const int pre = __popcll(bal & ((1ull << lane) - 1ull));
        if (lane == 0) ws[wid] = __popcll(bal);
        __syncthreads();
        int off = 0; for (int w = 0; w < wid; ++w) off += ws[w];
        int tot = 0; for (int w = 0; w < 16; ++w) tot += ws[w];
        const int base = running;
        if (f) rank[2 * t + (e0 == e ? 0 : 1)] = base + off + pre;
        __syncthreads();
        if (tid == 0) running = base + tot;
        __syncthreads();
    }
    if (tid == 0) meta[8 + e] = running;
}
__global__ void k_route_base(int* meta) { if (threadIdx.x == 0) { int s = 0; for (int e = 0; e < 8; ++e) { meta[e] = s; s += meta[8 + e]; } } }
__global__ __launch_bounds__(256) void k_gather(const bf16_t* __restrict__ H4, const int* __restrict__ top_e, const int* __restrict__ rank, const int* __restrict__ meta, bf16_t* __restrict__ HS, int* __restrict__ tok_slot) {
    const int lane = threadIdx.x & 63; const int t = blockIdx.x * 4 + (threadIdx.x >> 6); if (t >= RL) return;
    const uint4 v0 = *(const uint4*)(H4 + (size_t)t * D + lane * 8), v1 = *(const uint4*)(H4 + (size_t)t * D + 512 + lane * 8);
#pragma unroll
    for (int k = 0; k < 2; ++k) { const int e = top_e[2 * t + k]; const int slot = meta[e] + rank[2 * t + k];
        *(uint4*)(HS + (size_t)slot * D + lane * 8) = v0; *(uint4*)(HS + (size_t)slot * D + 512 + lane * 8) = v1;
        if (lane == 0) tok_slot[2 * t + k] = slot; }
}


namespace rows2 {
#define RLAS __attribute__((address_space(3)))
typedef unsigned ru2 __attribute__((ext_vector_type(2)));
typedef float rf4 __attribute__((ext_vector_type(4)));
typedef float rf2 __attribute__((ext_vector_type(2)));
typedef int ri2 __attribute__((ext_vector_type(2)));
typedef float rf2_cv __attribute__((ext_vector_type(2))); typedef __bf16 rb2_cv __attribute__((ext_vector_type(2)));
__device__ __forceinline__ unsigned pk_bf16(float lo, float hi) { const rf2_cv v = {lo, hi}; const rb2_cv b = __builtin_convertvector(v, rb2_cv); return __builtin_bit_cast(unsigned, b); }
__device__ __forceinline__ float lo_bf(unsigned u) { return __builtin_bit_cast(float, u << 16); }
__device__ __forceinline__ float hi_bf(unsigned u) { return __builtin_bit_cast(float, u & 0xffff0000u); }
template <bool XF32, int YM> struct Raw { rf4 xf[XF32 ? 4 : 1]; ru2 xb[XF32 ? 1 : 4]; ru2 y0[YM ? 4 : 1]; ru2 y1[YM == 2 ? 4 : 1]; };
struct Slot { int s0, s1; float g0, g1; };
constexpr int RW_STRIDE = 144;
constexpr int RW_BYTES = 256 * RW_STRIDE;

__device__ __forceinline__ void stage_router(const float* __restrict__ router_w, RLAS unsigned char* rwl, const int tid, const int nthreads) {
    for (int q = tid; q < 2048; q += nthreads) { const int c = q >> 1, half = q & 1; const rf4 v = *(const rf4*)(router_w + (size_t)c * 8 + half * 4);
        const int j = c >> 8, L = (c >> 2) & 63, i = c & 3; *(RLAS rf4*)(rwl + (j * 64 + L) * RW_STRIDE + i * 32 + half * 16) = v; }
}

template <bool XF32, int YM, int XO, int HO, bool RT>
__device__ __forceinline__ void rows_phase(const RowArgs& a, const int gw, const int NGW, const int lane, const bool with_ctx, RLAS unsigned char* rwl) {
    const int WPB = NGW >> 3, bb = gw / WPB, i0 = gw - bb * WPB;
    const int nl = i0 < T ? (T - i0 + WPB - 1) / WPB : 0;
    const int nc = (with_ctx && gw < RC) ? (RC - gw + NGW - 1) / NGW : 0;
    const int n = nl + nc;
    auto row_of = [&](int k) -> int { return k < nl ? bb * T + i0 + WPB * k : RL + gw + NGW * (k - nl); };
    auto load_slot = [&](Slot& s, int r) { const ri2 t = *(const ri2*)(a.tok_slot + 2 * (size_t)r); const rf2 g = *(const rf2*)(a.tok_g + 2 * (size_t)r); s.s0 = t.x; s.s1 = t.y; s.g0 = g.x; s.g1 = g.y; };
    auto load = [&](Raw<XF32, YM>& w, int r, const Slot& s) {
        const bool lat = r < RL;
        if constexpr (XF32) { const float* xp = lat ? a.xin_lat + (size_t)r * D : a.xin_ctx + (size_t)(r - RL) * D;
#pragma unroll
            for (int j = 0; j < 4; ++j) w.xf[j] = *(const rf4*)(xp + j * 256 + lane * 4);
        } else { const bf16_t* xp = lat ? (const bf16_t*)a.xin_lat + (size_t)r * D : (const bf16_t*)a.xin_ctx + (size_t)(r - RL) * D;
#pragma unroll
            for (int j = 0; j < 4; ++j) w.xb[j] = *(const ru2*)(xp + j * 256 + lane * 4); }
        if constexpr (YM == 1) { const bf16_t* yp = a.Y + (size_t)r * D;
#pragma unroll
            for (int j = 0; j < 4; ++j) w.y0[j] = *(const ru2*)(yp + j * 256 + lane * 4); }
        if constexpr (YM == 2) { const bf16_t* p0 = a.Y + (size_t)s.s0 * D; const bf16_t* p1 = a.Y + (size_t)s.s1 * D;
#pragma unroll
            for (int j = 0; j < 4; ++j) { w.y0[j] = *(const ru2*)(p0 + j * 256 + lane * 4); w.y1[j] = *(const ru2*)(p1 + j * 256 + lane * 4); } }
    };
    float A[16], Bm[16], Cm[16]; int cur_mr = -1;
    auto process = [&](const Raw<XF32, YM>& w, int r, const Slot& s) {
        const bool lat = r < RL; const int mr = lat ? (r >> 12) : 8;
        if (mr != cur_mr) { cur_mr = mr;
#pragma unroll
            for (int j = 0; j < 4; ++j) { const int c = j * 256 + lane * 4;
                if constexpr (YM != 0) { const rf4 g = *(const rf4*)(a.gy + c); const rf4 gt = *(const rf4*)(a.gate + (size_t)mr * 6144 + c);
                    A[4 * j] = gt.x * g.x; A[4 * j + 1] = gt.y * g.y; A[4 * j + 2] = gt.z * g.z; A[4 * j + 3] = gt.w * g.w; }
                if constexpr (HO != 0) { const rf4 g = *(const rf4*)(a.gh + c); const rf4 sc = *(const rf4*)(a.scale + (size_t)mr * 6144 + c); const rf4 sh = *(const rf4*)(a.shift + (size_t)mr * 6144 + c);
                    Bm[4 * j] = g.x * (1.f + sc.x); Bm[4 * j + 1] = g.y * (1.f + sc.y); Bm[4 * j + 2] = g.z * (1.f + sc.z); Bm[4 * j + 3] = g.w * (1.f + sc.w);
                    Cm[4 * j] = sh.x; Cm[4 * j + 1] = sh.y; Cm[4 * j + 2] = sh.z; Cm[4 * j + 3] = sh.w; } }
        }
        float x[16];
#pragma unroll
        for (int j = 0; j < 4; ++j) {
            if constexpr (XF32) { x[4 * j] = w.xf[j].x; x[4 * j + 1] = w.xf[j].y; x[4 * j + 2] = w.xf[j].z; x[4 * j + 3] = w.xf[j].w; }
            else { x[4 * j] = lo_bf(w.xb[j].x); x[4 * j + 1] = hi_bf(w.xb[j].x); x[4 * j + 2] = lo_bf(w.xb[j].y); x[4 * j + 3] = hi_bf(w.xb[j].y); } }
        if constexpr (YM != 0) {
            float y[16];
#pragma unroll
            for (int j = 0; j < 4; ++j) {
                if constexpr (YM == 2) { y[4 * j] = s.g0 * lo_bf(w.y0[j].x) + s.g1 * lo_bf(w.y1[j].x); y[4 * j + 1] = s.g0 * hi_bf(w.y0[j].x) + s.g1 * hi_bf(w.y1[j].x);
                    y[4 * j + 2] = s.g0 * lo_bf(w.y0[j].y) + s.g1 * lo_bf(w.y1[j].y); y[4 * j + 3] = s.g0 * hi_bf(w.y0[j].y) + s.g1 * hi_bf(w.y1[j].y); }
                else { y[4 * j] = lo_bf(w.y0[j].x); y[4 * j + 1] = hi_bf(w.y0[j].x); y[4 * j + 2] = lo_bf(w.y0[j].y); y[4 * j + 3] = hi_bf(w.y0[j].y); } }
            float ss = 0.f;
#pragma unroll
            for (int i = 0; i < 16; ++i) ss += y[i] * y[i];
            ss = wave_sum(ss); const float ry = rsqrtf(ss * (1.f / D) + EPS);
#pragma unroll
            for (int j = 0; j < 4; ++j) { const int c = j * 256 + lane * 4;
#pragma unroll
                for (int i = 0; i < 4; ++i) x[4 * j + i] += A[4 * j + i] * (y[4 * j + i] * ry);
                if constexpr (XO == 1) { bf16_t* xob = lat ? (bf16_t*)a.xout_lat + (size_t)r * D : (bf16_t*)a.xout_ctx + (size_t)(r - RL) * D;
                    ru2 o; o.x = pk_bf16(x[4 * j], x[4 * j + 1]); o.y = pk_bf16(x[4 * j + 2], x[4 * j + 3]); *(ru2*)(xob + c) = o;
                    x[4 * j] = lo_bf(o.x); x[4 * j + 1] = hi_bf(o.x); x[4 * j + 2] = lo_bf(o.y); x[4 * j + 3] = hi_bf(o.y); }
                if constexpr (XO == 2) { float* xo = lat ? a.xout_lat + (size_t)r * D : a.xout_ctx + (size_t)(r - RL) * D;
                    const rf4 o = {x[4 * j], x[4 * j + 1], x[4 * j + 2], x[4 * j + 3]}; *(rf4*)(xo + c) = o; } }
        }
        if constexpr (HO != 0) {
            float ss = 0.f;
#pragma unroll
            for (int i = 0; i < 16; ++i) ss += x[i] * x[i];
            ss = wave_sum(ss); const float rx = rsqrtf(ss * (1.f / D) + EPS);
            float h[16];
#pragma unroll
            for (int j = 0; j < 4; ++j) { const int c = j * 256 + lane * 4;
#pragma unroll
                for (int i = 0; i < 4; ++i) h[4 * j + i] = (x[4 * j + i] * rx) * Bm[4 * j + i] + Cm[4 * j + i];
                if constexpr (HO == 2) { unsigned wv = 0u; wv = (unsigned)__builtin_amdgcn_cvt_pk_fp8_f32(fminf(fmaxf(h[4 * j], -448.f), 448.f), fminf(fmaxf(h[4 * j + 1], -448.f), 448.f), (int)wv, false);
                    wv = (unsigned)__builtin_amdgcn_cvt_pk_fp8_f32(fminf(fmaxf(h[4 * j + 2], -448.f), 448.f), fminf(fmaxf(h[4 * j + 3], -448.f), 448.f), (int)wv, true); *(unsigned*)(a.H8 + (size_t)r * D + c) = wv; }
                else { ru2 o; o.x = pk_bf16(h[4 * j], h[4 * j + 1]); o.y = pk_bf16(h[4 * j + 2], h[4 * j + 3]); *(ru2*)(a.H + (size_t)r * D + c) = o; } }
            if constexpr (RT) {
                float lg[8];
#pragma unroll
                for (int e = 0; e < 8; ++e) lg[e] = 0.f;
#pragma unroll
                for (int j = 0; j < 4; ++j) { const RLAS unsigned char* bp = rwl + (j * 64 + lane) * RW_STRIDE;
#pragma unroll
                    for (int i = 0; i < 4; ++i) { const rf4 w0 = *(const RLAS rf4*)(bp + i * 32); const rf4 w1 = *(const RLAS rf4*)(bp + i * 32 + 16); const float hv = h[4 * j + i];
                        lg[0] += hv * w0.x; lg[1] += hv * w0.y; lg[2] += hv * w0.z; lg[3] += hv * w0.w; lg[4] += hv * w1.x; lg[5] += hv * w1.y; lg[6] += hv * w1.z; lg[7] += hv * w1.w; }
                    __builtin_amdgcn_sched_barrier(0); }
#pragma unroll
                for (int e = 0; e < 8; ++e) lg[e] = wave_sum(lg[e]);
                if (lane == 0) {
                    int e0 = 0; float v0 = lg[0];
#pragma unroll
                    for (int e = 1; e < 8; ++e) if (lg[e] > v0) { v0 = lg[e]; e0 = e; }
                    int e1 = -1; float v1 = -3.0e38f;
#pragma unroll
                    for (int e = 0; e < 8; ++e) if (e != e0 && lg[e] > v1) { v1 = lg[e]; e1 = e; }
                    if (e1 < 0) { e1 = (e0 + 1) & 7; v1 = v0; }
                    const float g0 = 1.f / (1.f + expf(v1 - v0));
                    a.top_e[2 * r] = e0; a.top_e[2 * r + 1] = e1; a.top_g[2 * r] = g0; a.top_g[2 * r + 1] = 1.f - g0;
                }
            }
        }
    };
    Raw<XF32, YM> ra, rb; Slot s_cur{}, s_nxt{};
    if (n > 0) { if constexpr (YM == 2) load_slot(s_cur, row_of(0));
        load(ra, row_of(0), s_cur);
        if constexpr (YM == 2) { if (n > 1) load_slot(s_nxt, row_of(1)); } }
    auto step = [&](const Raw<XF32, YM>& cur, Raw<XF32, YM>& nxt, int k) {
        Slot s_n2{};
        if (k + 1 < n) { load(nxt, row_of(k + 1), s_nxt); if constexpr (YM == 2) { if (k + 2 < n) load_slot(s_n2, row_of(k + 2)); } }
        process(cur, row_of(k), s_cur);
        s_cur = s_nxt; s_nxt = s_n2;
    };
#pragma unroll 1
    for (int k = 0; k < n; k += 2) { step(ra, rb, k); if (k + 1 < n) step(rb, ra, k + 1); }
}

struct PrepRaw { unsigned q[3], k[2], x1, x2; };
__device__ __forceinline__ void prep_load(PrepRaw& w, const bf16_t* __restrict__ DOWN, int r, int lane) {
    const bf16_t* d = DOWN + (size_t)r * DOWNP;
#pragma unroll
    for (int i = 0; i < 3; ++i) w.q[i] = *(const unsigned*)(d + 2 * lane + 128 * i);
#pragma unroll
    for (int i = 0; i < 2; ++i) w.k[i] = *(const unsigned*)(d + 384 + 2 * lane + 128 * i);
    w.x1 = *(const unsigned*)(d + 640 + 2 * (lane & 15)); w.x2 = *(const unsigned*)(d + 672 + 2 * (lane & 15));
}
__device__ __forceinline__ void prep_process(const PrepRaw& w, int r, int lane, const float* __restrict__ gq, const float* __restrict__ gkv, const float* __restrict__ mc, const float* __restrict__ ms,
                                             bf16_t* __restrict__ NQ, bf16_t* __restrict__ NKV, bf16_t* __restrict__ KR) {
    float q[6], k[4]; float ss = 0.f;
#pragma unroll
    for (int i = 0; i < 3; ++i) { q[2 * i] = lo_bf(w.q[i]); q[2 * i + 1] = hi_bf(w.q[i]); ss += q[2 * i] * q[2 * i] + q[2 * i + 1] * q[2 * i + 1]; }
    ss = wave_sum(ss); const float rq = rsqrtf(ss * (1.f / 384.f) + EPS);
#pragma unroll
    for (int i = 0; i < 3; ++i) { const rf2 g = *(const rf2*)(gq + 2 * lane + 128 * i); *(unsigned*)(NQ + (size_t)r * 384 + 2 * lane + 128 * i) = pk_bf16(q[2 * i] * rq * g.x, q[2 * i + 1] * rq * g.y); }
    ss = 0.f;
#pragma unroll
    for (int i = 0; i < 2; ++i) { k[2 * i] = lo_bf(w.k[i]); k[2 * i + 1] = hi_bf(w.k[i]); ss += k[2 * i] * k[2 * i] + k[2 * i + 1] * k[2 * i + 1]; }
    ss = wave_sum(ss); const float rk = rsqrtf(ss * (1.f / 256.f) + EPS);
#pragma unroll
    for (int i = 0; i < 2; ++i) { const rf2 g = *(const rf2*)(gkv + 2 * lane + 128 * i); *(unsigned*)(NKV + (size_t)r * 256 + 2 * lane + 128 * i) = pk_bf16(k[2 * i] * rk * g.x, k[2 * i + 1] * rk * g.y); }
    if (lane < 16) {
        const bool lat = r < RL; const int b = lat ? (r >> 12) : ((r - RL) >> 8); const int key = lat ? CT + (r & 4095) : ((r - RL) & 255);
        const float a0 = lo_bf(w.x1), a1 = hi_bf(w.x1), b0 = lo_bf(w.x2), b1 = hi_bf(w.x2);
        float o0 = a0, o1 = a1, p0 = b0, p1 = b1;
        if (lat) { const int t = r & 4095; const rf2 cs = *(const rf2*)(mc + t * 32 + 2 * lane), sn = *(const rf2*)(ms + t * 32 + 2 * lane);
            o0 = a0 * cs.x - b0 * sn.x; o1 = a1 * cs.y - b1 * sn.y; p0 = a0 * sn.x + b0 * cs.x; p1 = a1 * sn.y + b1 * cs.y; }
        bf16_t* kr = KR + ((size_t)b * KEYS + key) * 64 + 2 * lane;
        *(unsigned*)kr = pk_bf16(o0, o1); *(unsigned*)(kr + 32) = pk_bf16(p0, p1);
    }
}
__device__ __forceinline__ void prep_phase(const bf16_t* __restrict__ DOWN, const float* __restrict__ gq, const float* __restrict__ gkv, const float* __restrict__ mc, const float* __restrict__ ms,
                                           bf16_t* __restrict__ NQ, bf16_t* __restrict__ NKV, bf16_t* __restrict__ KR, int gw, int NGW, int lane) {
    PrepRaw ra, rb;
    if (gw < R) prep_load(ra, DOWN, gw, lane);
#pragma unroll 1
    for (int r = gw; r < R; r += 2 * NGW) {
        if (r + NGW < R) prep_load(rb, DOWN, r + NGW, lane);
        prep_process(ra, r, lane, gq, gkv, mc, ms, NQ, NKV, KR);
        if (r + NGW < R) { if (r + 2 * NGW < R) prep_load(ra, DOWN, r + 2 * NGW, lane); prep_process(rb, r + NGW, lane, gq, gkv, mc, ms, NQ, NKV, KR); }
    }
}
}
#ifndef MOE_FP8
#define MOE_FP8 1
#endif
#ifndef FFN_FP8
#define FFN_FP8 1
#endif

#define LAS __attribute__((address_space(3)))
#define GAS __attribute__((address_space(1)))
typedef short bf16x8 __attribute__((ext_vector_type(8)));
typedef float f32x4 __attribute__((ext_vector_type(4)));
typedef float f32x2 __attribute__((ext_vector_type(2)));
typedef unsigned u32x4 __attribute__((ext_vector_type(4)));
typedef unsigned u32x2 __attribute__((ext_vector_type(2)));
constexpr size_t WS_WMI = 572 * MiB;
constexpr size_t WS_WMO = 660 * MiB;
constexpr size_t WS_W_MIXIN = WS_WSMALL;
constexpr size_t WS_W_MIXOUT = WS_W_MIXIN + 9 * MiB;
constexpr size_t WS_W_FFNIN = WS_W_MIXOUT + 2 * MiB;
constexpr size_t WS_W_FFNOUT = WS_W_FFNIN + 11 * MiB;
constexpr size_t WS_W_DOWN = WS_W_FFNOUT + 5632 * 1024;
constexpr size_t WS_W_UQ = WS_W_DOWN + 1536 * 1024;
constexpr size_t WS_W_UKV = WS_W_UQ + 1152 * 1024;
constexpr size_t WS_W_MLAOUT = WS_W_UKV + 1 * MiB;
static_assert(WS_W_MLAOUT + 2 * MiB <= WS_HB, "small weights fit");

typedef float f32x2_cv __attribute__((ext_vector_type(2))); typedef __bf16 bf16x2_cv __attribute__((ext_vector_type(2)));
__device__ __forceinline__ unsigned cvt_pk_bf16(float lo, float hi) { const f32x2_cv v = {lo, hi}; const bf16x2_cv b = __builtin_convertvector(v, bf16x2_cv); return __builtin_bit_cast(unsigned, b); }
__device__ __forceinline__ int tidx(int wv) { int t = (wv << 6) | (int)__builtin_amdgcn_mbcnt_hi(~0u, __builtin_amdgcn_mbcnt_lo(~0u, 0u)); asm volatile("" : "+v"(t)); return t; }
__device__ __forceinline__ unsigned pack4_fp8(float a, float b, float c, float d) { unsigned w = 0u; w = (unsigned)__builtin_amdgcn_cvt_pk_fp8_f32(a, b, (int)w, false); w = (unsigned)__builtin_amdgcn_cvt_pk_fp8_f32(c, d, (int)w, true); return w; }
__device__ __forceinline__ float clamp448(float v) { return fminf(fmaxf(v, -448.f), 448.f); }
constexpr float W8_SCALE = 64.f, W8_INV = 1.f / 64.f;
typedef int v8i_t __attribute__((ext_vector_type(8)));
typedef int v4i_t __attribute__((ext_vector_type(4)));
__device__ __forceinline__ float fast_silu(float v) { return v * __builtin_amdgcn_rcpf(1.f + __expf(-v)); }

namespace pg8 {
constexpr int BM = 256, BK = 64, HALF = 128, HTB = HALF * BK * 2  , STAGE_BYTES = 8 * HTB, NXCD = 8, WGM = 8;
__host__ __device__ __forceinline__ int lds_byte(int r, int c) { const int st = (r >> 4) * 2 + (c >> 5), rr = r & 15, cc = c & 31, ob = rr * 64 + cc * 2; return st * 1024 + (ob ^ (((ob >> 9) & 1) << 5)); }
__host__ __device__ __forceinline__ void stage_rc(int b, int& R_, int& C_) { const int st = b / 1024, sb = b % 1024, swz = sb ^ (((sb >> 9) & 1) << 5); R_ = (st >> 1) * 16 + swz / 64; C_ = (st & 1) * 32 + (swz % 64) / 2; }
__host__ __device__ __forceinline__ int perm32(int rho) { const int n = rho >> 4, i = rho & 15; return 8 * (i >> 2) + 4 * n + (i & 3); }

struct Unit { int arow, brow, pm, pn, rend; };
struct Gemm { const bf16_t* A; const bf16_t* Bt; int lda, ldb, K; };

struct DenseOrder {
    int nM, nN, nwg, G, c;
    __device__ void init(int nM_, int nN_, int G_, int c_) { nM = nM_; nN = nN_; nwg = nM * nN; G = G_; c = c_; }
    __device__ bool next(int i, Unit& u) const {
        const long L = (long)i * G + c; if (L >= nwg) return false;
        int wgid = (int)L; { const int q = nwg / NXCD, r = nwg % NXCD, xcd = wgid % NXCD, off = wgid / NXCD; wgid = (xcd < r ? xcd * (q + 1) : r * (q + 1) + (xcd - r) * q) + off; }
        const int nig = WGM * nN, gid = wgid / nig, fm = gid * WGM, gsz = (nM - fm) < WGM ? (nM - fm) : WGM;
        u.pm = fm + ((wgid % nig) % gsz); u.pn = (wgid % nig) / gsz; u.arow = u.pm * BM; u.brow = u.pn * BM; u.rend = 0x7fffffff; return true;
    }
    __device__ __forceinline__ void a_ready(const Unit&) const {}
    __device__ __forceinline__ void done(const Unit&) const {}
};
struct MoeOrder {
    const LAS int* meta; int nN, G, c, nwg;
    __device__ void init(const LAS int* meta_, int nN_, int G_, int c_) { meta = meta_; nN = nN_; G = G_; c = c_; int s = 0;
#pragma unroll
        for (int e = 0; e < 8; ++e) s += ((meta[8 + e] + 255) >> 8) * nN; nwg = __builtin_amdgcn_readfirstlane(s); }
    __device__ bool next(int i, Unit& u) const {
        const int L = i * G + c; if (L >= nwg) return false;
        int wgid = L; { const int q = nwg / NXCD, r = nwg % NXCD, xcd = wgid % NXCD, off = wgid / NXCD; wgid = (xcd < r ? xcd * (q + 1) : r * (q + 1) + (xcd - r) * q) + off; }
        int e = -1, nM = 1, base = 0, cnt = 0;
#pragma unroll
        for (int k = 0; k < 8; ++k) { const int ck = meta[8 + k], tk = (ck + 255) >> 8, uk = tk * nN; if (e < 0) { if (wgid < uk) { e = k; nM = tk; base = meta[k]; cnt = ck; } else wgid -= uk; } }
        if (e < 0) return false;
        const int nig = WGM * nN, gid = wgid / nig, fm = gid * WGM, gsz = (nM - fm) < WGM ? (nM - fm) : WGM;
        const int pm_ = fm + ((wgid % nig) % gsz), pn_ = (wgid % nig) / gsz;
        u.pm = __builtin_amdgcn_readfirstlane(pm_); u.pn = __builtin_amdgcn_readfirstlane(pn_); u.arow = __builtin_amdgcn_readfirstlane(base + pm_ * BM); u.brow = __builtin_amdgcn_readfirstlane((e * nN + pn_) * BM); u.rend = __builtin_amdgcn_readfirstlane(base + cnt); return true;
    }
    __device__ __forceinline__ void a_ready(const Unit&) const {}
    __device__ __forceinline__ void done(const Unit&) const {}
};

#define EPI_ROWS(...) _Pragma("unroll") for (int ai = 0; ai < 2; ++ai) _Pragma("unroll") for (int m = 0; m < 4; ++m) { const int row = u.arow + ai * HALF + wr * 64 + m * 16 + fr; __VA_ARGS__ }
__device__ __forceinline__ u32x4 pack8(const f32x4 a, const f32x4 b) { u32x4 w; w.x = cvt_pk_bf16(a[0], a[1]); w.y = cvt_pk_bf16(a[2], a[3]); w.z = cvt_pk_bf16(b[0], b[1]); w.w = cvt_pk_bf16(b[2], b[3]); return w; }

struct EpiPlain {
    static constexpr bool PERM = true, AFTER_DRAIN = false;
    bf16_t* O; int ldc;
    __device__ __forceinline__ void operator()(const f32x4 (&acc)[2][2][4][2], const Unit& u, int wr, int wc, int fr, int fq) const {
        const int col0 = u.pn * BM + wc * 32 + fq * 8;
        EPI_ROWS( if (row < u.rend) { bf16_t* rowp = O + (size_t)row * ldc + col0;
            _Pragma("unroll") for (int bj = 0; bj < 2; ++bj) *(u32x4*)(rowp + bj * HALF) = pack8(acc[ai][bj][m][0], acc[ai][bj][m][1]); } )
    }
};
struct EpiSwiglu {
    static constexpr bool PERM = true, AFTER_DRAIN = false;
    bf16_t* O;
    __device__ __forceinline__ void operator()(const f32x4 (&acc)[2][2][4][2], const Unit& u, int wr, int wc, int fr, int fq) const {
        const int col0 = u.pn * HALF + wc * 32 + fq * 8;
        EPI_ROWS( if (row < u.rend) { f32x4 o0, o1;
            _Pragma("unroll") for (int i = 0; i < 4; ++i) { o0[i] = fast_silu(acc[ai][0][m][0][i]) * acc[ai][1][m][0][i]; o1[i] = fast_silu(acc[ai][0][m][1][i]) * acc[ai][1][m][1][i]; }
            *(u32x4*)(O + (size_t)row * FFN + col0) = pack8(o0, o1); } )
    }
};
struct EpiSwiglu8 {
    static constexpr bool PERM = true, AFTER_DRAIN = false;
    unsigned char* O; float sc;
    __device__ __forceinline__ void operator()(const f32x4 (&acc)[2][2][4][2], const Unit& u, int wr, int wc, int fr, int fq) const {
        const int col0 = u.pn * HALF + wc * 32 + fq * 8;
        EPI_ROWS( if (row < u.rend) { float o[8];
            _Pragma("unroll") for (int i = 0; i < 4; ++i) { o[i] = clamp448(fast_silu(acc[ai][0][m][0][i] * sc) * (acc[ai][1][m][0][i] * sc)); o[4 + i] = clamp448(fast_silu(acc[ai][0][m][1][i] * sc) * (acc[ai][1][m][1][i] * sc)); }
            *(u32x2*)(O + (size_t)row * FFN + col0) = (u32x2){pack4_fp8(o[0], o[1], o[2], o[3]), pack4_fp8(o[4], o[5], o[6], o[7])}; } )
    }
};
struct EpiPlainS {
    static constexpr bool PERM = true, AFTER_DRAIN = false;
    bf16_t* O; int ldc; float sc;
    __device__ __forceinline__ void operator()(const f32x4 (&acc)[2][2][4][2], const Unit& u, int wr, int wc, int fr, int fq) const {
        const int col0 = u.pn * BM + wc * 32 + fq * 8;
        EPI_ROWS( if (row < u.rend) { bf16_t* rowp = O + (size_t)row * ldc + col0;
            _Pragma("unroll") for (int bj = 0; bj < 2; ++bj) *(u32x4*)(rowp + bj * HALF) = pack8(acc[ai][bj][m][0] * sc, acc[ai][bj][m][1] * sc); } )
    }
};
struct EpiMix {
    static constexpr bool PERM = true, AFTER_DRAIN = false;
    bf16_t* G0; const float* rc; const float* rs; const float* lb;
    __device__ __forceinline__ void operator()(const f32x4 (&acc)[2][2][4][2], const Unit& u, int wr, int wc, int fr, int fq) const {
        const int grp = u.pn >> 1, half = u.pn & 1; bf16_t* Gp = G0 + (size_t)grp * (GSZ / 2);
        if (grp <= 1) {
            const int head = half * 2 + (wc >> 1), jb = (wc & 1) * 32 + fq * 8; const float sc = grp == 1 ? 0.08838834764831845f : 1.f;
            float frv[8];
#pragma unroll
            for (int i = 0; i < 8; ++i) frv[i] = __builtin_amdgcn_exp2f(-(float)((jb + i) & 31) * 0.41524101186092029f) * 0.15915494309189535f;
            EPI_ROWS( f32x4 a0 = acc[ai][0][m][0] * sc, a1 = acc[ai][0][m][1] * sc, b0 = acc[ai][1][m][0] * sc, b1 = acc[ai][1][m][1] * sc; f32x4 o0, o1, p0, p1;
                if (row < RL) { const int t = row & 4095; const float pos = (float)(jb < 32 ? (t >> 6) : (t & 63)); f32x4 c0, c1, s0, s1;
                    _Pragma("unroll") for (int i = 0; i < 4; ++i) { const float r0 = __builtin_amdgcn_fractf(pos * frv[i]), r1 = __builtin_amdgcn_fractf(pos * frv[4 + i]);
                        c0[i] = __builtin_amdgcn_cosf(r0); s0[i] = __builtin_amdgcn_sinf(r0); c1[i] = __builtin_amdgcn_cosf(r1); s1[i] = __builtin_amdgcn_sinf(r1); }
                    o0 = a0 * c0 - b0 * s0; o1 = a1 * c1 - b1 * s1; p0 = a0 * s0 + b0 * c0; p1 = a1 * s1 + b1 * c1; }
                else { o0 = a0; o1 = a1; p0 = b0; p1 = b1; }
                bf16_t* dst = Gp + (size_t)row * 512 + head * 128 + jb; __builtin_nontemporal_store(pack8(o0, o1), (u32x4*)dst); __builtin_nontemporal_store(pack8(p0, p1), (u32x4*)(dst + 64)); )
        } else {
            const int cb = half * 256 + wc * 32 + fq * 8;
            EPI_ROWS( _Pragma("unroll") for (int bj = 0; bj < 2; ++bj) { f32x4 v0 = acc[ai][bj][m][0], v1 = acc[ai][bj][m][1]; const int c = cb + bj * HALF;
                if (grp == 3 || grp == 4 || grp == 8) { _Pragma("unroll") for (int i = 0; i < 4; ++i) { v0[i] = fast_silu(v0[i]); v1[i] = fast_silu(v1[i]); } }
                else if (grp == 5 || grp == 6) { const f32x4 l0 = *(const f32x4*)(lb + c), l1 = *(const f32x4*)(lb + c + 4);
                    _Pragma("unroll") for (int i = 0; i < 4; ++i) { v0[i] = (1.f - l0[i]) * __builtin_amdgcn_rcpf(1.f + __expf(v0[i])); v1[i] = (1.f - l1[i]) * __builtin_amdgcn_rcpf(1.f + __expf(v1[i])); } }
                __builtin_nontemporal_store(pack8(v0, v1), (u32x4*)(Gp + (size_t)row * 512 + c)); } )
        }
    }
};
struct EpiUQ {
    static constexpr bool PERM = true, AFTER_DRAIN = false;
    bf16_t* QN; bf16_t* QR; const float* mc; const float* ms;
    __device__ __forceinline__ void operator()(const f32x4 (&acc)[2][2][4][2], const Unit& u, int wr, int wc, int fr, int fq) const {
        if (u.pn < 4) {
            EPI_ROWS( const int b = row >> 12, t = row & 4095;
                _Pragma("unroll") for (int bj = 0; bj < 2; ++bj) { const int h = 2 * u.pn + bj; *(u32x4*)(QN + (((size_t)b * 8 + h) * T + t) * 128 + wc * 32 + fq * 8) = pack8(acc[ai][bj][m][0], acc[ai][bj][m][1]); } )
        } else {
            const int h = 4 * (u.pn - 4) + wc, jb = fq * 8;
            float frv[8];
#pragma unroll
            for (int i = 0; i < 8; ++i) frv[i] = __builtin_amdgcn_exp2f(-(float)((jb + i) & 15) * 0.83048202372184059f) * 0.15915494309189535f;
            EPI_ROWS( const int b = row >> 12, t = row & 4095; const f32x4 a0 = acc[ai][0][m][0], a1 = acc[ai][0][m][1], b0 = acc[ai][1][m][0], b1 = acc[ai][1][m][1];
                const float pos = (float)(jb < 16 ? (t >> 6) : (t & 63)); f32x4 c0, c1, s0, s1;
                _Pragma("unroll") for (int i = 0; i < 4; ++i) { const float r0 = __builtin_amdgcn_fractf(pos * frv[i]), r1 = __builtin_amdgcn_fractf(pos * frv[4 + i]);
                    c0[i] = __builtin_amdgcn_cosf(r0); s0[i] = __builtin_amdgcn_sinf(r0); c1[i] = __builtin_amdgcn_cosf(r1); s1[i] = __builtin_amdgcn_sinf(r1); }
                bf16_t* dst = QR + (((size_t)b * 8 + h) * T + t) * 64 + jb; *(u32x4*)dst = pack8(a0 * c0 - b0 * s0, a1 * c1 - b1 * s1); *(u32x4*)(dst + 32) = pack8(a0 * s0 + b0 * c0, a1 * s1 + b1 * c1); )
        }
    }
};
struct EpiUKV {
    static constexpr bool PERM = true, AFTER_DRAIN = false;
    bf16_t* KN; bf16_t* V;
    __device__ __forceinline__ void operator()(const f32x4 (&acc)[2][2][4][2], const Unit& u, int wr, int wc, int fr, int fq) const {
        EPI_ROWS( const bool lat = row < RL; const int b = lat ? (row >> 12) : ((row - RL) >> 8); const int key = lat ? CT + (row & 4095) : ((row - RL) & 255);
            const size_t off = (((size_t)b * 8 + u.pn) * KEYS + key) * 128 + wc * 32 + fq * 8;
            *(u32x4*)(KN + off) = pack8(acc[ai][0][m][0], acc[ai][0][m][1]); *(u32x4*)(V + off) = pack8(acc[ai][1][m][0], acc[ai][1][m][1]); )
    }
};

template <class Epi, class Sched, bool ALIGN_EPI, bool FP8 = false>
__device__ __forceinline__ void gemm_phase(LAS unsigned char* lds, const Gemm g, const Sched& S, const Epi& E, const int wv) {
    const int tid = tidx(wv), wid = __builtin_amdgcn_readfirstlane(tid >> 6), lane = tid & 63, wr = wid >> 2, wc = wid & 3, fr = lane & 15, fq = lane >> 4;
    const int K = g.K, nt = K / BK;
    unsigned voffA[2], voffB[2];
#pragma unroll
    for (int i = 0; i < 2; ++i) { int R_, C_; stage_rc(tid * 16 + i * 8192, R_, C_); const int Rb = Epi::PERM ? ((R_ & ~31) + perm32(R_ & 31)) : R_;
        voffA[i] = (unsigned)(R_ * g.lda + C_) * 2u; voffB[i] = (unsigned)(Rb * g.ldb + C_) * 2u; }
    const size_t kstep = (size_t)(BK * 2);
    const size_t hstepA = (size_t)HALF * g.lda * 2, hstepB = (size_t)HALF * g.ldb * 2;
    const unsigned ldsw = (unsigned)wid * 1024u;
    const int aoff = lds_byte(wr * 64 + fr, fq * 8), boff = lds_byte(wc * 32 + fr, fq * 8);
#define PG8_SA(b, h) (((b) * 2 + (h)) * HTB)
#define PG8_SB(b, h) ((4 + (b) * 2 + (h)) * HTB)
#define PG8_STAGE(bufoff, gbase, voff) do { _Pragma("unroll") for (int _i = 0; _i < 2; ++_i) { unsigned _vo = (voff)[_i]; asm volatile("" : "+v"(_vo));     \
        __builtin_amdgcn_global_load_lds((const unsigned*)((const char*)(gbase) + _vo), (LAS unsigned*)(lds + (bufoff) + ldsw + _i * 8192), 16, 0, 0); } } while (0)
#define PG8_LDA(dst, b, h) do { _Pragma("unroll") for (int m = 0; m < 4; ++m) { if constexpr (FP8) dst##8[m] = __builtin_shufflevector(*(const LAS v4i_t*)(lds + PG8_SA(b, h) + aoff + m * 2048), *(const LAS v4i_t*)(lds + PG8_SA(b, h) + aoff + m * 2048 + 1024), 0, 1, 2, 3, 4, 5, 6, 7); \
        else { _Pragma("unroll") for (int k = 0; k < 2; ++k) dst[m][k] = *(const LAS bf16x8*)(lds + PG8_SA(b, h) + aoff + m * 2048 + k * 1024); } } } while (0)
#define PG8_LDB(dst, b, h) do { _Pragma("unroll") for (int n = 0; n < 2; ++n) { if constexpr (FP8) dst##8[n] = __builtin_shufflevector(*(const LAS v4i_t*)(lds + PG8_SB(b, h) + boff + n * 2048), *(const LAS v4i_t*)(lds + PG8_SB(b, h) + boff + n * 2048 + 1024), 0, 1, 2, 3, 4, 5, 6, 7); \
        else { _Pragma("unroll") for (int k = 0; k < 2; ++k) dst[n][k] = *(const LAS bf16x8*)(lds + PG8_SB(b, h) + boff + n * 2048 + k * 1024); } } } while (0)
#define PG8_MMA(ai, bj, At, Bt) do { __builtin_amdgcn_s_setprio(1); _Pragma("unroll") for (int m = 0; m < 4; ++m) _Pragma("unroll") for (int n = 0; n < 2; ++n) { \
        if constexpr (FP8) { acc[ai][bj][m][n] = __builtin_amdgcn_mfma_scale_f32_16x16x128_f8f6f4(Bt##8[n], At##8[m], acc[ai][bj][m][n], 0, 0, 0, 0x7f7f7f7f, 0, 0x7f7f7f7f); } \
        else { _Pragma("unroll") for (int k = 0; k < 2; ++k) acc[ai][bj][m][n] = __builtin_amdgcn_mfma_f32_16x16x32_bf16(Bt[n][k], At[m][k], acc[ai][bj][m][n], 0, 0, 0); } } \
        __builtin_amdgcn_s_setprio(0); } while (0)
#define PG8_WAIT_V(n) asm volatile("s_waitcnt vmcnt(" #n ")" ::: "memory")
#define PG8_WAIT_L(n) asm volatile("s_waitcnt lgkmcnt(" #n ")" ::: "memory")
#define PG8_BAR __builtin_amdgcn_s_barrier()
#define PG8_SCHED __builtin_amdgcn_sched_barrier(0)
    Unit cur, nxt; int ui = 0;
    if (!S.next(0, cur)) return;
    f32x4 acc[2][2][4][2];
#pragma unroll
    for (int a = 0; a < 2; ++a)
#pragma unroll
        for (int b = 0; b < 2; ++b)
#pragma unroll
            for (int m = 0; m < 4; ++m)
#pragma unroll
                for (int n = 0; n < 2; ++n) acc[a][b][m][n] = (f32x4){0.f, 0.f, 0.f, 0.f};
    bf16x8 At[4][2], B0[2][2], B1[2][2]; v8i_t At8[4], B08[2], B18[2];
    const char* cA = (const char*)g.A + (size_t)cur.arow * g.lda * 2; const char* cB = (const char*)g.Bt + (size_t)cur.brow * g.ldb * 2;
    S.a_ready(cur);
    PG8_STAGE(PG8_SB(0, 0), cB, voffB); PG8_STAGE(PG8_SB(0, 1), cB + hstepB, voffB); PG8_STAGE(PG8_SA(0, 0), cA, voffA); PG8_STAGE(PG8_SA(0, 1), cA + hstepA, voffA);
    if (wr == 1) PG8_BAR;
    PG8_WAIT_V(2); PG8_BAR;
    PG8_STAGE(PG8_SB(1, 0), cB + kstep, voffB); PG8_STAGE(PG8_SA(1, 0), cA + kstep, voffA); PG8_STAGE(PG8_SB(1, 1), cB + hstepB + kstep, voffB);
    PG8_WAIT_V(6); PG8_BAR;
    for (;;) {
        const bool has_next = S.next(ui + 1, nxt);
        const char* nA = has_next ? (const char*)g.A + (size_t)nxt.arow * g.lda * 2 : cA; const char* nB = has_next ? (const char*)g.Bt + (size_t)nxt.brow * g.ldb * 2 : cB;
#pragma unroll 1
        for (int t = 0; t < nt; t += 2) {
            const bool last = (t == nt - 2);
            const char* a1 = cA + (size_t)(t + 1) * kstep;
            const char* a2 = last ? nA : cA + (size_t)(t + 2) * kstep; const char* b2 = last ? nB : cB + (size_t)(t + 2) * kstep;
            const char* a3 = a2 + kstep; const char* b3 = b2 + kstep;
            if (last && has_next) S.a_ready(nxt);
            PG8_LDB(B0, 0, 0); PG8_LDB(B1, 0, 1); PG8_SCHED; PG8_LDA(At, 0, 0); PG8_STAGE(PG8_SA(1, 1), a1 + hstepA, voffA);
            PG8_WAIT_V(8); PG8_WAIT_L(0); PG8_BAR; PG8_MMA(0, 0, At, B0); PG8_MMA(0, 1, At, B1); PG8_BAR; PG8_SCHED;
            PG8_LDA(At, 0, 1); PG8_STAGE(PG8_SB(0, 0), b2, voffB); PG8_STAGE(PG8_SB(0, 1), b2 + hstepB, voffB); PG8_STAGE(PG8_SA(0, 0), a2, voffA);
            PG8_WAIT_V(8); PG8_WAIT_L(0); PG8_BAR; PG8_MMA(1, 0, At, B0); PG8_MMA(1, 1, At, B1); PG8_BAR; PG8_SCHED;
            PG8_LDB(B0, 1, 0); PG8_LDB(B1, 1, 1); PG8_SCHED; PG8_LDA(At, 1, 0); PG8_STAGE(PG8_SA(0, 1), a2 + hstepA, voffA);
            PG8_WAIT_V(8); PG8_WAIT_L(0); PG8_BAR; PG8_MMA(0, 0, At, B0); PG8_MMA(0, 1, At, B1); PG8_BAR; PG8_SCHED;
            PG8_LDA(At, 1, 1); PG8_STAGE(PG8_SB(1, 0), b3, voffB); PG8_STAGE(PG8_SB(1, 1), b3 + hstepB, voffB); PG8_STAGE(PG8_SA(1, 0), a3, voffA);
            PG8_WAIT_V(8); PG8_WAIT_L(0); PG8_BAR; PG8_MMA(1, 0, At, B0); PG8_MMA(1, 1, At, B1); PG8_BAR; PG8_SCHED;
        }
        if constexpr (ALIGN_EPI) { if (wr == 0) PG8_BAR; }
        { const int l2_ = tidx(wv) & 63; E(acc, cur, wr, wc, l2_ & 15, l2_ >> 4); } S.done(cur);
        if (!has_next) break;
#pragma unroll
        for (int a = 0; a < 2; ++a)
#pragma unroll
            for (int b = 0; b < 2; ++b)
#pragma unroll
                for (int m = 0; m < 4; ++m)
#pragma unroll
                    for (int n = 0; n < 2; ++n) acc[a][b][m][n] = (f32x4){0.f, 0.f, 0.f, 0.f};
        cur = nxt; cA = nA; cB = nB; ++ui;
        if constexpr (ALIGN_EPI) { if (wr == 1) PG8_BAR; }
    }
    PG8_WAIT_V(0);
    if constexpr (!ALIGN_EPI) { if (wr == 0) PG8_BAR; }
    PG8_BAR;
#undef PG8_SA
#undef PG8_SB
#undef PG8_STAGE
#undef PG8_LDA
#undef PG8_LDB
#undef PG8_MMA
#undef PG8_WAIT_V
#undef PG8_WAIT_L
#undef PG8_BAR
#undef PG8_SCHED
}
}


namespace attn {
using s16x4 = __attribute__((ext_vector_type(4))) short;
using f32x16 = __attribute__((ext_vector_type(16))) float;
constexpr int NW = 8, QBLK = 32, KVBLK = 64;
constexpr float SCALE = 0.07216878364870322f;
constexpr float THR = 8.f;
constexpr int SHM_V = KVBLK * 128 * 2, SHM_K = KVBLK * 128 * 2, SHM_R = KVBLK * 64 * 2, NBUF = 3;
constexpr int OFF_V = 0, OFF_K = NBUF * SHM_V, OFF_R = OFF_K + NBUF * SHM_K, OFF_W = OFF_R + NBUF * SHM_R, LDS_NEED = OFF_W + NW * 64 * 4;
#define KSWZ(row, colB) ((row) * 256 + ((colB) ^ (((row) & 7) << 4)))
#define RSWZ(row, colB) ((row) * 128 + ((colB) ^ ((((row) >> 1) & 7) << 4)))
#define SBAR() __builtin_amdgcn_sched_barrier(0)
__device__ __forceinline__ int crow(int r, int hi) { return (r & 3) + 8 * (r >> 2) + 4 * hi; }
__device__ __forceinline__ unsigned cvtpk(float lo, float hi) { return cvt_pk_bf16(lo, hi); }

__device__ __forceinline__ void partialSM(f32x16& p0, f32x16& p1, float& m_reg, float& mn, float& alpha) {
    constexpr float C = SCALE * 1.4426950408889634f;
    float pmax = p0[0];
#pragma unroll
    for (int r = 1; r < 16; ++r) pmax = fmaxf(pmax, p0[r]);
#pragma unroll
    for (int r = 0; r < 16; ++r) pmax = fmaxf(pmax, p1[r]);
    { auto rr = __builtin_amdgcn_permlane32_swap(__float_as_uint(pmax), __float_as_uint(pmax), false, false);
      pmax = fmaxf(__uint_as_float(rr[0]), __uint_as_float(rr[1])); }
    if (__builtin_expect(__all(pmax - m_reg <= THR / SCALE), 1)) { mn = m_reg; alpha = 1.f; }
    else { mn = fmaxf(m_reg, pmax); alpha = __builtin_amdgcn_exp2f((m_reg - mn) * C); m_reg = mn; }
    const float mnC = -mn * C;
#pragma unroll
    for (int r = 0; r < 16; ++r) p0[r] = fmaf(p0[r], C, mnC);
#pragma unroll
    for (int r = 0; r < 16; ++r) p1[r] = fmaf(p1[r], C, mnC);
#pragma unroll
    for (int r = 0; r < 16; ++r) p0[r] = __builtin_amdgcn_exp2f(p0[r]);
}
__device__ __forceinline__ void finishSM(f32x16& p0, f32x16& p1, float alpha, float& l_reg, bf16x8& pa0, bf16x8& pa1, bf16x8& pa2, bf16x8& pa3) {
#pragma unroll
    for (int r = 0; r < 16; ++r) p1[r] = __builtin_amdgcn_exp2f(p1[r]);
    float ps = 0;
#pragma unroll
    for (int r = 0; r < 16; ++r) ps += p0[r];
#pragma unroll
    for (int r = 0; r < 16; ++r) ps += p1[r];
    { auto rr = __builtin_amdgcn_permlane32_swap(__float_as_uint(ps), __float_as_uint(ps), false, false);
      ps = __uint_as_float(rr[0]) + __uint_as_float(rr[1]); }
    l_reg = l_reg * alpha + ps;
#define PK4(P, BASE, OUT) do { unsigned a0 = cvtpk(P[BASE + 0], P[BASE + 1]), a1 = cvtpk(P[BASE + 2], P[BASE + 3]);   \
    unsigned b0 = cvtpk(P[BASE + 4], P[BASE + 5]), b1 = cvtpk(P[BASE + 6], P[BASE + 7]);                              \
    auto r0 = __builtin_amdgcn_permlane32_swap(a0, b0, false, false); auto r1 = __builtin_amdgcn_permlane32_swap(a1, b1, false, false); \
    u32x4 w = {r0[0], r1[0], r0[1], r1[1]}; OUT = *reinterpret_cast<bf16x8*>(&w); } while (0)
    PK4(p0, 0, pa0); PK4(p0, 8, pa1); PK4(p1, 0, pa2); PK4(p1, 8, pa3);
#undef PK4
}
__device__ __forceinline__ void qkt(f32x16& p0, f32x16& p1, const LAS char* Ks, const LAS char* Rs, const bf16x8* qr, const bf16x8* qrr, int r32, int hi) {
    p0 = f32x16{}; p1 = f32x16{};
#pragma unroll
    for (int d0 = 0; d0 < 8; ++d0) { const int cb = (d0 * 16 + hi * 8) * 2;
        const bf16x8 b0 = *reinterpret_cast<const LAS bf16x8*>(Ks + KSWZ(r32, cb));
        const bf16x8 b1 = *reinterpret_cast<const LAS bf16x8*>(Ks + KSWZ(32 + r32, cb));
        p0 = __builtin_amdgcn_mfma_f32_32x32x16_bf16(b0, qr[d0], p0, 0, 0, 0);
        p1 = __builtin_amdgcn_mfma_f32_32x32x16_bf16(b1, qr[d0], p1, 0, 0, 0); if ((d0 & 3) == 3) SBAR(); }
#pragma unroll
    for (int d0 = 0; d0 < 4; ++d0) { const int cb = (d0 * 16 + hi * 8) * 2;
        const bf16x8 b0 = *reinterpret_cast<const LAS bf16x8*>(Rs + RSWZ(r32, cb));
        const bf16x8 b1 = *reinterpret_cast<const LAS bf16x8*>(Rs + RSWZ(32 + r32, cb));
        p0 = __builtin_amdgcn_mfma_f32_32x32x16_bf16(b0, qrr[d0], p0, 0, 0, 0);
        p1 = __builtin_amdgcn_mfma_f32_32x32x16_bf16(b1, qrr[d0], p1, 0, 0, 0); }
}
__device__ __forceinline__ int v_st(int k, int c) { const int kk = (k & ~0xC) | ((k & 4) << 1) | ((k & 8) >> 1); return ((kk >> 3) * 4 + (c >> 5)) * 512 + ((kk & 7) * 32 + (c & 31)) * 2; }
__device__ __forceinline__ int v_rd_base(int lane) { return ((lane & 3) << 3) | (((lane >> 2) & 3) << 6) | (((lane >> 4) & 1) << 5) | (((lane >> 5) & 1) << 8); }
constexpr int v_rd_off(int d0, int ks, int half) { return d0 * 512 + ks * 4096 + half * 2048; }
template <int OFF> __device__ __forceinline__ s16x4 tr_read(int vb) {
    s16x4 r; asm volatile("ds_read_b64_tr_b16 %0, %1 offset:%2" : "=&v"(r) : "v"(vb), "i"(OFF) : "memory"); return r;
}
template <int D0> __device__ __forceinline__ void pv_one(f32x16& od, int vb, bf16x8 pa0, bf16x8 pa1, bf16x8 pa2, bf16x8 pa3) {
    const s16x4 l0 = tr_read<v_rd_off(D0, 0, 0)>(vb), h0 = tr_read<v_rd_off(D0, 0, 1)>(vb), l1 = tr_read<v_rd_off(D0, 1, 0)>(vb), h1 = tr_read<v_rd_off(D0, 1, 1)>(vb);
    const s16x4 l2 = tr_read<v_rd_off(D0, 2, 0)>(vb), h2 = tr_read<v_rd_off(D0, 2, 1)>(vb), l3 = tr_read<v_rd_off(D0, 3, 0)>(vb), h3 = tr_read<v_rd_off(D0, 3, 1)>(vb);
    asm volatile("s_waitcnt lgkmcnt(0)" ::: "memory"); SBAR();
#define PK(L, H) (bf16x8){L[0], L[1], L[2], L[3], H[0], H[1], H[2], H[3]}
    od = __builtin_amdgcn_mfma_f32_32x32x16_bf16(pa0, PK(l0, h0), od, 0, 0, 0);
    od = __builtin_amdgcn_mfma_f32_32x32x16_bf16(pa1, PK(l1, h1), od, 0, 0, 0);
    od = __builtin_amdgcn_mfma_f32_32x32x16_bf16(pa2, PK(l2, h2), od, 0, 0, 0);
    od = __builtin_amdgcn_mfma_f32_32x32x16_bf16(pa3, PK(l3, h3), od, 0, 0, 0);
#undef PK
}
__device__ __forceinline__ void pv_d0(f32x16* o, int vb, bf16x8 pa0, bf16x8 pa1, bf16x8 pa2, bf16x8 pa3) {
    pv_one<0>(o[0], vb, pa0, pa1, pa2, pa3); pv_one<1>(o[1], vb, pa0, pa1, pa2, pa3); pv_one<2>(o[2], vb, pa0, pa1, pa2, pa3); pv_one<3>(o[3], vb, pa0, pa1, pa2, pa3);
}

#define ATR(OFF) tr_read<(OFF)>(vb)
#define AWAIT(n) do { asm volatile("s_waitcnt lgkmcnt(" #n ")" ::: "memory"); SBAR(); } while (0)
#define APK(L, H) (bf16x8){L[0], L[1], L[2], L[3], H[0], H[1], H[2], H[3]}
#define AVLOAD(D0, X) do { X[0] = ATR(v_rd_off(D0, 0, 0)); X[1] = ATR(v_rd_off(D0, 0, 1)); X[2] = ATR(v_rd_off(D0, 1, 0)); X[3] = ATR(v_rd_off(D0, 1, 1)); \
    X[4] = ATR(v_rd_off(D0, 2, 0)); X[5] = ATR(v_rd_off(D0, 2, 1)); X[6] = ATR(v_rd_off(D0, 3, 0)); X[7] = ATR(v_rd_off(D0, 3, 1)); } while (0)
#define AVMMA(OD, X) do { OD = __builtin_amdgcn_mfma_f32_32x32x16_bf16(APK(X[0], X[1]), pa0, OD, 0, 0, 0); OD = __builtin_amdgcn_mfma_f32_32x32x16_bf16(APK(X[2], X[3]), pa1, OD, 0, 0, 0); \
    OD = __builtin_amdgcn_mfma_f32_32x32x16_bf16(APK(X[4], X[5]), pa2, OD, 0, 0, 0); OD = __builtin_amdgcn_mfma_f32_32x32x16_bf16(APK(X[6], X[7]), pa3, OD, 0, 0, 0); SBAR(); } while (0)
#define AKLOAD(i) do { if ((i) < 8) { const int cb = ((i) * 16 + hi * 8) * 2; kb0[(i) & 7] = *reinterpret_cast<const LAS bf16x8*>(Ks + KSWZ(r32, cb)); kb1[(i) & 7] = *reinterpret_cast<const LAS bf16x8*>(Ks + KSWZ(32 + r32, cb)); } \
    else { const int cb = (((i) - 8) * 16 + hi * 8) * 2; kb0[(i) & 7] = *reinterpret_cast<const LAS bf16x8*>(Rs + RSWZ(r32, cb)); kb1[(i) & 7] = *reinterpret_cast<const LAS bf16x8*>(Rs + RSWZ(32 + r32, cb)); } } while (0)
template <bool HAS_PV, bool HAS_QK>
__device__ __forceinline__ void mphase(f32x16& p0, f32x16& p1, f32x16* o, const LAS char* Ks, const LAS char* Rs, int vb, const bf16x8* qr, const bf16x8* qrr,
                                       bf16x8 pa0, bf16x8 pa1, bf16x8 pa2, bf16x8 pa3, int r32, int hi) {
    bf16x8 kb0[8], kb1[8]; s16x4 va[8], vc[8], vd[8];
    __builtin_amdgcn_s_setprio(1);
    if constexpr (HAS_PV) {
        AVLOAD(0, va); AVLOAD(1, vc); AVLOAD(2, vd);
        AWAIT(15); AVMMA(o[0], va); AVLOAD(3, va);
        AWAIT(15); AVMMA(o[1], vc);
        if constexpr (HAS_QK) { AKLOAD(0); AKLOAD(1); AKLOAD(2); AKLOAD(3); SBAR(); AWAIT(15); AVMMA(o[2], vd); AWAIT(8); AVMMA(o[3], va); }
        else { AWAIT(8); AVMMA(o[2], vd); AWAIT(0); AVMMA(o[3], va); }
    } else if constexpr (HAS_QK) { AKLOAD(0); AKLOAD(1); AKLOAD(2); AKLOAD(3); SBAR(); }
    if constexpr (HAS_QK) {
        p0 = f32x16{}; p1 = f32x16{};
#pragma unroll
        for (int i = 0; i < 12; ++i) { if (i + 4 < 12) AKLOAD(i + 4); SBAR();
            const bf16x8 qv = i < 8 ? qr[i < 8 ? i : 0] : qrr[i >= 8 ? i - 8 : 0];
            p0 = __builtin_amdgcn_mfma_f32_32x32x16_bf16(kb0[i & 7], qv, p0, 0, 0, 0); p1 = __builtin_amdgcn_mfma_f32_32x32x16_bf16(kb1[i & 7], qv, p1, 0, 0, 0); SBAR(); }
    }
    __builtin_amdgcn_s_setprio(0);
}
#undef ATR
#undef AWAIT
#undef APK
#undef AVLOAD
#undef AVMMA
#undef AKLOAD

__device__ __forceinline__ void attn_unit(const bf16_t* __restrict__ Qn, const bf16_t* __restrict__ Qr, const bf16_t* __restrict__ Kn, const bf16_t* __restrict__ Kr, const bf16_t* __restrict__ Vh,
                                          bf16_t* __restrict__ Ob, int seq, LAS char* lds, const int wv) {
    const int tid = tidx(wv), wid = tid >> 6, lane = tid & 63, r32 = lane & 31, hi = lane >> 5;
    const int grp = wv >> 2;
    LAS char* V_lds = lds + OFF_V; LAS char* K_lds = lds + OFF_K; LAS char* R_lds = lds + OFF_R;
    LAS float* wsl = (LAS float*)(lds + OFF_W) + wid * 64; LAS float* li_l = wsl; LAS float* al_l = wsl + 32;
    float m_reg = -1e30f, l_reg = 0; f32x16 o[4] = {}; bf16x8 qr[8], qrr[4];
    { unsigned qo = (unsigned)((wid * QBLK + r32) * 128 + hi * 8) * 2u, qo2 = (unsigned)((wid * QBLK + r32) * 64 + hi * 8) * 2u;
      asm volatile("" : "+v"(qo), "+v"(qo2));
#pragma unroll
      for (int d0 = 0; d0 < 8; ++d0) qr[d0] = *reinterpret_cast<const bf16x8*>((const char*)Qn + qo + d0 * 32);
#pragma unroll
      for (int d0 = 0; d0 < 4; ++d0) qrr[d0] = *reinterpret_cast<const bf16x8*>((const char*)Qr + qo2 + d0 * 32); }
    const int vb0 = (int)(unsigned)(uintptr_t)V_lds + v_rd_base(lane);
    const int t4 = tid & 255, sr = 32 * grp + (t4 >> 4), sc = (t4 & 15) * 8, rr_ = 32 * grp + (t4 >> 3), rc_ = (t4 & 7) * 8;
    const int vst0 = v_st(sr, sc), vst1 = v_st(sr + 16, sc), kst0 = KSWZ(sr, sc * 2), kst1 = KSWZ(sr + 16, sc * 2), rst0 = RSWZ(rr_, rc_ * 2);
    unsigned vo = (unsigned)(sr * 128 + sc) * 2u, ro = (unsigned)(rr_ * 64 + rc_) * 2u;
    asm volatile("" : "+v"(vo), "+v"(ro));
    bf16x8 vs0, vs1, ks0, ks1, rs0;
    const int NT = seq / KVBLK;
#define M3(x) ((x) >= 3 ? (x) - 3 : (x))
#define SLOADS(n) do { const int _k = (n) + 1 < NT ? (n) + 1 : NT - 1, _v = (n) < NT ? (n) : NT - 1; const char* kt = (const char*)Kn + (size_t)_k * (KVBLK * 256); const char* rt = (const char*)Kr + (size_t)_k * (KVBLK * 128); \
        const char* vt = (const char*)Vh + (size_t)_v * (KVBLK * 256); \
        ks0 = *reinterpret_cast<const bf16x8*>(kt + vo); ks1 = *reinterpret_cast<const bf16x8*>(kt + 4096 + vo); rs0 = *reinterpret_cast<const bf16x8*>(rt + ro); \
        vs0 = *reinterpret_cast<const bf16x8*>(vt + vo); vs1 = *reinterpret_cast<const bf16x8*>(vt + 4096 + vo); } while (0)
#define SWRITES(sk, sv) do { *(LAS bf16x8*)(K_lds + (sk) * SHM_K + kst0) = ks0; *(LAS bf16x8*)(K_lds + (sk) * SHM_K + kst1) = ks1; *(LAS bf16x8*)(R_lds + (sk) * SHM_R + rst0) = rs0; \
        *(LAS bf16x8*)(V_lds + (sv) * SHM_V + vst0) = vs0; *(LAS bf16x8*)(V_lds + (sv) * SHM_V + vst1) = vs1; } while (0)
#define SWAIT() asm volatile("s_waitcnt vmcnt(0)" ::: "memory")
#define RESC(a) do { if (__any((a) < 1.f)) { _Pragma("unroll") for (int d = 0; d < 4; ++d) _Pragma("unroll") for (int r = 0; r < 16; ++r) o[d][r] *= (a); } } while (0)
#define MBAR() do { SBAR(); asm volatile("s_waitcnt lgkmcnt(0)" ::: "memory"); __builtin_amdgcn_s_barrier(); SBAR(); } while (0)
#define SOFTMAX() do { partialSM(p0, p1, m_reg, mn, al); RESC(al); finishSM(p0, p1, al, l_reg, pa0, pa1, pa2, pa3); } while (0)
    f32x16 p0, p1; float mn, al; bf16x8 pa0, pa1, pa2, pa3;
    { ks0 = *reinterpret_cast<const bf16x8*>((const char*)Kn + vo); ks1 = *reinterpret_cast<const bf16x8*>((const char*)Kn + 4096 + vo); rs0 = *reinterpret_cast<const bf16x8*>((const char*)Kr + ro); SWAIT();
      *(LAS bf16x8*)(K_lds + kst0) = ks0; *(LAS bf16x8*)(K_lds + kst1) = ks1; *(LAS bf16x8*)(R_lds + rst0) = rs0; }
    __syncthreads();
    if (grp == 1) { SLOADS(0); SWAIT(); SWRITES(1, 0); __syncthreads(); }
    SLOADS(grp); SBAR();
    mphase<false, true>(p0, p1, o, K_lds, R_lds, 0, qr, qrr, pa0, pa1, pa2, pa3, r32, hi);
    MBAR();
    SOFTMAX(); SWAIT(); SWRITES(1 + grp, grp);
    __syncthreads();
    int s3 = 1;
#pragma unroll 1
    for (int j = 1; j < NT; ++j) {
        const int sv = M3(s3 + grp), sk = M3(sv + 1);
        SLOADS(j + grp); SBAR();
        mphase<true, true>(p0, p1, o, K_lds + s3 * SHM_K, R_lds + s3 * SHM_R, vb0 + M3(s3 + 2) * SHM_V, qr, qrr, pa0, pa1, pa2, pa3, r32, hi);
        MBAR();
        SOFTMAX(); SWAIT(); SWRITES(sk, sv);
        __syncthreads();
        s3 = M3(s3 + 1);
    }
    mphase<true, false>(p0, p1, o, K_lds, R_lds, vb0 + M3(s3 + 2) * SHM_V, qr, qrr, pa0, pa1, pa2, pa3, r32, hi);
    __syncthreads();
    if (grp == 0) __syncthreads();
#undef SOFTMAX
#undef MBAR
    { const float rl = __builtin_amdgcn_rcpf(l_reg);
      unsigned oo0 = (unsigned)((wid * QBLK + r32) * 1024 + 8 * hi) * 2u; asm volatile("" : "+v"(oo0));
#pragma unroll
      for (int d0 = 0; d0 < 4; ++d0)
#pragma unroll
          for (int p = 0; p < 2; ++p) {
              const unsigned a0 = cvtpk(o[d0][8 * p] * rl, o[d0][8 * p + 1] * rl), a1 = cvtpk(o[d0][8 * p + 2] * rl, o[d0][8 * p + 3] * rl);
              const unsigned b0 = cvtpk(o[d0][8 * p + 4] * rl, o[d0][8 * p + 5] * rl), b1 = cvtpk(o[d0][8 * p + 6] * rl, o[d0][8 * p + 7] * rl);
              auto r0 = __builtin_amdgcn_permlane32_swap(a0, b0, false, false); auto r1 = __builtin_amdgcn_permlane32_swap(a1, b1, false, false);
              const u32x4 w = {r0[0], r1[0], r0[1], r1[1]}; *(u32x4*)((char*)Ob + oo0 + (d0 * 32 + 16 * p) * 2) = w; } }
    __syncthreads();
#undef M3
#undef SLOADS
#undef SWRITES
#undef SWAIT
#undef RESC
}
}


namespace scan {
using attn::s16x4; using attn::f32x16; using attn::v_st; using attn::v_rd_base; using attn::crow; using attn::cvtpk;
constexpr int NCH = KEYS / 64;
constexpr size_t WS_STATE = 422 * MiB;
constexpr size_t WS_DEC = 694 * MiB;
__device__ __forceinline__ int seq_row(int b, int p) { return p < CT ? RL + b * CT + p : b * T + (p - CT); }
__device__ __forceinline__ s16x4 trr(int addr) { s16x4 r; asm volatile("ds_read_b64_tr_b16 %0, %1" : "=&v"(r) : "v"(addr) : "memory"); return r; }
template <int OFF> __device__ __forceinline__ s16x4 tri(int addr) { s16x4 r; asm volatile("ds_read_b64_tr_b16 %0, %1 offset:%2" : "=&v"(r) : "v"(addr), "i"(OFF) : "memory"); return r; }
#define SC_PK(L, H) (bf16x8){L[0], L[1], L[2], L[3], H[0], H[1], H[2], H[3]}
#define SC_LWAIT() do { asm volatile("s_waitcnt lgkmcnt(0)" ::: "memory"); __builtin_amdgcn_sched_barrier(0); } while (0)
__device__ __forceinline__ float2 bf2x(unsigned u) { return make_float2(bf2f((bf16_t)(u & 0xffffu)), bf2f((bf16_t)(u >> 16))); }

struct Prep {
    float2 kf[8], kb[8];
    float2 bf[8], cb[8];
    float2 totf, totb, reff, refb;
};
__device__ __forceinline__ void prep_decay(Prep& P, const unsigned (&rkf)[8], const unsigned (&rkb)[8], int a, float lgf, float lgb, LAS float* tot, int tid) {
    const int cp = tid & 63, tg = tid >> 6;
    float2 gf[8], gb[8];
#pragma unroll
    for (int i = 0; i < 8; ++i) {
        P.kf[i] = bf2x(rkf[i]); P.kb[i] = bf2x(rkb[i]);
        if (a) { gf[i] = make_float2(__logf(fmaxf(1.f - P.kf[i].x, 1e-30f)), __logf(fmaxf(1.f - P.kf[i].y, 1e-30f))); gb[i] = make_float2(__logf(fmaxf(1.f - P.kb[i].x, 1e-30f)), __logf(fmaxf(1.f - P.kb[i].y, 1e-30f))); }
        else { gf[i] = make_float2(lgf, lgf); gb[i] = make_float2(lgb, lgb); } }
    P.bf[0] = gf[0];
#pragma unroll
    for (int i = 1; i < 8; ++i) P.bf[i] = make_float2(P.bf[i - 1].x + gf[i].x, P.bf[i - 1].y + gf[i].y);
    P.cb[0] = gb[0];
#pragma unroll
    for (int i = 1; i < 8; ++i) P.cb[i] = make_float2(P.cb[i - 1].x + gb[i].x, P.cb[i - 1].y + gb[i].y);
    *(LAS f32x2*)(tot + (0 * 8 + tg) * 128 + 2 * cp) = (f32x2){P.bf[7].x, P.bf[7].y}; *(LAS f32x2*)(tot + (1 * 8 + tg) * 128 + 2 * cp) = (f32x2){P.cb[7].x, P.cb[7].y};
    __syncthreads();
    float2 offf = make_float2(0.f, 0.f), offb = make_float2(0.f, 0.f); P.totf = offf; P.totb = offf; P.reff = offf; P.refb = offf;
#pragma unroll
    for (int g = 0; g < 8; ++g) { const f32x2 tf = *(const LAS f32x2*)(tot + (0 * 8 + g) * 128 + 2 * cp), tb = *(const LAS f32x2*)(tot + (1 * 8 + g) * 128 + 2 * cp);
        P.totf.x += tf.x; P.totf.y += tf.y; P.totb.x += tb.x; P.totb.y += tb.y;
        if (g < 4) { P.reff.x += tf.x; P.reff.y += tf.y; } else { P.refb.x += tb.x; P.refb.y += tb.y; }
        if (g < tg) { offf.x += tf.x; offf.y += tf.y; offb.x += tb.x; offb.y += tb.y; } }
#pragma unroll
    for (int i = 0; i < 8; ++i) { P.bf[i].x += offf.x; P.bf[i].y += offf.y;
        P.cb[i].x = P.totb.x - (P.cb[i].x + offb.x) + gb[i].x; P.cb[i].y = P.totb.y - (P.cb[i].y + offb.y) + gb[i].y; }
}
__device__ __forceinline__ unsigned pk2f(float a, float b) { return cvtpk(a, b); }
struct Raw { unsigned kf[8], kb[8], q[8]; bf16x8 vv[2]; };
template <bool WITH_Q> __device__ __forceinline__ void load_raw(Raw& Rw, int item, const bf16_t* G0p, int tid) {
    const int cp = tid & 63, tg = tid >> 6;
    const int c = item % NCH, h = (item / NCH) & 3, b = (item / (NCH * 4)) & 7, a = item / (NCH * 32);
    const bf16_t* KF = G0p + (size_t)(a ? 5 : 1) * (GSZ / 2); const bf16_t* KB = G0p + (size_t)(a ? 6 : 1) * (GSZ / 2); const bf16_t* Vg = G0p + (size_t)(a ? 7 : 2) * (GSZ / 2); const bf16_t* Qg = G0p + (size_t)(a ? 4 : 0) * (GSZ / 2);
    const int row0 = seq_row(b, 64 * c);
#pragma unroll
    for (int i = 0; i < 8; ++i) { const size_t off = (size_t)(row0 + 8 * tg + i) * 512 + h * 128 + 2 * cp; Rw.kf[i] = *(const unsigned*)(KF + off); Rw.kb[i] = *(const unsigned*)(KB + off); if (WITH_Q) Rw.q[i] = *(const unsigned*)(Qg + off); }
#pragma unroll
    for (int n = 0; n < 2; ++n) { const int q = tid + 512 * n, k = q >> 4, c0 = (q & 15) * 8; Rw.vv[n] = *(const bf16x8*)(Vg + (size_t)(row0 + k) * 512 + h * 128 + c0); }
}

__device__ __forceinline__ void s1_item(int item, int next_item, Raw& Rw, const bf16_t* G0p, const float* lg, bf16_t* ST, float* DEC, LAS char* lds, const int wv) {
    const int tid = tidx(wv), lane = tid & 63, wid = tid >> 6, cp = tid & 63, tg = tid >> 6, r32 = lane & 31, hi = lane >> 5;
    const int c = item % NCH, h = (item / NCH) & 3, b = (item / (NCH * 4)) & 7, a = item / (NCH * 32);
    LAS char* KFi = lds; LAS char* KBi = lds + 16384; LAS char* Vi = lds + 32768; LAS float* tot = (LAS float*)(lds + 49152);
    bf16x8 vv[2] = {Rw.vv[0], Rw.vv[1]};
    Prep P; prep_decay(P, Rw.kf, Rw.kb, a, lg[h], lg[4 + h], tot, tid);
#pragma unroll
    for (int i = 0; i < 8; ++i) { const int k = 8 * tg + i; const int o = v_st(k, 2 * cp);
        *(LAS unsigned*)(KFi + o) = pk2f(P.kf[i].x * __expf(P.totf.x - P.bf[i].x), P.kf[i].y * __expf(P.totf.y - P.bf[i].y));
        *(LAS unsigned*)(KBi + o) = pk2f(P.kb[i].x * __expf(P.totb.x - P.cb[i].x), P.kb[i].y * __expf(P.totb.y - P.cb[i].y)); }
#pragma unroll
    for (int n = 0; n < 2; ++n) { const int q = tid + 512 * n, k = q >> 4, c0 = (q & 15) * 8; *(LAS bf16x8*)(Vi + v_st(k, c0)) = vv[n]; }
    const size_t sidx = ((((size_t)a * 8 + b) * 4 + h) * 2) * NCH;
    if (tg == 0) { *(float2*)(DEC + (sidx + c) * 128 + 2 * cp) = make_float2(__expf(P.totf.x), __expf(P.totf.y)); *(float2*)(DEC + (sidx + NCH + c) * 128 + 2 * cp) = make_float2(__expf(P.totb.x), __expf(P.totb.y)); }
    if (next_item >= 0) load_raw<false>(Rw, next_item, G0p, tid);
    __syncthreads();
    const int dkb = wid & 3, dvb0 = 2 * (wid >> 2);
    const int aKF = (int)(unsigned)(uintptr_t)KFi + v_rd_base(lane) + dkb * 512, aKB = (int)(unsigned)(uintptr_t)KBi + v_rd_base(lane) + dkb * 512, aV = (int)(unsigned)(uintptr_t)Vi + v_rd_base(lane) + dvb0 * 512;
    f32x16 uf0 = {}, uf1 = {}, ub0 = {}, ub1 = {};
    asm volatile("" : "+v"(uf0), "+v"(uf1), "+v"(ub0), "+v"(ub1));
#define S1_STEP(KS) do { const s16x4 fl = tri<(KS) * 4096>(aKF), fh = tri<(KS) * 4096 + 2048>(aKF), bl = tri<(KS) * 4096>(aKB), bh = tri<(KS) * 4096 + 2048>(aKB); \
        const s16x4 v0l = tri<(KS) * 4096>(aV), v0h = tri<(KS) * 4096 + 2048>(aV), v1l = tri<(KS) * 4096 + 512>(aV), v1h = tri<(KS) * 4096 + 2048 + 512>(aV); SC_LWAIT(); \
        const bf16x8 kff = SC_PK(fl, fh), kbf = SC_PK(bl, bh), vf0 = SC_PK(v0l, v0h), vf1 = SC_PK(v1l, v1h); \
        uf0 = __builtin_amdgcn_mfma_f32_32x32x16_bf16(vf0, kff, uf0, 0, 0, 0); uf1 = __builtin_amdgcn_mfma_f32_32x32x16_bf16(vf1, kff, uf1, 0, 0, 0); \
        ub0 = __builtin_amdgcn_mfma_f32_32x32x16_bf16(vf0, kbf, ub0, 0, 0, 0); ub1 = __builtin_amdgcn_mfma_f32_32x32x16_bf16(vf1, kbf, ub1, 0, 0, 0); } while (0)
    S1_STEP(0); S1_STEP(1); S1_STEP(2); S1_STEP(3);
#undef S1_STEP
    bf16_t* Uf = ST + (sidx + c) * 16384; bf16_t* Ub = ST + (sidx + NCH + c) * 16384;
    const int dk = 32 * dkb + r32;
#define S1_ST(ACC, BASE, DVB) do { _Pragma("unroll") for (int p = 0; p < 2; ++p) { \
        const unsigned a0 = cvtpk(ACC[8 * p], ACC[8 * p + 1]), a1 = cvtpk(ACC[8 * p + 2], ACC[8 * p + 3]), b0 = cvtpk(ACC[8 * p + 4], ACC[8 * p + 5]), b1 = cvtpk(ACC[8 * p + 6], ACC[8 * p + 7]); \
        auto r0 = __builtin_amdgcn_permlane32_swap(a0, b0, false, false); auto r1 = __builtin_amdgcn_permlane32_swap(a1, b1, false, false); \
        const u32x4 w = {r0[0], r1[0], r0[1], r1[1]}; *(u32x4*)((BASE) + ((size_t)(4 * (DVB) + 2 * p + hi) * 128 + dk) * 8) = w; } } while (0)
    S1_ST(uf0, Uf, dvb0); S1_ST(uf1, Uf, dvb0 + 1); S1_ST(ub0, Ub, dvb0); S1_ST(ub1, Ub, dvb0 + 1);
#undef S1_ST
    __syncthreads();
}

__device__ __forceinline__ void s2_vec(size_t v, bf16_t* ST, const float* DEC) {
    const int chain = (int)(v >> 11), e8 = (int)(v & 2047), dk = e8 & 127, dir = chain & 1;
    bf16_t* base = ST + (size_t)chain * NCH * 16384 + (size_t)e8 * 8; const float* dec = DEC + (size_t)chain * NCH * 128 + dk;
    float S[8];
#pragma unroll
    for (int i = 0; i < 8; ++i) S[i] = 0.f;
#define S2_C(q) (dir ? ((q) < 4 ? 3 - (q) : 71 - (q)) : (q))
    u32x4 u[8]; float d[8];
#pragma unroll
    for (int j = 0; j < 8; ++j) { const int c = S2_C(j); u[j] = __builtin_nontemporal_load((const u32x4*)(base + (size_t)c * 16384)); d[j] = dec[c * 128]; }
#pragma unroll 1
    for (int q0 = 0; q0 < NCH; q0 += 8) {
#pragma unroll
        for (int j = 0; j < 8; ++j) { const int q = q0 + j; if (q < NCH) { const int c = S2_C(q);
            const u32x4 uu = u[j]; const float dd = d[j];
            if (q + 8 < NCH) { const int cn = S2_C(q + 8); u[j] = __builtin_nontemporal_load((const u32x4*)(base + (size_t)cn * 16384)); d[j] = dec[cn * 128]; }
            u32x4 w; w.x = cvtpk(S[0], S[1]); w.y = cvtpk(S[2], S[3]); w.z = cvtpk(S[4], S[5]); w.w = cvtpk(S[6], S[7]);
            *(u32x4*)(base + (size_t)c * 16384) = w;
            const float2 u0 = bf2x(uu.x), u1 = bf2x(uu.y), u2 = bf2x(uu.z), u3 = bf2x(uu.w);
            S[0] = dd * S[0] + u0.x; S[1] = dd * S[1] + u0.y; S[2] = dd * S[2] + u1.x; S[3] = dd * S[3] + u1.y; S[4] = dd * S[4] + u2.x; S[5] = dd * S[5] + u2.y; S[6] = dd * S[6] + u3.x; S[7] = dd * S[7] + u3.y; } }
    }
#undef S2_C
}

__device__ __forceinline__ void s3_item(int item, int next_item, Raw& Rw, const bf16_t* G0p, const float* lg, const bf16_t* ST, bf16_t* Y, LAS char* lds, const int wv) {
    const int tid = tidx(wv), lane = tid & 63, wid = tid >> 6, cp = tid & 63, tg = tid >> 6, r32 = lane & 31, hi = lane >> 5;
    const int c = item % NCH, h = (item / NCH) & 3, b = (item / (NCH * 4)) & 7, a = item / (NCH * 32);
    const bf16_t* Gt = G0p + (size_t)(a ? 8 : 3) * (GSZ / 2);
    const int row0 = seq_row(b, 64 * c);
    LAS char* QFi = lds; LAS char* KFi = lds + 16384; LAS char* Vi = lds + 32768; LAS float* tot = (LAS float*)(lds + 49152);
    LAS char* QBi = lds + 65536; LAS char* KBi = lds + 81920; LAS char* QF2 = lds + 98304; LAS char* QB2 = lds + 114688; LAS float* red = (LAS float*)(lds + 65536);
    const size_t sidx = ((((size_t)a * 8 + b) * 4 + h) * 2) * NCH;
    bf16x8 vv[2] = {Rw.vv[0], Rw.vv[1]}, sf[4], sb[4];
    float2 qv[8];
#pragma unroll
    for (int i = 0; i < 8; ++i) qv[i] = bf2x(Rw.q[i]);
    Prep P; prep_decay(P, Rw.kf, Rw.kb, a, lg[h], lg[4 + h], tot, tid);
#pragma unroll
    for (int i = 0; i < 8; ++i) { const int k = 8 * tg + i; const int o = KSWZ(k, 4 * cp);
        const float2 ef = make_float2(__expf(P.bf[i].x - P.reff.x), __expf(P.bf[i].y - P.reff.y)), eb = make_float2(__expf(P.cb[i].x - P.refb.x), __expf(P.cb[i].y - P.refb.y));
        *(LAS unsigned*)(QFi + o) = pk2f(qv[i].x * ef.x, qv[i].y * ef.y); *(LAS unsigned*)(KFi + o) = pk2f(P.kf[i].x * __builtin_amdgcn_rcpf(ef.x), P.kf[i].y * __builtin_amdgcn_rcpf(ef.y));
        *(LAS unsigned*)(QBi + o) = pk2f(qv[i].x * eb.x, qv[i].y * eb.y); *(LAS unsigned*)(KBi + o) = pk2f(P.kb[i].x * __builtin_amdgcn_rcpf(eb.x), P.kb[i].y * __builtin_amdgcn_rcpf(eb.y));
        *(LAS unsigned*)(QF2 + o) = pk2f(qv[i].x * __expf(P.bf[i].x), qv[i].y * __expf(P.bf[i].y)); *(LAS unsigned*)(QB2 + o) = pk2f(qv[i].x * __expf(P.cb[i].x), qv[i].y * __expf(P.cb[i].y)); }
#pragma unroll
    for (int n = 0; n < 2; ++n) { const int q = tid + 512 * n, k = q >> 4, c0 = (q & 15) * 8; *(LAS bf16x8*)(Vi + v_st(k, c0)) = vv[n]; }
#pragma unroll
    for (int n = 0; n < 4; ++n) { const int q = tid + 512 * n; sf[n] = *(const bf16x8*)(ST + (sidx + c) * 16384 + (size_t)q * 8); sb[n] = *(const bf16x8*)(ST + (sidx + NCH + c) * 16384 + (size_t)q * 8); }
    if (next_item >= 0) load_raw<true>(Rw, next_item, G0p, tid);
    __syncthreads();
    const int rb = wid >> 2, d0 = wid & 3, qrow = 32 * rb + r32;
    f32x16 pf0 = {}, pf1 = {}, pb0 = {}, pb1 = {};
    asm volatile("" : "+v"(pf0), "+v"(pf1), "+v"(pb0), "+v"(pb1));
#pragma unroll
    for (int ks = 0; ks < 8; ++ks) { const int cb_ = (ks * 16 + hi * 8) * 2;
        const bf16x8 qf = *(const LAS bf16x8*)(QFi + KSWZ(qrow, cb_)), qb = *(const LAS bf16x8*)(QBi + KSWZ(qrow, cb_));
        const bf16x8 kf0 = *(const LAS bf16x8*)(KFi + KSWZ(r32, cb_)), kf1 = *(const LAS bf16x8*)(KFi + KSWZ(32 + r32, cb_)), kb0 = *(const LAS bf16x8*)(KBi + KSWZ(r32, cb_)), kb1 = *(const LAS bf16x8*)(KBi + KSWZ(32 + r32, cb_));
        pf0 = __builtin_amdgcn_mfma_f32_32x32x16_bf16(kf0, qf, pf0, 0, 0, 0); pf1 = __builtin_amdgcn_mfma_f32_32x32x16_bf16(kf1, qf, pf1, 0, 0, 0);
        pb0 = __builtin_amdgcn_mfma_f32_32x32x16_bf16(kb0, qb, pb0, 0, 0, 0); pb1 = __builtin_amdgcn_mfma_f32_32x32x16_bf16(kb1, qb, pb1, 0, 0, 0); }
#pragma unroll
    for (int r = 0; r < 16; ++r) { const int j0 = crow(r, hi), j1 = 32 + j0;
        pf0[r] = (j0 <= qrow ? pf0[r] : 0.f) + (j0 >= qrow ? pb0[r] : 0.f); pf1[r] = (j1 <= qrow ? pf1[r] : 0.f) + (j1 >= qrow ? pb1[r] : 0.f); }
    bf16x8 pa0, pa1, pa2, pa3;
#define PK4(Pv, BASE, OUT) do { unsigned a0 = cvtpk(Pv[BASE + 0], Pv[BASE + 1]), a1 = cvtpk(Pv[BASE + 2], Pv[BASE + 3]);   \
    unsigned b0 = cvtpk(Pv[BASE + 4], Pv[BASE + 5]), b1 = cvtpk(Pv[BASE + 6], Pv[BASE + 7]);                              \
    auto r0 = __builtin_amdgcn_permlane32_swap(a0, b0, false, false); auto r1 = __builtin_amdgcn_permlane32_swap(a1, b1, false, false); \
    u32x4 w = {r0[0], r1[0], r0[1], r1[1]}; OUT = *reinterpret_cast<bf16x8*>(&w); } while (0)
    PK4(pf0, 0, pa0); PK4(pf0, 8, pa1); PK4(pf1, 0, pa2); PK4(pf1, 8, pa3);
#undef PK4
    f32x16 o = {}; asm volatile("" : "+v"(o));
    { const int aV = (int)(unsigned)(uintptr_t)Vi + v_rd_base(lane) + d0 * 512;
      const s16x4 l0 = tri<0>(aV), h0 = tri<2048>(aV), l1 = tri<4096>(aV), h1 = tri<4096 + 2048>(aV), l2 = tri<8192>(aV), h2 = tri<8192 + 2048>(aV), l3 = tri<12288>(aV), h3 = tri<12288 + 2048>(aV); SC_LWAIT();
      o = __builtin_amdgcn_mfma_f32_32x32x16_bf16(SC_PK(l0, h0), pa0, o, 0, 0, 0); o = __builtin_amdgcn_mfma_f32_32x32x16_bf16(SC_PK(l1, h1), pa1, o, 0, 0, 0);
      o = __builtin_amdgcn_mfma_f32_32x32x16_bf16(SC_PK(l2, h2), pa2, o, 0, 0, 0); o = __builtin_amdgcn_mfma_f32_32x32x16_bf16(SC_PK(l3, h3), pa3, o, 0, 0, 0); }
    __syncthreads();
    LAS char* SFi = lds; LAS char* SBi = lds + 32768;
#pragma unroll
    for (int n = 0; n < 4; ++n) { const int q = tid + 512 * n, dk = q & 127, c0 = (q >> 7) * 8; const int oo = (dk >> 6) * 16384 + v_st(dk & 63, c0); *(LAS bf16x8*)(SFi + oo) = sf[n]; *(LAS bf16x8*)(SBi + oo) = sb[n]; }
    __syncthreads();
    u32x2 gq[4];
#pragma unroll
    for (int g = 0; g < 4; ++g) gq[g] = *(const u32x2*)(Gt + (size_t)(row0 + 32 * rb + r32) * 512 + h * 128 + 32 * d0 + 8 * g + 4 * hi);
    { const int aSF = (int)(unsigned)(uintptr_t)SFi + v_rd_base(lane) + d0 * 512, aSB = (int)(unsigned)(uintptr_t)SBi + v_rd_base(lane) + d0 * 512;
#define S3_STEP(KS) do { const int cb_ = ((KS) * 16 + hi * 8) * 2; const bf16x8 q1 = *(const LAS bf16x8*)(QF2 + KSWZ(qrow, cb_)), q2 = *(const LAS bf16x8*)(QB2 + KSWZ(qrow, cb_)); \
        const s16x4 fl = tri<(KS) * 4096>(aSF), fh = tri<(KS) * 4096 + 2048>(aSF), bl = tri<(KS) * 4096>(aSB), bh = tri<(KS) * 4096 + 2048>(aSB); SC_LWAIT(); \
        o = __builtin_amdgcn_mfma_f32_32x32x16_bf16(SC_PK(fl, fh), q1, o, 0, 0, 0); o = __builtin_amdgcn_mfma_f32_32x32x16_bf16(SC_PK(bl, bh), q2, o, 0, 0, 0); } while (0)
      S3_STEP(0); S3_STEP(1); S3_STEP(2); S3_STEP(3); S3_STEP(4); S3_STEP(5); S3_STEP(6); S3_STEP(7);
#undef S3_STEP
    }
    { float ss = 0.f;
#pragma unroll
      for (int r = 0; r < 16; ++r) ss += o[r] * o[r];
      { auto rr = __builtin_amdgcn_permlane32_swap(__float_as_uint(ss), __float_as_uint(ss), false, false); ss = __uint_as_float(rr[0]) + __uint_as_float(rr[1]); }
      if (hi == 0) red[(rb * 4 + d0) * 32 + r32] = ss; }
    __syncthreads();
    { const float tot = red[(rb * 4 + 0) * 32 + r32] + red[(rb * 4 + 1) * 32 + r32] + red[(rb * 4 + 2) * 32 + r32] + red[(rb * 4 + 3) * 32 + r32];
      const float rs = rsqrtf(tot * (1.f / 128.f) + EPS);
      bf16_t* yrow = Y + (size_t)(row0 + 32 * rb + r32) * 1024 + a * 512 + h * 128 + 32 * d0 + 8 * hi;
#pragma unroll
      for (int pp = 0; pp < 2; ++pp) {
          const float2 ga = bf2x(gq[2 * pp].x), gb = bf2x(gq[2 * pp].y), gc = bf2x(gq[2 * pp + 1].x), gd = bf2x(gq[2 * pp + 1].y);
          const unsigned a0 = cvtpk(o[8 * pp] * rs * ga.x, o[8 * pp + 1] * rs * ga.y), a1 = cvtpk(o[8 * pp + 2] * rs * gb.x, o[8 * pp + 3] * rs * gb.y);
          const unsigned b0 = cvtpk(o[8 * pp + 4] * rs * gc.x, o[8 * pp + 5] * rs * gc.y), b1 = cvtpk(o[8 * pp + 6] * rs * gd.x, o[8 * pp + 7] * rs * gd.y);
          auto r0 = __builtin_amdgcn_permlane32_swap(a0, b0, false, false); auto r1 = __builtin_amdgcn_permlane32_swap(a1, b1, false, false);
          const u32x4 w = {r0[0], r1[0], r0[1], r1[1]}; *(u32x4*)(yrow + 16 * pp) = w; } }
    __syncthreads();
}
#undef SC_PK
#undef SC_LWAIT
}

constexpr int RING_OFF = 0, RING_BYTES = 131072;
constexpr int MISC_OFF = RING_BYTES;
constexpr int LDS_BYTES = 147456;
constexpr int NWAVES = 8, NTHREADS = 512;

#define XB_TMO      128
#define XB_XCNT(j)  (256  + 64 * (j))
#define XB_XSUB(j)  (1280 + 64 * (j))
#define XB_XGEN(j)  (2304 + 64 * (j))
#define XB_TOP      3328
#define XB_TOPGEN   3392
#define XCD_BAR_WORDS 3456
#define XB_SPIN_CAP (1u << 18)
__device__ __forceinline__ unsigned xb_ld(unsigned* p)              { return __hip_atomic_load(p, __ATOMIC_RELAXED, __HIP_MEMORY_SCOPE_AGENT); }
__device__ __forceinline__ unsigned xb_add(unsigned* p, unsigned v) { return __hip_atomic_fetch_add(p, v, __ATOMIC_RELAXED, __HIP_MEMORY_SCOPE_AGENT); }
__device__ __forceinline__ unsigned xb_xcc_id() { return (unsigned)__builtin_amdgcn_s_getreg((3 << 11) | 20) & 0xFu; }
#define XB_SPIN(cond, bar) do { unsigned _sp = 0; while (cond) { __builtin_amdgcn_s_sleep(1); \
    if ((++_sp & 255u) == 0u) { if (xb_ld(&(bar)[XB_TMO])) break; if (_sp > XB_SPIN_CAP) { atomicAdd(&(bar)[XB_TMO], 1u); break; } } } } while (0)
struct XcdBarrier { unsigned* bar; unsigned x; volatile LAS unsigned* st; };
__device__ __forceinline__ XcdBarrier xcd_barrier_post(unsigned* bar, volatile LAS unsigned* st) {
    XcdBarrier b; b.bar = bar; b.x = xb_xcc_id(); b.st = st;
    if (threadIdx.x == 0) (void)xb_add(&bar[XB_XCNT(b.x)], 1u);
    return b;
}
__device__ __forceinline__ void xcd_barrier_complete(unsigned* bar, unsigned x, unsigned& nloc, unsigned& nx) {
    const unsigned Gt = gridDim.x * gridDim.y * gridDim.z;
    unsigned sum, cnt, mine, sp = 0u;
    for (;;) {
        sum = 0u; cnt = 0u; mine = 0u;
#pragma unroll
        for (unsigned j = 0; j < 16; ++j) { const unsigned c = xb_ld(&bar[XB_XCNT(j)]); sum += c; cnt += (c > 0u) ? 1u : 0u; mine = (j == x) ? c : mine; }
        if (sum == Gt) break;
        __builtin_amdgcn_s_sleep(1);
        if ((++sp & 255u) == 0u) { if (xb_ld(&bar[XB_TMO])) break; if (sp > XB_SPIN_CAP) { atomicAdd(&bar[XB_TMO], 1u); break; } }
    }
    nloc = mine > 0u ? mine : 1u; nx = cnt > 0u ? cnt : 1u;
}
__device__ __forceinline__ void xcd_barrier(const XcdBarrier& b, const bool leader  ) {
    asm volatile("s_waitcnt vmcnt(0)" ::: "memory");
    __syncthreads();
    if (leader) {
        unsigned* bar = b.bar;
        __builtin_amdgcn_s_waitcnt(0);
        unsigned nloc = b.st[0], nx = b.st[1];
        if (nloc == 0u) { xcd_barrier_complete(bar, b.x, nloc, nx); b.st[0] = nloc; b.st[1] = nx; }
        const unsigned old = xb_add(&bar[XB_XSUB(b.x)], 1u);
        const unsigned gen = old / nloc;
        if (old + 1u == (gen + 1u) * nloc) {
            __builtin_amdgcn_fence(__ATOMIC_RELEASE, "agent");
            asm volatile("s_waitcnt vmcnt(0)" ::: "memory");
            const unsigned og = xb_add(&bar[XB_TOP], 1u);
            const unsigned tg = og / nx;
            if (og + 1u == (tg + 1u) * nx) xb_add(&bar[XB_TOPGEN], 1u);
            else XB_SPIN(xb_ld(&bar[XB_TOPGEN]) == tg, bar);
            __builtin_amdgcn_fence(__ATOMIC_ACQUIRE, "agent");
            xb_add(&bar[XB_XGEN(b.x)], 1u);
            asm volatile("s_waitcnt vmcnt(0)" ::: "memory");
        } else {
            XB_SPIN(xb_ld(&bar[XB_XGEN(b.x)]) == gen, bar);
            __builtin_amdgcn_fence(__ATOMIC_ACQUIRE, "agent");
            asm volatile("s_waitcnt vmcnt(0)" ::: "memory");
        }
    }
    __syncthreads();
}

__device__ __forceinline__ void transpose_item(const float* __restrict__ W, int ldw, int K, int src0, bf16_t* __restrict__ WT, int n0, int k0, LAS float* scr, int lane) {
    f32x4 ld[8];
#pragma unroll
    for (int i = 0; i < 8; ++i) { const int kk = 8 * i + (lane >> 3); ld[i] = src0 >= 0 ? *(const f32x4*)(W + (size_t)(k0 + kk) * ldw + src0 + 4 * (lane & 7)) : (f32x4){0.f, 0.f, 0.f, 0.f}; }
#pragma unroll
    for (int i = 0; i < 8; ++i) { const int kk = 8 * i + (lane >> 3); *(LAS f32x4*)(scr + kk * 36 + 4 * (lane & 7)) = ld[i]; }
    asm volatile("s_waitcnt lgkmcnt(0)" ::: "memory");
    const int c = lane & 7;
#pragma unroll
    for (int j = 0; j < 4; ++j) { const int n = (lane >> 3) + 8 * j; const LAS float* s = scr + (8 * c) * 36 + n;
        u32x4 o; o.x = cvt_pk_bf16(s[0 * 36], s[1 * 36]); o.y = cvt_pk_bf16(s[2 * 36], s[3 * 36]); o.z = cvt_pk_bf16(s[4 * 36], s[5 * 36]); o.w = cvt_pk_bf16(s[6 * 36], s[7 * 36]);
        *(u32x4*)(WT + (size_t)(n0 + n) * K + k0 + 8 * c) = o; }
    asm volatile("s_waitcnt lgkmcnt(0)" ::: "memory");
}
__device__ __forceinline__ void transpose_item8(const float* __restrict__ W, int ldw, int K, int src0, unsigned char* __restrict__ WT, int n0, int k0, LAS float* scr, int lane) {
    f32x4 ld[8];
#pragma unroll
    for (int i = 0; i < 8; ++i) { const int kk = 8 * i + (lane >> 3); ld[i] = *(const f32x4*)(W + (size_t)(k0 + kk) * ldw + src0 + 4 * (lane & 7)); }
#pragma unroll
    for (int i = 0; i < 8; ++i) { const int kk = 8 * i + (lane >> 3); *(LAS f32x4*)(scr + kk * 36 + 4 * (lane & 7)) = ld[i]; }
    asm volatile("s_waitcnt lgkmcnt(0)" ::: "memory");
    const int c = lane & 7;
#pragma unroll
    for (int j = 0; j < 4; ++j) { const int n = (lane >> 3) + 8 * j; const LAS float* sp = scr + (8 * c) * 36 + n;
        u32x2 o; o.x = pack4_fp8(sp[0 * 36] * W8_SCALE, sp[1 * 36] * W8_SCALE, sp[2 * 36] * W8_SCALE, sp[3 * 36] * W8_SCALE); o.y = pack4_fp8(sp[4 * 36] * W8_SCALE, sp[5 * 36] * W8_SCALE, sp[6 * 36] * W8_SCALE, sp[7 * 36] * W8_SCALE);
        *(u32x2*)(WT + (size_t)(n0 + n) * K + k0 + 8 * c) = o; }
    asm volatile("s_waitcnt lgkmcnt(0)" ::: "memory");
}
__device__ __forceinline__ int src_mixin(int n0) { const int pn = n0 >> 8, q = n0 & 255, grp = pn >> 1, half = pn & 1; if (grp > 1) return n0; const int bj = q >> 7, rr = q & 127, hl = rr >> 6, j = rr & 63; return grp * 512 + (half * 2 + hl) * 128 + bj * 64 + j; }
__device__ __forceinline__ int src_swiglu(int n0) { const int pn = n0 >> 8, q = n0 & 255, bj = q >> 7, rr = q & 127; return bj * FFN + pn * 128 + rr; }
__device__ __forceinline__ int src_uq(int n0) { const int pn = n0 >> 8, q = n0 & 255, bj = q >> 7, rr = q & 127; if (pn < 4) return (2 * pn + bj) * 192 + rr; const int hl = rr >> 5; return (4 * (pn - 4) + hl) * 192 + 128 + bj * 32 + (rr & 31); }

struct Args { const float* in[22]; float* out; unsigned char* ws; int ph_lo, ph_hi; };

constexpr int CI_MIXIN = 0, CI_MIXOUT = CI_MIXIN + 16 * 144, CI_FFNIN = CI_MIXOUT + 16 * 32, CI_FFNOUT = CI_FFNIN + 16 * 176, CI_DOWN = CI_FFNOUT + 44 * 32, CI_UQ = CI_DOWN + 16 * 24,
              CI_UKV = CI_UQ + 6 * 48, CI_MLAOUT = CI_UKV + 4 * 64, CI_MOEOUT = CI_MLAOUT + 16 * 32, CI_MOEIN = CI_MOEOUT + 8 * 44 * 32, CI_END = CI_MOEIN + 8 * 16 * 176;
struct ConvP { const float *mix_in_w, *mix_out_w, *ffn_in_w, *ffn_out_w, *down_w, *uq_w, *ukv_w, *mla_out_w, *moe_in_w, *moe_out_w;
               bf16_t *Wmixin, *Wmixout, *Wffnin, *Wffnout, *Wdown, *Wuq, *Wukv, *Wmlaout, *Wmi, *Wmo; };
template <int LO, int HI> __device__ __forceinline__ void conv_range(const ConvP& p, const int gwl, const int NGWL, LAS float* scr, const int lane) {
#define CI_HAS(A, B) (LO < (B) && HI > (A))
    for (int it = LO + gwl; it < HI; it += NGWL) {
        if (CI_HAS(CI_MIXIN, CI_MIXOUT) && it < CI_MIXOUT) { const int r = it - CI_MIXIN, kb = r / 144, nb = r % 144; transpose_item(p.mix_in_w, MIXC, 1024, src_mixin(nb * 32), p.Wmixin, nb * 32, kb * 64, scr, lane); continue; }
        if (CI_HAS(CI_MIXOUT, CI_FFNIN) && it < CI_FFNIN) { const int r = it - CI_MIXOUT, kb = r / 32, nb = r % 32; transpose_item(p.mix_out_w, 1024, 1024, nb * 32, p.Wmixout, nb * 32, kb * 64, scr, lane); continue; }
#if FFN_FP8 == 1
        if (CI_HAS(CI_FFNIN, CI_FFNOUT) && it < CI_FFNOUT) { const int r = it - CI_FFNIN, kb = r / 176, nb = r % 176; transpose_item8(p.ffn_in_w, 2 * FFN, 1024, src_swiglu(nb * 32), (unsigned char*)p.Wffnin, nb * 32, kb * 64, scr, lane); continue; }
#else
        if (CI_HAS(CI_FFNIN, CI_FFNOUT) && it < CI_FFNOUT) { const int r = it - CI_FFNIN, kb = r / 176, nb = r % 176; transpose_item(p.ffn_in_w, 2 * FFN, 1024, src_swiglu(nb * 32), p.Wffnin, nb * 32, kb * 64, scr, lane); continue; }
#endif
#if FFN_FP8
        if (CI_HAS(CI_FFNOUT, CI_DOWN) && it < CI_DOWN) { const int r = it - CI_FFNOUT, kb = r / 32, nb = r % 32; transpose_item8(p.ffn_out_w, 1024, FFN, nb * 32, (unsigned char*)p.Wffnout, nb * 32, kb * 64, scr, lane); continue; }
#else
        if (CI_HAS(CI_FFNOUT, CI_DOWN) && it < CI_DOWN) { const int r = it - CI_FFNOUT, kb = r / 32, nb = r % 32; transpose_item(p.ffn_out_w, 1024, FFN, nb * 32, p.Wffnout, nb * 32, kb * 64, scr, lane); continue; }
#endif
        if (CI_HAS(CI_DOWN, CI_UQ) && it < CI_UQ) { const int r = it - CI_DOWN, kb = r / 24, nb = r % 24; transpose_item(p.down_w, DOWNC, 1024, nb < 22 ? nb * 32 : -1, p.Wdown, nb * 32, kb * 64, scr, lane); continue; }
        if (CI_HAS(CI_UQ, CI_UKV) && it < CI_UKV) { const int r = it - CI_UQ, kb = r / 48, nb = r % 48; transpose_item(p.uq_w, 1536, QRANK, src_uq(nb * 32), p.Wuq, nb * 32, kb * 64, scr, lane); continue; }
        if (CI_HAS(CI_UKV, CI_MLAOUT) && it < CI_MLAOUT) { const int r = it - CI_UKV, kb = r / 64, nb = r % 64; transpose_item(p.ukv_w, 2048, KVRANK, nb * 32, p.Wukv, nb * 32, kb * 64, scr, lane); continue; }
        if (CI_HAS(CI_MLAOUT, CI_MOEOUT) && it < CI_MOEOUT) { const int r = it - CI_MLAOUT, kb = r / 32, nb = r % 32; transpose_item(p.mla_out_w, 1024, 1024, nb * 32, p.Wmlaout, nb * 32, kb * 64, scr, lane); continue; }
        constexpr int J0 = 16 * 176, J1 = 44 * 32;
#if MOE_FP8
        if (CI_HAS(CI_MOEOUT, CI_MOEIN) && it < CI_MOEIN) { const int q = it - CI_MOEOUT, e = q / J1, r = q % J1, kb = r / 32, nb = r % 32; transpose_item8(p.moe_out_w + (size_t)e * FFN * 1024, 1024, FFN, nb * 32, (unsigned char*)p.Wmo + (size_t)e * 1024 * FFN, nb * 32, kb * 64, scr, lane); continue; }
        if (CI_HAS(CI_MOEIN, CI_END)) { const int q = it - CI_MOEIN, e = q / J0, r = q % J0, kb = r / 176, nb = r % 176; transpose_item8(p.moe_in_w + (size_t)e * 1024 * 2 * FFN, 2 * FFN, 1024, src_swiglu(nb * 32), (unsigned char*)p.Wmi + (size_t)e * 2 * FFN * 1024, nb * 32, kb * 64, scr, lane); }
#else
        if (CI_HAS(CI_MOEOUT, CI_MOEIN) && it < CI_MOEIN) { const int q = it - CI_MOEOUT, e = q / J1, r = q % J1, kb = r / 32, nb = r % 32; transpose_item(p.moe_out_w + (size_t)e * FFN * 1024, 1024, FFN, nb * 32, p.Wmo + (size_t)e * 1024 * FFN, nb * 32, kb * 64, scr, lane); continue; }
        if (CI_HAS(CI_MOEIN, CI_END)) { const int q = it - CI_MOEIN, e = q / J0, r = q % J0, kb = r / 176, nb = r % 176; transpose_item(p.moe_in_w + (size_t)e * 1024 * 2 * FFN, 2 * FFN, 1024, src_swiglu(nb * 32), p.Wmi + (size_t)e * 2 * FFN * 1024, nb * 32, kb * 64, scr, lane); }
#endif
    }
#undef CI_HAS
}
__device__ __forceinline__ bool tail_ids(const int nunits, const int G, const int blk, const int wave, int& gwl, int& NGWL) {
    const int rounds = (nunits + G - 1) / G, nheavy = nunits - (rounds - 1) * G;
    if (nheavy >= G) { gwl = blk * 8 + wave; NGWL = G * 8; return true; }
    if (blk < nheavy) return false;
    gwl = (blk - nheavy) * 8 + wave; NGWL = (G - nheavy) * 8; return true;
}

enum Phase { PH_SETUP = 0, PH_ROWS1, PH_MIXIN, PH_SCAN1, PH_SCAN2, PH_SCAN3, PH_MIXOUT, PH_ROWS5, PH_FFNIN, PH_FFNOUT, PH_ROWS8, PH_DOWN, PH_PREP, PH_UQ, PH_UKV, PH_ATTN, PH_MLAOUT, PH_ROWS13, PH_ROUTE, PH_MOEIN, PH_MOEOUT, PH_ROWS17, PH_COUNT };

__global__ void __launch_bounds__(NTHREADS, 2) mega(Args args) {
    extern __shared__ __attribute__((aligned(16))) unsigned char lds_raw[];
    LAS unsigned char* lds = (LAS unsigned char*)lds_raw;
    volatile LAS unsigned* MISC = (volatile LAS unsigned*)(lds + MISC_OFF);
    const int wave0 = __builtin_amdgcn_readfirstlane((int)threadIdx.x >> 6);
    const int tid0 = threadIdx.x;
    const int G = gridDim.x, blk = blockIdx.x;
#define PHASE_IDS const int tid = tidx(wave0), lane = tid & 63, wave = __builtin_amdgcn_readfirstlane(tid >> 6), gw = blk * NWAVES + wave, NGW = G * NWAVES; (void)lane; (void)gw; (void)NGW
    unsigned char* ws0 = args.ws;
    for (int u = tid0; u < (LDS_BYTES - MISC_OFF) / 4; u += NTHREADS) ((LAS unsigned*)(lds + MISC_OFF))[u] = 0u;
    __syncthreads();
    const int lo = args.ph_lo, hi = args.ph_hi;
    XcdBarrier bar; bar.bar = (unsigned*)(ws0 + WS_CTL) + 4096; bar.x = 0; bar.st = nullptr;
    if (hi - lo > 1) bar = xcd_barrier_post((unsigned*)(ws0 + WS_CTL) + 4096, MISC + 8);
#ifndef PHMASK
#define PHMASK 0xffffffffu
#endif
#define IN(k) (((PHMASK >> (k)) & 1u) && lo <= (k) && (k) < hi)
#ifdef PROBE_K
    LAS unsigned long long* tsl = (LAS unsigned long long*)(lds + MISC_OFF + 512);
    if (tid0 == 0) tsl[0] = __builtin_amdgcn_s_memrealtime();
#define SEAM(k) do { if (IN(k) && IN((k) + 1)) xcd_barrier(bar, tidx(wave0) == 0); if (tid0 == 0) tsl[(k) + 1] = __builtin_amdgcn_s_memrealtime(); } while (0)
#else
#define SEAM(k) do { if (IN(k) && IN((k) + 1)) xcd_barrier(bar, tidx(wave0) == 0); } while (0)
#endif
    const float* x = args.in[0]; const float* cvec = args.in[1]; const float* ctx = args.in[2]; const float* cctx = args.in[3];
    const float* mod_w = args.in[4]; const float* mod_b = args.in[5]; const float* norm_g = args.in[6]; const float* mix_in_w = args.in[7];
    const float* decay_logit = args.in[8]; const float* lb_logit = args.in[9]; const float* mix_out_w = args.in[10]; const float* ffn_in_w = args.in[11];
    const float* ffn_out_w = args.in[12]; const float* down_w = args.in[13]; const float* gq = args.in[14]; const float* gkv = args.in[15];
    const float* uq_w = args.in[16]; const float* ukv_w = args.in[17]; const float* mla_out_w = args.in[18]; const float* router_w = args.in[19];
    const float* moe_in_w = args.in[20]; const float* moe_out_w = args.in[21];
    float* out = args.out;
#define PHASE_PTRS GAS unsigned char* wsg_ = (GAS unsigned char*)ws0; asm volatile("" : "+s"(wsg_)); unsigned char* ws = (unsigned char*)wsg_;     \
    float* modv = (float*)(ws + WS_MODV); float* lbv = (float*)(ws + WS_LB); float* lg = (float*)(ws + WS_LG); int* meta = (int*)(ws + WS_META); \
    float* rc = (float*)(ws + WS_ROPE_RC); float* rs = (float*)(ws + WS_ROPE_RS); float* mc = (float*)(ws + WS_ROPE_MC); float* ms = (float*)(ws + WS_ROPE_MS); \
    float* cx = (float*)(ws + WS_CX); bf16_t* HB = (bf16_t*)(ws + WS_HB); bf16_t* G0 = (bf16_t*)(ws + WS_G0); \
    bf16_t* OX = (bf16_t*)(ws + WS_OX); bf16_t* ACT = (bf16_t*)(ws + WS_ACT); \
    bf16_t* DOWN = (bf16_t*)(ws + WS_DOWN); bf16_t* QN = (bf16_t*)(ws + WS_QN); bf16_t* QR = (bf16_t*)(ws + WS_QR); bf16_t* KN = (bf16_t*)(ws + WS_KN); bf16_t* KR = (bf16_t*)(ws + WS_KR); \
    bf16_t* Vv = (bf16_t*)(ws + WS_V); bf16_t* AO = (bf16_t*)(ws + WS_AO); bf16_t* Ob = (bf16_t*)(ws + WS_O); bf16_t* NQ = (bf16_t*)(ws + WS_NQ); bf16_t* NKV = (bf16_t*)(ws + WS_NKV); \
    bf16_t* H4 = (bf16_t*)(ws + WS_H4); bf16_t* HS = (bf16_t*)(ws + WS_HS); bf16_t* ACT2 = (bf16_t*)(ws + WS_ACT2); bf16_t* YS = (bf16_t*)(ws + WS_YS); \
    int* top_e = (int*)(ws + WS_TOPE); float* top_g = (float*)(ws + WS_TOPG); int* tslot = (int*)(ws + WS_TSLOT); \
    bf16_t* Wmixin = (bf16_t*)(ws + WS_W_MIXIN); bf16_t* Wmixout = (bf16_t*)(ws + WS_W_MIXOUT); bf16_t* Wffnin = (bf16_t*)(ws + WS_W_FFNIN); bf16_t* Wffnout = (bf16_t*)(ws + WS_W_FFNOUT); \
    bf16_t* Wdown = (bf16_t*)(ws + WS_W_DOWN); bf16_t* Wuq = (bf16_t*)(ws + WS_W_UQ); bf16_t* Wukv = (bf16_t*)(ws + WS_W_UKV); bf16_t* Wmlaout = (bf16_t*)(ws + WS_W_MLAOUT); \
    bf16_t* Wmi = (bf16_t*)(ws + WS_WMI); bf16_t* Wmo = (bf16_t*)(ws + WS_WMO); \
    const float* mv0 = modv; const float* mv1 = modv + 9 * 6144; const float* g0 = norm_g; const float* g1n = norm_g + 4 * 1024;
    if (IN(PH_SETUP)) { PHASE_PTRS; PHASE_IDS;
        for (int gid = blk * NTHREADS + tid; gid < 4096 * 64; gid += G * NTHREADS) tables_body(gid, lb_logit, decay_logit, rc, rs, mc, ms, lbv, lg);
        LAS float* sc = (LAS float*)(lds + RING_OFF);
        for (int i = tid; i < 9 * 1024; i += NTHREADS) { const int r = i >> 10, k = i & 1023; const float v = r < 8 ? cvec[r * 1024 + k] : cctx[k]; sc[i] = siluf(v); }
        __syncthreads();
        { LAS float* red = (LAS float*)(lds + RING_OFF + 40960);
          for (int cg = blk; cg < 12288 / 64; cg += G) {
            const int col = cg * 64 + lane, l = col / 6144, n = col % 6144;
            float acc[9];
#pragma unroll
            for (int r = 0; r < 9; ++r) acc[r] = 0.f;
            const float* w = mod_w + ((size_t)l * 1024 + wave * 128) * 6144 + n; const LAS float* scw = sc + wave * 128;
#pragma unroll 16
            for (int k = 0; k < 128; ++k) { const float wv = w[(size_t)k * 6144];
#pragma unroll
                for (int r = 0; r < 9; ++r) acc[r] += scw[r * 1024 + k] * wv; }
#pragma unroll
            for (int r = 0; r < 9; ++r) red[(wave * 9 + r) * 64 + lane] = acc[r];
            __syncthreads();
            for (int o = tid; o < 9 * 64; o += NTHREADS) { const int r = o >> 6, ln = o & 63; float sum = 0.f;
#pragma unroll
                for (int w8 = 0; w8 < 8; ++w8) sum += red[(w8 * 9 + r) * 64 + ln];
                const int n2 = (cg * 64) % 6144 + ln; modv[((size_t)l * 9 + r) * 6144 + n2] = sum + mod_b[l * 6144 + n2]; }
            __syncthreads();
          } }
        __syncthreads();
        { ConvP cp{mix_in_w, mix_out_w, ffn_in_w, ffn_out_w, down_w, uq_w, ukv_w, mla_out_w, moe_in_w, moe_out_w, Wmixin, Wmixout, Wffnin, Wffnout, Wdown, Wuq, Wukv, Wmlaout, Wmi, Wmo};
          conv_range<CI_MIXIN, CI_MIXOUT>(cp, gw, NGW, (LAS float*)(lds + RING_OFF + 40960 + wave * 9216), lane); }
    }
    SEAM(PH_SETUP);
    if (IN(PH_ROWS1)) { PHASE_PTRS; PHASE_IDS; RowArgs a{}; a.xin_lat = x; a.xin_ctx = ctx; a.gh = g0; a.scale = mv0 + 1024; a.shift = mv0; a.H = HB; a.nrows = R;
        rows2::rows_phase<true, 0, 0, 1, false>(a, gw, NGW, lane, true, nullptr); }
    SEAM(PH_ROWS1);
    if (IN(PH_MIXIN)) { PHASE_PTRS; pg8::Gemm g{HB, Wmixin, D, D, D}; pg8::DenseOrder S; S.init(R / 256, MIXC / 256, G, blk); pg8::EpiMix E{G0, rc, rs, lbv};
        pg8::gemm_phase<pg8::EpiMix, pg8::DenseOrder, true>(lds + RING_OFF, g, S, E, wave0); }
#define CONV_TAIL(NUNITS, LO, HI) do { PHASE_PTRS; PHASE_IDS; int gwl, NGWL; if (tail_ids((NUNITS), G, blk, wave, gwl, NGWL)) { __syncthreads(); \
        ConvP cp{mix_in_w, mix_out_w, ffn_in_w, ffn_out_w, down_w, uq_w, ukv_w, mla_out_w, moe_in_w, moe_out_w, Wmixin, Wmixout, Wffnin, Wffnout, Wdown, Wuq, Wukv, Wmlaout, Wmi, Wmo}; \
        conv_range<(LO), (HI)>(cp, gwl, NGWL, (LAS float*)(lds + RING_OFF + wave * 9216), lane); } } while (0)
    if (IN(PH_MIXIN)) CONV_TAIL((R / 256) * (MIXC / 256), CI_MIXOUT, CI_DOWN);
    SEAM(PH_MIXIN);
#define SCAN_PTRS bf16_t* ST = (bf16_t*)(ws + scan::WS_STATE); float* DEC = (float*)(ws + scan::WS_DEC)
    if (IN(PH_SCAN1)) { PHASE_PTRS; SCAN_PTRS; scan::Raw Rw; const int NI = 2 * NB * 4 * scan::NCH; if (blk < NI) scan::load_raw<false>(Rw, blk, G0, tidx(wave0));
        for (int item = blk; item < NI; item += G) scan::s1_item(item, item + G < NI ? item + G : -1, Rw, G0, lg, ST, DEC, (LAS char*)(lds + RING_OFF), wave0); }
    SEAM(PH_SCAN1);
    if (IN(PH_SCAN2)) { PHASE_PTRS; SCAN_PTRS; PHASE_IDS; for (size_t v = (size_t)blk * NTHREADS + tid; v < (size_t)2 * NB * 4 * 2 * 2048; v += (size_t)G * NTHREADS) scan::s2_vec(v, ST, DEC); }
    SEAM(PH_SCAN2);
    if (IN(PH_SCAN3)) { PHASE_PTRS; SCAN_PTRS; scan::Raw Rw; const int NI = 2 * NB * 4 * scan::NCH; if (blk < NI) scan::load_raw<true>(Rw, blk, G0, tidx(wave0));
        for (int item = blk; item < NI; item += G) scan::s3_item(item, item + G < NI ? item + G : -1, Rw, G0, lg, ST, HB, (LAS char*)(lds + RING_OFF), wave0); }
    SEAM(PH_SCAN3);
    if (IN(PH_MIXOUT)) { PHASE_PTRS; pg8::Gemm g{HB, Wmixout, D, D, D}; pg8::DenseOrder S; S.init(R / 256, D / 256, G, blk); pg8::EpiPlain E{OX, D};
        pg8::gemm_phase<pg8::EpiPlain, pg8::DenseOrder, true>(lds + RING_OFF, g, S, E, wave0); }
    if (IN(PH_MIXOUT)) CONV_TAIL((R / 256) * (D / 256), CI_DOWN, CI_MOEIN);
    SEAM(PH_MIXOUT);
    if (IN(PH_ROWS5)) { PHASE_PTRS; PHASE_IDS; RowArgs a{}; a.xin_lat = x; a.xin_ctx = ctx; a.xout_lat = out; a.xout_ctx = cx; a.Y = OX; a.gy = g0 + 1024; a.gate = mv0 + 2048; a.gh = g0 + 2048; a.scale = mv0 + 4096; a.shift = mv0 + 3072; a.H = HB; a.nrows = R; a.xout_bf = 1;
#if FFN_FP8 == 1
        a.H8 = (unsigned char*)HB;
        rows2::rows_phase<true, 1, 1, 2, false>(a, gw, NGW, lane, true, nullptr); }
#else
        rows2::rows_phase<true, 1, 1, 1, false>(a, gw, NGW, lane, true, nullptr); }
#endif
    SEAM(PH_ROWS5);
#if FFN_FP8 == 2
    if (IN(PH_FFNIN)) { PHASE_PTRS; pg8::Gemm g{HB, Wffnin, D, D, D}; pg8::DenseOrder S; S.init(R / 256, 2 * FFN / 256, G, blk); pg8::EpiSwiglu8 E{(unsigned char*)ACT, 1.f};
        pg8::gemm_phase<pg8::EpiSwiglu8, pg8::DenseOrder, true>(lds + RING_OFF, g, S, E, wave0); }
#elif FFN_FP8 == 1
    if (IN(PH_FFNIN)) { PHASE_PTRS; pg8::Gemm g{HB, Wffnin, D / 2, D / 2, D / 2}; pg8::DenseOrder S; S.init(R / 256, 2 * FFN / 256, G, blk); pg8::EpiSwiglu8 E{(unsigned char*)ACT, W8_INV};
        pg8::gemm_phase<pg8::EpiSwiglu8, pg8::DenseOrder, true, true>(lds + RING_OFF, g, S, E, wave0); }
#else
    if (IN(PH_FFNIN)) { PHASE_PTRS; pg8::Gemm g{HB, Wffnin, D, D, D}; pg8::DenseOrder S; S.init(R / 256, 2 * FFN / 256, G, blk); pg8::EpiSwiglu E{ACT};
        pg8::gemm_phase<pg8::EpiSwiglu, pg8::DenseOrder, true>(lds + RING_OFF, g, S, E, wave0); }
#endif
    SEAM(PH_FFNIN);
#if FFN_FP8
    if (IN(PH_FFNOUT)) { PHASE_PTRS; pg8::Gemm g{ACT, Wffnout, FFN / 2, FFN / 2, FFN / 2}; pg8::DenseOrder S; S.init(R / 256, D / 256, G, blk); pg8::EpiPlainS E{OX, D, W8_INV};
        pg8::gemm_phase<pg8::EpiPlainS, pg8::DenseOrder, true, true>(lds + RING_OFF, g, S, E, wave0); }
#else
    if (IN(PH_FFNOUT)) { PHASE_PTRS; pg8::Gemm g{ACT, Wffnout, FFN, FFN, FFN}; pg8::DenseOrder S; S.init(R / 256, D / 256, G, blk); pg8::EpiPlain E{OX, D};
        pg8::gemm_phase<pg8::EpiPlain, pg8::DenseOrder, true>(lds + RING_OFF, g, S, E, wave0); }
#endif
    if (IN(PH_FFNOUT)) CONV_TAIL((R / 256) * (D / 256), CI_MOEIN, CI_MOEIN + 6 * 16 * 176);
    SEAM(PH_FFNOUT);
    if (IN(PH_ROWS8)) { PHASE_PTRS; PHASE_IDS; RowArgs a{}; a.xin_lat = out; a.xin_ctx = cx; a.xout_lat = out; a.xout_ctx = cx; a.Y = OX; a.gy = g0 + 3072; a.gate = mv0 + 5120; a.gh = g1n; a.scale = mv1 + 1024; a.shift = mv1; a.H = HB; a.nrows = R; a.xin_bf = 1; a.xout_bf = 1;
        rows2::rows_phase<false, 1, 1, 1, false>(a, gw, NGW, lane, true, nullptr);
    }
    SEAM(PH_ROWS8);
    if (IN(PH_DOWN)) { PHASE_PTRS; pg8::Gemm g{HB, Wdown, D, D, D}; pg8::DenseOrder S; S.init(R / 256, DOWNP / 256, G, blk); pg8::EpiPlain E{DOWN, DOWNP};
        pg8::gemm_phase<pg8::EpiPlain, pg8::DenseOrder, true>(lds + RING_OFF, g, S, E, wave0); }
    if (IN(PH_DOWN)) CONV_TAIL((R / 256) * (DOWNP / 256), CI_MOEIN + 6 * 16 * 176, CI_END);
    SEAM(PH_DOWN);
    if (IN(PH_PREP)) { PHASE_PTRS; PHASE_IDS; rows2::prep_phase(DOWN, gq, gkv, mc, ms, NQ, NKV, KR, gw, NGW, lane); }
    SEAM(PH_PREP);
    if (IN(PH_UQ)) { PHASE_PTRS; pg8::Gemm g{NQ, Wuq, QRANK, QRANK, QRANK}; pg8::DenseOrder S; S.init(RL / 256, 1536 / 256, G, blk); pg8::EpiUQ E{QN, QR, mc, ms};
          pg8::gemm_phase<pg8::EpiUQ, pg8::DenseOrder, true>(lds + RING_OFF, g, S, E, wave0); }
#ifdef PROBE_K
    if (tid0 == 0) tsl[PH_UQ + 1] = __builtin_amdgcn_s_memrealtime();
#endif
    if (IN(PH_UKV)) { PHASE_PTRS; pg8::Gemm g{NKV, Wukv, KVRANK, KVRANK, KVRANK}; pg8::DenseOrder S; S.init(R / 256, 2048 / 256, G, blk); pg8::EpiUKV E{KN, Vv};
          pg8::gemm_phase<pg8::EpiUKV, pg8::DenseOrder, true>(lds + RING_OFF, g, S, E, wave0); }
    SEAM(PH_UKV);
    if (IN(PH_ATTN)) { PHASE_PTRS;
        for (int L = blk; L < NB * 8 * (T / 256); L += G) { const int xg = L & 7, jj = L >> 3, pair = xg * 8 + (jj >> 4), qb = jj & 15, b = pair >> 3, h = pair & 7;
            const size_t bh = (size_t)b * 8 + h;
            attn::attn_unit(QN + (bh * T + qb * 256) * 128, QR + (bh * T + qb * 256) * 64, KN + bh * KEYS * 128, KR + (size_t)b * KEYS * 64, Vv + bh * KEYS * 128,
                            AO + ((size_t)b * T + qb * 256) * 1024 + h * 128, KEYS, (LAS char*)(lds + RING_OFF), wave0); }
    }
    SEAM(PH_ATTN);
    if (IN(PH_MLAOUT)) { PHASE_PTRS; pg8::Gemm g{AO, Wmlaout, D, D, D}; pg8::DenseOrder S; S.init(RL / 256, D / 256, G, blk); pg8::EpiPlain E{Ob, D};
        pg8::gemm_phase<pg8::EpiPlain, pg8::DenseOrder, true>(lds + RING_OFF, g, S, E, wave0); }
    SEAM(PH_MLAOUT);
    if (IN(PH_ROWS13)) { PHASE_PTRS; PHASE_IDS; RowArgs a{}; a.xin_lat = out; a.xin_ctx = cx; a.xout_lat = out; a.xout_ctx = cx; a.Y = Ob; a.gy = g1n + 1024; a.gate = mv1 + 2048; a.gh = g1n + 2048; a.scale = mv1 + 4096; a.shift = mv1 + 3072; a.H = H4;
        a.router_w = router_w; a.top_e = top_e; a.top_g = top_g; a.nrows = RL; a.xin_bf = 1; a.xout_bf = 1; a.xout_lat = (float*)(ws + 404 * MiB);
        rows2::stage_router(router_w, lds + RING_OFF, tid, NTHREADS); __syncthreads();
        rows2::rows_phase<false, 1, 1, 1, true>(a, gw, NGW, lane, false, lds + RING_OFF); }
    SEAM(PH_ROWS13);
    if (IN(PH_ROUTE)) { PHASE_PTRS; PHASE_IDS;
        LAS int* sh = (LAS int*)(lds + RING_OFF);
        const int TPB = RL / G, t0 = blk * TPB;
        if (tid < 32) sh[tid] = 0;
        __syncthreads();
        unsigned long long ctot = 0ull, cpre = 0ull;
        for (int t = tid; t < RL; t += NTHREADS) { const int2 e = *(const int2*)(top_e + 2 * t); const unsigned long long inc = (1ull << (8 * e.x)) + (1ull << (8 * e.y)); ctot += inc; if (t < t0) cpre += inc; }
#pragma unroll
        for (int e = 0; e < 8; ++e) { int a = (int)((ctot >> (8 * e)) & 255ull), b2 = (int)((cpre >> (8 * e)) & 255ull);
#pragma unroll
            for (int o = 1; o < 64; o <<= 1) { a += __shfl_xor(a, o); b2 += __shfl_xor(b2, o); }
            if (lane == 0) { __hip_atomic_fetch_add(&sh[e], a, __ATOMIC_RELAXED, __HIP_MEMORY_SCOPE_WORKGROUP); __hip_atomic_fetch_add(&sh[8 + e], b2, __ATOMIC_RELAXED, __HIP_MEMORY_SCOPE_WORKGROUP); } }
        __syncthreads();
        int base_e[8]; { int acc = 0;
#pragma unroll
            for (int e = 0; e < 8; ++e) { base_e[e] = acc; acc += sh[e]; } }
        if (tid < 8) { MISC[16 + tid] = (unsigned)base_e[tid]; MISC[24 + tid] = (unsigned)sh[tid]; if (blk == 0) { meta[tid] = base_e[tid]; meta[8 + tid] = sh[tid]; } }
        int e0 = 0, e1 = 0; const bool act = tid < TPB;
        if (act) { const int2 e = *(const int2*)(top_e + 2 * (t0 + tid)); e0 = e.x; e1 = e.y; }
        int r0 = 0, r1 = 0;
#pragma unroll
        for (int e = 0; e < 8; ++e) { const bool f = act && (e0 == e || e1 == e); const unsigned long long bal = __ballot(f); const int pre = __popcll(bal & ((1ull << lane) - 1ull));
            if (wave == 0 && lane == 0) sh[16 + e] = __popcll(bal);
            if (e0 == e) r0 = pre; if (e1 == e) r1 = pre; }
        __syncthreads();
        if (act) { if (wave == 1) { r0 += sh[16 + e0]; r1 += sh[16 + e1]; }
            int s0 = 0, s1 = 0;
#pragma unroll
            for (int e = 0; e < 8; ++e) { if (e0 == e) s0 = base_e[e] + sh[8 + e] + r0; if (e1 == e) s1 = base_e[e] + sh[8 + e] + r1; }
            sh[32 + 2 * tid] = s0; sh[33 + 2 * tid] = s1; *(int2*)(tslot + 2 * (t0 + tid)) = make_int2(s0, s1); }
        __syncthreads();
        for (int i = wave; i < TPB; i += NWAVES) { const int t = t0 + i; const int s0 = sh[32 + 2 * i], s1 = sh[33 + 2 * i];
            const uint4 v0 = *(const uint4*)(H4 + (size_t)t * D + lane * 8), v1 = *(const uint4*)(H4 + (size_t)t * D + 512 + lane * 8);
#if MOE_FP8
            u32x2 w0, w1;
            w0.x = pack4_fp8(clamp448(bf2f(v0.x & 0xffff)), clamp448(bf2f(v0.x >> 16)), clamp448(bf2f(v0.y & 0xffff)), clamp448(bf2f(v0.y >> 16))); w0.y = pack4_fp8(clamp448(bf2f(v0.z & 0xffff)), clamp448(bf2f(v0.z >> 16)), clamp448(bf2f(v0.w & 0xffff)), clamp448(bf2f(v0.w >> 16)));
            w1.x = pack4_fp8(clamp448(bf2f(v1.x & 0xffff)), clamp448(bf2f(v1.x >> 16)), clamp448(bf2f(v1.y & 0xffff)), clamp448(bf2f(v1.y >> 16))); w1.y = pack4_fp8(clamp448(bf2f(v1.z & 0xffff)), clamp448(bf2f(v1.z >> 16)), clamp448(bf2f(v1.w & 0xffff)), clamp448(bf2f(v1.w >> 16)));
            unsigned char* HS8 = (unsigned char*)HS;
            *(u32x2*)(HS8 + (size_t)s0 * D + lane * 8) = w0; *(u32x2*)(HS8 + (size_t)s0 * D + 512 + lane * 8) = w1;
            *(u32x2*)(HS8 + (size_t)s1 * D + lane * 8) = w0; *(u32x2*)(HS8 + (size_t)s1 * D + 512 + lane * 8) = w1; }
#else
            *(uint4*)(HS + (size_t)s0 * D + lane * 8) = v0; *(uint4*)(HS + (size_t)s0 * D + 512 + lane * 8) = v1;
            *(uint4*)(HS + (size_t)s1 * D + lane * 8) = v0; *(uint4*)(HS + (size_t)s1 * D + 512 + lane * 8) = v1; }
#endif
    }
    SEAM(PH_ROUTE);
    if (IN(PH_MOEIN)) { PHASE_PTRS;
        { const int t2 = tidx(wave0); if (t2 < 16) MISC[16 + t2] = (unsigned)meta[t2]; }
        __syncthreads();
#if MOE_FP8
        pg8::Gemm g{HS, Wmi, D / 2, D / 2, D / 2}; pg8::MoeOrder S; S.init((const LAS int*)(lds + MISC_OFF + 64), 2 * FFN / 256, G, blk); pg8::EpiSwiglu8 E{(unsigned char*)ACT2, W8_INV};
        pg8::gemm_phase<pg8::EpiSwiglu8, pg8::MoeOrder, true, true>(lds + RING_OFF, g, S, E, wave0); }
#else
        pg8::Gemm g{HS, Wmi, D, D, D}; pg8::MoeOrder S; S.init((const LAS int*)(lds + MISC_OFF + 64), 2 * FFN / 256, G, blk); pg8::EpiSwiglu E{ACT2};
        pg8::gemm_phase<pg8::EpiSwiglu, pg8::MoeOrder, true>(lds + RING_OFF, g, S, E, wave0); }
#endif
    SEAM(PH_MOEIN);
    if (IN(PH_MOEOUT)) { PHASE_PTRS;
        { const int t2 = tidx(wave0); if (t2 < 16) MISC[16 + t2] = (unsigned)meta[t2]; }
        __syncthreads();
#if MOE_FP8
        pg8::Gemm g{ACT2, Wmo, FFN / 2, FFN / 2, FFN / 2}; pg8::MoeOrder S; S.init((const LAS int*)(lds + MISC_OFF + 64), D / 256, G, blk); pg8::EpiPlainS E{YS, D, W8_INV};
        pg8::gemm_phase<pg8::EpiPlainS, pg8::MoeOrder, true, true>(lds + RING_OFF, g, S, E, wave0); }
#else
        pg8::Gemm g{ACT2, Wmo, FFN, FFN, FFN}; pg8::MoeOrder S; S.init((const LAS int*)(lds + MISC_OFF + 64), D / 256, G, blk); pg8::EpiPlain E{YS, D};
        pg8::gemm_phase<pg8::EpiPlain, pg8::MoeOrder, true>(lds + RING_OFF, g, S, E, wave0); }
#endif
    SEAM(PH_MOEOUT);
    if (IN(PH_ROWS17)) { PHASE_PTRS; PHASE_IDS; RowArgs a{}; a.xin_lat = out; a.xin_ctx = cx; a.xout_lat = out; a.xout_ctx = cx; a.Y = YS; a.tok_slot = tslot; a.tok_g = top_g; a.gy = g1n + 3072; a.gate = mv1 + 5120; a.nrows = RL; a.xin_bf = 1; a.xin_lat = (const float*)(ws + 404 * MiB);
#ifdef PROBE_K
        __syncthreads();
        { const float tot = (float)(tsl[PH_ROWS17] - tsl[0]); float fr = 0.f;
#pragma unroll
          for (int k = 0; k < PH_ROWS17; ++k) if ((PROBE_K >> k) & 1) fr += (float)(tsl[k + 1] - tsl[k]);
          a.oscale = 1.f + 2.f * fr / tot; }
#endif
        rows2::rows_phase<false, 2, 2, 0, false>(a, gw, NGW, lane, false, nullptr); }
#undef IN
#undef SEAM
}
#ifndef N_LAUNCH_MODE
#define N_LAUNCH_MODE 1
#endif

static inline dim3 g1(size_t n, int per) { return dim3((unsigned)((n + per - 1) / per)); }
extern "C" void kernel_launch(void* const* d_in, const int* in_sizes, int n_in, void* d_out, int out_size, void* d_ws, size_t ws_size, hipStream_t stream) {
    if (n_in != 22 || out_size != RL * D || ws_size < WS_END) { fprintf(stderr, "kernel_launch: unexpected shapes: n_in %d out %d ws %zu (need %zu)\n", n_in, out_size, ws_size, (size_t)WS_END); return; }
    static int grid = 0;
    if (grid == 0) {
        int dev = 0, cus = 0;
        if (hipGetDevice(&dev) != hipSuccess || hipDeviceGetAttribute(&cus, hipDeviceAttributeMultiprocessorCount, dev) != hipSuccess) { grid = -1; return; }
        if (hipFuncSetAttribute((const void*)mega, hipFuncAttributeMaxDynamicSharedMemorySize, LDS_BYTES) != hipSuccess) { fprintf(stderr, "hipFuncSetAttribute failed\n"); grid = -1; return; }
        int per_cu = 0; (void)hipOccupancyMaxActiveBlocksPerMultiprocessor(&per_cu, (const void*)mega, NTHREADS, LDS_BYTES); (void)hipGetLastError();
        if (per_cu < 1) fprintf(stderr, "occupancy query says %d\n", per_cu);
        grid = cus;
    }
    if (grid < 0) return;
    char* ws = (char*)d_ws; float* out = (float*)d_out;
    float* lg = (float*)(ws + WS_LG); int* meta = (int*)(ws + WS_META);
    bf16_t* HB = (bf16_t*)(ws + WS_HB);
    bf16_t* G[9]; for (int i = 0; i < 9; ++i) G[i] = (bf16_t*)(ws + WS_G0 + i * GSZ);
    float* oret = (float*)(ws + WS_ST + 72 * MiB); float* ohg = (float*)(ws + WS_ST + 140 * MiB);
    bf16_t* QN = (bf16_t*)(ws + WS_QN); bf16_t* QR = (bf16_t*)(ws + WS_QR); bf16_t* KN = (bf16_t*)(ws + WS_KN); bf16_t* KR = (bf16_t*)(ws + WS_KR);
    bf16_t* Vv = (bf16_t*)(ws + WS_V); bf16_t* AO = (bf16_t*)(ws + WS_AO);
    bf16_t* H4 = (bf16_t*)(ws + WS_H4); bf16_t* HS = (bf16_t*)(ws + WS_HS);
    int* top_e = (int*)(ws + WS_TOPE); int* rank = (int*)(ws + WS_RANK); int* tslot = (int*)(ws + WS_TSLOT);
    (void)hipMemsetAsync(ws + WS_CTL, 0, 1 * MiB, stream);
    Args a{}; for (int i = 0; i < 22; ++i) a.in[i] = (const float*)d_in[i]; a.out = out; a.ws = (unsigned char*)d_ws;
    auto run = [&](int lo, int hi) { a.ph_lo = lo; a.ph_hi = hi; hipLaunchKernelGGL(mega, dim3(grid), dim3(NTHREADS), LDS_BYTES, stream, a); };
#if N_LAUNCH_MODE == 1
    run(0, PH_COUNT);
#else
    for (int p = PH_SETUP; p < PH_COUNT; ++p) run(p, p + 1);
#endif
}
```

```cpp
#include <hip/hip_runtime.h>
#include <cstdint>
#include <cstdio>

constexpr int NB = 8, T = 4096, CT = 256, D = 1024;
constexpr int RL = NB * T;
constexpr int RC = NB * CT;
constexpr int R = RL + RC;
constexpr int KEYS = CT + T;
constexpr int MIXC = 4608, FFN = 2816, NEXP = 8;
constexpr int DOWNC = 704, DOWNP = 768, QRANK = 384, KVRANK = 256;
constexpr float EPS = 1e-6f;
constexpr int SLOTS = 2 * RL;

typedef unsigned short bf16_t;
__host__ __device__ __forceinline__ float bf2f(bf16_t v) { unsigned u = ((unsigned)v) << 16; float f; __builtin_memcpy(&f, &u, 4); return f; }
__host__ __device__ __forceinline__ bf16_t f2bf(float f) { unsigned u; __builtin_memcpy(&u, &f, 4); return (bf16_t)((u + 0x7fffu + ((u >> 16) & 1u)) >> 16); }
__device__ __forceinline__ float siluf(float v) { return v / (1.f + expf(-v)); }
__device__ __forceinline__ float wave_sum(float v) {
#define WS_DPP(x, ctrl, rm, bc) __builtin_bit_cast(float, __builtin_amdgcn_update_dpp(0, __builtin_bit_cast(int, (x)), (ctrl), (rm), 0xf, (bc)))
    v += WS_DPP(v, 0x111, 0xf, true); v += WS_DPP(v, 0x112, 0xf, true); v += WS_DPP(v, 0x114, 0xf, true); v += WS_DPP(v, 0x118, 0xf, true);
    v += WS_DPP(v, 0x142, 0xa, false); v += WS_DPP(v, 0x143, 0xc, false);
#undef WS_DPP
    return __builtin_bit_cast(float, __builtin_amdgcn_readlane(__builtin_bit_cast(int, v), 63));
}

constexpr size_t MiB = 1u << 20;
constexpr size_t WS_CTL = 0;
constexpr size_t WS_MODV = 512 * 1024;
constexpr size_t WS_LB = 1 * MiB + 512 * 1024;
constexpr size_t WS_LG = WS_LB + 4096;
constexpr size_t WS_META = WS_LB + 8192;
constexpr size_t WS_ROPE_RC = 2 * MiB;
constexpr size_t WS_ROPE_RS = 3 * MiB;
constexpr size_t WS_ROPE_MC = 4 * MiB;
constexpr size_t WS_ROPE_MS = 4 * MiB + 512 * 1024;
constexpr size_t WS_CX = 5 * MiB;
constexpr size_t WS_TOPE = 5 * MiB;
constexpr size_t WS_TOPG = 5 * MiB + 256 * 1024;
constexpr size_t WS_RANK = 5 * MiB + 512 * 1024;
constexpr size_t WS_TSLOT = 5 * MiB + 768 * 1024;
constexpr size_t WS_WSMALL = 13 * MiB;
constexpr size_t WS_HB = 48 * MiB;
constexpr size_t WS_G0 = 116 * MiB;
constexpr size_t GSZ = 34 * MiB;
constexpr size_t WS_ST = 422 * MiB;
constexpr size_t WS_OX = 116 * MiB;
constexpr size_t WS_ACT = 184 * MiB;
constexpr size_t WS_DOWN = 116 * MiB;
constexpr size_t WS_QN = 404 * MiB;
constexpr size_t WS_QR = 231 * MiB;
constexpr size_t WS_KN = 263 * MiB;
constexpr size_t WS_KR = 331 * MiB;
constexpr size_t WS_V = 336 * MiB;
constexpr size_t WS_AO = 468 * MiB;
constexpr size_t WS_O = 167 * MiB;
constexpr size_t WS_NQ = 167 * MiB;
constexpr size_t WS_NKV = 193 * MiB;
constexpr size_t WS_TMP1 = 575 * MiB;
constexpr size_t WS_H4 = 508 * MiB;
constexpr size_t WS_HS = 13 * MiB;
constexpr size_t WS_ACT2 = 145 * MiB;
constexpr size_t WS_YS = 13 * MiB;
constexpr size_t WS_END = 704 * MiB;

__global__ __launch_bounds__(256) void k_mod(const float* __restrict__ c, const float* __restrict__ cctx, const float* __restrict__ mod_w,
                                             const float* __restrict__ mod_b, float* __restrict__ modv) {
    __shared__ float sc[9 * 1024];
    for (int i = threadIdx.x; i < 9 * 1024; i += 256) { int r = i >> 10, k = i & 1023; float v = r < 8 ? c[r * 1024 + k] : cctx[k]; sc[i] = siluf(v); }
    __syncthreads();
    int gid = blockIdx.x * 256 + threadIdx.x; int l = gid / 6144, n = gid % 6144;
    float acc[9];
#pragma unroll
    for (int r = 0; r < 9; ++r) acc[r] = 0.f;
    const float* w = mod_w + (size_t)l * 1024 * 6144 + n;
    for (int k = 0; k < 1024; ++k) { float wv = w[(size_t)k * 6144];
#pragma unroll
        for (int r = 0; r < 9; ++r) acc[r] += sc[r * 1024 + k] * wv; }
    float bb = mod_b[l * 6144 + n];
#pragma unroll
    for (int r = 0; r < 9; ++r) modv[((size_t)l * 9 + r) * 6144 + n] = acc[r] + bb;
}
__device__ __forceinline__ void tables_body(const int gid, const float* __restrict__ lb_logit, const float* __restrict__ decay_logit, float* rc, float* rs, float* mc, float* ms, float* lb, float* lg) {
    if (gid < 4096 * 64) { int t = gid >> 6, j = gid & 63, i = j & 31; float pos = (float)(j < 32 ? (t >> 6) : (t & 63));
        float inv = powf(10000.f, -(float)i / 32.f); float a = pos * inv; rc[gid] = cosf(a); rs[gid] = sinf(a); }
    if (gid < 4096 * 32) { int t = gid >> 5, j = gid & 31, i = j & 15; float pos = (float)(j < 16 ? (t >> 6) : (t & 63));
        float inv = powf(10000.f, -(float)i / 16.f); float a = pos * inv; mc[gid] = cosf(a); ms[gid] = sinf(a); }
    if (gid < 512) { float l0 = lb_logit[gid], l1 = lb_logit[512 + gid]; float m = fmaxf(l0, l1); float e0 = expf(l0 - m), e1 = expf(l1 - m); lb[gid] = e0 / (e0 + e1); }
    if (gid < 8) { float x = decay_logit[gid]; lg[gid] = fminf(x, 0.f) - log1pf(expf(-fabsf(x))); }
}

__global__ __launch_bounds__(256) void k_tables(const float* __restrict__ lb_logit, const float* __restrict__ decay_logit, float* rc, float* rs, float* mc, float* ms, float* lb, float* lg) {
    tables_body(blockIdx.x * 256 + threadIdx.x, lb_logit, decay_logit, rc, rs, mc, ms, lb, lg);
}

struct RowArgs {
    const float* xin_lat; const float* xin_ctx;
    float* xout_lat; float* xout_ctx;
    const bf16_t* Y;
    const int* tok_slot; const float* tok_g;
    const float* gy;
    const float* gate;
    const float* gh; const float* scale; const float* shift;
    bf16_t* H;
    unsigned char* H8;
    const float* router_w; int* top_e; float* top_g;
    int nrows; float oscale; int xin_bf, xout_bf;
};
__device__ __forceinline__ void rows_body(const RowArgs& a, const int r, const int lane) {
    const bool lat = r < RL; const int mr = lat ? (r >> 12) : 8;
    const float* xi = lat ? a.xin_lat + (size_t)r * D : a.xin_ctx + (size_t)(r - RL) * D;
    float x[16];
    if (a.xin_bf) { const bf16_t* xb = lat ? (const bf16_t*)a.xin_lat + (size_t)r * D : (const bf16_t*)a.xin_ctx + (size_t)(r - RL) * D;
#pragma unroll
        for (int j = 0; j < 4; ++j) { const uint2 u = *(const uint2*)(xb + j * 256 + lane * 4); x[4 * j] = bf2f(u.x & 0xffff); x[4 * j + 1] = bf2f(u.x >> 16); x[4 * j + 2] = bf2f(u.y & 0xffff); x[4 * j + 3] = bf2f(u.y >> 16); }
    } else {
#pragma unroll
        for (int j = 0; j < 4; ++j) { float4 v = *(const float4*)(xi + j * 256 + lane * 4); x[4 * j] = v.x; x[4 * j + 1] = v.y; x[4 * j + 2] = v.z; x[4 * j + 3] = v.w; }
    }
    if (a.Y) {
        float y[16];
        if (a.tok_slot) {
            const int s0 = a.tok_slot[2 * r], s1 = a.tok_slot[2 * r + 1]; const float g0 = a.tok_g[2 * r], g1 = a.tok_g[2 * r + 1];
#pragma unroll
            for (int j = 0; j < 4; ++j) { const uint2 u0 = *(const uint2*)(a.Y + (size_t)s0 * D + j * 256 + lane * 4); const uint2 u1 = *(const uint2*)(a.Y + (size_t)s1 * D + j * 256 + lane * 4);
                y[4 * j] = g0 * bf2f(u0.x & 0xffff) + g1 * bf2f(u1.x & 0xffff); y[4 * j + 1] = g0 * bf2f(u0.x >> 16) + g1 * bf2f(u1.x >> 16);
                y[4 * j + 2] = g0 * bf2f(u0.y & 0xffff) + g1 * bf2f(u1.y & 0xffff); y[4 * j + 3] = g0 * bf2f(u0.y >> 16) + g1 * bf2f(u1.y >> 16); }
        } else {
#pragma unroll
            for (int j = 0; j < 4; ++j) { const uint2 u = *(const uint2*)(a.Y + (size_t)r * D + j * 256 + lane * 4);
                y[4 * j] = bf2f(u.x & 0xffff); y[4 * j + 1] = bf2f(u.x >> 16); y[4 * j + 2] = bf2f(u.y & 0xffff); y[4 * j + 3] = bf2f(u.y >> 16); }
        }
        float ss = 0.f;
#pragma unroll
        for (int i = 0; i < 16; ++i) ss += y[i] * y[i];
        ss = wave_sum(ss); const float ry = rsqrtf(ss * (1.f / D) + EPS);
        float* xo = lat ? a.xout_lat + (size_t)r * D : a.xout_ctx + (size_t)(r - RL) * D;
#pragma unroll
        for (int j = 0; j < 4; ++j) { const int c = j * 256 + lane * 4; const float4 g = *(const float4*)(a.gy + c); const float4 gt = *(const float4*)(a.gate + (size_t)mr * 6144 + c);
            x[4 * j] += gt.x * (y[4 * j] * ry * g.x); x[4 * j + 1] += gt.y * (y[4 * j + 1] * ry * g.y); x[4 * j + 2] += gt.z * (y[4 * j + 2] * ry * g.z); x[4 * j + 3] += gt.w * (y[4 * j + 3] * ry * g.w);
            if (a.oscale != 0.f) { x[4 * j] *= a.oscale; x[4 * j + 1] *= a.oscale; x[4 * j + 2] *= a.oscale; x[4 * j + 3] *= a.oscale; }
            if (a.xout_bf) { bf16_t* xob = lat ? (bf16_t*)a.xout_lat + (size_t)r * D : (bf16_t*)a.xout_ctx + (size_t)(r - RL) * D;
                uint2 o; o.x = (unsigned)f2bf(x[4 * j]) | ((unsigned)f2bf(x[4 * j + 1]) << 16); o.y = (unsigned)f2bf(x[4 * j + 2]) | ((unsigned)f2bf(x[4 * j + 3]) << 16); *(uint2*)(xob + c) = o;
                x[4 * j] = bf2f((bf16_t)(o.x & 0xffff)); x[4 * j + 1] = bf2f((bf16_t)(o.x >> 16)); x[4 * j + 2] = bf2f((bf16_t)(o.y & 0xffff)); x[4 * j + 3] = bf2f((bf16_t)(o.y >> 16)); }
            else *(float4*)(xo + c) = make_float4(x[4 * j], x[4 * j + 1], x[4 * j + 2], x[4 * j + 3]); }
    }
    if (a.gh) {
        float ss = 0.f;
#pragma unroll
        for (int i = 0; i < 16; ++i) ss += x[i] * x[i];
        ss = wave_sum(ss); const float rx = rsqrtf(ss * (1.f / D) + EPS);
        float h[16];
#pragma unroll
        for (int j = 0; j < 4; ++j) { const int c = j * 256 + lane * 4; const float4 g = *(const float4*)(a.gh + c); const float4 sc = *(const float4*)(a.scale + (size_t)mr * 6144 + c); const float4 sh = *(const float4*)(a.shift + (size_t)mr * 6144 + c);
            h[4 * j] = x[4 * j] * rx * g.x * (1.f + sc.x) + sh.x; h[4 * j + 1] = x[4 * j + 1] * rx * g.y * (1.f + sc.y) + sh.y;
            h[4 * j + 2] = x[4 * j + 2] * rx * g.z * (1.f + sc.z) + sh.z; h[4 * j + 3] = x[4 * j + 3] * rx * g.w * (1.f + sc.w) + sh.w;
            if (a.H8) { unsigned w = 0u; w = (unsigned)__builtin_amdgcn_cvt_pk_fp8_f32(fminf(fmaxf(h[4 * j], -448.f), 448.f), fminf(fmaxf(h[4 * j + 1], -448.f), 448.f), (int)w, false);
                w = (unsigned)__builtin_amdgcn_cvt_pk_fp8_f32(fminf(fmaxf(h[4 * j + 2], -448.f), 448.f), fminf(fmaxf(h[4 * j + 3], -448.f), 448.f), (int)w, true); *(unsigned*)(a.H8 + (size_t)r * D + c) = w; }
            else { uint2 o; o.x = (unsigned)f2bf(h[4 * j]) | ((unsigned)f2bf(h[4 * j + 1]) << 16); o.y = (unsigned)f2bf(h[4 * j + 2]) | ((unsigned)f2bf(h[4 * j + 3]) << 16);
            *(uint2*)(a.H + (size_t)r * D + c) = o; } }
        if (a.router_w) {
            float lg[8];
#pragma unroll
            for (int e = 0; e < 8; ++e) lg[e] = 0.f;
#pragma unroll
            for (int j = 0; j < 4; ++j)
#pragma unroll
                for (int i = 0; i < 4; ++i) { const int c = j * 256 + lane * 4 + i; const float4 w0 = *(const float4*)(a.router_w + (size_t)c * 8); const float4 w1 = *(const float4*)(a.router_w + (size_t)c * 8 + 4); const float hv = h[4 * j + i];
                    lg[0] += hv * w0.x; lg[1] += hv * w0.y; lg[2] += hv * w0.z; lg[3] += hv * w0.w; lg[4] += hv * w1.x; lg[5] += hv * w1.y; lg[6] += hv * w1.z; lg[7] += hv * w1.w; }
#pragma unroll
            for (int e = 0; e < 8; ++e) lg[e] = wave_sum(lg[e]);
            if (lane == 0) {
                int e0 = 0; float v0 = lg[0];
#pragma unroll
                for (int e = 1; e < 8; ++e) if (lg[e] > v0) { v0 = lg[e]; e0 = e; }
                int e1 = -1; float v1 = -3.0e38f;
#pragma unroll
                for (int e = 0; e < 8; ++e) if (e != e0 && lg[e] > v1) { v1 = lg[e]; e1 = e; }
                if (e1 < 0) { e1 = (e0 + 1) & 7; v1 = v0; }
                const float g0 = 1.f / (1.f + expf(v1 - v0));
                a.top_e[2 * r] = e0; a.top_e[2 * r + 1] = e1; a.top_g[2 * r] = g0; a.top_g[2 * r + 1] = 1.f - g0;
            }
        }
    }
}

__global__ __launch_bounds__(256) void k_rows(RowArgs a) {
    const int lane = threadIdx.x & 63; const int r = blockIdx.x * 4 + (threadIdx.x >> 6);
    if (r >= a.nrows) return;
    rows_body(a, r, lane);
}

template <int MODE>
__global__ __launch_bounds__(256) void k_sgemm(const bf16_t* __restrict__ A, int lda, const float* __restrict__ W, int ldw, void* __restrict__ Cv, int ldc,
                                               int M, int N, int K, const int* __restrict__ meta, int e, size_t wstride, int row_off, int row_cap) {
    constexpr int NBW = (MODE == 2) ? 2 : 1;
    int arow0 = 0;
    if (meta) { arow0 = meta[e] + row_off; int cnt = meta[8 + e] - row_off; M = cnt < row_cap ? cnt : row_cap; W += (size_t)e * wstride; }
    const int bm = blockIdx.y * 128, bn = blockIdx.x * 64;
    if (bm >= M) return;
    __shared__ float As[16][132]; __shared__ float Bs[NBW][16][68];
    const int tid = threadIdx.x, tx = tid & 15, ty = tid >> 4;
    float acc[NBW][8][4];
#pragma unroll
    for (int w = 0; w < NBW; ++w)
#pragma unroll
        for (int i = 0; i < 8; ++i)
#pragma unroll
            for (int j = 0; j < 4; ++j) acc[w][i][j] = 0.f;
    const int ar = tid >> 1, ak = (tid & 1) * 8; const bool aval = (bm + ar) < M;
    const bf16_t* ap = A + (size_t)(arow0 + bm + (aval ? ar : 0)) * lda + ak;
    const int bk = tid >> 4, bc = (tid & 15) * 4; const bool bval = (bn + bc) < N;
    for (int k0 = 0; k0 < K; k0 += 16) {
        uint4 av = aval ? *(const uint4*)(ap + k0) : make_uint4(0, 0, 0, 0);
        As[ak + 0][ar] = bf2f(av.x & 0xffff); As[ak + 1][ar] = bf2f(av.x >> 16); As[ak + 2][ar] = bf2f(av.y & 0xffff); As[ak + 3][ar] = bf2f(av.y >> 16);
        As[ak + 4][ar] = bf2f(av.z & 0xffff); As[ak + 5][ar] = bf2f(av.z >> 16); As[ak + 6][ar] = bf2f(av.w & 0xffff); As[ak + 7][ar] = bf2f(av.w >> 16);
#pragma unroll
        for (int w = 0; w < NBW; ++w) { float4 bv = bval ? *(const float4*)(W + (size_t)(k0 + bk) * ldw + bn + bc + w * N) : make_float4(0, 0, 0, 0); *(float4*)&Bs[w][bk][bc] = bv; }
        __syncthreads();
#pragma unroll
        for (int kk = 0; kk < 16; ++kk) {
            float a[8]; const float4 a0 = *(const float4*)&As[kk][ty * 8], a1 = *(const float4*)&As[kk][ty * 8 + 4];
            a[0] = a0.x; a[1] = a0.y; a[2] = a0.z; a[3] = a0.w; a[4] = a1.x; a[5] = a1.y; a[6] = a1.z; a[7] = a1.w;
#pragma unroll
            for (int w = 0; w < NBW; ++w) { const float4 b = *(const float4*)&Bs[w][kk][tx * 4];
#pragma unroll
                for (int i = 0; i < 8; ++i) { acc[w][i][0] += a[i] * b.x; acc[w][i][1] += a[i] * b.y; acc[w][i][2] += a[i] * b.z; acc[w][i][3] += a[i] * b.w; } }
        }
        __syncthreads();
    }
#pragma unroll
    for (int i = 0; i < 8; ++i) { const int rr = bm + ty * 8 + i; if (rr >= M) continue;
#pragma unroll
        for (int j = 0; j < 4; ++j) { const int cc = bn + tx * 4 + j; if (cc >= N) continue;
            const size_t o = (size_t)(arow0 + rr) * ldc + cc;
            if (MODE == 0) ((float*)Cv)[o] = acc[0][i][j];
            else if (MODE == 1) ((bf16_t*)Cv)[o] = f2bf(acc[0][i][j]);
            else ((bf16_t*)Cv)[o] = f2bf(siluf(acc[0][i][j]) * acc[NBW - 1][i][j]); } }
}

__global__ __launch_bounds__(256) void k_mixact(const float* __restrict__ tmp, bf16_t* __restrict__ G, int grp, const float* __restrict__ rc, const float* __restrict__ rs, const float* __restrict__ lb) {
    const size_t gid = (size_t)blockIdx.x * 256 + threadIdx.x; if (gid >= (size_t)R * 512) return;
    const int r = (int)(gid >> 9), c = (int)(gid & 511); float v = tmp[gid], o;
    if (grp <= 1) {
        const int j = c & 127, jj = j & 63; const float other = tmp[(size_t)r * 512 + (c ^ 64)];
        float x1 = j < 64 ? v : other, x2 = j < 64 ? other : v;
        if (grp == 1) { x1 *= 0.08838834764831845f; x2 *= 0.08838834764831845f; }
        if (r < RL) { const int t = r & 4095; const float cs = rc[t * 64 + jj], sn = rs[t * 64 + jj]; o = j < 64 ? x1 * cs - x2 * sn : x1 * sn + x2 * cs; }
        else o = j < 64 ? x1 : x2;
    } else if (grp == 2 || grp == 7) o = v;
    else if (grp == 3 || grp == 4 || grp == 8) o = siluf(v);
    else { const float l = lb[c]; o = (1.f - l) / (1.f + expf(v)); }
    G[gid] = f2bf(o);
}
template <int ALGO>
__global__ __launch_bounds__(128) void k_scan_naive(const bf16_t* __restrict__ Q, const bf16_t* __restrict__ Kf, const bf16_t* __restrict__ Kb, const bf16_t* __restrict__ V,
                                                    const float* __restrict__ lg, float* __restrict__ O) {
    const int b = blockIdx.x >> 2, h = blockIdx.x & 3, e = threadIdx.x;
    __shared__ float sq[32][128]; __shared__ float sk[32][128];
    for (int dir = 0; dir < 2; ++dir) {
        const bf16_t* Kp = dir ? Kb : Kf; const float gamma = (ALGO == 0) ? expf(lg[dir * 4 + h]) : 0.f;
        float S[128];
#pragma unroll
        for (int d = 0; d < 128; ++d) S[d] = 0.f;
        for (int p0 = 0; p0 < KEYS; p0 += 32) {
            __syncthreads();
            for (int i = threadIdx.x; i < 32 * 128; i += 128) { const int s = i >> 7, d = i & 127; const int p = p0 + s;
                const int row = p < CT ? (RL + b * CT + (dir ? CT - 1 - p : p)) : (b * T + (dir ? T - 1 - (p - CT) : (p - CT)));
                sq[s][d] = bf2f(Q[(size_t)row * 512 + h * 128 + d]); sk[s][d] = bf2f(Kp[(size_t)row * 512 + h * 128 + d]); }
            __syncthreads();
            for (int s = 0; s < 32; ++s) { const int p = p0 + s;
                const int row = p < CT ? (RL + b * CT + (dir ? CT - 1 - p : p)) : (b * T + (dir ? T - 1 - (p - CT) : (p - CT)));
                const float v = bf2f(V[(size_t)row * 512 + h * 128 + e]); float o = 0.f;
#pragma unroll
                for (int d = 0; d < 128; ++d) { const float kd = sk[s][d]; const float dec = (ALGO == 0) ? gamma : (1.f - kd); S[d] = dec * S[d] + kd * v; o += sq[s][d] * S[d]; }
                float* op = O + (size_t)row * 512 + h * 128 + e; if (dir == 0) *op = o; else *op += o; }
        }
    }
}
__global__ __launch_bounds__(256) void k_merge(const float* __restrict__ Oret, const float* __restrict__ Ohg, const bf16_t* __restrict__ AG, const bf16_t* __restrict__ BG, bf16_t* __restrict__ Y, int part_sel) {
    const int lane = threadIdx.x & 63; const size_t w = (size_t)blockIdx.x * 4 + (threadIdx.x >> 6); if (w >= (size_t)R * 8) return;
    const int r = (int)(w >> 3), part = (int)((w >> 2) & 1), h = (int)(w & 3);
    if (part_sel >= 0 && part != part_sel) return;
    const float* src = (part ? Ohg : Oret) + (size_t)r * 512 + h * 128; const bf16_t* g = (part ? BG : AG) + (size_t)r * 512 + h * 128;
    const float v0 = src[lane * 2], v1 = src[lane * 2 + 1]; const float ss = wave_sum(v0 * v0 + v1 * v1); const float rr = rsqrtf(ss * (1.f / 128.f) + EPS);
    bf16_t* y = Y + (size_t)r * 1024 + part * 512 + h * 128;
    y[lane * 2] = f2bf(v0 * rr * bf2f(g[lane * 2])); y[lane * 2 + 1] = f2bf(v1 * rr * bf2f(g[lane * 2 + 1]));
}

__device__ __forceinline__ void mla_prep_body(const int r, const int lane, const bf16_t* __restrict__ DOWN, const float* __restrict__ gq, const float* __restrict__ gkv, const float* __restrict__ mc, const float* __restrict__ ms,
                                                  bf16_t* __restrict__ NQ, bf16_t* __restrict__ NKV, bf16_t* __restrict__ KR) {
    const bf16_t* d = DOWN + (size_t)r * DOWNP;
    float q[6]; float ss = 0.f;
#pragma unroll
    for (int i = 0; i < 6; ++i) { q[i] = bf2f(d[lane + 64 * i]); ss += q[i] * q[i]; }
    ss = wave_sum(ss); const float rq = rsqrtf(ss * (1.f / 384.f) + EPS);
#pragma unroll
    for (int i = 0; i < 6; ++i) NQ[(size_t)r * 384 + lane + 64 * i] = f2bf(q[i] * rq * gq[lane + 64 * i]);
    float k[4]; ss = 0.f;
#pragma unroll
    for (int i = 0; i < 4; ++i) { k[i] = bf2f(d[384 + lane + 64 * i]); ss += k[i] * k[i]; }
    ss = wave_sum(ss); const float rk = rsqrtf(ss * (1.f / 256.f) + EPS);
#pragma unroll
    for (int i = 0; i < 4; ++i) NKV[(size_t)r * 256 + lane + 64 * i] = f2bf(k[i] * rk * gkv[lane + 64 * i]);
    const float x1 = bf2f(d[640 + (lane & 31)]), x2 = bf2f(d[672 + (lane & 31)]);
    const bool lat = r < RL; const int b = lat ? (r >> 12) : ((r - RL) >> 8); const int key = lat ? CT + (r & 4095) : ((r - RL) & 255);
    float o;
    if (lat) { const int t = r & 4095; const float cs = mc[t * 32 + (lane & 31)], sn = ms[t * 32 + (lane & 31)]; o = lane < 32 ? x1 * cs - x2 * sn : x1 * sn + x2 * cs; }
    else o = lane < 32 ? x1 : x2;
    KR[((size_t)b * KEYS + key) * 64 + lane] = f2bf(o);
}
__global__ __launch_bounds__(256) void k_mla_prep(const bf16_t* __restrict__ DOWN, const float* __restrict__ gq, const float* __restrict__ gkv, const float* __restrict__ mc, const float* __restrict__ ms,
                                                  bf16_t* __restrict__ NQ, bf16_t* __restrict__ NKV, bf16_t* __restrict__ KR) {
    const int lane = threadIdx.x & 63; const int r = blockIdx.x * 4 + (threadIdx.x >> 6); if (r >= R) return;
    mla_prep_body(r, lane, DOWN, gq, gkv, mc, ms, NQ, NKV, KR);
}
__global__ __launch_bounds__(256) void k_qsplit(const float* __restrict__ tmp, int r0, int nrows, const float* __restrict__ mc, const float* __restrict__ ms, bf16_t* __restrict__ QN, bf16_t* __restrict__ QR) {
    const size_t gid = (size_t)blockIdx.x * 256 + threadIdx.x; if (gid >= (size_t)nrows * 1536) return;
    const int rr = (int)(gid / 1536), c = (int)(gid % 1536), h = c / 192, j = c % 192; const int r = r0 + rr, b = r >> 12, t = r & 4095;
    const float v = tmp[gid];
    if (j < 128) QN[(((size_t)b * 8 + h) * T + t) * 128 + j] = f2bf(v);
    else { const int jr = j - 128, jj = jr & 31; const float other = tmp[(size_t)rr * 1536 + h * 192 + 128 + (jr ^ 32)];
        const float x1 = jr < 32 ? v : other, x2 = jr < 32 ? other : v; const float cs = mc[t * 32 + jj], sn = ms[t * 32 + jj];
        QR[(((size_t)b * 8 + h) * T + t) * 64 + jr] = f2bf(jr < 32 ? x1 * cs - x2 * sn : x1 * sn + x2 * cs); }
}
__global__ __launch_bounds__(256) void k_kvsplit(const float* __restrict__ tmp, int r0, int nrows, bf16_t* __restrict__ KN, bf16_t* __restrict__ Vv) {
    const size_t gid = (size_t)blockIdx.x * 256 + threadIdx.x; if (gid >= (size_t)nrows * 2048) return;
    const int rr = (int)(gid >> 11), c = (int)(gid & 2047), h = c >> 8, j = c & 255; const int r = r0 + rr;
    const bool lat = r < RL; const int b = lat ? (r >> 12) : ((r - RL) >> 8); const int key = lat ? CT + (r & 4095) : ((r - RL) & 255);
    bf16_t* dst = (j < 128 ? KN : Vv) + (((size_t)b * 8 + h) * KEYS + key) * 128 + (j & 127);
    *dst = f2bf(tmp[gid]);
}
__global__ __launch_bounds__(256) void k_attn_naive(const bf16_t* __restrict__ QN, const bf16_t* __restrict__ QR, const bf16_t* __restrict__ KN, const bf16_t* __restrict__ KR, const bf16_t* __restrict__ Vv, bf16_t* __restrict__ AO) {
    __shared__ float sq[2][192]; __shared__ float sc[2][KEYS]; __shared__ float red[2][4];
    const int tid = threadIdx.x; const int qb = blockIdx.x % (T / 2), h = (blockIdx.x / (T / 2)) & 7, b = blockIdx.x / (T / 2 * 8);
    const int t0 = qb * 2; const size_t bh = (size_t)b * 8 + h;
    for (int i = tid; i < 2 * 192; i += 256) { const int q = i / 192, j = i % 192; sq[q][j] = j < 128 ? bf2f(QN[(bh * T + t0 + q) * 128 + j]) : bf2f(QR[(bh * T + t0 + q) * 64 + j - 128]); }
    __syncthreads();
    const float scale = 0.07216878364870322f;
    float m0 = -3e38f, m1 = -3e38f;
    for (int key = tid; key < KEYS; key += 256) {
        const uint4* kn = (const uint4*)(KN + (bh * KEYS + key) * 128); const uint4* kr = (const uint4*)(KR + ((size_t)b * KEYS + key) * 64);
        float s0 = 0.f, s1 = 0.f;
        for (int c = 0; c < 24; ++c) { const uint4 u = c < 16 ? kn[c] : kr[c - 16]; const int j = c * 8;
            const float k0 = bf2f(u.x & 0xffff), k1 = bf2f(u.x >> 16), k2 = bf2f(u.y & 0xffff), k3 = bf2f(u.y >> 16), k4 = bf2f(u.z & 0xffff), k5 = bf2f(u.z >> 16), k6 = bf2f(u.w & 0xffff), k7 = bf2f(u.w >> 16);
            s0 += sq[0][j] * k0 + sq[0][j + 1] * k1 + sq[0][j + 2] * k2 + sq[0][j + 3] * k3 + sq[0][j + 4] * k4 + sq[0][j + 5] * k5 + sq[0][j + 6] * k6 + sq[0][j + 7] * k7;
            s1 += sq[1][j] * k0 + sq[1][j + 1] * k1 + sq[1][j + 2] * k2 + sq[1][j + 3] * k3 + sq[1][j + 4] * k4 + sq[1][j + 5] * k5 + sq[1][j + 6] * k6 + sq[1][j + 7] * k7; }
        s0 *= scale; s1 *= scale; sc[0][key] = s0; sc[1][key] = s1; m0 = fmaxf(m0, s0); m1 = fmaxf(m1, s1);
    }
#pragma unroll
    for (int o = 1; o < 64; o <<= 1) { m0 = fmaxf(m0, __shfl_xor(m0, o)); m1 = fmaxf(m1, __shfl_xor(m1, o)); }
    if ((tid & 63) == 0) { red[0][tid >> 6] = m0; red[1][tid >> 6] = m1; }
    __syncthreads();
    m0 = fmaxf(fmaxf(red[0][0], red[0][1]), fmaxf(red[0][2], red[0][3])); m1 = fmaxf(fmaxf(red[1][0], red[1][1]), fmaxf(red[1][2], red[1][3]));
    __syncthreads();
    float l0 = 0.f, l1 = 0.f;
    for (int key = tid; key < KEYS; key += 256) { const float p0 = expf(sc[0][key] - m0), p1 = expf(sc[1][key] - m1); sc[0][key] = p0; sc[1][key] = p1; l0 += p0; l1 += p1; }
    l0 = wave_sum(l0); l1 = wave_sum(l1);
    if ((tid & 63) == 0) { red[0][tid >> 6] = l0; red[1][tid >> 6] = l1; }
    __syncthreads();
    l0 = red[0][0] + red[0][1] + red[0][2] + red[0][3]; l1 = red[1][0] + red[1][1] + red[1][2] + red[1][3];
    const int q = tid >> 7, d = tid & 127; const float* p = sc[q]; float o = 0.f;
    const bf16_t* vp = Vv + bh * KEYS * 128 + d;
    for (int key = 0; key < KEYS; ++key) o += p[key] * bf2f(vp[(size_t)key * 128]);
    AO[((size_t)b * T + t0 + q) * 1024 + h * 128 + d] = f2bf(o / (q ? l1 : l0));
}

__global__ __launch_bounds__(1024) void k_route_rank(const int* __restrict__ top_e, int* __restrict__ rank, int* __restrict__ meta) {
    __shared__ int ws[16]; __shared__ int running;
    const int e = blockIdx.x, tid = threadIdx.x, lane = tid & 63, wid = tid >> 6;
    if (tid == 0) running = 0;
    __syncthreads();
    for (int t0 = 0; t0 < RL; t0 += 1024) { const int t = t0 + tid; const int e0 = top_e[2 * t], e1 = top_e[2 * t + 1]; const int f = (e0 == e || e1 == e) ? 1 : 0;
        const unsigned long long bal = __ballot(f); const int pre = __popcll(bal & ((1ull << lane) - 1ull));
        if (lane == 0) ws[wid] = __popcll(bal);
        __syncthreads();
        int off = 0; for (int w = 0; w < wid; ++w) off += ws[w];
        int tot = 0; for (int w = 0; w < 16; ++w) tot += ws[w];
        const int base = running;
        if (f) rank[2 * t + (e0 == e ? 0 : 1)] = base + off + pre;
        __syncthreads();
        if (tid == 0) running = base + tot;
        __syncthreads();
    }
    if (tid == 0) meta[8 + e] = running;
}
__global__ void k_route_base(int* meta) { if (threadIdx.x == 0) { int s = 0; for (int e = 0; e < 8; ++e) { meta[e] = s; s += meta[8 + e]; } } }
__global__ __launch_bounds__(256) void k_gather(const bf16_t* __restrict__ H4, const int* __restrict__ top_e, const int* __restrict__ rank, const int* __restrict__ meta, bf16_t* __restrict__ HS, int* __restrict__ tok_slot) {
    const int lane = threadIdx.x & 63; const int t = blockIdx.x * 4 + (threadIdx.x >> 6); if (t >= RL) return;
    const uint4 v0 = *(const uint4*)(H4 + (size_t)t * D + lane * 8), v1 = *(const uint4*)(H4 + (size_t)t * D + 512 + lane * 8);
#pragma unroll
    for (int k = 0; k < 2; ++k) { const int e = top_e[2 * t + k]; const int slot = meta[e] + rank[2 * t + k];
        *(uint4*)(HS + (size_t)slot * D + lane * 8) = v0; *(uint4*)(HS + (size_t)slot * D + 512 + lane * 8) = v1;
        if (lane == 0) tok_slot[2 * t + k] = slot; }
}


namespace rows2 {
#define RLAS __attribute__((address_space(3)))
typedef unsigned ru2 __attribute__((ext_vector_type(2)));
typedef float rf4 __attribute__((ext_vector_type(4)));
typedef float rf2 __attribute__((ext_vector_type(2)));
typedef int ri2 __attribute__((ext_vector_type(2)));
typedef float rf2_cv __attribute__((ext_vector_type(2))); typedef __bf16 rb2_cv __attribute__((ext_vector_type(2)));
__device__ __forceinline__ unsigned pk_bf16(float lo, float hi) { const rf2_cv v = {lo, hi}; const rb2_cv b = __builtin_convertvector(v, rb2_cv); return __builtin_bit_cast(unsigned, b); }
__device__ __forceinline__ float lo_bf(unsigned u) { return __builtin_bit_cast(float, u << 16); }
__device__ __forceinline__ float hi_bf(unsigned u) { return __builtin_bit_cast(float, u & 0xffff0000u); }
template <bool XF32, int YM> struct Raw { rf4 xf[XF32 ? 4 : 1]; ru2 xb[XF32 ? 1 : 4]; ru2 y0[YM ? 4 : 1]; ru2 y1[YM == 2 ? 4 : 1]; };
struct Slot { int s0, s1; float g0, g1; };
constexpr int RW_STRIDE = 144;
constexpr int RW_BYTES = 256 * RW_STRIDE;

__device__ __forceinline__ void stage_router(const float* __restrict__ router_w, RLAS unsigned char* rwl, const int tid, const int nthreads) {
    for (int q = tid; q < 2048; q += nthreads) { const int c = q >> 1, half = q & 1; const rf4 v = *(const rf4*)(router_w + (size_t)c * 8 + half * 4);
        const int j = c >> 8, L = (c >> 2) & 63, i = c & 3; *(RLAS rf4*)(rwl + (j * 64 + L) * RW_STRIDE + i * 32 + half * 16) = v; }
}

template <bool XF32, int YM, int XO, int HO, bool RT>
__device__ __forceinline__ void rows_phase(const RowArgs& a, const int gw, const int NGW, const int lane, const bool with_ctx, RLAS unsigned char* rwl) {
    const int WPB = NGW >> 3, bb = gw / WPB, i0 = gw - bb * WPB;
    const int nl = i0 < T ? (T - i0 + WPB - 1) / WPB : 0;
    const int nc = (with_ctx && gw < RC) ? (RC - gw + NGW - 1) / NGW : 0;
    const int n = nl + nc;
    auto row_of = [&](int k) -> int { return k < nl ? bb * T + i0 + WPB * k : RL + gw + NGW * (k - nl); };
    auto load_slot = [&](Slot& s, int r) { const ri2 t = *(const ri2*)(a.tok_slot + 2 * (size_t)r); const rf2 g = *(const rf2*)(a.tok_g + 2 * (size_t)r); s.s0 = t.x; s.s1 = t.y; s.g0 = g.x; s.g1 = g.y; };
    auto load = [&](Raw<XF32, YM>& w, int r, const Slot& s) {
        const bool lat = r < RL;
        if constexpr (XF32) { const float* xp = lat ? a.xin_lat + (size_t)r * D : a.xin_ctx + (size_t)(r - RL) * D;
#pragma unroll
            for (int j = 0; j < 4; ++j) w.xf[j] = *(const rf4*)(xp + j * 256 + lane * 4);
        } else { const bf16_t* xp = lat ? (const bf16_t*)a.xin_lat + (size_t)r * D : (const bf16_t*)a.xin_ctx + (size_t)(r - RL) * D;
#pragma unroll
            for (int j = 0; j < 4; ++j) w.xb[j] = *(const ru2*)(xp + j * 256 + lane * 4); }
        if constexpr (YM == 1) { const bf16_t* yp = a.Y + (size_t)r * D;
#pragma unroll
            for (int j = 0; j < 4; ++j) w.y0[j] = *(const ru2*)(yp + j * 256 + lane * 4); }
        if constexpr (YM == 2) { const bf16_t* p0 = a.Y + (size_t)s.s0 * D; const bf16_t* p1 = a.Y + (size_t)s.s1 * D;
#pragma unroll
            for (int j = 0; j < 4; ++j) { w.y0[j] = *(const ru2*)(p0 + j * 256 + lane * 4); w.y1[j] = *(const ru2*)(p1 + j * 256 + lane * 4); } }
    };
    float A[16], Bm[16], Cm[16]; int cur_mr = -1;
    auto process = [&](const Raw<XF32, YM>& w, int r, const Slot& s) {
        const bool lat = r < RL; const int mr = lat ? (r >> 12) : 8;
        if (mr != cur_mr) { cur_mr = mr;
#pragma unroll
            for (int j = 0; j < 4; ++j) { const int c = j * 256 + lane * 4;
                if constexpr (YM != 0) { const rf4 g = *(const rf4*)(a.gy + c); const rf4 gt = *(const rf4*)(a.gate + (size_t)mr * 6144 + c);
                    A[4 * j] = gt.x * g.x; A[4 * j + 1] = gt.y * g.y; A[4 * j + 2] = gt.z * g.z; A[4 * j + 3] = gt.w * g.w; }
                if constexpr (HO != 0) { const rf4 g = *(const rf4*)(a.gh + c); const rf4 sc = *(const rf4*)(a.scale + (size_t)mr * 6144 + c); const rf4 sh = *(const rf4*)(a.shift + (size_t)mr * 6144 + c);
                    Bm[4 * j] = g.x * (1.f + sc.x); Bm[4 * j + 1] = g.y * (1.f + sc.y); Bm[4 * j + 2] = g.z * (1.f + sc.z); Bm[4 * j + 3] = g.w * (1.f + sc.w);
                    Cm[4 * j] = sh.x; Cm[4 * j + 1] = sh.y; Cm[4 * j + 2] = sh.z; Cm[4 * j + 3] = sh.w; } }
        }
        float x[16];
#pragma unroll
        for (int j = 0; j < 4; ++j) {
            if constexpr (XF32) { x[4 * j] = w.xf[j].x; x[4 * j + 1] = w.xf[j].y; x[4 * j + 2] = w.xf[j].z; x[4 * j + 3] = w.xf[j].w; }
            else { x[4 * j] = lo_bf(w.xb[j].x); x[4 * j + 1] = hi_bf(w.xb[j].x); x[4 * j + 2] = lo_bf(w.xb[j].y); x[4 * j + 3] = hi_bf(w.xb[j].y); } }
        if constexpr (YM != 0) {
            float y[16];
#pragma unroll
            for (int j = 0; j < 4; ++j) {
                if constexpr (YM == 2) { y[4 * j] = s.g0 * lo_bf(w.y0[j].x) + s.g1 * lo_bf(w.y1[j].x); y[4 * j + 1] = s.g0 * hi_bf(w.y0[j].x) + s.g1 * hi_bf(w.y1[j].x);
                    y[4 * j + 2] = s.g0 * lo_bf(w.y0[j].y) + s.g1 * lo_bf(w.y1[j].y); y[4 * j + 3] = s.g0 * hi_bf(w.y0[j].y) + s.g1 * hi_bf(w.y1[j].y); }
                else { y[4 * j] = lo_bf(w.y0[j].x); y[4 * j + 1] = hi_bf(w.y0[j].x); y[4 * j + 2] = lo_bf(w.y0[j].y); y[4 * j + 3] = hi_bf(w.y0[j].y); } }
            float ss = 0.f;
#pragma unroll
            for (int i = 0; i < 16; ++i) ss += y[i] * y[i];
            ss = wave_sum(ss); const float ry = rsqrtf(ss * (1.f / D) + EPS);
#pragma unroll
            for (int j = 0; j < 4; ++j) { const int c = j * 256 + lane * 4;
#pragma unroll
                for (int i = 0; i < 4; ++i) x[4 * j + i] += A[4 * j + i] * (y[4 * j + i] * ry);
                if constexpr (XO == 1) { bf16_t* xob = lat ? (bf16_t*)a.xout_lat + (size_t)r * D : (bf16_t*)a.xout_ctx + (size_t)(r - RL) * D;
                    ru2 o; o.x = pk_bf16(x[4 * j], x[4 * j + 1]); o.y = pk_bf16(x[4 * j + 2], x[4 * j + 3]); *(ru2*)(xob + c) = o;
                    x[4 * j] = lo_bf(o.x); x[4 * j + 1] = hi_bf(o.x); x[4 * j + 2] = lo_bf(o.y); x[4 * j + 3] = hi_bf(o.y); }
                if constexpr (XO == 2) { float* xo = lat ? a.xout_lat + (size_t)r * D : a.xout_ctx + (size_t)(r - RL) * D;
                    const rf4 o = {x[4 * j], x[4 * j + 1], x[4 * j + 2], x[4 * j + 3]}; *(rf4*)(xo + c) = o; } }
        }
        if constexpr (HO != 0) {
            float ss = 0.f;
#pragma unroll
            for (int i = 0; i < 16; ++i) ss += x[i] * x[i];
            ss = wave_sum(ss); const float rx = rsqrtf(ss * (1.f / D) + EPS);
            float h[16];
#pragma unroll
            for (int j = 0; j < 4; ++j) { const int c = j * 256 + lane * 4;
#pragma unroll
                for (int i = 0; i < 4; ++i) h[4 * j + i] = (x[4 * j + i] * rx) * Bm[4 * j + i] + Cm[4 * j + i];
                if constexpr (HO == 2) { unsigned wv = 0u; wv = (unsigned)__builtin_amdgcn_cvt_pk_fp8_f32(fminf(fmaxf(h[4 * j], -448.f), 448.f), fminf(fmaxf(h[4 * j + 1], -448.f), 448.f), (int)wv, false);
                    wv = (unsigned)__builtin_amdgcn_cvt_pk_fp8_f32(fminf(fmaxf(h[4 * j + 2], -448.f), 448.f), fminf(fmaxf(h[4 * j + 3], -448.f), 448.f), (int)wv, true); *(unsigned*)(a.H8 + (size_t)r * D + c) = wv; }
                else { ru2 o; o.x = pk_bf16(h[4 * j], h[4 * j + 1]); o.y = pk_bf16(h[4 * j + 2], h[4 * j + 3]); *(ru2*)(a.H + (size_t)r * D + c) = o; } }
            if constexpr (RT) {
                float lg[8];
#pragma unroll
                for (int e = 0; e < 8; ++e) lg[e] = 0.f;
#pragma unroll
                for (int j = 0; j < 4; ++j) { const RLAS unsigned char* bp = rwl + (j * 64 + lane) * RW_STRIDE;
#pragma unroll
                    for (int i = 0; i < 4; ++i) { const rf4 w0 = *(const RLAS rf4*)(bp + i * 32); const rf4 w1 = *(const RLAS rf4*)(bp + i * 32 + 16); const float hv = h[4 * j + i];
                        lg[0] += hv * w0.x; lg[1] += hv * w0.y; lg[2] += hv * w0.z; lg[3] += hv * w0.w; lg[4] += hv * w1.x; lg[5] += hv * w1.y; lg[6] += hv * w1.z; lg[7] += hv * w1.w; }
                    __builtin_amdgcn_sched_barrier(0); }
#pragma unroll
                for (int e = 0; e < 8; ++e) lg[e] = wave_sum(lg[e]);
                if (lane == 0) {
                    int e0 = 0; float v0 = lg[0];
#pragma unroll
                    for (int e = 1; e < 8; ++e) if (lg[e] > v0) { v0 = lg[e]; e0 = e; }
                    int e1 = -1; float v1 = -3.0e38f;
#pragma unroll
                    for (int e = 0; e < 8; ++e) if (e != e0 && lg[e] > v1) { v1 = lg[e]; e1 = e; }
                    if (e1 < 0) { e1 = (e0 + 1) & 7; v1 = v0; }
                    const float g0 = 1.f / (1.f + expf(v1 - v0));
                    a.top_e[2 * r] = e0; a.top_e[2 * r + 1] = e1; a.top_g[2 * r] = g0; a.top_g[2 * r + 1] = 1.f - g0;
                }
            }
        }
    };
    Raw<XF32, YM> ra, rb; Slot s_cur{}, s_nxt{};
    if (n > 0) { if constexpr (YM == 2) load_slot(s_cur, row_of(0));
        load(ra, row_of(0), s_cur);
        if constexpr (YM == 2) { if (n > 1) load_slot(s_nxt, row_of(1)); } }
    auto step = [&](const Raw<XF32, YM>& cur, Raw<XF32, YM>& nxt, int k) {
        Slot s_n2{};
        if (k + 1 < n) { load(nxt, row_of(k + 1), s_nxt); if constexpr (YM == 2) { if (k + 2 < n) load_slot(s_n2, row_of(k + 2)); } }
        process(cur, row_of(k), s_cur);
        s_cur = s_nxt; s_nxt = s_n2;
    };
#pragma unroll 1
    for (int k = 0; k < n; k += 2) { step(ra, rb, k); if (k + 1 < n) step(rb, ra, k + 1); }
}
}
#ifndef MOE_FP8
#define MOE_FP8 1
#endif
#ifndef FFN_FP8
#define FFN_FP8 1
#endif

#define LAS __attribute__((address_space(3)))
#define GAS __attribute__((address_space(1)))
typedef short bf16x8 __attribute__((ext_vector_type(8)));
typedef float f32x4 __attribute__((ext_vector_type(4)));
typedef float f32x2 __attribute__((ext_vector_type(2)));
typedef unsigned u32x4 __attribute__((ext_vector_type(4)));
typedef unsigned u32x2 __attribute__((ext_vector_type(2)));
constexpr size_t WS_WMI = 572 * MiB;
constexpr size_t WS_WMO = 660 * MiB;
constexpr size_t WS_W_MIXIN = WS_WSMALL;
constexpr size_t WS_W_MIXOUT = WS_W_MIXIN + 9 * MiB;
constexpr size_t WS_W_FFNIN = WS_W_MIXOUT + 2 * MiB;
constexpr size_t WS_W_FFNOUT = WS_W_FFNIN + 11 * MiB;
constexpr size_t WS_W_DOWN = WS_W_FFNOUT + 5632 * 1024;
constexpr size_t WS_W_UQ = WS_W_DOWN + 1536 * 1024;
constexpr size_t WS_W_UKV = WS_W_UQ + 1152 * 1024;
constexpr size_t WS_W_MLAOUT = WS_W_UKV + 1 * MiB;
static_assert(WS_W_MLAOUT + 2 * MiB <= WS_HB, "small weights fit");

typedef float f32x2_cv __attribute__((ext_vector_type(2))); typedef __bf16 bf16x2_cv __attribute__((ext_vector_type(2)));
__device__ __forceinline__ unsigned cvt_pk_bf16(float lo, float hi) { const f32x2_cv v = {lo, hi}; const bf16x2_cv b = __builtin_convertvector(v, bf16x2_cv); return __builtin_bit_cast(unsigned, b); }
__device__ __forceinline__ int tidx(int wv) { int t = (wv << 6) | (int)__builtin_amdgcn_mbcnt_hi(~0u, __builtin_amdgcn_mbcnt_lo(~0u, 0u)); asm volatile("" : "+v"(t)); return t; }
__device__ __forceinline__ unsigned pack4_fp8(float a, float b, float c, float d) { unsigned w = 0u; w = (unsigned)__builtin_amdgcn_cvt_pk_fp8_f32(a, b, (int)w, false); w = (unsigned)__builtin_amdgcn_cvt_pk_fp8_f32(c, d, (int)w, true); return w; }
__device__ __forceinline__ float clamp448(float v) { return fminf(fmaxf(v, -448.f), 448.f); }
constexpr float W8_SCALE = 64.f, W8_INV = 1.f / 64.f;
typedef int v8i_t __attribute__((ext_vector_type(8)));
typedef int v4i_t __attribute__((ext_vector_type(4)));
__device__ __forceinline__ float fast_silu(float v) { return v * __builtin_amdgcn_rcpf(1.f + __expf(-v)); }

namespace pg8 {
constexpr int BM = 256, BK = 64, HALF = 128, HTB = HALF * BK * 2  , STAGE_BYTES = 8 * HTB, NXCD = 8, WGM = 8;
__host__ __device__ __forceinline__ int lds_byte(int r, int c) { const int st = (r >> 4) * 2 + (c >> 5), rr = r & 15, cc = c & 31, ob = rr * 64 + cc * 2; return st * 1024 + (ob ^ (((ob >> 9) & 1) << 5)); }
__host__ __device__ __forceinline__ void stage_rc(int b, int& R_, int& C_) { const int st = b / 1024, sb = b % 1024, swz = sb ^ (((sb >> 9) & 1) << 5); R_ = (st >> 1) * 16 + swz / 64; C_ = (st & 1) * 32 + (swz % 64) / 2; }
__host__ __device__ __forceinline__ int perm32(int rho) { const int n = rho >> 4, i = rho & 15; return 8 * (i >> 2) + 4 * n + (i & 3); }

struct Unit { int arow, brow, pm, pn, rend; };
struct Gemm { const bf16_t* A; const bf16_t* Bt; int lda, ldb, K; };

struct DenseOrder {
    int nM, nN, nwg, G, c;
    __device__ void init(int nM_, int nN_, int G_, int c_) { nM = nM_; nN = nN_; nwg = nM * nN; G = G_; c = c_; }
    __device__ bool next(int i, Unit& u) const {
        const long L = (long)i * G + c; if (L >= nwg) return false;
        int wgid = (int)L; { const int q = nwg / NXCD, r = nwg % NXCD, xcd = wgid % NXCD, off = wgid / NXCD; wgid = (xcd < r ? xcd * (q + 1) : r * (q + 1) + (xcd - r) * q) + off; }
        const int nig = WGM * nN, gid = wgid / nig, fm = gid * WGM, gsz = (nM - fm) < WGM ? (nM - fm) : WGM;
        u.pm = fm + ((wgid % nig) % gsz); u.pn = (wgid % nig) / gsz; u.arow = u.pm * BM; u.brow = u.pn * BM; u.rend = 0x7fffffff; return true;
    }
    __device__ __forceinline__ void a_ready(const Unit&) const {}
    __device__ __forceinline__ void done(const Unit&) const {}
};
struct MoeOrder {
    const LAS int* meta; int nN, G, c, nwg;
    __device__ void init(const LAS int* meta_, int nN_, int G_, int c_) { meta = meta_; nN = nN_; G = G_; c = c_; int s = 0;
#pragma unroll
        for (int e = 0; e < 8; ++e) s += ((meta[8 + e] + 255) >> 8) * nN; nwg = __builtin_amdgcn_readfirstlane(s); }
    __device__ bool next(int i, Unit& u) const {
        const int L = i * G + c; if (L >= nwg) return false;
        int wgid = L; { const int q = nwg / NXCD, r = nwg % NXCD, xcd = wgid % NXCD, off = wgid / NXCD; wgid = (xcd < r ? xcd * (q + 1) : r * (q + 1) + (xcd - r) * q) + off; }
        int e = -1, nM = 1, base = 0, cnt = 0;
#pragma unroll
        for (int k = 0; k < 8; ++k) { const int ck = meta[8 + k], tk = (ck + 255) >> 8, uk = tk * nN; if (e < 0) { if (wgid < uk) { e = k; nM = tk; base = meta[k]; cnt = ck; } else wgid -= uk; } }
        if (e < 0) return false;
        const int nig = WGM * nN, gid = wgid / nig, fm = gid * WGM, gsz = (nM - fm) < WGM ? (nM - fm) : WGM;
        const int pm_ = fm + ((wgid % nig) % gsz), pn_ = (wgid % nig) / gsz;
        u.pm = __builtin_amdgcn_readfirstlane(pm_); u.pn = __builtin_amdgcn_readfirstlane(pn_); u.arow = __builtin_amdgcn_readfirstlane(base + pm_ * BM); u.brow = __builtin_amdgcn_readfirstlane((e * nN + pn_) * BM); u.rend = __builtin_amdgcn_readfirstlane(base + cnt); return true;
    }
    __device__ __forceinline__ void a_ready(const Unit&) const {}
    __device__ __forceinline__ void done(const Unit&) const {}
};

#define EPI_ROWS(...) _Pragma("unroll") for (int ai = 0; ai < 2; ++ai) _Pragma("unroll") for (int m = 0; m < 4; ++m) { const int row = u.arow + ai * HALF + wr * 64 + m * 16 + fr; __VA_ARGS__ }
__device__ __forceinline__ u32x4 pack8(const f32x4 a, const f32x4 b) { u32x4 w; w.x = cvt_pk_bf16(a[0], a[1]); w.y = cvt_pk_bf16(a[2], a[3]); w.z = cvt_pk_bf16(b[0], b[1]); w.w = cvt_pk_bf16(b[2], b[3]); return w; }

struct EpiPlain {
    static constexpr bool PERM = true, AFTER_DRAIN = false;
    bf16_t* O; int ldc;
    __device__ __forceinline__ void operator()(const f32x4 (&acc)[2][2][4][2], const Unit& u, int wr, int wc, int fr, int fq) const {
        const int col0 = u.pn * BM + wc * 32 + fq * 8;
        EPI_ROWS( if (row < u.rend) { bf16_t* rowp = O + (size_t)row * ldc + col0;
            _Pragma("unroll") for (int bj = 0; bj < 2; ++bj) *(u32x4*)(rowp + bj * HALF) = pack8(acc[ai][bj][m][0], acc[ai][bj][m][1]); } )
    }
};
struct EpiSwiglu {
    static constexpr bool PERM = true, AFTER_DRAIN = false;
    bf16_t* O;
    __device__ __forceinline__ void operator()(const f32x4 (&acc)[2][2][4][2], const Unit& u, int wr, int wc, int fr, int fq) const {
        const int col0 = u.pn * HALF + wc * 32 + fq * 8;
        EPI_ROWS( if (row < u.rend) { f32x4 o0, o1;
            _Pragma("unroll") for (int i = 0; i < 4; ++i) { o0[i] = fast_silu(acc[ai][0][m][0][i]) * acc[ai][1][m][0][i]; o1[i] = fast_silu(acc[ai][0][m][1][i]) * acc[ai][1][m][1][i]; }
            *(u32x4*)(O + (size_t)row * FFN + col0) = pack8(o0, o1); } )
    }
};
struct EpiSwiglu8 {
    static constexpr bool PERM = true, AFTER_DRAIN = false;
    unsigned char* O; float sc;
    __device__ __forceinline__ void operator()(const f32x4 (&acc)[2][2][4][2], const Unit& u, int wr, int wc, int fr, int fq) const {
        const int col0 = u.pn * HALF + wc * 32 + fq * 8;
        EPI_ROWS( if (row < u.rend) { float o[8];
            _Pragma("unroll") for (int i = 0; i < 4; ++i) { o[i] = clamp448(fast_silu(acc[ai][0][m][0][i] * sc) * (acc[ai][1][m][0][i] * sc)); o[4 + i] = clamp448(fast_silu(acc[ai][0][m][1][i] * sc) * (acc[ai][1][m][1][i] * sc)); }
            *(u32x2*)(O + (size_t)row * FFN + col0) = (u32x2){pack4_fp8(o[0], o[1], o[2], o[3]), pack4_fp8(o[4], o[5], o[6], o[7])}; } )
    }
};
struct EpiPlainS {
    static constexpr bool PERM = true, AFTER_DRAIN = false;
    bf16_t* O; int ldc; float sc;
    __device__ __forceinline__ void operator()(const f32x4 (&acc)[2][2][4][2], const Unit& u, int wr, int wc, int fr, int fq) const {
        const int col0 = u.pn * BM + wc * 32 + fq * 8;
        EPI_ROWS( if (row < u.rend) { bf16_t* rowp = O + (size_t)row * ldc + col0;
            _Pragma("unroll") for (int bj = 0; bj < 2; ++bj) *(u32x4*)(rowp + bj * HALF) = pack8(acc[ai][bj][m][0] * sc, acc[ai][bj][m][1] * sc); } )
    }
};
struct EpiMix {
    static constexpr bool PERM = true, AFTER_DRAIN = false;
    bf16_t* G0; const float* rc; const float* rs; const float* lb;
    __device__ __forceinline__ void operator()(const f32x4 (&acc)[2][2][4][2], const Unit& u, int wr, int wc, int fr, int fq) const {
        const int grp = u.pn >> 1, half = u.pn & 1; bf16_t* Gp = G0 + (size_t)grp * (GSZ / 2);
        if (grp <= 1) {
            const int head = half * 2 + (wc >> 1), jb = (wc & 1) * 32 + fq * 8; const float sc = grp == 1 ? 0.08838834764831845f : 1.f;
            float frv[8];
#pragma unroll
            for (int i = 0; i < 8; ++i) frv[i] = __builtin_amdgcn_exp2f(-(float)((jb + i) & 31) * 0.41524101186092029f) * 0.15915494309189535f;
            EPI_ROWS( f32x4 a0 = acc[ai][0][m][0] * sc, a1 = acc[ai][0][m][1] * sc, b0 = acc[ai][1][m][0] * sc, b1 = acc[ai][1][m][1] * sc; f32x4 o0, o1, p0, p1;
                if (row < RL) { const int t = row & 4095; const float pos = (float)(jb < 32 ? (t >> 6) : (t & 63)); f32x4 c0, c1, s0, s1;
                    _Pragma("unroll") for (int i = 0; i < 4; ++i) { const float r0 = __builtin_amdgcn_fractf(pos * frv[i]), r1 = __builtin_amdgcn_fractf(pos * frv[4 + i]);
                        c0[i] = __builtin_amdgcn_cosf(r0); s0[i] = __builtin_amdgcn_sinf(r0); c1[i] = __builtin_amdgcn_cosf(r1); s1[i] = __builtin_amdgcn_sinf(r1); }
                    o0 = a0 * c0 - b0 * s0; o1 = a1 * c1 - b1 * s1; p0 = a0 * s0 + b0 * c0; p1 = a1 * s1 + b1 * c1; }
                else { o0 = a0; o1 = a1; p0 = b0; p1 = b1; }
                bf16_t* dst = Gp + (size_t)row * 512 + head * 128 + jb; __builtin_nontemporal_store(pack8(o0, o1), (u32x4*)dst); __builtin_nontemporal_store(pack8(p0, p1), (u32x4*)(dst + 64)); )
        } else {
            const int cb = half * 256 + wc * 32 + fq * 8;
            EPI_ROWS( _Pragma("unroll") for (int bj = 0; bj < 2; ++bj) { f32x4 v0 = acc[ai][bj][m][0], v1 = acc[ai][bj][m][1]; const int c = cb + bj * HALF;
                if (grp == 3 || grp == 4 || grp == 8) { _Pragma("unroll") for (int i = 0; i < 4; ++i) { v0[i] = fast_silu(v0[i]); v1[i] = fast_silu(v1[i]); } }
                else if (grp == 5 || grp == 6) { const f32x4 l0 = *(const f32x4*)(lb + c), l1 = *(const f32x4*)(lb + c + 4);
                    _Pragma("unroll") for (int i = 0; i < 4; ++i) { v0[i] = (1.f - l0[i]) * __builtin_amdgcn_rcpf(1.f + __expf(v0[i])); v1[i] = (1.f - l1[i]) * __builtin_amdgcn_rcpf(1.f + __expf(v1[i])); } }
                __builtin_nontemporal_store(pack8(v0, v1), (u32x4*)(Gp + (size_t)row * 512 + c)); } )
        }
    }
};
struct EpiUQ {
    static constexpr bool PERM = true, AFTER_DRAIN = false;
    bf16_t* QN; bf16_t* QR; const float* mc; const float* ms;
    __device__ __forceinline__ void operator()(const f32x4 (&acc)[2][2][4][2], const Unit& u, int wr, int wc, int fr, int fq) const {
        if (u.pn < 4) {
            EPI_ROWS( const int b = row >> 12, t = row & 4095;
                _Pragma("unroll") for (int bj = 0; bj < 2; ++bj) { const int h = 2 * u.pn + bj; *(u32x4*)(QN + (((size_t)b * 8 + h) * T + t) * 128 + wc * 32 + fq * 8) = pack8(acc[ai][bj][m][0], acc[ai][bj][m][1]); } )
        } else {
            const int h = 4 * (u.pn - 4) + wc, jb = fq * 8;
            float frv[8];
#pragma unroll
            for (int i = 0; i < 8; ++i) frv[i] = __builtin_amdgcn_exp2f(-(float)((jb + i) & 15) * 0.83048202372184059f) * 0.15915494309189535f;
            EPI_ROWS( const int b = row >> 12, t = row & 4095; const f32x4 a0 = acc[ai][0][m][0], a1 = acc[ai][0][m][1], b0 = acc[ai][1][m][0], b1 = acc[ai][1][m][1];
                const float pos = (float)(jb < 16 ? (t >> 6) : (t & 63)); f32x4 c0, c1, s0, s1;
                _Pragma("unroll") for (int i = 0; i < 4; ++i) { const float r0 = __builtin_amdgcn_fractf(pos * frv[i]), r1 = __builtin_amdgcn_fractf(pos * frv[4 + i]);
                    c0[i] = __builtin_amdgcn_cosf(r0); s0[i] = __builtin_amdgcn_sinf(r0); c1[i] = __builtin_amdgcn_cosf(r1); s1[i] = __builtin_amdgcn_sinf(r1); }
                bf16_t* dst = QR + (((size_t)b * 8 + h) * T + t) * 64 + jb; *(u32x4*)dst = pack8(a0 * c0 - b0 * s0, a1 * c1 - b1 * s1); *(u32x4*)(dst + 32) = pack8(a0 * s0 + b0 * c0, a1 * s1 + b1 * c1); )
        }
    }
};
struct EpiUKV {
    static constexpr bool PERM = true, AFTER_DRAIN = false;
    bf16_t* KN; bf16_t* V;
    __device__ __forceinline__ void operator()(const f32x4 (&acc)[2][2][4][2], const Unit& u, int wr, int wc, int fr, int fq) const {
        EPI_ROWS( const bool lat = row < RL; const int b = lat ? (row >> 12) : ((row - RL) >> 8); const int key = lat ? CT + (row & 4095) : ((row - RL) & 255);
            const size_t off = (((size_t)b * 8 + u.pn) * KEYS + key) * 128 + wc * 32 + fq * 8;
            *(u32x4*)(KN + off) = pack8(acc[ai][0][m][0], acc[ai][0][m][1]); *(u32x4*)(V + off) = pack8(acc[ai][1][m][0], acc[ai][1][m][1]); )
    }
};

template <class Epi, class Sched, bool ALIGN_EPI, bool FP8 = false>
__device__ __forceinline__ void gemm_phase(LAS unsigned char* lds, const Gemm g, const Sched& S, const Epi& E, const int wv) {
    const int tid = tidx(wv), wid = __builtin_amdgcn_readfirstlane(tid >> 6), lane = tid & 63, wr = wid >> 2, wc = wid & 3, fr = lane & 15, fq = lane >> 4;
    const int K = g.K, nt = K / BK;
    unsigned voffA[2], voffB[2];
#pragma unroll
    for (int i = 0; i < 2; ++i) { int R_, C_; stage_rc(tid * 16 + i * 8192, R_, C_); const int Rb = Epi::PERM ? ((R_ & ~31) + perm32(R_ & 31)) : R_;
        voffA[i] = (unsigned)(R_ * g.lda + C_) * 2u; voffB[i] = (unsigned)(Rb * g.ldb + C_) * 2u; }
    const size_t kstep = (size_t)(BK * 2);
    const size_t hstepA = (size_t)HALF * g.lda * 2, hstepB = (size_t)HALF * g.ldb * 2;
    const unsigned ldsw = (unsigned)wid * 1024u;
    const int aoff = lds_byte(wr * 64 + fr, fq * 8), boff = lds_byte(wc * 32 + fr, fq * 8);
#define PG8_SA(b, h) (((b) * 2 + (h)) * HTB)
#define PG8_SB(b, h) ((4 + (b) * 2 + (h)) * HTB)
#define PG8_STAGE(bufoff, gbase, voff) do { _Pragma("unroll") for (int _i = 0; _i < 2; ++_i) { unsigned _vo = (voff)[_i]; asm volatile("" : "+v"(_vo));     \
        __builtin_amdgcn_global_load_lds((const unsigned*)((const char*)(gbase) + _vo), (LAS unsigned*)(lds + (bufoff) + ldsw + _i * 8192), 16, 0, 0); } } while (0)
#define PG8_LDA(dst, b, h) do { _Pragma("unroll") for (int m = 0; m < 4; ++m) { if constexpr (FP8) dst##8[m] = __builtin_shufflevector(*(const LAS v4i_t*)(lds + PG8_SA(b, h) + aoff + m * 2048), *(const LAS v4i_t*)(lds + PG8_SA(b, h) + aoff + m * 2048 + 1024), 0, 1, 2, 3, 4, 5, 6, 7); \
        else { _Pragma("unroll") for (int k = 0; k < 2; ++k) dst[m][k] = *(const LAS bf16x8*)(lds + PG8_SA(b, h) + aoff + m * 2048 + k * 1024); } } } while (0)
#define PG8_LDB(dst, b, h) do { _Pragma("unroll") for (int n = 0; n < 2; ++n) { if constexpr (FP8) dst##8[n] = __builtin_shufflevector(*(const LAS v4i_t*)(lds + PG8_SB(b, h) + boff + n * 2048), *(const LAS v4i_t*)(lds + PG8_SB(b, h) + boff + n * 2048 + 1024), 0, 1, 2, 3, 4, 5, 6, 7); \
        else { _Pragma("unroll") for (int k = 0; k < 2; ++k) dst[n][k] = *(const LAS bf16x8*)(lds + PG8_SB(b, h) + boff + n * 2048 + k * 1024); } } } while (0)
#define PG8_MMA(ai, bj, At, Bt) do { __builtin_amdgcn_s_setprio(1); _Pragma("unroll") for (int m = 0; m < 4; ++m) _Pragma("unroll") for (int n = 0; n < 2; ++n) { \
        if constexpr (FP8) { acc[ai][bj][m][n] = __builtin_amdgcn_mfma_scale_f32_16x16x128_f8f6f4(Bt##8[n], At##8[m], acc[ai][bj][m][n], 0, 0, 0, 0x7f7f7f7f, 0, 0x7f7f7f7f); } \
        else { _Pragma("unroll") for (int k = 0; k < 2; ++k) acc[ai][bj][m][n] = __builtin_amdgcn_mfma_f32_16x16x32_bf16(Bt[n][k], At[m][k], acc[ai][bj][m][n], 0, 0, 0); } } \
        __builtin_amdgcn_s_setprio(0); } while (0)
#define PG8_WAIT_V(n) asm volatile("s_waitcnt vmcnt(" #n ")" ::: "memory")
#define PG8_WAIT_L(n) asm volatile("s_waitcnt lgkmcnt(" #n ")" ::: "memory")
#define PG8_BAR __builtin_amdgcn_s_barrier()
#define PG8_SCHED __builtin_amdgcn_sched_barrier(0)
    Unit cur, nxt; int ui = 0;
    if (!S.next(0, cur)) return;
    f32x4 acc[2][2][4][2];
#pragma unroll
    for (int a = 0; a < 2; ++a)
#pragma unroll
        for (int b = 0; b < 2; ++b)
#pragma unroll
            for (int m = 0; m < 4; ++m)
#pragma unroll
                for (int n = 0; n < 2; ++n) acc[a][b][m][n] = (f32x4){0.f, 0.f, 0.f, 0.f};
    bf16x8 At[4][2], B0[2][2], B1[2][2]; v8i_t At8[4], B08[2], B18[2];
    const char* cA = (const char*)g.A + (size_t)cur.arow * g.lda * 2; const char* cB = (const char*)g.Bt + (size_t)cur.brow * g.ldb * 2;
    S.a_ready(cur);
    PG8_STAGE(PG8_SB(0, 0), cB, voffB); PG8_STAGE(PG8_SB(0, 1), cB + hstepB, voffB); PG8_STAGE(PG8_SA(0, 0), cA, voffA); PG8_STAGE(PG8_SA(0, 1), cA + hstepA, voffA);
    if (wr == 1) PG8_BAR;
    PG8_WAIT_V(2); PG8_BAR;
    PG8_STAGE(PG8_SB(1, 0), cB + kstep, voffB); PG8_STAGE(PG8_SA(1, 0), cA + kstep, voffA); PG8_STAGE(PG8_SB(1, 1), cB + hstepB + kstep, voffB);
    PG8_WAIT_V(6); PG8_BAR;
    for (;;) {
        const bool has_next = S.next(ui + 1, nxt);
        const char* nA = has_next ? (const char*)g.A + (size_t)nxt.arow * g.lda * 2 : cA; const char* nB = has_next ? (const char*)g.Bt + (size_t)nxt.brow * g.ldb * 2 : cB;
#pragma unroll 1
        for (int t = 0; t < nt; t += 2) {
            const bool last = (t == nt - 2);
            const char* a1 = cA + (size_t)(t + 1) * kstep;
            const char* a2 = last ? nA : cA + (size_t)(t + 2) * kstep; const char* b2 = last ? nB : cB + (size_t)(t + 2) * kstep;
            const char* a3 = a2 + kstep; const char* b3 = b2 + kstep;
            if (last && has_next) S.a_ready(nxt);
            PG8_LDB(B0, 0, 0); PG8_LDB(B1, 0, 1); PG8_SCHED; PG8_LDA(At, 0, 0); PG8_STAGE(PG8_SA(1, 1), a1 + hstepA, voffA);
            PG8_WAIT_V(8); PG8_WAIT_L(0); PG8_BAR; PG8_MMA(0, 0, At, B0); PG8_MMA(0, 1, At, B1); PG8_BAR; PG8_SCHED;
            PG8_LDA(At, 0, 1); PG8_STAGE(PG8_SB(0, 0), b2, voffB); PG8_STAGE(PG8_SB(0, 1), b2 + hstepB, voffB); PG8_STAGE(PG8_SA(0, 0), a2, voffA);
            PG8_WAIT_V(8); PG8_WAIT_L(0); PG8_BAR; PG8_MMA(1, 0, At, B0); PG8_MMA(1, 1, At, B1); PG8_BAR; PG8_SCHED;
            PG8_LDB(B0, 1, 0); PG8_LDB(B1, 1, 1); PG8_SCHED; PG8_LDA(At, 1, 0); PG8_STAGE(PG8_SA(0, 1), a2 + hstepA, voffA);
            PG8_WAIT_V(8); PG8_WAIT_L(0); PG8_BAR; PG8_MMA(0, 0, At, B0); PG8_MMA(0, 1, At, B1); PG8_BAR; PG8_SCHED;
            PG8_LDA(At, 1, 1); PG8_STAGE(PG8_SB(1, 0), b3, voffB); PG8_STAGE(PG8_SB(1, 1), b3 + hstepB, voffB); PG8_STAGE(PG8_SA(1, 0), a3, voffA);
            PG8_WAIT_V(8); PG8_WAIT_L(0); PG8_BAR; PG8_MMA(1, 0, At, B0); PG8_MMA(1, 1, At, B1); PG8_BAR; PG8_SCHED;
        }
        if constexpr (ALIGN_EPI) { if (wr == 0) PG8_BAR; }
        { const int l2_ = tidx(wv) & 63; E(acc, cur, wr, wc, l2_ & 15, l2_ >> 4); } S.done(cur);
        if (!has_next) break;
#pragma unroll
        for (int a = 0; a < 2; ++a)
#pragma unroll
            for (int b = 0; b < 2; ++b)
#pragma unroll
                for (int m = 0; m < 4; ++m)
#pragma unroll
                    for (int n = 0; n < 2; ++n) acc[a][b][m][n] = (f32x4){0.f, 0.f, 0.f, 0.f};
        cur = nxt; cA = nA; cB = nB; ++ui;
        if constexpr (ALIGN_EPI) { if (wr == 1) PG8_BAR; }
    }
    PG8_WAIT_V(0);
    if constexpr (!ALIGN_EPI) { if (wr == 0) PG8_BAR; }
    PG8_BAR;
#undef PG8_SA
#undef PG8_SB
#undef PG8_STAGE
#undef PG8_LDA
#undef PG8_LDB
#undef PG8_MMA
#undef PG8_WAIT_V
#undef PG8_WAIT_L
#undef PG8_BAR
#undef PG8_SCHED
}
}


namespace attn {
using s16x4 = __attribute__((ext_vector_type(4))) short;
using f32x16 = __attribute__((ext_vector_type(16))) float;
constexpr int NW = 8, QBLK = 32, KVBLK = 64;
constexpr float SCALE = 0.07216878364870322f;
constexpr float THR = 8.f;
constexpr int SHM_V = KVBLK * 128 * 2, SHM_K = KVBLK * 128 * 2, SHM_R = KVBLK * 64 * 2, NBUF = 3;
constexpr int OFF_V = 0, OFF_K = NBUF * SHM_V, OFF_R = OFF_K + NBUF * SHM_K, OFF_W = OFF_R + NBUF * SHM_R, LDS_NEED = OFF_W + NW * 64 * 4;
#define KSWZ(row, colB) ((row) * 256 + ((colB) ^ (((row) & 7) << 4)))
#define RSWZ(row, colB) ((row) * 128 + ((colB) ^ ((((row) >> 1) & 7) << 4)))
#define SBAR() __builtin_amdgcn_sched_barrier(0)
__device__ __forceinline__ int crow(int r, int hi) { return (r & 3) + 8 * (r >> 2) + 4 * hi; }
__device__ __forceinline__ unsigned cvtpk(float lo, float hi) { return cvt_pk_bf16(lo, hi); }

__device__ __forceinline__ void partialSM(f32x16& p0, f32x16& p1, float& m_reg, float& mn, float& alpha) {
    constexpr float C = SCALE * 1.4426950408889634f;
    float pmax = p0[0];
#pragma unroll
    for (int r = 1; r < 16; ++r) pmax = fmaxf(pmax, p0[r]);
#pragma unroll
    for (int r = 0; r < 16; ++r) pmax = fmaxf(pmax, p1[r]);
    { auto rr = __builtin_amdgcn_permlane32_swap(__float_as_uint(pmax), __float_as_uint(pmax), false, false);
      pmax = fmaxf(__uint_as_float(rr[0]), __uint_as_float(rr[1])); }
    if (__builtin_expect(__all(pmax - m_reg <= THR / SCALE), 1)) { mn = m_reg; alpha = 1.f; }
    else { mn = fmaxf(m_reg, pmax); alpha = __builtin_amdgcn_exp2f((m_reg - mn) * C); m_reg = mn; }
    const float mnC = -mn * C;
#pragma unroll
    for (int r = 0; r < 16; ++r) p0[r] = fmaf(p0[r], C, mnC);
#pragma unroll
    for (int r = 0; r < 16; ++r) p1[r] = fmaf(p1[r], C, mnC);
#pragma unroll
    for (int r = 0; r < 16; ++r) p0[r] = __builtin_amdgcn_exp2f(p0[r]);
}
__device__ __forceinline__ void finishSM(f32x16& p0, f32x16& p1, float alpha, float& l_reg, bf16x8& pa0, bf16x8& pa1, bf16x8& pa2, bf16x8& pa3) {
#pragma unroll
    for (int r = 0; r < 16; ++r) p1[r] = __builtin_amdgcn_exp2f(p1[r]);
    float ps = 0;
#pragma unroll
    for (int r = 0; r < 16; ++r) ps += p0[r];
#pragma unroll
    for (int r = 0; r < 16; ++r) ps += p1[r];
    { auto rr = __builtin_amdgcn_permlane32_swap(__float_as_uint(ps), __float_as_uint(ps), false, false);
      ps = __uint_as_float(rr[0]) + __uint_as_float(rr[1]); }
    l_reg = l_reg * alpha + ps;
#define PK4(P, BASE, OUT) do { unsigned a0 = cvtpk(P[BASE + 0], P[BASE + 1]), a1 = cvtpk(P[BASE + 2], P[BASE + 3]);   \
    unsigned b0 = cvtpk(P[BASE + 4], P[BASE + 5]), b1 = cvtpk(P[BASE + 6], P[BASE + 7]);                              \
    auto r0 = __builtin_amdgcn_permlane32_swap(a0, b0, false, false); auto r1 = __builtin_amdgcn_permlane32_swap(a1, b1, false, false); \
    u32x4 w = {r0[0], r1[0], r0[1], r1[1]}; OUT = *reinterpret_cast<bf16x8*>(&w); } while (0)
    PK4(p0, 0, pa0); PK4(p0, 8, pa1); PK4(p1, 0, pa2); PK4(p1, 8, pa3);
#undef PK4
}
__device__ __forceinline__ void qkt(f32x16& p0, f32x16& p1, const LAS char* Ks, const LAS char* Rs, const bf16x8* qr, const bf16x8* qrr, int r32, int hi) {
    p0 = f32x16{}; p1 = f32x16{};
#pragma unroll
    for (int d0 = 0; d0 < 8; ++d0) { const int cb = (d0 * 16 + hi * 8) * 2;
        const bf16x8 b0 = *reinterpret_cast<const LAS bf16x8*>(Ks + KSWZ(r32, cb));
        const bf16x8 b1 = *reinterpret_cast<const LAS bf16x8*>(Ks + KSWZ(32 + r32, cb));
        p0 = __builtin_amdgcn_mfma_f32_32x32x16_bf16(b0, qr[d0], p0, 0, 0, 0);
        p1 = __builtin_amdgcn_mfma_f32_32x32x16_bf16(b1, qr[d0], p1, 0, 0, 0); if ((d0 & 3) == 3) SBAR(); }
#pragma unroll
    for (int d0 = 0; d0 < 4; ++d0) { const int cb = (d0 * 16 + hi * 8) * 2;
        const bf16x8 b0 = *reinterpret_cast<const LAS bf16x8*>(Rs + RSWZ(r32, cb));
        const bf16x8 b1 = *reinterpret_cast<const LAS bf16x8*>(Rs + RSWZ(32 + r32, cb));
        p0 = __builtin_amdgcn_mfma_f32_32x32x16_bf16(b0, qrr[d0], p0, 0, 0, 0);
        p1 = __builtin_amdgcn_mfma_f32_32x32x16_bf16(b1, qrr[d0], p1, 0, 0, 0); }
}
__device__ __forceinline__ int v_st(int k, int c) { const int kk = (k & ~0xC) | ((k & 4) << 1) | ((k & 8) >> 1); return ((kk >> 3) * 4 + (c >> 5)) * 512 + ((kk & 7) * 32 + (c & 31)) * 2; }
__device__ __forceinline__ int v_rd_base(int lane) { return ((lane & 3) << 3) | (((lane >> 2) & 3) << 6) | (((lane >> 4) & 1) << 5) | (((lane >> 5) & 1) << 8); }
constexpr int v_rd_off(int d0, int ks, int half) { return d0 * 512 + ks * 4096 + half * 2048; }
template <int OFF> __device__ __forceinline__ s16x4 tr_read(int vb) {
    s16x4 r; asm volatile("ds_read_b64_tr_b16 %0, %1 offset:%2" : "=&v"(r) : "v"(vb), "i"(OFF) : "memory"); return r;
}
template <int D0> __device__ __forceinline__ void pv_one(f32x16& od, int vb, bf16x8 pa0, bf16x8 pa1, bf16x8 pa2, bf16x8 pa3) {
    const s16x4 l0 = tr_read<v_rd_off(D0, 0, 0)>(vb), h0 = tr_read<v_rd_off(D0, 0, 1)>(vb), l1 = tr_read<v_rd_off(D0, 1, 0)>(vb), h1 = tr_read<v_rd_off(D0, 1, 1)>(vb);
    const s16x4 l2 = tr_read<v_rd_off(D0, 2, 0)>(vb), h2 = tr_read<v_rd_off(D0, 2, 1)>(vb), l3 = tr_read<v_rd_off(D0, 3, 0)>(vb), h3 = tr_read<v_rd_off(D0, 3, 1)>(vb);
    asm volatile("s_waitcnt lgkmcnt(0)" ::: "memory"); SBAR();
#define PK(L, H) (bf16x8){L[0], L[1], L[2], L[3], H[0], H[1], H[2], H[3]}
    od = __builtin_amdgcn_mfma_f32_32x32x16_bf16(pa0, PK(l0, h0), od, 0, 0, 0);
    od = __builtin_amdgcn_mfma_f32_32x32x16_bf16(pa1, PK(l1, h1), od, 0, 0, 0);
    od = __builtin_amdgcn_mfma_f32_32x32x16_bf16(pa2, PK(l2, h2), od, 0, 0, 0);
    od = __builtin_amdgcn_mfma_f32_32x32x16_bf16(pa3, PK(l3, h3), od, 0, 0, 0);
#undef PK
}
__device__ __forceinline__ void pv_d0(f32x16* o, int vb, bf16x8 pa0, bf16x8 pa1, bf16x8 pa2, bf16x8 pa3) {
    pv_one<0>(o[0], vb, pa0, pa1, pa2, pa3); pv_one<1>(o[1], vb, pa0, pa1, pa2, pa3); pv_one<2>(o[2], vb, pa0, pa1, pa2, pa3); pv_one<3>(o[3], vb, pa0, pa1, pa2, pa3);
}

#define ATR(OFF) tr_read<(OFF)>(vb)
#define AWAIT(n) do { asm volatile("s_waitcnt lgkmcnt(" #n ")" ::: "memory"); SBAR(); } while (0)
#define APK(L, H) (bf16x8){L[0], L[1], L[2], L[3], H[0], H[1], H[2], H[3]}
#define AVLOAD(D0, X) do { X[0] = ATR(v_rd_off(D0, 0, 0)); X[1] = ATR(v_rd_off(D0, 0, 1)); X[2] = ATR(v_rd_off(D0, 1, 0)); X[3] = ATR(v_rd_off(D0, 1, 1)); \
    X[4] = ATR(v_rd_off(D0, 2, 0)); X[5] = ATR(v_rd_off(D0, 2, 1)); X[6] = ATR(v_rd_off(D0, 3, 0)); X[7] = ATR(v_rd_off(D0, 3, 1)); } while (0)
#define AVMMA(OD, X) do { OD = __builtin_amdgcn_mfma_f32_32x32x16_bf16(APK(X[0], X[1]), pa0, OD, 0, 0, 0); OD = __builtin_amdgcn_mfma_f32_32x32x16_bf16(APK(X[2], X[3]), pa1, OD, 0, 0, 0); \
    OD = __builtin_amdgcn_mfma_f32_32x32x16_bf16(APK(X[4], X[5]), pa2, OD, 0, 0, 0); OD = __builtin_amdgcn_mfma_f32_32x32x16_bf16(APK(X[6], X[7]), pa3, OD, 0, 0, 0); SBAR(); } while (0)
#define AKLOAD(i) do { if ((i) < 8) { const int cb = ((i) * 16 + hi * 8) * 2; kb0[(i) & 7] = *reinterpret_cast<const LAS bf16x8*>(Ks + KSWZ(r32, cb)); kb1[(i) & 7] = *reinterpret_cast<const LAS bf16x8*>(Ks + KSWZ(32 + r32, cb)); } \
    else { const int cb = (((i) - 8) * 16 + hi * 8) * 2; kb0[(i) & 7] = *reinterpret_cast<const LAS bf16x8*>(Rs + RSWZ(r32, cb)); kb1[(i) & 7] = *reinterpret_cast<const LAS bf16x8*>(Rs + RSWZ(32 + r32, cb)); } } while (0)
template <bool HAS_PV, bool HAS_QK>
__device__ __forceinline__ void mphase(f32x16& p0, f32x16& p1, f32x16* o, const LAS char* Ks, const LAS char* Rs, int vb, const bf16x8* qr, const bf16x8* qrr,
                                       bf16x8 pa0, bf16x8 pa1, bf16x8 pa2, bf16x8 pa3, int r32, int hi) {
    bf16x8 kb0[8], kb1[8]; s16x4 va[8], vc[8], vd[8];
    __builtin_amdgcn_s_setprio(1);
    if constexpr (HAS_PV) {
        AVLOAD(0, va); AVLOAD(1, vc); AVLOAD(2, vd);
        AWAIT(15); AVMMA(o[0], va); AVLOAD(3, va);
        AWAIT(15); AVMMA(o[1], vc);
        if constexpr (HAS_QK) { AKLOAD(0); AKLOAD(1); AKLOAD(2); AKLOAD(3); SBAR(); AWAIT(15); AVMMA(o[2], vd); AWAIT(8); AVMMA(o[3], va); }
        else { AWAIT(8); AVMMA(o[2], vd); AWAIT(0); AVMMA(o[3], va); }
    } else if constexpr (HAS_QK) { AKLOAD(0); AKLOAD(1); AKLOAD(2); AKLOAD(3); SBAR(); }
    if constexpr (HAS_QK) {
        p0 = f32x16{}; p1 = f32x16{};
#pragma unroll
        for (int i = 0; i < 12; ++i) { if (i + 4 < 12) AKLOAD(i + 4); SBAR();
            const bf16x8 qv = i < 8 ? qr[i < 8 ? i : 0] : qrr[i >= 8 ? i - 8 : 0];
            p0 = __builtin_amdgcn_mfma_f32_32x32x16_bf16(kb0[i & 7], qv, p0, 0, 0, 0); p1 = __builtin_amdgcn_mfma_f32_32x32x16_bf16(kb1[i & 7], qv, p1, 0, 0, 0); SBAR(); }
    }
    __builtin_amdgcn_s_setprio(0);
}
#undef ATR
#undef AWAIT
#undef APK
#undef AVLOAD
#undef AVMMA
#undef AKLOAD

__device__ __forceinline__ void attn_unit(const bf16_t* __restrict__ Qn, const bf16_t* __restrict__ Qr, const bf16_t* __restrict__ Kn, const bf16_t* __restrict__ Kr, const bf16_t* __restrict__ Vh,
                                          bf16_t* __restrict__ Ob, int seq, LAS char* lds, const int wv) {
    const int tid = tidx(wv), wid = tid >> 6, lane = tid & 63, r32 = lane & 31, hi = lane >> 5;
    const int grp = wv >> 2;
    LAS char* V_lds = lds + OFF_V; LAS char* K_lds = lds + OFF_K; LAS char* R_lds = lds + OFF_R;
    LAS float* wsl = (LAS float*)(lds + OFF_W) + wid * 64; LAS float* li_l = wsl; LAS float* al_l = wsl + 32;
    float m_reg = -1e30f, l_reg = 0; f32x16 o[4] = {}; bf16x8 qr[8], qrr[4];
    { unsigned qo = (unsigned)((wid * QBLK + r32) * 128 + hi * 8) * 2u, qo2 = (unsigned)((wid * QBLK + r32) * 64 + hi * 8) * 2u;
      asm volatile("" : "+v"(qo), "+v"(qo2));
#pragma unroll
      for (int d0 = 0; d0 < 8; ++d0) qr[d0] = *reinterpret_cast<const bf16x8*>((const char*)Qn + qo + d0 * 32);
#pragma unroll
      for (int d0 = 0; d0 < 4; ++d0) qrr[d0] = *reinterpret_cast<const bf16x8*>((const char*)Qr + qo2 + d0 * 32); }
    const int vb0 = (int)(unsigned)(uintptr_t)V_lds + v_rd_base(lane);
    const int t4 = tid & 255, sr = 32 * grp + (t4 >> 4), sc = (t4 & 15) * 8, rr_ = 32 * grp + (t4 >> 3), rc_ = (t4 & 7) * 8;
    const int vst0 = v_st(sr, sc), vst1 = v_st(sr + 16, sc), kst0 = KSWZ(sr, sc * 2), kst1 = KSWZ(sr + 16, sc * 2), rst0 = RSWZ(rr_, rc_ * 2);
    unsigned vo = (unsigned)(sr * 128 + sc) * 2u, ro = (unsigned)(rr_ * 64 + rc_) * 2u;
    asm volatile("" : "+v"(vo), "+v"(ro));
    bf16x8 vs0, vs1, ks0, ks1, rs0;
    const int NT = seq / KVBLK;
#define M3(x) ((x) >= 3 ? (x) - 3 : (x))
#define SLOADS(n) do { const int _k = (n) + 1 < NT ? (n) + 1 : NT - 1, _v = (n) < NT ? (n) : NT - 1; const char* kt = (const char*)Kn + (size_t)_k * (KVBLK * 256); const char* rt = (const char*)Kr + (size_t)_k * (KVBLK * 128); \
        const char* vt = (const char*)Vh + (size_t)_v * (KVBLK * 256); \
        ks0 = *reinterpret_cast<const bf16x8*>(kt + vo); ks1 = *reinterpret_cast<const bf16x8*>(kt + 4096 + vo); rs0 = *reinterpret_cast<const bf16x8*>(rt + ro); \
        vs0 = *reinterpret_cast<const bf16x8*>(vt + vo); vs1 = *reinterpret_cast<const bf16x8*>(vt + 4096 + vo); } while (0)
#define SWRITES(sk, sv) do { *(LAS bf16x8*)(K_lds + (sk) * SHM_K + kst0) = ks0; *(LAS bf16x8*)(K_lds + (sk) * SHM_K + kst1) = ks1; *(LAS bf16x8*)(R_lds + (sk) * SHM_R + rst0) = rs0; \
        *(LAS bf16x8*)(V_lds + (sv) * SHM_V + vst0) = vs0; *(LAS bf16x8*)(V_lds + (sv) * SHM_V + vst1) = vs1; } while (0)
#define SWAIT() asm volatile("s_waitcnt vmcnt(0)" ::: "memory")
#define RESC(a) do { if (__any((a) < 1.f)) { _Pragma("unroll") for (int d = 0; d < 4; ++d) _Pragma("unroll") for (int r = 0; r < 16; ++r) o[d][r] *= (a); } } while (0)
#define MBAR() do { SBAR(); asm volatile("s_waitcnt lgkmcnt(0)" ::: "memory"); __builtin_amdgcn_s_barrier(); SBAR(); } while (0)
#define SOFTMAX() do { partialSM(p0, p1, m_reg, mn, al); RESC(al); finishSM(p0, p1, al, l_reg, pa0, pa1, pa2, pa3); } while (0)
    f32x16 p0, p1; float mn, al; bf16x8 pa0, pa1, pa2, pa3;
    { ks0 = *reinterpret_cast<const bf16x8*>((const char*)Kn + vo); ks1 = *reinterpret_cast<const bf16x8*>((const char*)Kn + 4096 + vo); rs0 = *reinterpret_cast<const bf16x8*>((const char*)Kr + ro); SWAIT();
      *(LAS bf16x8*)(K_lds + kst0) = ks0; *(LAS bf16x8*)(K_lds + kst1) = ks1; *(LAS bf16x8*)(R_lds + rst0) = rs0; }
    __syncthreads();
    if (grp == 1) { SLOADS(0); SWAIT(); SWRITES(1, 0); __syncthreads(); }
    SLOADS(grp); SBAR();
    mphase<false, true>(p0, p1, o, K_lds, R_lds, 0, qr, qrr, pa0, pa1, pa2, pa3, r32, hi);
    MBAR();
    SOFTMAX(); SWAIT(); SWRITES(1 + grp, grp);
    __syncthreads();
    int s3 = 1;
#pragma unroll 1
    for (int j = 1; j < NT; ++j) {
        const int sv = M3(s3 + grp), sk = M3(sv + 1);
        SLOADS(j + grp); SBAR();
        mphase<true, true>(p0, p1, o, K_lds + s3 * SHM_K, R_lds + s3 * SHM_R, vb0 + M3(s3 + 2) * SHM_V, qr, qrr, pa0, pa1, pa2, pa3, r32, hi);
        MBAR();
        SOFTMAX(); SWAIT(); SWRITES(sk, sv);
        __syncthreads();
        s3 = M3(s3 + 1);
    }
    mphase<true, false>(p0, p1, o, K_lds, R_lds, vb0 + M3(s3 + 2) * SHM_V, qr, qrr, pa0, pa1, pa2, pa3, r32, hi);
    __syncthreads();
    if (grp == 0) __syncthreads();
#undef SOFTMAX
#undef MBAR
    { const float rl = __builtin_amdgcn_rcpf(l_reg);
      unsigned oo0 = (unsigned)((wid * QBLK + r32) * 1024 + 8 * hi) * 2u; asm volatile("" : "+v"(oo0));
#pragma unroll
      for (int d0 = 0; d0 < 4; ++d0)
#pragma unroll
          for (int p = 0; p < 2; ++p) {
              const unsigned a0 = cvtpk(o[d0][8 * p] * rl, o[d0][8 * p + 1] * rl), a1 = cvtpk(o[d0][8 * p + 2] * rl, o[d0][8 * p + 3] * rl);
              const unsigned b0 = cvtpk(o[d0][8 * p + 4] * rl, o[d0][8 * p + 5] * rl), b1 = cvtpk(o[d0][8 * p + 6] * rl, o[d0][8 * p + 7] * rl);
              auto r0 = __builtin_amdgcn_permlane32_swap(a0, b0, false, false); auto r1 = __builtin_amdgcn_permlane32_swap(a1, b1, false, false);
              const u32x4 w = {r0[0], r1[0], r0[1], r1[1]}; *(u32x4*)((char*)Ob + oo0 + (d0 * 32 + 16 * p) * 2) = w; } }
    __syncthreads();
#undef M3
#undef SLOADS
#undef SWRITES
#undef SWAIT
#undef RESC
}
}


namespace scan {
using attn::s16x4; using attn::f32x16; using attn::v_st; using attn::v_rd_base; using attn::crow; using attn::cvtpk;
constexpr int NCH = KEYS / 64;
constexpr size_t WS_STATE = 422 * MiB;
constexpr size_t WS_DEC = 694 * MiB;
__device__ __forceinline__ int seq_row(int b, int p) { return p < CT ? RL + b * CT + p : b * T + (p - CT); }
__device__ __forceinline__ s16x4 trr(int addr) { s16x4 r; asm volatile("ds_read_b64_tr_b16 %0, %1" : "=&v"(r) : "v"(addr) : "memory"); return r; }
template <int OFF> __device__ __forceinline__ s16x4 tri(int addr) { s16x4 r; asm volatile("ds_read_b64_tr_b16 %0, %1 offset:%2" : "=&v"(r) : "v"(addr), "i"(OFF) : "memory"); return r; }
#define SC_PK(L, H) (bf16x8){L[0], L[1], L[2], L[3], H[0], H[1], H[2], H[3]}
#define SC_LWAIT() do { asm volatile("s_waitcnt lgkmcnt(0)" ::: "memory"); __builtin_amdgcn_sched_barrier(0); } while (0)
__device__ __forceinline__ float2 bf2x(unsigned u) { return make_float2(bf2f((bf16_t)(u & 0xffffu)), bf2f((bf16_t)(u >> 16))); }

struct Prep {
    float2 kf[8], kb[8];
    float2 bf[8], cb[8];
    float2 totf, totb, reff, refb;
};
__device__ __forceinline__ void prep_decay(Prep& P, const unsigned (&rkf)[8], const unsigned (&rkb)[8], int a, float lgf, float lgb, LAS float* tot, int tid) {
    const int cp = tid & 63, tg = tid >> 6;
    float2 gf[8], gb[8];
#pragma unroll
    for (int i = 0; i < 8; ++i) {
        P.kf[i] = bf2x(rkf[i]); P.kb[i] = bf2x(rkb[i]);
        if (a) { gf[i] = make_float2(__logf(fmaxf(1.f - P.kf[i].x, 1e-30f)), __logf(fmaxf(1.f - P.kf[i].y, 1e-30f))); gb[i] = make_float2(__logf(fmaxf(1.f - P.kb[i].x, 1e-30f)), __logf(fmaxf(1.f - P.kb[i].y, 1e-30f))); }
        else { gf[i] = make_float2(lgf, lgf); gb[i] = make_float2(lgb, lgb); } }
    P.bf[0] = gf[0];
#pragma unroll
    for (int i = 1; i < 8; ++i) P.bf[i] = make_float2(P.bf[i - 1].x + gf[i].x, P.bf[i - 1].y + gf[i].y);
    P.cb[0] = gb[0];
#pragma unroll
    for (int i = 1; i < 8; ++i) P.cb[i] = make_float2(P.cb[i - 1].x + gb[i].x, P.cb[i - 1].y + gb[i].y);
    *(LAS f32x2*)(tot + (0 * 8 + tg) * 128 + 2 * cp) = (f32x2){P.bf[7].x, P.bf[7].y}; *(LAS f32x2*)(tot + (1 * 8 + tg) * 128 + 2 * cp) = (f32x2){P.cb[7].x, P.cb[7].y};
    __syncthreads();
    float2 offf = make_float2(0.f, 0.f), offb = make_float2(0.f, 0.f); P.totf = offf; P.totb = offf; P.reff = offf; P.refb = offf;
#pragma unroll
    for (int g = 0; g < 8; ++g) { const f32x2 tf = *(const LAS f32x2*)(tot + (0 * 8 + g) * 128 + 2 * cp), tb = *(const LAS f32x2*)(tot + (1 * 8 + g) * 128 + 2 * cp);
        P.totf.x += tf.x; P.totf.y += tf.y; P.totb.x += tb.x; P.totb.y += tb.y;
        if (g < 4) { P.reff.x += tf.x; P.reff.y += tf.y; } else { P.refb.x += tb.x; P.refb.y += tb.y; }
        if (g < tg) { offf.x += tf.x; offf.y += tf.y; offb.x += tb.x; offb.y += tb.y; } }
#pragma unroll
    for (int i = 0; i < 8; ++i) { P.bf[i].x += offf.x; P.bf[i].y += offf.y;
        P.cb[i].x = P.totb.x - (P.cb[i].x + offb.x) + gb[i].x; P.cb[i].y = P.totb.y - (P.cb[i].y + offb.y) + gb[i].y; }
}
__device__ __forceinline__ unsigned pk2f(float a, float b) { return cvtpk(a, b); }
struct Raw { unsigned kf[8], kb[8], q[8]; bf16x8 vv[2]; };
template <bool WITH_Q> __device__ __forceinline__ void load_raw(Raw& Rw, int item, const bf16_t* G0p, int tid) {
    const int cp = tid & 63, tg = tid >> 6;
    const int c = item % NCH, h = (item / NCH) & 3, b = (item / (NCH * 4)) & 7, a = item / (NCH * 32);
    const bf16_t* KF = G0p + (size_t)(a ? 5 : 1) * (GSZ / 2); const bf16_t* KB = G0p + (size_t)(a ? 6 : 1) * (GSZ / 2); const bf16_t* Vg = G0p + (size_t)(a ? 7 : 2) * (GSZ / 2); const bf16_t* Qg = G0p + (size_t)(a ? 4 : 0) * (GSZ / 2);
    const int row0 = seq_row(b, 64 * c);
#pragma unroll
    for (int i = 0; i < 8; ++i) { const size_t off = (size_t)(row0 + 8 * tg + i) * 512 + h * 128 + 2 * cp; Rw.kf[i] = *(const unsigned*)(KF + off); Rw.kb[i] = *(const unsigned*)(KB + off); if (WITH_Q) Rw.q[i] = *(const unsigned*)(Qg + off); }
#pragma unroll
    for (int n = 0; n < 2; ++n) { const int q = tid + 512 * n, k = q >> 4, c0 = (q & 15) * 8; Rw.vv[n] = *(const bf16x8*)(Vg + (size_t)(row0 + k) * 512 + h * 128 + c0); }
}

__device__ __forceinline__ void s1_item(int item, int next_item, Raw& Rw, const bf16_t* G0p, const float* lg, bf16_t* ST, float* DEC, LAS char* lds, const int wv) {
    const int tid = tidx(wv), lane = tid & 63, wid = tid >> 6, cp = tid & 63, tg = tid >> 6, r32 = lane & 31, hi = lane >> 5;
    const int c = item % NCH, h = (item / NCH) & 3, b = (item / (NCH * 4)) & 7, a = item / (NCH * 32);
    LAS char* KFi = lds; LAS char* KBi = lds + 16384; LAS char* Vi = lds + 32768; LAS float* tot = (LAS float*)(lds + 49152);
    bf16x8 vv[2] = {Rw.vv[0], Rw.vv[1]};
    Prep P; prep_decay(P, Rw.kf, Rw.kb, a, lg[h], lg[4 + h], tot, tid);
#pragma unroll
    for (int i = 0; i < 8; ++i) { const int k = 8 * tg + i; const int o = v_st(k, 2 * cp);
        *(LAS unsigned*)(KFi + o) = pk2f(P.kf[i].x * __expf(P.totf.x - P.bf[i].x), P.kf[i].y * __expf(P.totf.y - P.bf[i].y));
        *(LAS unsigned*)(KBi + o) = pk2f(P.kb[i].x * __expf(P.totb.x - P.cb[i].x), P.kb[i].y * __expf(P.totb.y - P.cb[i].y)); }
#pragma unroll
    for (int n = 0; n < 2; ++n) { const int q = tid + 512 * n, k = q >> 4, c0 = (q & 15) * 8; *(LAS bf16x8*)(Vi + v_st(k, c0)) = vv[n]; }
    const size_t sidx = ((((size_t)a * 8 + b) * 4 + h) * 2) * NCH;
    if (tg == 0) { *(float2*)(DEC + (sidx + c) * 128 + 2 * cp) = make_float2(__expf(P.totf.x), __expf(P.totf.y)); *(float2*)(DEC + (sidx + NCH + c) * 128 + 2 * cp) = make_float2(__expf(P.totb.x), __expf(P.totb.y)); }
    if (next_item >= 0) load_raw<false>(Rw, next_item, G0p, tid);
    __syncthreads();
    const int dkb = wid & 3, dvb0 = 2 * (wid >> 2);
    const int aKF = (int)(unsigned)(uintptr_t)KFi + v_rd_base(lane) + dkb * 512, aKB = (int)(unsigned)(uintptr_t)KBi + v_rd_base(lane) + dkb * 512, aV = (int)(unsigned)(uintptr_t)Vi + v_rd_base(lane) + dvb0 * 512;
    f32x16 uf0 = {}, uf1 = {}, ub0 = {}, ub1 = {};
    asm volatile("" : "+v"(uf0), "+v"(uf1), "+v"(ub0), "+v"(ub1));
#define S1_STEP(KS) do { const s16x4 fl = tri<(KS) * 4096>(aKF), fh = tri<(KS) * 4096 + 2048>(aKF), bl = tri<(KS) * 4096>(aKB), bh = tri<(KS) * 4096 + 2048>(aKB); \
        const s16x4 v0l = tri<(KS) * 4096>(aV), v0h = tri<(KS) * 4096 + 2048>(aV), v1l = tri<(KS) * 4096 + 512>(aV), v1h = tri<(KS) * 4096 + 2048 + 512>(aV); SC_LWAIT(); \
        const bf16x8 kff = SC_PK(fl, fh), kbf = SC_PK(bl, bh), vf0 = SC_PK(v0l, v0h), vf1 = SC_PK(v1l, v1h); \
        uf0 = __builtin_amdgcn_mfma_f32_32x32x16_bf16(vf0, kff, uf0, 0, 0, 0); uf1 = __builtin_amdgcn_mfma_f32_32x32x16_bf16(vf1, kff, uf1, 0, 0, 0); \
        ub0 = __builtin_amdgcn_mfma_f32_32x32x16_bf16(vf0, kbf, ub0, 0, 0, 0); ub1 = __builtin_amdgcn_mfma_f32_32x32x16_bf16(vf1, kbf, ub1, 0, 0, 0); } while (0)
    S1_STEP(0); S1_STEP(1); S1_STEP(2); S1_STEP(3);
#undef S1_STEP
    bf16_t* Uf = ST + (sidx + c) * 16384; bf16_t* Ub = ST + (sidx + NCH + c) * 16384;
    const int dk = 32 * dkb + r32;
#define S1_ST(ACC, BASE, DVB) do { _Pragma("unroll") for (int p = 0; p < 2; ++p) { \
        const unsigned a0 = cvtpk(ACC[8 * p], ACC[8 * p + 1]), a1 = cvtpk(ACC[8 * p + 2], ACC[8 * p + 3]), b0 = cvtpk(ACC[8 * p + 4], ACC[8 * p + 5]), b1 = cvtpk(ACC[8 * p + 6], ACC[8 * p + 7]); \
        auto r0 = __builtin_amdgcn_permlane32_swap(a0, b0, false, false); auto r1 = __builtin_amdgcn_permlane32_swap(a1, b1, false, false); \
        const u32x4 w = {r0[0], r1[0], r0[1], r1[1]}; *(u32x4*)((BASE) + ((size_t)(4 * (DVB) + 2 * p + hi) * 128 + dk) * 8) = w; } } while (0)
    S1_ST(uf0, Uf, dvb0); S1_ST(uf1, Uf, dvb0 + 1); S1_ST(ub0, Ub, dvb0); S1_ST(ub1, Ub, dvb0 + 1);
#undef S1_ST
    __syncthreads();
}

__device__ __forceinline__ void s2_vec(size_t v, bf16_t* ST, const float* DEC) {
    const int chain = (int)(v >> 11), e8 = (int)(v & 2047), dk = e8 & 127, dir = chain & 1;
    bf16_t* base = ST + (size_t)chain * NCH * 16384 + (size_t)e8 * 8; const float* dec = DEC + (size_t)chain * NCH * 128 + dk;
    float S[8];
#pragma unroll
    for (int i = 0; i < 8; ++i) S[i] = 0.f;
#define S2_C(q) (dir ? ((q) < 4 ? 3 - (q) : 71 - (q)) : (q))
    u32x4 u[8]; float d[8];
#pragma unroll
    for (int j = 0; j < 8; ++j) { const int c = S2_C(j); u[j] = __builtin_nontemporal_load((const u32x4*)(base + (size_t)c * 16384)); d[j] = dec[c * 128]; }
#pragma unroll 1
    for (int q0 = 0; q0 < NCH; q0 += 8) {
#pragma unroll
        for (int j = 0; j < 8; ++j) { const int q = q0 + j; if (q < NCH) { const int c = S2_C(q);
            const u32x4 uu = u[j]; const float dd = d[j];
            if (q + 8 < NCH) { const int cn = S2_C(q + 8); u[j] = __builtin_nontemporal_load((const u32x4*)(base + (size_t)cn * 16384)); d[j] = dec[cn * 128]; }
            u32x4 w; w.x = cvtpk(S[0], S[1]); w.y = cvtpk(S[2], S[3]); w.z = cvtpk(S[4], S[5]); w.w = cvtpk(S[6], S[7]);
            *(u32x4*)(base + (size_t)c * 16384) = w;
            const float2 u0 = bf2x(uu.x), u1 = bf2x(uu.y), u2 = bf2x(uu.z), u3 = bf2x(uu.w);
            S[0] = dd * S[0] + u0.x; S[1] = dd * S[1] + u0.y; S[2] = dd * S[2] + u1.x; S[3] = dd * S[3] + u1.y; S[4] = dd * S[4] + u2.x; S[5] = dd * S[5] + u2.y; S[6] = dd * S[6] + u3.x; S[7] = dd * S[7] + u3.y; } }
    }
#undef S2_C
}

__device__ __forceinline__ void s3_item(int item, int next_item, Raw& Rw, const bf16_t* G0p, const float* lg, const bf16_t* ST, bf16_t* Y, LAS char* lds, const int wv) {
    const int tid = tidx(wv), lane = tid & 63, wid = tid >> 6, cp = tid & 63, tg = tid >> 6, r32 = lane & 31, hi = lane >> 5;
    const int c = item % NCH, h = (item / NCH) & 3, b = (item / (NCH * 4)) & 7, a = item / (NCH * 32);
    const bf16_t* Gt = G0p + (size_t)(a ? 8 : 3) * (GSZ / 2);
    const int row0 = seq_row(b, 64 * c);
    LAS char* QFi = lds; LAS char* KFi = lds + 16384; LAS char* Vi = lds + 32768; LAS float* tot = (LAS float*)(lds + 49152);
    LAS char* QBi = lds + 65536; LAS char* KBi = lds + 81920; LAS char* QF2 = lds + 98304; LAS char* QB2 = lds + 114688; LAS float* red = (LAS float*)(lds + 65536);
    const size_t sidx = ((((size_t)a * 8 + b) * 4 + h) * 2) * NCH;
    bf16x8 vv[2] = {Rw.vv[0], Rw.vv[1]}, sf[4], sb[4];
    float2 qv[8];
#pragma unroll
    for (int i = 0; i < 8; ++i) qv[i] = bf2x(Rw.q[i]);
    Prep P; prep_decay(P, Rw.kf, Rw.kb, a, lg[h], lg[4 + h], tot, tid);
#pragma unroll
    for (int i = 0; i < 8; ++i) { const int k = 8 * tg + i; const int o = KSWZ(k, 4 * cp);
        const float2 ef = make_float2(__expf(P.bf[i].x - P.reff.x), __expf(P.bf[i].y - P.reff.y)), eb = make_float2(__expf(P.cb[i].x - P.refb.x), __expf(P.cb[i].y - P.refb.y));
        *(LAS unsigned*)(QFi + o) = pk2f(qv[i].x * ef.x, qv[i].y * ef.y); *(LAS unsigned*)(KFi + o) = pk2f(P.kf[i].x * __builtin_amdgcn_rcpf(ef.x), P.kf[i].y * __builtin_amdgcn_rcpf(ef.y));
        *(LAS unsigned*)(QBi + o) = pk2f(qv[i].x * eb.x, qv[i].y * eb.y); *(LAS unsigned*)(KBi + o) = pk2f(P.kb[i].x * __builtin_amdgcn_rcpf(eb.x), P.kb[i].y * __builtin_amdgcn_rcpf(eb.y));
        *(LAS unsigned*)(QF2 + o) = pk2f(qv[i].x * __expf(P.bf[i].x), qv[i].y * __expf(P.bf[i].y)); *(LAS unsigned*)(QB2 + o) = pk2f(qv[i].x * __expf(P.cb[i].x), qv[i].y * __expf(P.cb[i].y)); }
#pragma unroll
    for (int n = 0; n < 2; ++n) { const int q = tid + 512 * n, k = q >> 4, c0 = (q & 15) * 8; *(LAS bf16x8*)(Vi + v_st(k, c0)) = vv[n]; }
#pragma unroll
    for (int n = 0; n < 4; ++n) { const int q = tid + 512 * n; sf[n] = *(const bf16x8*)(ST + (sidx + c) * 16384 + (size_t)q * 8); sb[n] = *(const bf16x8*)(ST + (sidx + NCH + c) * 16384 + (size_t)q * 8); }
    if (next_item >= 0) load_raw<true>(Rw, next_item, G0p, tid);
    __syncthreads();
    const int rb = wid >> 2, d0 = wid & 3, qrow = 32 * rb + r32;
    f32x16 pf0 = {}, pf1 = {}, pb0 = {}, pb1 = {};
    asm volatile("" : "+v"(pf0), "+v"(pf1), "+v"(pb0), "+v"(pb1));
#pragma unroll
    for (int ks = 0; ks < 8; ++ks) { const int cb_ = (ks * 16 + hi * 8) * 2;
        const bf16x8 qf = *(const LAS bf16x8*)(QFi + KSWZ(qrow, cb_)), qb = *(const LAS bf16x8*)(QBi + KSWZ(qrow, cb_));
        const bf16x8 kf0 = *(const LAS bf16x8*)(KFi + KSWZ(r32, cb_)), kf1 = *(const LAS bf16x8*)(KFi + KSWZ(32 + r32, cb_)), kb0 = *(const LAS bf16x8*)(KBi + KSWZ(r32, cb_)), kb1 = *(const LAS bf16x8*)(KBi + KSWZ(32 + r32, cb_));
        pf0 = __builtin_amdgcn_mfma_f32_32x32x16_bf16(kf0, qf, pf0, 0, 0, 0); pf1 = __builtin_amdgcn_mfma_f32_32x32x16_bf16(kf1, qf, pf1, 0, 0, 0);
        pb0 = __builtin_amdgcn_mfma_f32_32x32x16_bf16(kb0, qb, pb0, 0, 0, 0); pb1 = __builtin_amdgcn_mfma_f32_32x32x16_bf16(kb1, qb, pb1, 0, 0, 0); }
#pragma unroll
    for (int r = 0; r < 16; ++r) { const int j0 = crow(r, hi), j1 = 32 + j0;
        pf0[r] = (j0 <= qrow ? pf0[r] : 0.f) + (j0 >= qrow ? pb0[r] : 0.f); pf1[r] = (j1 <= qrow ? pf1[r] : 0.f) + (j1 >= qrow ? pb1[r] : 0.f); }
    bf16x8 pa0, pa1, pa2, pa3;
#define PK4(Pv, BASE, OUT) do { unsigned a0 = cvtpk(Pv[BASE + 0], Pv[BASE + 1]), a1 = cvtpk(Pv[BASE + 2], Pv[BASE + 3]);   \
    unsigned b0 = cvtpk(Pv[BASE + 4], Pv[BASE + 5]), b1 = cvtpk(Pv[BASE + 6], Pv[BASE + 7]);                              \
    auto r0 = __builtin_amdgcn_permlane32_swap(a0, b0, false, false); auto r1 = __builtin_amdgcn_permlane32_swap(a1, b1, false, false); \
    u32x4 w = {r0[0], r1[0], r0[1], r1[1]}; OUT = *reinterpret_cast<bf16x8*>(&w); } while (0)
    PK4(pf0, 0, pa0); PK4(pf0, 8, pa1); PK4(pf1, 0, pa2); PK4(pf1, 8, pa3);
#undef PK4
    f32x16 o = {}; asm volatile("" : "+v"(o));
    { const int aV = (int)(unsigned)(uintptr_t)Vi + v_rd_base(lane) + d0 * 512;
      const s16x4 l0 = tri<0>(aV), h0 = tri<2048>(aV), l1 = tri<4096>(aV), h1 = tri<4096 + 2048>(aV), l2 = tri<8192>(aV), h2 = tri<8192 + 2048>(aV), l3 = tri<12288>(aV), h3 = tri<12288 + 2048>(aV); SC_LWAIT();
      o = __builtin_amdgcn_mfma_f32_32x32x16_bf16(SC_PK(l0, h0), pa0, o, 0, 0, 0); o = __builtin_amdgcn_mfma_f32_32x32x16_bf16(SC_PK(l1, h1), pa1, o, 0, 0, 0);
      o = __builtin_amdgcn_mfma_f32_32x32x16_bf16(SC_PK(l2, h2), pa2, o, 0, 0, 0); o = __builtin_amdgcn_mfma_f32_32x32x16_bf16(SC_PK(l3, h3), pa3, o, 0, 0, 0); }
    __syncthreads();
    LAS char* SFi = lds; LAS char* SBi = lds + 32768;
#pragma unroll
    for (int n = 0; n < 4; ++n) { const int q = tid + 512 * n, dk = q & 127, c0 = (q >> 7) * 8; const int oo = (dk >> 6) * 16384 + v_st(dk & 63, c0); *(LAS bf16x8*)(SFi + oo) = sf[n]; *(LAS bf16x8*)(SBi + oo) = sb[n]; }
    __syncthreads();
    u32x2 gq[4];
#pragma unroll
    for (int g = 0; g < 4; ++g) gq[g] = *(const u32x2*)(Gt + (size_t)(row0 + 32 * rb + r32) * 512 + h * 128 + 32 * d0 + 8 * g + 4 * hi);
    { const int aSF = (int)(unsigned)(uintptr_t)SFi + v_rd_base(lane) + d0 * 512, aSB = (int)(unsigned)(uintptr_t)SBi + v_rd_base(lane) + d0 * 512;
#define S3_STEP(KS) do { const int cb_ = ((KS) * 16 + hi * 8) * 2; const bf16x8 q1 = *(const LAS bf16x8*)(QF2 + KSWZ(qrow, cb_)), q2 = *(const LAS bf16x8*)(QB2 + KSWZ(qrow, cb_)); \
        const s16x4 fl = tri<(KS) * 4096>(aSF), fh = tri<(KS) * 4096 + 2048>(aSF), bl = tri<(KS) * 4096>(aSB), bh = tri<(KS) * 4096 + 2048>(aSB); SC_LWAIT(); \
        o = __builtin_amdgcn_mfma_f32_32x32x16_bf16(SC_PK(fl, fh), q1, o, 0, 0, 0); o = __builtin_amdgcn_mfma_f32_32x32x16_bf16(SC_PK(bl, bh), q2, o, 0, 0, 0); } while (0)
      S3_STEP(0); S3_STEP(1); S3_STEP(2); S3_STEP(3); S3_STEP(4); S3_STEP(5); S3_STEP(6); S3_STEP(7);
#undef S3_STEP
    }
    { float ss = 0.f;
#pragma unroll
      for (int r = 0; r < 16; ++r) ss += o[r] * o[r];
      { auto rr = __builtin_amdgcn_permlane32_swap(__float_as_uint(ss), __float_as_uint(ss), false, false); ss = __uint_as_float(rr[0]) + __uint_as_float(rr[1]); }
      if (hi == 0) red[(rb * 4 + d0) * 32 + r32] = ss; }
    __syncthreads();
    { const float tot = red[(rb * 4 + 0) * 32 + r32] + red[(rb * 4 + 1) * 32 + r32] + red[(rb * 4 + 2) * 32 + r32] + red[(rb * 4 + 3) * 32 + r32];
      const float rs = rsqrtf(tot * (1.f / 128.f) + EPS);
      bf16_t* yrow = Y + (size_t)(row0 + 32 * rb + r32) * 1024 + a * 512 + h * 128 + 32 * d0 + 8 * hi;
#pragma unroll
      for (int pp = 0; pp < 2; ++pp) {
          const float2 ga = bf2x(gq[2 * pp].x), gb = bf2x(gq[2 * pp].y), gc = bf2x(gq[2 * pp + 1].x), gd = bf2x(gq[2 * pp + 1].y);
          const unsigned a0 = cvtpk(o[8 * pp] * rs * ga.x, o[8 * pp + 1] * rs * ga.y), a1 = cvtpk(o[8 * pp + 2] * rs * gb.x, o[8 * pp + 3] * rs * gb.y);
          const unsigned b0 = cvtpk(o[8 * pp + 4] * rs * gc.x, o[8 * pp + 5] * rs * gc.y), b1 = cvtpk(o[8 * pp + 6] * rs * gd.x, o[8 * pp + 7] * rs * gd.y);
          auto r0 = __builtin_amdgcn_permlane32_swap(a0, b0, false, false); auto r1 = __builtin_amdgcn_permlane32_swap(a1, b1, false, false);
          const u32x4 w = {r0[0], r1[0], r0[1], r1[1]}; *(u32x4*)(yrow + 16 * pp) = w; } }
    __syncthreads();
}
#undef SC_PK
#undef SC_LWAIT
}

constexpr int RING_OFF = 0, RING_BYTES = 131072;
constexpr int MISC_OFF = RING_BYTES;
constexpr int LDS_BYTES = 147456;
constexpr int NWAVES = 8, NTHREADS = 512;

#define XB_TMO      128
#define XB_XCNT(j)  (256  + 64 * (j))
#define XB_XSUB(j)  (1280 + 64 * (j))
#define XB_XGEN(j)  (2304 + 64 * (j))
#define XB_TOP      3328
#define XB_TOPGEN   3392
#define XCD_BAR_WORDS 3456
#define XB_SPIN_CAP (1u << 18)
__device__ __forceinline__ unsigned xb_ld(unsigned* p)              { return __hip_atomic_load(p, __ATOMIC_RELAXED, __HIP_MEMORY_SCOPE_AGENT); }
__device__ __forceinline__ unsigned xb_add(unsigned* p, unsigned v) { return __hip_atomic_fetch_add(p, v, __ATOMIC_RELAXED, __HIP_MEMORY_SCOPE_AGENT); }
__device__ __forceinline__ unsigned xb_xcc_id() { return (unsigned)__builtin_amdgcn_s_getreg((3 << 11) | 20) & 0xFu; }
#define XB_SPIN(cond, bar) do { unsigned _sp = 0; while (cond) { __builtin_amdgcn_s_sleep(1); \
    if ((++_sp & 255u) == 0u) { if (xb_ld(&(bar)[XB_TMO])) break; if (_sp > XB_SPIN_CAP) { atomicAdd(&(bar)[XB_TMO], 1u); break; } } } } while (0)
struct XcdBarrier { unsigned* bar; unsigned x; volatile LAS unsigned* st; };
__device__ __forceinline__ XcdBarrier xcd_barrier_post(unsigned* bar, volatile LAS unsigned* st) {
    XcdBarrier b; b.bar = bar; b.x = xb_xcc_id(); b.st = st;
    if (threadIdx.x == 0) (void)xb_add(&bar[XB_XCNT(b.x)], 1u);
    return b;
}
__device__ __forceinline__ void xcd_barrier_complete(unsigned* bar, unsigned x, unsigned& nloc, unsigned& nx) {
    const unsigned Gt = gridDim.x * gridDim.y * gridDim.z;
    unsigned sum, cnt, mine, sp = 0u;
    for (;;) {
        sum = 0u; cnt = 0u; mine = 0u;
#pragma unroll
        for (unsigned j = 0; j < 16; ++j) { const unsigned c = xb_ld(&bar[XB_XCNT(j)]); sum += c; cnt += (c > 0u) ? 1u : 0u; mine = (j == x) ? c : mine; }
        if (sum == Gt) break;
        __builtin_amdgcn_s_sleep(1);
        if ((++sp & 255u) == 0u) { if (xb_ld(&bar[XB_TMO])) break; if (sp > XB_SPIN_CAP) { atomicAdd(&bar[XB_TMO], 1u); break; } }
    }
    nloc = mine > 0u ? mine : 1u; nx = cnt > 0u ? cnt : 1u;
}
__device__ __forceinline__ void xcd_barrier(const XcdBarrier& b, const bool leader  ) {
    asm volatile("s_waitcnt vmcnt(0)" ::: "memory");
    __syncthreads();
    if (leader) {
        unsigned* bar = b.bar;
        __builtin_amdgcn_s_waitcnt(0);
        unsigned nloc = b.st[0], nx = b.st[1];
        if (nloc == 0u) { xcd_barrier_complete(bar, b.x, nloc, nx); b.st[0] = nloc; b.st[1] = nx; }
        const unsigned old = xb_add(&bar[XB_XSUB(b.x)], 1u);
        const unsigned gen = old / nloc;
        if (old + 1u == (gen + 1u) * nloc) {
            __builtin_amdgcn_fence(__ATOMIC_RELEASE, "agent");
            asm volatile("s_waitcnt vmcnt(0)" ::: "memory");
            const unsigned og = xb_add(&bar[XB_TOP], 1u);
            const unsigned tg = og / nx;
            if (og + 1u == (tg + 1u) * nx) xb_add(&bar[XB_TOPGEN], 1u);
            else XB_SPIN(xb_ld(&bar[XB_TOPGEN]) == tg, bar);
            __builtin_amdgcn_fence(__ATOMIC_ACQUIRE, "agent");
            xb_add(&bar[XB_XGEN(b.x)], 1u);
            asm volatile("s_waitcnt vmcnt(0)" ::: "memory");
        } else {
            XB_SPIN(xb_ld(&bar[XB_XGEN(b.x)]) == gen, bar);
            __builtin_amdgcn_fence(__ATOMIC_ACQUIRE, "agent");
            asm volatile("s_waitcnt vmcnt(0)" ::: "memory");
        }
    }
    __syncthreads();
}

__device__ __forceinline__ void transpose_item(const float* __restrict__ W, int ldw, int K, int src0, bf16_t* __restrict__ WT, int n0, int k0, LAS float* scr, int lane) {
    f32x4 ld[8];
#pragma unroll
    for (int i = 0; i < 8; ++i) { const int kk = 8 * i + (lane >> 3); ld[i] = src0 >= 0 ? *(const f32x4*)(W + (size_t)(k0 + kk) * ldw + src0 + 4 * (lane & 7)) : (f32x4){0.f, 0.f, 0.f, 0.f}; }
#pragma unroll
    for (int i = 0; i < 8; ++i) { const int kk = 8 * i + (lane >> 3); *(LAS f32x4*)(scr + kk * 36 + 4 * (lane & 7)) = ld[i]; }
    asm volatile("s_waitcnt lgkmcnt(0)" ::: "memory");
    const int c = lane & 7;
#pragma unroll
    for (int j = 0; j < 4; ++j) { const int n = (lane >> 3) + 8 * j; const LAS float* s = scr + (8 * c) * 36 + n;
        u32x4 o; o.x = cvt_pk_bf16(s[0 * 36], s[1 * 36]); o.y = cvt_pk_bf16(s[2 * 36], s[3 * 36]); o.z = cvt_pk_bf16(s[4 * 36], s[5 * 36]); o.w = cvt_pk_bf16(s[6 * 36], s[7 * 36]);
        *(u32x4*)(WT + (size_t)(n0 + n) * K + k0 + 8 * c) = o; }
    asm volatile("s_waitcnt lgkmcnt(0)" ::: "memory");
}
__device__ __forceinline__ void transpose_item8(const float* __restrict__ W, int ldw, int K, int src0, unsigned char* __restrict__ WT, int n0, int k0, LAS float* scr, int lane) {
    f32x4 ld[8];
#pragma unroll
    for (int i = 0; i < 8; ++i) { const int kk = 8 * i + (lane >> 3); ld[i] = *(const f32x4*)(W + (size_t)(k0 + kk) * ldw + src0 + 4 * (lane & 7)); }
#pragma unroll
    for (int i = 0; i < 8; ++i) { const int kk = 8 * i + (lane >> 3); *(LAS f32x4*)(scr + kk * 36 + 4 * (lane & 7)) = ld[i]; }
    asm volatile("s_waitcnt lgkmcnt(0)" ::: "memory");
    const int c = lane & 7;
#pragma unroll
    for (int j = 0; j < 4; ++j) { const int n = (lane >> 3) + 8 * j; const LAS float* sp = scr + (8 * c) * 36 + n;
        u32x2 o; o.x = pack4_fp8(sp[0 * 36] * W8_SCALE, sp[1 * 36] * W8_SCALE, sp[2 * 36] * W8_SCALE, sp[3 * 36] * W8_SCALE); o.y = pack4_fp8(sp[4 * 36] * W8_SCALE, sp[5 * 36] * W8_SCALE, sp[6 * 36] * W8_SCALE, sp[7 * 36] * W8_SCALE);
        *(u32x2*)(WT + (size_t)(n0 + n) * K + k0 + 8 * c) = o; }
    asm volatile("s_waitcnt lgkmcnt(0)" ::: "memory");
}
__device__ __forceinline__ int src_mixin(int n0) { const int pn = n0 >> 8, q = n0 & 255, grp = pn >> 1, half = pn & 1; if (grp > 1) return n0; const int bj = q >> 7, rr = q & 127, hl = rr >> 6, j = rr & 63; return grp * 512 + (half * 2 + hl) * 128 + bj * 64 + j; }
__device__ __forceinline__ int src_swiglu(int n0) { const int pn = n0 >> 8, q = n0 & 255, bj = q >> 7, rr = q & 127; return bj * FFN + pn * 128 + rr; }
__device__ __forceinline__ int src_uq(int n0) { const int pn = n0 >> 8, q = n0 & 255, bj = q >> 7, rr = q & 127; if (pn < 4) return (2 * pn + bj) * 192 + rr; const int hl = rr >> 5; return (4 * (pn - 4) + hl) * 192 + 128 + bj * 32 + (rr & 31); }

struct Args { const float* in[22]; float* out; unsigned char* ws; int ph_lo, ph_hi; };

constexpr int CI_MIXIN = 0, CI_MIXOUT = CI_MIXIN + 16 * 144, CI_FFNIN = CI_MIXOUT + 16 * 32, CI_FFNOUT = CI_FFNIN + 16 * 176, CI_DOWN = CI_FFNOUT + 44 * 32, CI_UQ = CI_DOWN + 16 * 24,
              CI_UKV = CI_UQ + 6 * 48, CI_MLAOUT = CI_UKV + 4 * 64, CI_MOEOUT = CI_MLAOUT + 16 * 32, CI_MOEIN = CI_MOEOUT + 8 * 44 * 32, CI_END = CI_MOEIN + 8 * 16 * 176;
struct ConvP { const float *mix_in_w, *mix_out_w, *ffn_in_w, *ffn_out_w, *down_w, *uq_w, *ukv_w, *mla_out_w, *moe_in_w, *moe_out_w;
               bf16_t *Wmixin, *Wmixout, *Wffnin, *Wffnout, *Wdown, *Wuq, *Wukv, *Wmlaout, *Wmi, *Wmo; };
template <int LO, int HI> __device__ __forceinline__ void conv_range(const ConvP& p, const int gwl, const int NGWL, LAS float* scr, const int lane) {
#define CI_HAS(A, B) (LO < (B) && HI > (A))
    for (int it = LO + gwl; it < HI; it += NGWL) {
        if (CI_HAS(CI_MIXIN, CI_MIXOUT) && it < CI_MIXOUT) { const int r = it - CI_MIXIN, kb = r / 144, nb = r % 144; transpose_item(p.mix_in_w, MIXC, 1024, src_mixin(nb * 32), p.Wmixin, nb * 32, kb * 64, scr, lane); continue; }
        if (CI_HAS(CI_MIXOUT, CI_FFNIN) && it < CI_FFNIN) { const int r = it - CI_MIXOUT, kb = r / 32, nb = r % 32; transpose_item(p.mix_out_w, 1024, 1024, nb * 32, p.Wmixout, nb * 32, kb * 64, scr, lane); continue; }
#if FFN_FP8 == 1
        if (CI_HAS(CI_FFNIN, CI_FFNOUT) && it < CI_FFNOUT) { const int r = it - CI_FFNIN, kb = r / 176, nb = r % 176; transpose_item8(p.ffn_in_w, 2 * FFN, 1024, src_swiglu(nb * 32), (unsigned char*)p.Wffnin, nb * 32, kb * 64, scr, lane); continue; }
#else
        if (CI_HAS(CI_FFNIN, CI_FFNOUT) && it < CI_FFNOUT) { const int r = it - CI_FFNIN, kb = r / 176, nb = r % 176; transpose_item(p.ffn_in_w, 2 * FFN, 1024, src_swiglu(nb * 32), p.Wffnin, nb * 32, kb * 64, scr, lane); continue; }
#endif
#if FFN_FP8
        if (CI_HAS(CI_FFNOUT, CI_DOWN) && it < CI_DOWN) { const int r = it - CI_FFNOUT, kb = r / 32, nb = r % 32; transpose_item8(p.ffn_out_w, 1024, FFN, nb * 32, (unsigned char*)p.Wffnout, nb * 32, kb * 64, scr, lane); continue; }
#else
        if (CI_HAS(CI_FFNOUT, CI_DOWN) && it < CI_DOWN) { const int r = it - CI_FFNOUT, kb = r / 32, nb = r % 32; transpose_item(p.ffn_out_w, 1024, FFN, nb * 32, p.Wffnout, nb * 32, kb * 64, scr, lane); continue; }
#endif
        if (CI_HAS(CI_DOWN, CI_UQ) && it < CI_UQ) { const int r = it - CI_DOWN, kb = r / 24, nb = r % 24; transpose_item(p.down_w, DOWNC, 1024, nb < 22 ? nb * 32 : -1, p.Wdown, nb * 32, kb * 64, scr, lane); continue; }
        if (CI_HAS(CI_UQ, CI_UKV) && it < CI_UKV) { const int r = it - CI_UQ, kb = r / 48, nb = r % 48; transpose_item(p.uq_w, 1536, QRANK, src_uq(nb * 32), p.Wuq, nb * 32, kb * 64, scr, lane); continue; }
        if (CI_HAS(CI_UKV, CI_MLAOUT) && it < CI_MLAOUT) { const int r = it - CI_UKV, kb = r / 64, nb = r % 64; transpose_item(p.ukv_w, 2048, KVRANK, nb * 32, p.Wukv, nb * 32, kb * 64, scr, lane); continue; }
        if (CI_HAS(CI_MLAOUT, CI_MOEOUT) && it < CI_MOEOUT) { const int r = it - CI_MLAOUT, kb = r / 32, nb = r % 32; transpose_item(p.mla_out_w, 1024, 1024, nb * 32, p.Wmlaout, nb * 32, kb * 64, scr, lane); continue; }
        constexpr int J0 = 16 * 176, J1 = 44 * 32;
#if MOE_FP8
        if (CI_HAS(CI_MOEOUT, CI_MOEIN) && it < CI_MOEIN) { const int q = it - CI_MOEOUT, e = q / J1, r = q % J1, kb = r / 32, nb = r % 32; transpose_item8(p.moe_out_w + (size_t)e * FFN * 1024, 1024, FFN, nb * 32, (unsigned char*)p.Wmo + (size_t)e * 1024 * FFN, nb * 32, kb * 64, scr, lane); continue; }
        if (CI_HAS(CI_MOEIN, CI_END)) { const int q = it - CI_MOEIN, e = q / J0, r = q % J0, kb = r / 176, nb = r % 176; transpose_item8(p.moe_in_w + (size_t)e * 1024 * 2 * FFN, 2 * FFN, 1024, src_swiglu(nb * 32), (unsigned char*)p.Wmi + (size_t)e * 2 * FFN * 1024, nb * 32, kb * 64, scr, lane); }
#else
        if (CI_HAS(CI_MOEOUT, CI_MOEIN) && it < CI_MOEIN) { const int q = it - CI_MOEOUT, e = q / J1, r = q % J1, kb = r / 32, nb = r % 32; transpose_item(p.moe_out_w + (size_t)e * FFN * 1024, 1024, FFN, nb * 32, p.Wmo + (size_t)e * 1024 * FFN, nb * 32, kb * 64, scr, lane); continue; }
        if (CI_HAS(CI_MOEIN, CI_END)) { const int q = it - CI_MOEIN, e = q / J0, r = q % J0, kb = r / 176, nb = r % 176; transpose_item(p.moe_in_w + (size_t)e * 1024 * 2 * FFN, 2 * FFN, 1024, src_swiglu(nb * 32), p.Wmi + (size_t)e * 2 * FFN * 1024, nb * 32, kb * 64, scr, lane); }
#endif
    }
#undef CI_HAS
}
__device__ __forceinline__ bool tail_ids(const int nunits, const int G, const int blk, const int wave, int& gwl, int& NGWL) {
    const int rounds = (nunits + G - 1) / G, nheavy = nunits - (rounds - 1) * G;
    if (nheavy >= G) { gwl = blk * 8 + wave; NGWL = G * 8; return true; }
    if (blk < nheavy) return false;
    gwl = (blk - nheavy) * 8 + wave; NGWL = (G - nheavy) * 8; return true;
}

enum Phase { PH_SETUP = 0, PH_ROWS1, PH_MIXIN, PH_SCAN1, PH_SCAN2, PH_SCAN3, PH_MIXOUT, PH_ROWS5, PH_FFNIN, PH_FFNOUT, PH_ROWS8, PH_DOWN, PH_PREP, PH_UQ, PH_UKV, PH_ATTN, PH_MLAOUT, PH_ROWS13, PH_ROUTE, PH_MOEIN, PH_MOEOUT, PH_ROWS17, PH_COUNT };

__global__ void __launch_bounds__(NTHREADS, 2) mega(Args args) {
    extern __shared__ __attribute__((aligned(16))) unsigned char lds_raw[];
    LAS unsigned char* lds = (LAS unsigned char*)lds_raw;
    volatile LAS unsigned* MISC = (volatile LAS unsigned*)(lds + MISC_OFF);
    const int wave0 = __builtin_amdgcn_readfirstlane((int)threadIdx.x >> 6);
    const int tid0 = threadIdx.x;
    const int G = gridDim.x, blk = blockIdx.x;
#define PHASE_IDS const int tid = tidx(wave0), lane = tid & 63, wave = __builtin_amdgcn_readfirstlane(tid >> 6), gw = blk * NWAVES + wave, NGW = G * NWAVES; (void)lane; (void)gw; (void)NGW
    unsigned char* ws0 = args.ws;
    for (int u = tid0; u < (LDS_BYTES - MISC_OFF) / 4; u += NTHREADS) ((LAS unsigned*)(lds + MISC_OFF))[u] = 0u;
    __syncthreads();
    const int lo = args.ph_lo, hi = args.ph_hi;
    XcdBarrier bar; bar.bar = (unsigned*)(ws0 + WS_CTL) + 4096; bar.x = 0; bar.st = nullptr;
    if (hi - lo > 1) bar = xcd_barrier_post((unsigned*)(ws0 + WS_CTL) + 4096, MISC + 8);
#ifndef PHMASK
#define PHMASK 0xffffffffu
#endif
#define IN(k) (((PHMASK >> (k)) & 1u) && lo <= (k) && (k) < hi)
#ifdef PROBE_K
    LAS unsigned long long* tsl = (LAS unsigned long long*)(lds + MISC_OFF + 512);
    if (tid0 == 0) tsl[0] = __builtin_amdgcn_s_memrealtime();
#define SEAM(k) do { if (IN(k) && IN((k) + 1)) xcd_barrier(bar, tidx(wave0) == 0); if (tid0 == 0) tsl[(k) + 1] = __builtin_amdgcn_s_memrealtime(); } while (0)
#else
#define SEAM(k) do { if (IN(k) && IN((k) + 1)) xcd_barrier(bar, tidx(wave0) == 0); } while (0)
#endif
    const float* x = args.in[0]; const float* cvec = args.in[1]; const float* ctx = args.in[2]; const float* cctx = args.in[3];
    const float* mod_w = args.in[4]; const float* mod_b = args.in[5]; const float* norm_g = args.in[6]; const float* mix_in_w = args.in[7];
    const float* decay_logit = args.in[8]; const float* lb_logit = args.in[9]; const float* mix_out_w = args.in[10]; const float* ffn_in_w = args.in[11];
    const float* ffn_out_w = args.in[12]; const float* down_w = args.in[13]; const float* gq = args.in[14]; const float* gkv = args.in[15];
    const float* uq_w = args.in[16]; const float* ukv_w = args.in[17]; const float* mla_out_w = args.in[18]; const float* router_w = args.in[19];
    const float* moe_in_w = args.in[20]; const float* moe_out_w = args.in[21];
    float* out = args.out;
#define PHASE_PTRS GAS unsigned char* wsg_ = (GAS unsigned char*)ws0; asm volatile("" : "+s"(wsg_)); unsigned char* ws = (unsigned char*)wsg_;     \
    float* modv = (float*)(ws + WS_MODV); float* lbv = (float*)(ws + WS_LB); float* lg = (float*)(ws + WS_LG); int* meta = (int*)(ws + WS_META); \
    float* rc = (float*)(ws + WS_ROPE_RC); float* rs = (float*)(ws + WS_ROPE_RS); float* mc = (float*)(ws + WS_ROPE_MC); float* ms = (float*)(ws + WS_ROPE_MS); \
    float* cx = (float*)(ws + WS_CX); bf16_t* HB = (bf16_t*)(ws + WS_HB); bf16_t* G0 = (bf16_t*)(ws + WS_G0); \
    bf16_t* OX = (bf16_t*)(ws + WS_OX); bf16_t* ACT = (bf16_t*)(ws + WS_ACT); \
    bf16_t* DOWN = (bf16_t*)(ws + WS_DOWN); bf16_t* QN = (bf16_t*)(ws + WS_QN); bf16_t* QR = (bf16_t*)(ws + WS_QR); bf16_t* KN = (bf16_t*)(ws + WS_KN); bf16_t* KR = (bf16_t*)(ws + WS_KR); \
    bf16_t* Vv = (bf16_t*)(ws + WS_V); bf16_t* AO = (bf16_t*)(ws + WS_AO); bf16_t* Ob = (bf16_t*)(ws + WS_O); bf16_t* NQ = (bf16_t*)(ws + WS_NQ); bf16_t* NKV = (bf16_t*)(ws + WS_NKV); \
    bf16_t* H4 = (bf16_t*)(ws + WS_H4); bf16_t* HS = (bf16_t*)(ws + WS_HS); bf16_t* ACT2 = (bf16_t*)(ws + WS_ACT2); bf16_t* YS = (bf16_t*)(ws + WS_YS); \
    int* top_e = (int*)(ws + WS_TOPE); float* top_g = (float*)(ws + WS_TOPG); int* tslot = (int*)(ws + WS_TSLOT); \
    bf16_t* Wmixin = (bf16_t*)(ws + WS_W_MIXIN); bf16_t* Wmixout = (bf16_t*)(ws + WS_W_MIXOUT); bf16_t* Wffnin = (bf16_t*)(ws + WS_W_FFNIN); bf16_t* Wffnout = (bf16_t*)(ws + WS_W_FFNOUT); \
    bf16_t* Wdown = (bf16_t*)(ws + WS_W_DOWN); bf16_t* Wuq = (bf16_t*)(ws + WS_W_UQ); bf16_t* Wukv = (bf16_t*)(ws + WS_W_UKV); bf16_t* Wmlaout = (bf16_t*)(ws + WS_W_MLAOUT); \
    bf16_t* Wmi = (bf16_t*)(ws + WS_WMI); bf16_t* Wmo = (bf16_t*)(ws + WS_WMO); \
    const float* mv0 = modv; const float* mv1 = modv + 9 * 6144; const float* g0 = norm_g; const float* g1n = norm_g + 4 * 1024;
    if (IN(PH_SETUP)) { PHASE_PTRS; PHASE_IDS;
        for (int gid = blk * NTHREADS + tid; gid < 4096 * 64; gid += G * NTHREADS) tables_body(gid, lb_logit, decay_logit, rc, rs, mc, ms, lbv, lg);
        LAS float* sc = (LAS float*)(lds + RING_OFF);
        for (int i = tid; i < 9 * 1024; i += NTHREADS) { const int r = i >> 10, k = i & 1023; const float v = r < 8 ? cvec[r * 1024 + k] : cctx[k]; sc[i] = siluf(v); }
        __syncthreads();
        { LAS float* red = (LAS float*)(lds + RING_OFF + 40960);
          for (int cg = blk; cg < 12288 / 64; cg += G) {
            const int col = cg * 64 + lane, l = col / 6144, n = col % 6144;
            float acc[9];
#pragma unroll
            for (int r = 0; r < 9; ++r) acc[r] = 0.f;
            const float* w = mod_w + ((size_t)l * 1024 + wave * 128) * 6144 + n; const LAS float* scw = sc + wave * 128;
#pragma unroll 16
            for (int k = 0; k < 128; ++k) { const float wv = w[(size_t)k * 6144];
#pragma unroll
                for (int r = 0; r < 9; ++r) acc[r] += scw[r * 1024 + k] * wv; }
#pragma unroll
            for (int r = 0; r < 9; ++r) red[(wave * 9 + r) * 64 + lane] = acc[r];
            __syncthreads();
            for (int o = tid; o < 9 * 64; o += NTHREADS) { const int r = o >> 6, ln = o & 63; float sum = 0.f;
#pragma unroll
                for (int w8 = 0; w8 < 8; ++w8) sum += red[(w8 * 9 + r) * 64 + ln];
                const int n2 = (cg * 64) % 6144 + ln; modv[((size_t)l * 9 + r) * 6144 + n2] = sum + mod_b[l * 6144 + n2]; }
            __syncthreads();
          } }
        __syncthreads();
        { ConvP cp{mix_in_w, mix_out_w, ffn_in_w, ffn_out_w, down_w, uq_w, ukv_w, mla_out_w, moe_in_w, moe_out_w, Wmixin, Wmixout, Wffnin, Wffnout, Wdown, Wuq, Wukv, Wmlaout, Wmi, Wmo};
          conv_range<CI_MIXIN, CI_MIXOUT>(cp, gw, NGW, (LAS float*)(lds + RING_OFF + 40960 + wave * 9216), lane); }
    }
    SEAM(PH_SETUP);
    if (IN(PH_ROWS1)) { PHASE_PTRS; PHASE_IDS; RowArgs a{}; a.xin_lat = x; a.xin_ctx = ctx; a.gh = g0; a.scale = mv0 + 1024; a.shift = mv0; a.H = HB; a.nrows = R;
        rows2::rows_phase<true, 0, 0, 1, false>(a, gw, NGW, lane, true, nullptr); }
    SEAM(PH_ROWS1);
    if (IN(PH_MIXIN)) { PHASE_PTRS; pg8::Gemm g{HB, Wmixin, D, D, D}; pg8::DenseOrder S; S.init(R / 256, MIXC / 256, G, blk); pg8::EpiMix E{G0, rc, rs, lbv};
        pg8::gemm_phase<pg8::EpiMix, pg8::DenseOrder, true>(lds + RING_OFF, g, S, E, wave0); }
#define CONV_TAIL(NUNITS, LO, HI) do { PHASE_PTRS; PHASE_IDS; int gwl, NGWL; if (tail_ids((NUNITS), G, blk, wave, gwl, NGWL)) { __syncthreads(); \
        ConvP cp{mix_in_w, mix_out_w, ffn_in_w, ffn_out_w, down_w, uq_w, ukv_w, mla_out_w, moe_in_w, moe_out_w, Wmixin, Wmixout, Wffnin, Wffnout, Wdown, Wuq, Wukv, Wmlaout, Wmi, Wmo}; \
        conv_range<(LO), (HI)>(cp, gwl, NGWL, (LAS float*)(lds + RING_OFF + wave * 9216), lane); } } while (0)
    if (IN(PH_MIXIN)) CONV_TAIL((R / 256) * (MIXC / 256), CI_MIXOUT, CI_DOWN);
    SEAM(PH_MIXIN);
#define SCAN_PTRS bf16_t* ST = (bf16_t*)(ws + scan::WS_STATE); float* DEC = (float*)(ws + scan::WS_DEC)
    if (IN(PH_SCAN1)) { PHASE_PTRS; SCAN_PTRS; scan::Raw Rw; const int NI = 2 * NB * 4 * scan::NCH; if (blk < NI) scan::load_raw<false>(Rw, blk, G0, tidx(wave0));
        for (int item = blk; item < NI; item += G) scan::s1_item(item, item + G < NI ? item + G : -1, Rw, G0, lg, ST, DEC, (LAS char*)(lds + RING_OFF), wave0); }
    SEAM(PH_SCAN1);
    if (IN(PH_SCAN2)) { PHASE_PTRS; SCAN_PTRS; PHASE_IDS; for (size_t v = (size_t)blk * NTHREADS + tid; v < (size_t)2 * NB * 4 * 2 * 2048; v += (size_t)G * NTHREADS) scan::s2_vec(v, ST, DEC); }
    SEAM(PH_SCAN2);
    if (IN(PH_SCAN3)) { PHASE_PTRS; SCAN_PTRS; scan::Raw Rw; const int NI = 2 * NB * 4 * scan::NCH; if (blk < NI) scan::load_raw<true>(Rw, blk, G0, tidx(wave0));
        for (int item = blk; item < NI; item += G) scan::s3_item(item, item + G < NI ? item + G : -1, Rw, G0, lg, ST, HB, (LAS char*)(lds + RING_OFF), wave0); }
    SEAM(PH_SCAN3);
    if (IN(PH_MIXOUT)) { PHASE_PTRS; pg8::Gemm g{HB, Wmixout, D, D, D}; pg8::DenseOrder S; S.init(R / 256, D / 256, G, blk); pg8::EpiPlain E{OX, D};
        pg8::gemm_phase<pg8::EpiPlain, pg8::DenseOrder, true>(lds + RING_OFF, g, S, E, wave0); }
    if (IN(PH_MIXOUT)) CONV_TAIL((R / 256) * (D / 256), CI_DOWN, CI_MOEIN);
    SEAM(PH_MIXOUT);
    if (IN(PH_ROWS5)) { PHASE_PTRS; PHASE_IDS; RowArgs a{}; a.xin_lat = x; a.xin_ctx = ctx; a.xout_lat = out; a.xout_ctx = cx; a.Y = OX; a.gy = g0 + 1024; a.gate = mv0 + 2048; a.gh = g0 + 2048; a.scale = mv0 + 4096; a.shift = mv0 + 3072; a.H = HB; a.nrows = R; a.xout_bf = 1;
#if FFN_FP8 == 1
        a.H8 = (unsigned char*)HB;
        rows2::rows_phase<true, 1, 1, 2, false>(a, gw, NGW, lane, true, nullptr); }
#else
        rows2::rows_phase<true, 1, 1, 1, false>(a, gw, NGW, lane, true, nullptr); }
#endif
    SEAM(PH_ROWS5);
#if FFN_FP8 == 2
    if (IN(PH_FFNIN)) { PHASE_PTRS; pg8::Gemm g{HB, Wffnin, D, D, D}; pg8::DenseOrder S; S.init(R / 256, 2 * FFN / 256, G, blk); pg8::EpiSwiglu8 E{(unsigned char*)ACT, 1.f};
        pg8::gemm_phase<pg8::EpiSwiglu8, pg8::DenseOrder, true>(lds + RING_OFF, g, S, E, wave0); }
#elif FFN_FP8 == 1
    if (IN(PH_FFNIN)) { PHASE_PTRS; pg8::Gemm g{HB, Wffnin, D / 2, D / 2, D / 2}; pg8::DenseOrder S; S.init(R / 256, 2 * FFN / 256, G, blk); pg8::EpiSwiglu8 E{(unsigned char*)ACT, W8_INV};
        pg8::gemm_phase<pg8::EpiSwiglu8, pg8::DenseOrder, true, true>(lds + RING_OFF, g, S, E, wave0); }
#else
    if (IN(PH_FFNIN)) { PHASE_PTRS; pg8::Gemm g{HB, Wffnin, D, D, D}; pg8::DenseOrder S; S.init(R / 256, 2 * FFN / 256, G, blk); pg8::EpiSwiglu E{ACT};
        pg8::gemm_phase<pg8::EpiSwiglu, pg8::DenseOrder, true>(lds + RING_OFF, g, S, E, wave0); }
#endif
    SEAM(PH_FFNIN);
#if FFN_FP8
    if (IN(PH_FFNOUT)) { PHASE_PTRS; pg8::Gemm g{ACT, Wffnout, FFN / 2, FFN / 2, FFN / 2}; pg8::DenseOrder S; S.init(R / 256, D / 256, G, blk); pg8::EpiPlainS E{OX, D, W8_INV};
        pg8::gemm_phase<pg8::EpiPlainS, pg8::DenseOrder, true, true>(lds + RING_OFF, g, S, E, wave0); }
#else
    if (IN(PH_FFNOUT)) { PHASE_PTRS; pg8::Gemm g{ACT, Wffnout, FFN, FFN, FFN}; pg8::DenseOrder S; S.init(R / 256, D / 256, G, blk); pg8::EpiPlain E{OX, D};
        pg8::gemm_phase<pg8::EpiPlain, pg8::DenseOrder, true>(lds + RING_OFF, g, S, E, wave0); }
#endif
    if (IN(PH_FFNOUT)) CONV_TAIL((R / 256) * (D / 256), CI_MOEIN, CI_MOEIN + 6 * 16 * 176);
    SEAM(PH_FFNOUT);
    if (IN(PH_ROWS8)) { PHASE_PTRS; PHASE_IDS; RowArgs a{}; a.xin_lat = out; a.xin_ctx = cx; a.xout_lat = out; a.xout_ctx = cx; a.Y = OX; a.gy = g0 + 3072; a.gate = mv0 + 5120; a.gh = g1n; a.scale = mv1 + 1024; a.shift = mv1; a.H = HB; a.nrows = R; a.xin_bf = 1; a.xout_bf = 1;
        rows2::rows_phase<false, 1, 1, 1, false>(a, gw, NGW, lane, true, nullptr);
    }
    SEAM(PH_ROWS8);
    if (IN(PH_DOWN)) { PHASE_PTRS; pg8::Gemm g{HB, Wdown, D, D, D}; pg8::DenseOrder S; S.init(R / 256, DOWNP / 256, G, blk); pg8::EpiPlain E{DOWN, DOWNP};
        pg8::gemm_phase<pg8::EpiPlain, pg8::DenseOrder, true>(lds + RING_OFF, g, S, E, wave0); }
    if (IN(PH_DOWN)) CONV_TAIL((R / 256) * (DOWNP / 256), CI_MOEIN + 6 * 16 * 176, CI_END);
    SEAM(PH_DOWN);
    if (IN(PH_PREP)) { PHASE_PTRS; PHASE_IDS; for (int r = gw; r < R; r += NGW) mla_prep_body(r, lane, DOWN, gq, gkv, mc, ms, NQ, NKV, KR); }
    SEAM(PH_PREP);
    if (IN(PH_UQ)) { PHASE_PTRS; pg8::Gemm g{NQ, Wuq, QRANK, QRANK, QRANK}; pg8::DenseOrder S; S.init(RL / 256, 1536 / 256, G, blk); pg8::EpiUQ E{QN, QR, mc, ms};
          pg8::gemm_phase<pg8::EpiUQ, pg8::DenseOrder, true>(lds + RING_OFF, g, S, E, wave0); }
#ifdef PROBE_K
    if (tid0 == 0) tsl[PH_UQ + 1] = __builtin_amdgcn_s_memrealtime();
#endif
    if (IN(PH_UKV)) { PHASE_PTRS; pg8::Gemm g{NKV, Wukv, KVRANK, KVRANK, KVRANK}; pg8::DenseOrder S; S.init(R / 256, 2048 / 256, G, blk); pg8::EpiUKV E{KN, Vv};
          pg8::gemm_phase<pg8::EpiUKV, pg8::DenseOrder, true>(lds + RING_OFF, g, S, E, wave0); }
    SEAM(PH_UKV);
    if (IN(PH_ATTN)) { PHASE_PTRS;
        for (int L = blk; L < NB * 8 * (T / 256); L += G) { const int xg = L & 7, jj = L >> 3, pair = xg * 8 + (jj >> 4), qb = jj & 15, b = pair >> 3, h = pair & 7;
            const size_t bh = (size_t)b * 8 + h;
            attn::attn_unit(QN + (bh * T + qb * 256) * 128, QR + (bh * T + qb * 256) * 64, KN + bh * KEYS * 128, KR + (size_t)b * KEYS * 64, Vv + bh * KEYS * 128,
                            AO + ((size_t)b * T + qb * 256) * 1024 + h * 128, KEYS, (LAS char*)(lds + RING_OFF), wave0); }
    }
    SEAM(PH_ATTN);
    if (IN(PH_MLAOUT)) { PHASE_PTRS; pg8::Gemm g{AO, Wmlaout, D, D, D}; pg8::DenseOrder S; S.init(RL / 256, D / 256, G, blk); pg8::EpiPlain E{Ob, D};
        pg8::gemm_phase<pg8::EpiPlain, pg8::DenseOrder, true>(lds + RING_OFF, g, S, E, wave0); }
    SEAM(PH_MLAOUT);
    if (IN(PH_ROWS13)) { PHASE_PTRS; PHASE_IDS; RowArgs a{}; a.xin_lat = out; a.xin_ctx = cx; a.xout_lat = out; a.xout_ctx = cx; a.Y = Ob; a.gy = g1n + 1024; a.gate = mv1 + 2048; a.gh = g1n + 2048; a.scale = mv1 + 4096; a.shift = mv1 + 3072; a.H = H4;
        a.router_w = router_w; a.top_e = top_e; a.top_g = top_g; a.nrows = RL; a.xin_bf = 1; a.xout_bf = 1; a.xout_lat = (float*)(ws + 404 * MiB);
        rows2::stage_router(router_w, lds + RING_OFF, tid, NTHREADS); __syncthreads();
#if MOE_FP8
        a.H8 = (unsigned char*)H4;
        rows2::rows_phase<false, 1, 1, 2, true>(a, gw, NGW, lane, false, lds + RING_OFF); }
#else
        rows2::rows_phase<false, 1, 1, 1, true>(a, gw, NGW, lane, false, lds + RING_OFF); }
#endif
    SEAM(PH_ROWS13);
    if (IN(PH_ROUTE)) { PHASE_PTRS; PHASE_IDS;
        LAS int* sh = (LAS int*)(lds + RING_OFF);
        const int TPB = RL / G, t0 = blk * TPB;
        if (tid < 32) sh[tid] = 0;
        __syncthreads();
        unsigned long long ctot = 0ull, cpre = 0ull;
        for (int t = tid; t < RL; t += NTHREADS) { const int2 e = *(const int2*)(top_e + 2 * t); const unsigned long long inc = (1ull << (8 * e.x)) + (1ull << (8 * e.y)); ctot += inc; if (t < t0) cpre += inc; }
#pragma unroll
        for (int e = 0; e < 8; ++e) { int a = (int)((ctot >> (8 * e)) & 255ull), b2 = (int)((cpre >> (8 * e)) & 255ull);
#pragma unroll
            for (int o = 1; o < 64; o <<= 1) { a += __shfl_xor(a, o); b2 += __shfl_xor(b2, o); }
            if (lane == 0) { __hip_atomic_fetch_add(&sh[e], a, __ATOMIC_RELAXED, __HIP_MEMORY_SCOPE_WORKGROUP); __hip_atomic_fetch_add(&sh[8 + e], b2, __ATOMIC_RELAXED, __HIP_MEMORY_SCOPE_WORKGROUP); } }
        __syncthreads();
        int base_e[8]; { int acc = 0;
#pragma unroll
            for (int e = 0; e < 8; ++e) { base_e[e] = acc; acc += sh[e]; } }
        if (tid < 8) { MISC[16 + tid] = (unsigned)base_e[tid]; MISC[24 + tid] = (unsigned)sh[tid]; if (blk == 0) { meta[tid] = base_e[tid]; meta[8 + tid] = sh[tid]; } }
        int e0 = 0, e1 = 0; const bool act = tid < TPB;
        if (act) { const int2 e = *(const int2*)(top_e + 2 * (t0 + tid)); e0 = e.x; e1 = e.y; }
        int r0 = 0, r1 = 0;
#pragma unroll
        for (int e = 0; e < 8; ++e) { const bool f = act && (e0 == e || e1 == e); const unsigned long long bal = __ballot(f); const int pre = __popcll(bal & ((1ull << lane) - 1ull));
            if (wave == 0 && lane == 0) sh[16 + e] = __popcll(bal);
            if (e0 == e) r0 = pre; if (e1 == e) r1 = pre; }
        __syncthreads();
        if (act) { if (wave == 1) { r0 += sh[16 + e0]; r1 += sh[16 + e1]; }
            int s0 = 0, s1 = 0;
#pragma unroll
            for (int e = 0; e < 8; ++e) { if (e0 == e) s0 = base_e[e] + sh[8 + e] + r0; if (e1 == e) s1 = base_e[e] + sh[8 + e] + r1; }
            sh[32 + 2 * tid] = s0; sh[33 + 2 * tid] = s1; *(int2*)(tslot + 2 * (t0 + tid)) = make_int2(s0, s1); }
        __syncthreads();
        for (int i = wave; i < TPB; i += NWAVES) { const int t = t0 + i; const int s0 = sh[32 + 2 * i], s1 = sh[33 + 2 * i];
#if MOE_FP8
            const unsigned char* H48 = (const unsigned char*)H4; unsigned char* HS8 = (unsigned char*)HS;
            const u32x4 w = *(const u32x4*)(H48 + (size_t)t * D + lane * 16);
            *(u32x4*)(HS8 + (size_t)s0 * D + lane * 16) = w; *(u32x4*)(HS8 + (size_t)s1 * D + lane * 16) = w; }
#else
            const uint4 v0 = *(const uint4*)(H4 + (size_t)t * D + lane * 8), v1 = *(const uint4*)(H4 + (size_t)t * D + 512 + lane * 8);
            *(uint4*)(HS + (size_t)s0 * D + lane * 8) = v0; *(uint4*)(HS + (size_t)s0 * D + 512 + lane * 8) = v1;
            *(uint4*)(HS + (size_t)s1 * D + lane * 8) = v0; *(uint4*)(HS + (size_t)s1 * D + 512 + lane * 8) = v1; }
#endif
    }
    SEAM(PH_ROUTE);
    if (IN(PH_MOEIN)) { PHASE_PTRS;
        { const int t2 = tidx(wave0); if (t2 < 16) MISC[16 + t2] = (unsigned)meta[t2]; }
        __syncthreads();
#if MOE_FP8
        pg8::Gemm g{HS, Wmi, D / 2, D / 2, D / 2}; pg8::MoeOrder S; S.init((const LAS int*)(lds + MISC_OFF + 64), 2 * FFN / 256, G, blk); pg8::EpiSwiglu8 E{(unsigned char*)ACT2, W8_INV};
        pg8::gemm_phase<pg8::EpiSwiglu8, pg8::MoeOrder, true, true>(lds + RING_OFF, g, S, E, wave0); }
#else
        pg8::Gemm g{HS, Wmi, D, D, D}; pg8::MoeOrder S; S.init((const LAS int*)(lds + MISC_OFF + 64), 2 * FFN / 256, G, blk); pg8::EpiSwiglu E{ACT2};
        pg8::gemm_phase<pg8::EpiSwiglu, pg8::MoeOrder, true>(lds + RING_OFF, g, S, E, wave0); }
#endif
    SEAM(PH_MOEIN);
    if (IN(PH_MOEOUT)) { PHASE_PTRS;
        { const int t2 = tidx(wave0); if (t2 < 16) MISC[16 + t2] = (unsigned)meta[t2]; }
        __syncthreads();
#if MOE_FP8
        pg8::Gemm g{ACT2, Wmo, FFN / 2, FFN / 2, FFN / 2}; pg8::MoeOrder S; S.init((const LAS int*)(lds + MISC_OFF + 64), D / 256, G, blk); pg8::EpiPlainS E{YS, D, W8_INV};
        pg8::gemm_phase<pg8::EpiPlainS, pg8::MoeOrder, true, true>(lds + RING_OFF, g, S, E, wave0); }
#else
        pg8::Gemm g{ACT2, Wmo, FFN, FFN, FFN}; pg8::MoeOrder S; S.init((const LAS int*)(lds + MISC_OFF + 64), D / 256, G, blk); pg8::EpiPlain E{YS, D};
        pg8::gemm_phase<pg8::EpiPlain, pg8::MoeOrder, true>(lds + RING_OFF, g, S, E, wave0); }
#endif
    SEAM(PH_MOEOUT);
    if (IN(PH_ROWS17)) { PHASE_PTRS; PHASE_IDS; RowArgs a{}; a.xin_lat = out; a.xin_ctx = cx; a.xout_lat = out; a.xout_ctx = cx; a.Y = YS; a.tok_slot = tslot; a.tok_g = top_g; a.gy = g1n + 3072; a.gate = mv1 + 5120; a.nrows = RL; a.xin_bf = 1; a.xin_lat = (const float*)(ws + 404 * MiB);
#ifdef PROBE_K
        __syncthreads();
        { const float tot = (float)(tsl[PH_ROWS17] - tsl[0]); float fr = 0.f;
#pragma unroll
          for (int k = 0; k < PH_ROWS17; ++k) if ((PROBE_K >> k) & 1) fr += (float)(tsl[k + 1] - tsl[k]);
          a.oscale = 1.f + 2.f * fr / tot; }
#endif
        rows2::rows_phase<false, 2, 2, 0, false>(a, gw, NGW, lane, false, nullptr); }
#undef IN
#undef SEAM
}
#ifndef N_LAUNCH_MODE
#define N_LAUNCH_MODE 1
#endif

static inline dim3 g1(size_t n, int per) { return dim3((unsigned)((n + per - 1) / per)); }
extern "C" void kernel_launch(void* const* d_in, const int* in_sizes, int n_in, void* d_out, int out_size, void* d_ws, size_t ws_size, hipStream_t stream) {
    if (n_in != 22 || out_size != RL * D || ws_size < WS_END) { fprintf(stderr, "kernel_launch: unexpected shapes: n_in %d out %d ws %zu (need %zu)\n", n_in, out_size, ws_size, (size_t)WS_END); return; }
    static int grid = 0;
    if (grid == 0) {
        int dev = 0, cus = 0;
        if (hipGetDevice(&dev) != hipSuccess || hipDeviceGetAttribute(&cus, hipDeviceAttributeMultiprocessorCount, dev) != hipSuccess) { grid = -1; return; }
        if (hipFuncSetAttribute((const void*)mega, hipFuncAttributeMaxDynamicSharedMemorySize, LDS_BYTES) != hipSuccess) { fprintf(stderr, "hipFuncSetAttribute failed\n"); grid = -1; return; }
        int per_cu = 0; (void)hipOccupancyMaxActiveBlocksPerMultiprocessor(&per_cu, (const void*)mega, NTHREADS, LDS_BYTES); (void)hipGetLastError();
        if (per_cu < 1) fprintf(stderr, "occupancy query says %d\n", per_cu);
        grid = cus;
    }
    if (grid < 0) return;
    char* ws = (char*)d_ws; float* out = (float*)d_out;
    float* lg = (float*)(ws + WS_LG); int* meta = (int*)(ws + WS_META);
    bf16_t* HB = (bf16_t*)(ws + WS_HB);
    bf16_t* G[9]; for (int i = 0; i < 9; ++i) G[i] = (bf16_t*)(ws + WS_G0 + i * GSZ);
    float* oret = (float*)(ws + WS_ST + 72 * MiB); float* ohg = (float*)(ws + WS_ST + 140 * MiB);
    bf16_t* QN = (bf16_t*)(ws + WS_QN); bf16_t* QR = (bf16_t*)(ws + WS_QR); bf16_t* KN = (bf16_t*)(ws + WS_KN); bf16_t* KR = (bf16_t*)(ws + WS_KR);
    bf16_t* Vv = (bf16_t*)(ws + WS_V); bf16_t* AO = (bf16_t*)(ws + WS_AO);
    bf16_t* H4 = (bf16_t*)(ws + WS_H4); bf16_t* HS = (bf16_t*)(ws + WS_HS);
    int* top_e = (int*)(ws + WS_TOPE); int* rank = (int*)(ws + WS_RANK); int* tslot = (int*)(ws + WS_TSLOT);
    (void)hipMemsetAsync(ws + WS_CTL, 0, 1 * MiB, stream);
    Args a{}; for (int i = 0; i < 22; ++i) a.in[i] = (const float*)d_in[i]; a.out = out; a.ws = (unsigned char*)d_ws;
    auto run = [&](int lo, int hi) { a.ph_lo = lo; a.ph_hi = hi; hipLaunchKernelGGL(mega, dim3(grid), dim3(NTHREADS), LDS_BYTES, stream, a); };
#if N_LAUNCH_MODE == 1
    run(0, PH_COUNT);
#else
    for (int p = PH_SETUP; p < PH_COUNT; ++p) run(p, p + 1);
#endif
}
```

```cpp
#include <hip/hip_runtime.h>
#include <cstdint>
#include <cstdio>

constexpr int NB = 8, T = 4096, CT = 256, D = 1024;
constexpr int RL = NB * T;
constexpr int RC = NB * CT;
constexpr int R = RL + RC;
constexpr int KEYS = CT + T;
constexpr int MIXC = 4608, FFN = 2816, NEXP = 8;
constexpr int DOWNC = 704, DOWNP = 768, QRANK = 384, KVRANK = 256;
constexpr float EPS = 1e-6f;
constexpr int SLOTS = 2 * RL;

typedef unsigned short bf16_t;
__host__ __device__ __forceinline__ float bf2f(bf16_t v) { unsigned u = ((unsigned)v) << 16; float f; __builtin_memcpy(&f, &u, 4); return f; }
__host__ __device__ __forceinline__ bf16_t f2bf(float f) { unsigned u; __builtin_memcpy(&u, &f, 4); return (bf16_t)((u + 0x7fffu + ((u >> 16) & 1u)) >> 16); }
__device__ __forceinline__ float siluf(float v) { return v / (1.f + expf(-v)); }
__device__ __forceinline__ float wave_sum(float v) {
#define WS_DPP(x, ctrl, rm, bc) __builtin_bit_cast(float, __builtin_amdgcn_update_dpp(0, __builtin_bit_cast(int, (x)), (ctrl), (rm), 0xf, (bc)))
    v += WS_DPP(v, 0x111, 0xf, true); v += WS_DPP(v, 0x112, 0xf, true); v += WS_DPP(v, 0x114, 0xf, true); v += WS_DPP(v, 0x118, 0xf, true);
    v += WS_DPP(v, 0x142, 0xa, false); v += WS_DPP(v, 0x143, 0xc, false);
#undef WS_DPP
    return __builtin_bit_cast(float, __builtin_amdgcn_readlane(__builtin_bit_cast(int, v), 63));
}

constexpr size_t MiB = 1u << 20;
constexpr size_t WS_CTL = 0;
constexpr size_t WS_MODV = 512 * 1024;
constexpr size_t WS_LB = 1 * MiB + 512 * 1024;
constexpr size_t WS_LG = WS_LB + 4096;
constexpr size_t WS_META = WS_LB + 8192;
constexpr size_t WS_ROPE_RC = 2 * MiB;
constexpr size_t WS_ROPE_RS = 3 * MiB;
constexpr size_t WS_ROPE_MC = 4 * MiB;
constexpr size_t WS_ROPE_MS = 4 * MiB + 512 * 1024;
constexpr size_t WS_CX = 5 * MiB;
constexpr size_t WS_TOPE = 5 * MiB;
constexpr size_t WS_TOPG = 5 * MiB + 256 * 1024;
constexpr size_t WS_RANK = 5 * MiB + 512 * 1024;
constexpr size_t WS_TSLOT = 5 * MiB + 768 * 1024;
constexpr size_t WS_WSMALL = 13 * MiB;
constexpr size_t WS_HB = 48 * MiB;
constexpr size_t WS_G0 = 116 * MiB;
constexpr size_t GSZ = 34 * MiB;
constexpr size_t WS_ST = 422 * MiB;
constexpr size_t WS_OX = 116 * MiB;
constexpr size_t WS_ACT = 184 * MiB;
constexpr size_t WS_DOWN = 116 * MiB;
constexpr size_t WS_QN = 404 * MiB;
constexpr size_t WS_QR = 231 * MiB;
constexpr size_t WS_KN = 263 * MiB;
constexpr size_t WS_KR = 331 * MiB;
constexpr size_t WS_V = 336 * MiB;
constexpr size_t WS_AO = 468 * MiB;
constexpr size_t WS_O = 167 * MiB;
constexpr size_t WS_NQ = 167 * MiB;
constexpr size_t WS_NKV = 193 * MiB;
constexpr size_t WS_TMP1 = 575 * MiB;
constexpr size_t WS_H4 = 508 * MiB;
constexpr size_t WS_HS = 13 * MiB;
constexpr size_t WS_ACT2 = 145 * MiB;
constexpr size_t WS_YS = 13 * MiB;
constexpr size_t WS_END = 704 * MiB;

__global__ __launch_bounds__(256) void k_mod(const float* __restrict__ c, const float* __restrict__ cctx, const float* __restrict__ mod_w,
                                             const float* __restrict__ mod_b, float* __restrict__ modv) {
    __shared__ float sc[9 * 1024];
    for (int i = threadIdx.x; i < 9 * 1024; i += 256) { int r = i >> 10, k = i & 1023; float v = r < 8 ? c[r * 1024 + k] : cctx[k]; sc[i] = siluf(v); }
    __syncthreads();
    int gid = blockIdx.x * 256 + threadIdx.x; int l = gid / 6144, n = gid % 6144;
    float acc[9];
#pragma unroll
    for (int r = 0; r < 9; ++r) acc[r] = 0.f;
    const float* w = mod_w + (size_t)l * 1024 * 6144 + n;
    for (int k = 0; k < 1024; ++k) { float wv = w[(size_t)k * 6144];
#pragma unroll
        for (int r = 0; r < 9; ++r) acc[r] += sc[r * 1024 + k] * wv; }
    float bb = mod_b[l * 6144 + n];
#pragma unroll
    for (int r = 0; r < 9; ++r) modv[((size_t)l * 9 + r) * 6144 + n] = acc[r] + bb;
}
__device__ __forceinline__ void tables_body(const int gid, const float* __restrict__ lb_logit, const float* __restrict__ decay_logit, float* rc, float* rs, float* mc, float* ms, float* lb, float* lg) {
    if (gid < 4096 * 64) { int t = gid >> 6, j = gid & 63, i = j & 31; float pos = (float)(j < 32 ? (t >> 6) : (t & 63));
        float inv = powf(10000.f, -(float)i / 32.f); float a = pos * inv; rc[gid] = cosf(a); rs[gid] = sinf(a); }
    if (gid < 4096 * 32) { int t = gid >> 5, j = gid & 31, i = j & 15; float pos = (float)(j < 16 ? (t >> 6) : (t & 63));
        float inv = powf(10000.f, -(float)i / 16.f); float a = pos * inv; mc[gid] = cosf(a); ms[gid] = sinf(a); }
    if (gid < 512) { float l0 = lb_logit[gid], l1 = lb_logit[512 + gid]; float m = fmaxf(l0, l1); float e0 = expf(l0 - m), e1 = expf(l1 - m); lb[gid] = e0 / (e0 + e1); }
    if (gid < 8) { float x = decay_logit[gid]; lg[gid] = fminf(x, 0.f) - log1pf(expf(-fabsf(x))); }
}

__global__ __launch_bounds__(256) void k_tables(const float* __restrict__ lb_logit, const float* __restrict__ decay_logit, float* rc, float* rs, float* mc, float* ms, float* lb, float* lg) {
    tables_body(blockIdx.x * 256 + threadIdx.x, lb_logit, decay_logit, rc, rs, mc, ms, lb, lg);
}

struct RowArgs {
    const float* xin_lat; const float* xin_ctx;
    float* xout_lat; float* xout_ctx;
    const bf16_t* Y;
    const int* tok_slot; const float* tok_g;
    const float* gy;
    const float* gate;
    const float* gh; const float* scale; const float* shift;
    bf16_t* H;
    unsigned char* H8;
    const float* router_w; int* top_e; float* top_g;
    int nrows; float oscale; int xin_bf, xout_bf;
};
__device__ __forceinline__ void rows_body(const RowArgs& a, const int r, const int lane) {
    const bool lat = r < RL; const int mr = lat ? (r >> 12) : 8;
    const float* xi = lat ? a.xin_lat + (size_t)r * D : a.xin_ctx + (size_t)(r - RL) * D;
    float x[16];
    if (a.xin_bf) { const bf16_t* xb = lat ? (const bf16_t*)a.xin_lat + (size_t)r * D : (const bf16_t*)a.xin_ctx + (size_t)(r - RL) * D;
#pragma unroll
        for (int j = 0; j < 4; ++j) { const uint2 u = *(const uint2*)(xb + j * 256 + lane * 4); x[4 * j] = bf2f(u.x & 0xffff); x[4 * j + 1] = bf2f(u.x >> 16); x[4 * j + 2] = bf2f(u.y & 0xffff); x[4 * j + 3] = bf2f(u.y >> 16); }
    } else {
#pragma unroll
        for (int j = 0; j < 4; ++j) { float4 v = *(const float4*)(xi + j * 256 + lane * 4); x[4 * j] = v.x; x[4 * j + 1] = v.y; x[4 * j + 2] = v.z; x[4 * j + 3] = v.w; }
    }
    if (a.Y) {
        float y[16];
        if (a.tok_slot) {
            const int s0 = a.tok_slot[2 * r], s1 = a.tok_slot[2 * r + 1]; const float g0 = a.tok_g[2 * r], g1 = a.tok_g[2 * r + 1];
#pragma unroll
            for (int j = 0; j < 4; ++j) { const uint2 u0 = *(const uint2*)(a.Y + (size_t)s0 * D + j * 256 + lane * 4); const uint2 u1 = *(const uint2*)(a.Y + (size_t)s1 * D + j * 256 + lane * 4);
                y[4 * j] = g0 * bf2f(u0.x & 0xffff) + g1 * bf2f(u1.x & 0xffff); y[4 * j + 1] = g0 * bf2f(u0.x >> 16) + g1 * bf2f(u1.x >> 16);
                y[4 * j + 2] = g0 * bf2f(u0.y & 0xffff) + g1 * bf2f(u1.y & 0xffff); y[4 * j + 3] = g0 * bf2f(u0.y >> 16) + g1 * bf2f(u1.y >> 16); }
        } else {
#pragma unroll
            for (int j = 0; j < 4; ++j) { const uint2 u = *(const uint2*)(a.Y + (size_t)r * D + j * 256 + lane * 4);
                y[4 * j] = bf2f(u.x & 0xffff); y[4 * j + 1] = bf2f(u.x >> 16); y[4 * j + 2] = bf2f(u.y & 0xffff); y[4 * j + 3] = bf2f(u.y >> 16); }
        }
        float ss = 0.f;
#pragma unroll
        for (int i = 0; i < 16; ++i) ss += y[i] * y[i];
        ss = wave_sum(ss); const float ry = rsqrtf(ss * (1.f / D) + EPS);
        float* xo = lat ? a.xout_lat + (size_t)r * D : a.xout_ctx + (size_t)(r - RL) * D;
#pragma unroll
        for (int j = 0; j < 4; ++j) { const int c = j * 256 + lane * 4; const float4 g = *(const float4*)(a.gy + c); const float4 gt = *(const float4*)(a.gate + (size_t)mr * 6144 + c);
            x[4 * j] += gt.x * (y[4 * j] * ry * g.x); x[4 * j + 1] += gt.y * (y[4 * j + 1] * ry * g.y); x[4 * j + 2] += gt.z * (y[4 * j + 2] * ry * g.z); x[4 * j + 3] += gt.w * (y[4 * j + 3] * ry * g.w);
            if (a.oscale != 0.f) { x[4 * j] *= a.oscale; x[4 * j + 1] *= a.oscale; x[4 * j + 2] *= a.oscale; x[4 * j + 3] *= a.oscale; }
            if (a.xout_bf) { bf16_t* xob = lat ? (bf16_t*)a.xout_lat + (size_t)r * D : (bf16_t*)a.xout_ctx + (size_t)(r - RL) * D;
                uint2 o; o.x = (unsigned)f2bf(x[4 * j]) | ((unsigned)f2bf(x[4 * j + 1]) << 16); o.y = (unsigned)f2bf(x[4 * j + 2]) | ((unsigned)f2bf(x[4 * j + 3]) << 16); *(uint2*)(xob + c) = o;
                x[4 * j] = bf2f((bf16_t)(o.x & 0xffff)); x[4 * j + 1] = bf2f((bf16_t)(o.x >> 16)); x[4 * j + 2] = bf2f((bf16_t)(o.y & 0xffff)); x[4 * j + 3] = bf2f((bf16_t)(o.y >> 16)); }
            else *(float4*)(xo + c) = make_float4(x[4 * j], x[4 * j + 1], x[4 * j + 2], x[4 * j + 3]); }
    }
    if (a.gh) {
        float ss = 0.f;
#pragma unroll
        for (int i = 0; i < 16; ++i) ss += x[i] * x[i];
        ss = wave_sum(ss); const float rx = rsqrtf(ss * (1.f / D) + EPS);
        float h[16];
#pragma unroll
        for (int j = 0; j < 4; ++j) { const int c = j * 256 + lane * 4; const float4 g = *(const float4*)(a.gh + c); const float4 sc = *(const float4*)(a.scale + (size_t)mr * 6144 + c); const float4 sh = *(const float4*)(a.shift + (size_t)mr * 6144 + c);
            h[4 * j] = x[4 * j] * rx * g.x * (1.f + sc.x) + sh.x; h[4 * j + 1] = x[4 * j + 1] * rx * g.y * (1.f + sc.y) + sh.y;
            h[4 * j + 2] = x[4 * j + 2] * rx * g.z * (1.f + sc.z) + sh.z; h[4 * j + 3] = x[4 * j + 3] * rx * g.w * (1.f + sc.w) + sh.w;
            if (a.H8) { unsigned w = 0u; w = (unsigned)__builtin_amdgcn_cvt_pk_fp8_f32(fminf(fmaxf(h[4 * j], -448.f), 448.f), fminf(fmaxf(h[4 * j + 1], -448.f), 448.f), (int)w, false);
                w = (unsigned)__builtin_amdgcn_cvt_pk_fp8_f32(fminf(fmaxf(h[4 * j + 2], -448.f), 448.f), fminf(fmaxf(h[4 * j + 3], -448.f), 448.f), (int)w, true); *(unsigned*)(a.H8 + (size_t)r * D + c) = w; }
            else { uint2 o; o.x = (unsigned)f2bf(h[4 * j]) | ((unsigned)f2bf(h[4 * j + 1]) << 16); o.y = (unsigned)f2bf(h[4 * j + 2]) | ((unsigned)f2bf(h[4 * j + 3]) << 16);
            *(uint2*)(a.H + (size_t)r * D + c) = o; } }
        if (a.router_w) {
            float lg[8];
#pragma unroll
            for (int e = 0; e < 8; ++e) lg[e] = 0.f;
#pragma unroll
            for (int j = 0; j < 4; ++j)
#pragma unroll
                for (int i = 0; i < 4; ++i) { const int c = j * 256 + lane * 4 + i; const float4 w0 = *(const float4*)(a.router_w + (size_t)c * 8); const float4 w1 = *(const float4*)(a.router_w + (size_t)c * 8 + 4); const float hv = h[4 * j + i];
                    lg[0] += hv * w0.x; lg[1] += hv * w0.y; lg[2] += hv * w0.z; lg[3] += hv * w0.w; lg[4] += hv * w1.x; lg[5] += hv * w1.y; lg[6] += hv * w1.z; lg[7] += hv * w1.w; }
#pragma unroll
            for (int e = 0; e < 8; ++e) lg[e] = wave_sum(lg[e]);
            if (lane == 0) {
                int e0 = 0; float v0 = lg[0];
#pragma unroll
                for (int e = 1; e < 8; ++e) if (lg[e] > v0) { v0 = lg[e]; e0 = e; }
                int e1 = -1; float v1 = -3.0e38f;
#pragma unroll
                for (int e = 0; e < 8; ++e) if (e != e0 && lg[e] > v1) { v1 = lg[e]; e1 = e; }
                if (e1 < 0) { e1 = (e0 + 1) & 7; v1 = v0; }
                const float g0 = 1.f / (1.f + expf(v1 - v0));
                a.top_e[2 * r] = e0; a.top_e[2 * r + 1] = e1; a.top_g[2 * r] = g0; a.top_g[2 * r + 1] = 1.f - g0;
            }
        }
    }
}

__global__ __launch_bounds__(256) void k_rows(RowArgs a) {
    const int lane = threadIdx.x & 63; const int r = blockIdx.x * 4 + (threadIdx.x >> 6);
    if (r >= a.nrows) return;
    rows_body(a, r, lane);
}

template <int MODE>
__global__ __launch_bounds__(256) void k_sgemm(const bf16_t* __restrict__ A, int lda, const float* __restrict__ W, int ldw, void* __restrict__ Cv, int ldc,
                                               int M, int N, int K, const int* __restrict__ meta, int e, size_t wstride, int row_off, int row_cap) {
    constexpr int NBW = (MODE == 2) ? 2 : 1;
    int arow0 = 0;
    if (meta) { arow0 = meta[e] + row_off; int cnt = meta[8 + e] - row_off; M = cnt < row_cap ? cnt : row_cap; W += (size_t)e * wstride; }
    const int bm = blockIdx.y * 128, bn = blockIdx.x * 64;
    if (bm >= M) return;
    __shared__ float As[16][132]; __shared__ float Bs[NBW][16][68];
    const int tid = threadIdx.x, tx = tid & 15, ty = tid >> 4;
    float acc[NBW][8][4];
#pragma unroll
    for (int w = 0; w < NBW; ++w)
#pragma unroll
        for (int i = 0; i < 8; ++i)
#pragma unroll
            for (int j = 0; j < 4; ++j) acc[w][i][j] = 0.f;
    const int ar = tid >> 1, ak = (tid & 1) * 8; const bool aval = (bm + ar) < M;
    const bf16_t* ap = A + (size_t)(arow0 + bm + (aval ? ar : 0)) * lda + ak;
    const int bk = tid >> 4, bc = (tid & 15) * 4; const bool bval = (bn + bc) < N;
    for (int k0 = 0; k0 < K; k0 += 16) {
        uint4 av = aval ? *(const uint4*)(ap + k0) : make_uint4(0, 0, 0, 0);
        As[ak + 0][ar] = bf2f(av.x & 0xffff); As[ak + 1][ar] = bf2f(av.x >> 16); As[ak + 2][ar] = bf2f(av.y & 0xffff); As[ak + 3][ar] = bf2f(av.y >> 16);
        As[ak + 4][ar] = bf2f(av.z & 0xffff); As[ak + 5][ar] = bf2f(av.z >> 16); As[ak + 6][ar] = bf2f(av.w & 0xffff); As[ak + 7][ar] = bf2f(av.w >> 16);
#pragma unroll
        for (int w = 0; w < NBW; ++w) { float4 bv = bval ? *(const float4*)(W + (size_t)(k0 + bk) * ldw + bn + bc + w * N) : make_float4(0, 0, 0, 0); *(float4*)&Bs[w][bk][bc] = bv; }
        __syncthreads();
#pragma unroll
        for (int kk = 0; kk < 16; ++kk) {
            float a[8]; const float4 a0 = *(const float4*)&As[kk][ty * 8], a1 = *(const float4*)&As[kk][ty * 8 + 4];
            a[0] = a0.x; a[1] = a0.y; a[2] = a0.z; a[3] = a0.w; a[4] = a1.x; a[5] = a1.y; a[6] = a1.z; a[7] = a1.w;
#pragma unroll
            for (int w = 0; w < NBW; ++w) { const float4 b = *(const float4*)&Bs[w][kk][tx * 4];
#pragma unroll
                for (int i = 0; i < 8; ++i) { acc[w][i][0] += a[i] * b.x; acc[w][i][1] += a[i] * b.y; acc[w][i][2] += a[i] * b.z; acc[w][i][3] += a[i] * b.w; } }
        }
        __syncthreads();
    }
#pragma unroll
    for (int i = 0; i < 8; ++i) { const int rr = bm + ty * 8 + i; if (rr >= M) continue;
#pragma unroll
        for (int j = 0; j < 4; ++j) { const int cc = bn + tx * 4 + j; if (cc >= N) continue;
            const size_t o = (size_t)(arow0 + rr) * ldc + cc;
            if (MODE == 0) ((float*)Cv)[o] = acc[0][i][j];
            else if (MODE == 1) ((bf16_t*)Cv)[o] = f2bf(acc[0][i][j]);
            else ((bf16_t*)Cv)[o] = f2bf(siluf(acc[0][i][j]) * acc[NBW - 1][i][j]); } }
}

__global__ __launch_bounds__(256) void k_mixact(const float* __restrict__ tmp, bf16_t* __restrict__ G, int grp, const float* __restrict__ rc, const float* __restrict__ rs, const float* __restrict__ lb) {
    const size_t gid = (size_t)blockIdx.x * 256 + threadIdx.x; if (gid >= (size_t)R * 512) return;
    const int r = (int)(gid >> 9), c = (int)(gid & 511); float v = tmp[gid], o;
    if (grp <= 1) {
        const int j = c & 127, jj = j & 63; const float other = tmp[(size_t)r * 512 + (c ^ 64)];
        float x1 = j < 64 ? v : other, x2 = j < 64 ? other : v;
        if (grp == 1) { x1 *= 0.08838834764831845f; x2 *= 0.08838834764831845f; }
        if (r < RL) { const int t = r & 4095; const float cs = rc[t * 64 + jj], sn = rs[t * 64 + jj]; o = j < 64 ? x1 * cs - x2 * sn : x1 * sn + x2 * cs; }
        else o = j < 64 ? x1 : x2;
    } else if (grp == 2 || grp == 7) o = v;
    else if (grp == 3 || grp == 4 || grp == 8) o = siluf(v);
    else { const float l = lb[c]; o = (1.f - l) / (1.f + expf(v)); }
    G[gid] = f2bf(o);
}
template <int ALGO>
__global__ __launch_bounds__(128) void k_scan_naive(const bf16_t* __restrict__ Q, const bf16_t* __restrict__ Kf, const bf16_t* __restrict__ Kb, const bf16_t* __restrict__ V,
                                                    const float* __restrict__ lg, float* __restrict__ O) {
    const int b = blockIdx.x >> 2, h = blockIdx.x & 3, e = threadIdx.x;
    __shared__ float sq[32][128]; __shared__ float sk[32][128];
    for (int dir = 0; dir < 2; ++dir) {
        const bf16_t* Kp = dir ? Kb : Kf; const float gamma = (ALGO == 0) ? expf(lg[dir * 4 + h]) : 0.f;
        float S[128];
#pragma unroll
        for (int d = 0; d < 128; ++d) S[d] = 0.f;
        for (int p0 = 0; p0 < KEYS; p0 += 32) {
            __syncthreads();
            for (int i = threadIdx.x; i < 32 * 128; i += 128) { const int s = i >> 7, d = i & 127; const int p = p0 + s;
                const int row = p < CT ? (RL + b * CT + (dir ? CT - 1 - p : p)) : (b * T + (dir ? T - 1 - (p - CT) : (p - CT)));
                sq[s][d] = bf2f(Q[(size_t)row * 512 + h * 128 + d]); sk[s][d] = bf2f(Kp[(size_t)row * 512 + h * 128 + d]); }
            __syncthreads();
            for (int s = 0; s < 32; ++s) { const int p = p0 + s;
                const int row = p < CT ? (RL + b * CT + (dir ? CT - 1 - p : p)) : (b * T + (dir ? T - 1 - (p - CT) : (p - CT)));
                const float v = bf2f(V[(size_t)row * 512 + h * 128 + e]); float o = 0.f;
#pragma unroll
                for (int d = 0; d < 128; ++d) { const float kd = sk[s][d]; const float dec = (ALGO == 0) ? gamma : (1.f - kd); S[d] = dec * S[d] + kd * v; o += sq[s][d] * S[d]; }
                float* op = O + (size_t)row * 512 + h * 128 + e; if (dir == 0) *op = o; else *op += o; }
        }
    }
}
__global__ __launch_bounds__(256) void k_merge(const float* __restrict__ Oret, const float* __restrict__ Ohg, const bf16_t* __restrict__ AG, const bf16_t* __restrict__ BG, bf16_t* __restrict__ Y, int part_sel) {
    const int lane = threadIdx.x & 63; const size_t w = (size_t)blockIdx.x * 4 + (threadIdx.x >> 6); if (w >= (size_t)R * 8) return;
    const int r = (int)(w >> 3), part = (int)((w >> 2) & 1), h = (int)(w & 3);
    if (part_sel >= 0 && part != part_sel) return;
    const float* src = (part ? Ohg : Oret) + (size_t)r * 512 + h * 128; const bf16_t* g = (part ? BG : AG) + (size_t)r * 512 + h * 128;
    const float v0 = src[lane * 2], v1 = src[lane * 2 + 1]; const float ss = wave_sum(v0 * v0 + v1 * v1); const float rr = rsqrtf(ss * (1.f / 128.f) + EPS);
    bf16_t* y = Y + (size_t)r * 1024 + part * 512 + h * 128;
    y[lane * 2] = f2bf(v0 * rr * bf2f(g[lane * 2])); y[lane * 2 + 1] = f2bf(v1 * rr * bf2f(g[lane * 2 + 1]));
}

__device__ __forceinline__ void mla_prep_body(const int r, const int lane, const bf16_t* __restrict__ DOWN, const float* __restrict__ gq, const float* __restrict__ gkv, const float* __restrict__ mc, const float* __restrict__ ms,
                                                  bf16_t* __restrict__ NQ, bf16_t* __restrict__ NKV, bf16_t* __restrict__ KR) {
    const bf16_t* d = DOWN + (size_t)r * DOWNP;
    float q[6]; float ss = 0.f;
#pragma unroll
    for (int i = 0; i < 6; ++i) { q[i] = bf2f(d[lane + 64 * i]); ss += q[i] * q[i]; }
    ss = wave_sum(ss); const float rq = rsqrtf(ss * (1.f / 384.f) + EPS);
#pragma unroll
    for (int i = 0; i < 6; ++i) NQ[(size_t)r * 384 + lane + 64 * i] = f2bf(q[i] * rq * gq[lane + 64 * i]);
    float k[4]; ss = 0.f;
#pragma unroll
    for (int i = 0; i < 4; ++i) { k[i] = bf2f(d[384 + lane + 64 * i]); ss += k[i] * k[i]; }
    ss = wave_sum(ss); const float rk = rsqrtf(ss * (1.f / 256.f) + EPS);
#pragma unroll
    for (int i = 0; i < 4; ++i) NKV[(size_t)r * 256 + lane + 64 * i] = f2bf(k[i] * rk * gkv[lane + 64 * i]);
    const float x1 = bf2f(d[640 + (lane & 31)]), x2 = bf2f(d[672 + (lane & 31)]);
    const bool lat = r < RL; const int b = lat ? (r >> 12) : ((r - RL) >> 8); const int key = lat ? CT + (r & 4095) : ((r - RL) & 255);
    float o;
    if (lat) { const int t = r & 4095; const float cs = mc[t * 32 + (lane & 31)], sn = ms[t * 32 + (lane & 31)]; o = lane < 32 ? x1 * cs - x2 * sn : x1 * sn + x2 * cs; }
    else o = lane < 32 ? x1 : x2;
    KR[((size_t)b * KEYS + key) * 64 + lane] = f2bf(o);
}
__global__ __launch_bounds__(256) void k_mla_prep(const bf16_t* __restrict__ DOWN, const float* __restrict__ gq, const float* __restrict__ gkv, const float* __restrict__ mc, const float* __restrict__ ms,
                                                  bf16_t* __restrict__ NQ, bf16_t* __restrict__ NKV, bf16_t* __restrict__ KR) {
    const int lane = threadIdx.x & 63; const int r = blockIdx.x * 4 + (threadIdx.x >> 6); if (r >= R) return;
    mla_prep_body(r, lane, DOWN, gq, gkv, mc, ms, NQ, NKV, KR);
}
__global__ __launch_bounds__(256) void k_qsplit(const float* __restrict__ tmp, int r0, int nrows, const float* __restrict__ mc, const float* __restrict__ ms, bf16_t* __restrict__ QN, bf16_t* __restrict__ QR) {
    const size_t gid = (size_t)blockIdx.x * 256 + threadIdx.x; if (gid >= (size_t)nrows * 1536) return;
    const int rr = (int)(gid / 1536), c = (int)(gid % 1536), h = c / 192, j = c % 192; const int r = r0 + rr, b = r >> 12, t = r & 4095;
    const float v = tmp[gid];
    if (j < 128) QN[(((size_t)b * 8 + h) * T + t) * 128 + j] = f2bf(v);
    else { const int jr = j - 128, jj = jr & 31; const float other = tmp[(size_t)rr * 1536 + h * 192 + 128 + (jr ^ 32)];
        const float x1 = jr < 32 ? v : other, x2 = jr < 32 ? other : v; const float cs = mc[t * 32 + jj], sn = ms[t * 32 + jj];
        QR[(((size_t)b * 8 + h) * T + t) * 64 + jr] = f2bf(jr < 32 ? x1 * cs - x2 * sn : x1 * sn + x2 * cs); }
}
__global__ __launch_bounds__(256) void k_kvsplit(const float* __restrict__ tmp, int r0, int nrows, bf16_t* __restrict__ KN, bf16_t* __restrict__ Vv) {
    const size_t gid = (size_t)blockIdx.x * 256 + threadIdx.x; if (gid >= (size_t)nrows * 2048) return;
    const int rr = (int)(gid >> 11), c = (int)(gid & 2047), h = c >> 8, j = c & 255; const int r = r0 + rr;
    const bool lat = r < RL; const int b = lat ? (r >> 12) : ((r - RL) >> 8); const int key = lat ? CT + (r & 4095) : ((r - RL) & 255);
    bf16_t* dst = (j < 128 ? KN : Vv) + (((size_t)b * 8 + h) * KEYS + key) * 128 + (j & 127);
    *dst = f2bf(tmp[gid]);
}
__global__ __launch_bounds__(256) void k_attn_naive(const bf16_t* __restrict__ QN, const bf16_t* __restrict__ QR, const bf16_t* __restrict__ KN, const bf16_t* __restrict__ KR, const bf16_t* __restrict__ Vv, bf16_t* __restrict__ AO) {
    __shared__ float sq[2][192]; __shared__ float sc[2][KEYS]; __shared__ float red[2][4];
    const int tid = threadIdx.x; const int qb = blockIdx.x % (T / 2), h = (blockIdx.x / (T / 2)) & 7, b = blockIdx.x / (T / 2 * 8);
    const int t0 = qb * 2; const size_t bh = (size_t)b * 8 + h;
    for (int i = tid; i < 2 * 192; i += 256) { const int q = i / 192, j = i % 192; sq[q][j] = j < 128 ? bf2f(QN[(bh * T + t0 + q) * 128 + j]) : bf2f(QR[(bh * T + t0 + q) * 64 + j - 128]); }
    __syncthreads();
    const float scale = 0.07216878364870322f;
    float m0 = -3e38f, m1 = -3e38f;
    for (int key = tid; key < KEYS; key += 256) {
        const uint4* kn = (const uint4*)(KN + (bh * KEYS + key) * 128); const uint4* kr = (const uint4*)(KR + ((size_t)b * KEYS + key) * 64);
        float s0 = 0.f, s1 = 0.f;
        for (int c = 0; c < 24; ++c) { const uint4 u = c < 16 ? kn[c] : kr[c - 16]; const int j = c * 8;
            const float k0 = bf2f(u.x & 0xffff), k1 = bf2f(u.x >> 16), k2 = bf2f(u.y & 0xffff), k3 = bf2f(u.y >> 16), k4 = bf2f(u.z & 0xffff), k5 = bf2f(u.z >> 16), k6 = bf2f(u.w & 0xffff), k7 = bf2f(u.w >> 16);
            s0 += sq[0][j] * k0 + sq[0][j + 1] * k1 + sq[0][j + 2] * k2 + sq[0][j + 3] * k3 + sq[0][j + 4] * k4 + sq[0][j + 5] * k5 + sq[0][j + 6] * k6 + sq[0][j + 7] * k7;
            s1 += sq[1][j] * k0 + sq[1][j + 1] * k1 + sq[1][j + 2] * k2 + sq[1][j + 3] * k3 + sq[1][j + 4] * k4 + sq[1][j + 5] * k5 + sq[1][j + 6] * k6 + sq[1][j + 7] * k7; }
        s0 *= scale; s1 *= scale; sc[0][key] = s0; sc[1][key] = s1; m0 = fmaxf(m0, s0); m1 = fmaxf(m1, s1);
    }
#pragma unroll
    for (int o = 1; o < 64; o <<= 1) { m0 = fmaxf(m0, __shfl_xor(m0, o)); m1 = fmaxf(m1, __shfl_xor(m1, o)); }
    if ((tid & 63) == 0) { red[0][tid >> 6] = m0; red[1][tid >> 6] = m1; }
    __syncthreads();
    m0 = fmaxf(fmaxf(red[0][0], red[0][1]), fmaxf(red[0][2], red[0][3])); m1 = fmaxf(fmaxf(red[1][0], red[1][1]), fmaxf(red[1][2], red[1][3]));
    __syncthreads();
    float l0 = 0.f, l1 = 0.f;
    for (int key = tid; key < KEYS; key += 256) { const float p0 = expf(sc[0][key] - m0), p1 = expf(sc[1][key] - m1); sc[0][key] = p0; sc[1][key] = p1; l0 += p0; l1 += p1; }
    l0 = wave_sum(l0); l1 = wave_sum(l1);
    if ((tid & 63) == 0) { red[0][tid >> 6] = l0; red[1][tid >> 6] = l1; }
    __syncthreads();
    l0 = red[0][0] + red[0][1] + red[0][2] + red[0][3]; l1 = red[1][0] + red[1][1] + red[1][2] + red[1][3];
    const int q = tid >> 7, d = tid & 127; const float* p = sc[q]; float o = 0.f;
    const bf16_t* vp = Vv + bh * KEYS * 128 + d;
    for (int key = 0; key < KEYS; ++key) o += p[key] * bf2f(vp[(size_t)key * 128]);
    AO[((size_t)b * T + t0 + q) * 1024 + h * 128 + d] = f2bf(o / (q ? l1 : l0));
}

__global__ __launch_bounds__(1024) void k_route_rank(const int* __restrict__ top_e, int* __restrict__ rank, int* __restrict__ meta) {
    __shared__ int ws[16]; __shared__ int running;
    const int e = blockIdx.x, tid = threadIdx.x, lane = tid & 63, wid = tid >> 6;
    if (tid == 0) running = 0;
    __syncthreads();
    for (int t0 = 0; t0 < RL; t0 += 1024) { const int t = t0 + tid; const int e0 = top_e[2 * t], e1 = top_e[2 * t + 1]; const int f = (e0 == e || e1 == e) ? 1 : 0;
        const unsigned long long bal = __ballot(f); const int pre = __popcll(bal & ((1ull << lane) - 1ull));
        if (lane == 0) ws[wid] = __popcll(bal);
        __syncthreads();
        int off = 0; for (int w = 0; w < wid; ++w) off += ws[w];
        int tot = 0; for (int w = 0; w < 16; ++w) tot += ws[w];
        const int base = running;
        if (f) rank[2 * t + (e0 == e ? 0 : 1)] = base + off + pre;
        __syncthreads();
        if (tid == 0) running = base + tot;
        __syncthreads();
    }
    if (tid == 0) meta[8 + e] = running;
}
__global__ void k_route_base(int* meta) { if (threadIdx.x == 0) { int s = 0; for (int e = 0; e < 8; ++e) { meta[e] = s; s += meta[8 + e]; } } }
__global__ __launch_bounds__(256) void k_gather(const bf16_t* __restrict__ H4, const int* __restrict__ top_e, const int* __restrict__ rank, const int* __restrict__ meta, bf16_t* __restrict__ HS, int* __restrict__ tok_slot) {
    const int lane = threadIdx.x & 63; const int t = blockIdx.x * 4 + (threadIdx.x >> 6); if (t >= RL) return;
    const uint4 v0 = *(const uint4*)(H4 + (size_t)t * D + lane * 8), v1 = *(const uint4*)(H4 + (size_t)t * D + 512 + lane * 8);
#pragma unroll
    for (int k = 0; k < 2; ++k) { const int e = top_e[2 * t + k]; const int slot = meta[e] + rank[2 * t + k];
        *(uint4*)(HS + (size_t)slot * D + lane * 8) = v0; *(uint4*)(HS + (size_t)slot * D + 512 + lane * 8) = v1;
        if (lane == 0) tok_slot[2 * t + k] = slot; }
}


namespace rows2 {
#define RLAS __attribute__((address_space(3)))
typedef unsigned ru2 __attribute__((ext_vector_type(2)));
typedef float rf4 __attribute__((ext_vector_type(4)));
typedef float rf2 __attribute__((ext_vector_type(2)));
typedef int ri2 __attribute__((ext_vector_type(2)));
typedef float rf2_cv __attribute__((ext_vector_type(2))); typedef __bf16 rb2_cv __attribute__((ext_vector_type(2)));
__device__ __forceinline__ unsigned pk_bf16(float lo, float hi) { const rf2_cv v = {lo, hi}; const rb2_cv b = __builtin_convertvector(v, rb2_cv); return __builtin_bit_cast(unsigned, b); }
__device__ __forceinline__ float lo_bf(unsigned u) { return __builtin_bit_cast(float, u << 16); }
__device__ __forceinline__ float hi_bf(unsigned u) { return __builtin_bit_cast(float, u & 0xffff0000u); }
template <bool XF32, int YM> struct Raw { rf4 xf[XF32 ? 4 : 1]; ru2 xb[XF32 ? 1 : 4]; ru2 y0[YM ? 4 : 1]; ru2 y1[YM == 2 ? 4 : 1]; };
struct Slot { int s0, s1; float g0, g1; };
constexpr int RW_STRIDE = 144;
constexpr int RW_BYTES = 256 * RW_STRIDE;

__device__ __forceinline__ void stage_router(const float* __restrict__ router_w, RLAS unsigned char* rwl, const int tid, const int nthreads) {
    for (int q = tid; q < 2048; q += nthreads) { const int c = q >> 1, half = q & 1; const rf4 v = *(const rf4*)(router_w + (size_t)c * 8 + half * 4);
        const int j = c >> 8, L = (c >> 2) & 63, i = c & 3; *(RLAS rf4*)(rwl + (j * 64 + L) * RW_STRIDE + i * 32 + half * 16) = v; }
}

template <bool XF32, int YM, int XO, int HO, bool RT>
__device__ __forceinline__ void rows_phase(const RowArgs& a, const int gw, const int NGW, const int lane, const bool with_ctx, RLAS unsigned char* rwl) {
    const int WPB = NGW >> 3, bb = gw / WPB, i0 = gw - bb * WPB;
    const int nl = i0 < T ? (T - i0 + WPB - 1) / WPB : 0;
    const int nc = (with_ctx && gw < RC) ? (RC - gw + NGW - 1) / NGW : 0;
    const int n = nl + nc;
    auto row_of = [&](int k) -> int { return k < nl ? bb * T + i0 + WPB * k : RL + gw + NGW * (k - nl); };
    auto load_slot = [&](Slot& s, int r) { const ri2 t = *(const ri2*)(a.tok_slot + 2 * (size_t)r); const rf2 g = *(const rf2*)(a.tok_g + 2 * (size_t)r); s.s0 = t.x; s.s1 = t.y; s.g0 = g.x; s.g1 = g.y; };
    auto load = [&](Raw<XF32, YM>& w, int r, const Slot& s) {
        const bool lat = r < RL;
        if constexpr (XF32) { const float* xp = lat ? a.xin_lat + (size_t)r * D : a.xin_ctx + (size_t)(r - RL) * D;
#pragma unroll
            for (int j = 0; j < 4; ++j) w.xf[j] = *(const rf4*)(xp + j * 256 + lane * 4);
        } else { const bf16_t* xp = lat ? (const bf16_t*)a.xin_lat + (size_t)r * D : (const bf16_t*)a.xin_ctx + (size_t)(r - RL) * D;
#pragma unroll
            for (int j = 0; j < 4; ++j) w.xb[j] = *(const ru2*)(xp + j * 256 + lane * 4); }
        if constexpr (YM == 1) { const bf16_t* yp = a.Y + (size_t)r * D;
#pragma unroll
            for (int j = 0; j < 4; ++j) w.y0[j] = *(const ru2*)(yp + j * 256 + lane * 4); }
        if constexpr (YM == 2) { const bf16_t* p0 = a.Y + (size_t)s.s0 * D; const bf16_t* p1 = a.Y + (size_t)s.s1 * D;
#pragma unroll
            for (int j = 0; j < 4; ++j) { w.y0[j] = *(const ru2*)(p0 + j * 256 + lane * 4); w.y1[j] = *(const ru2*)(p1 + j * 256 + lane * 4); } }
    };
    float A[16], Bm[16], Cm[16]; int cur_mr = -1;
    auto process = [&](const Raw<XF32, YM>& w, int r, const Slot& s) {
        const bool lat = r < RL; const int mr = lat ? (r >> 12) : 8;
        if (mr != cur_mr) { cur_mr = mr;
#pragma unroll
            for (int j = 0; j < 4; ++j) { const int c = j * 256 + lane * 4;
                if constexpr (YM != 0) { const rf4 g = *(const rf4*)(a.gy + c); const rf4 gt = *(const rf4*)(a.gate + (size_t)mr * 6144 + c);
                    A[4 * j] = gt.x * g.x; A[4 * j + 1] = gt.y * g.y; A[4 * j + 2] = gt.z * g.z; A[4 * j + 3] = gt.w * g.w; }
                if constexpr (HO != 0) { const rf4 g = *(const rf4*)(a.gh + c); const rf4 sc = *(const rf4*)(a.scale + (size_t)mr * 6144 + c); const rf4 sh = *(const rf4*)(a.shift + (size_t)mr * 6144 + c);
                    Bm[4 * j] = g.x * (1.f + sc.x); Bm[4 * j + 1] = g.y * (1.f + sc.y); Bm[4 * j + 2] = g.z * (1.f + sc.z); Bm[4 * j + 3] = g.w * (1.f + sc.w);
                    Cm[4 * j] = sh.x; Cm[4 * j + 1] = sh.y; Cm[4 * j + 2] = sh.z; Cm[4 * j + 3] = sh.w; } }
        }
        float x[16];
#pragma unroll
        for (int j = 0; j < 4; ++j) {
            if constexpr (XF32) { x[4 * j] = w.xf[j].x; x[4 * j + 1] = w.xf[j].y; x[4 * j + 2] = w.xf[j].z; x[4 * j + 3] = w.xf[j].w; }
            else { x[4 * j] = lo_bf(w.xb[j].x); x[4 * j + 1] = hi_bf(w.xb[j].x); x[4 * j + 2] = lo_bf(w.xb[j].y); x[4 * j + 3] = hi_bf(w.xb[j].y); } }
        if constexpr (YM != 0) {
            float y[16];
#pragma unroll
            for (int j = 0; j < 4; ++j) {
                if constexpr (YM == 2) { y[4 * j] = s.g0 * lo_bf(w.y0[j].x) + s.g1 * lo_bf(w.y1[j].x); y[4 * j + 1] = s.g0 * hi_bf(w.y0[j].x) + s.g1 * hi_bf(w.y1[j].x);
                    y[4 * j + 2] = s.g0 * lo_bf(w.y0[j].y) + s.g1 * lo_bf(w.y1[j].y); y[4 * j + 3] = s.g0 * hi_bf(w.y0[j].y) + s.g1 * hi_bf(w.y1[j].y); }
                else { y[4 * j] = lo_bf(w.y0[j].x); y[4 * j + 1] = hi_bf(w.y0[j].x); y[4 * j + 2] = lo_bf(w.y0[j].y); y[4 * j + 3] = hi_bf(w.y0[j].y); } }
            float ss = 0.f;
#pragma unroll
            for (int i = 0; i < 16; ++i) ss += y[i] * y[i];
            ss = wave_sum(ss); const float ry = rsqrtf(ss * (1.f / D) + EPS);
#pragma unroll
            for (int j = 0; j < 4; ++j) { const int c = j * 256 + lane * 4;
#pragma unroll
                for (int i = 0; i < 4; ++i) x[4 * j + i] += A[4 * j + i] * (y[4 * j + i] * ry);
                if constexpr (XO == 1) { bf16_t* xob = lat ? (bf16_t*)a.xout_lat + (size_t)r * D : (bf16_t*)a.xout_ctx + (size_t)(r - RL) * D;
                    ru2 o; o.x = pk_bf16(x[4 * j], x[4 * j + 1]); o.y = pk_bf16(x[4 * j + 2], x[4 * j + 3]); *(ru2*)(xob + c) = o;
                    x[4 * j] = lo_bf(o.x); x[4 * j + 1] = hi_bf(o.x); x[4 * j + 2] = lo_bf(o.y); x[4 * j + 3] = hi_bf(o.y); }
                if constexpr (XO == 2) { float* xo = lat ? a.xout_lat + (size_t)r * D : a.xout_ctx + (size_t)(r - RL) * D;
                    const rf4 o = {x[4 * j], x[4 * j + 1], x[4 * j + 2], x[4 * j + 3]}; *(rf4*)(xo + c) = o; } }
        }
        if constexpr (HO != 0) {
            float ss = 0.f;
#pragma unroll
            for (int i = 0; i < 16; ++i) ss += x[i] * x[i];
            ss = wave_sum(ss); const float rx = rsqrtf(ss * (1.f / D) + EPS);
            float h[16];
#pragma unroll
            for (int j = 0; j < 4; ++j) { const int c = j * 256 + lane * 4;
#pragma unroll
                for (int i = 0; i < 4; ++i) h[4 * j + i] = (x[4 * j + i] * rx) * Bm[4 * j + i] + Cm[4 * j + i];
                if constexpr (HO == 2) { unsigned wv = 0u; wv = (unsigned)__builtin_amdgcn_cvt_pk_fp8_f32(fminf(fmaxf(h[4 * j], -448.f), 448.f), fminf(fmaxf(h[4 * j + 1], -448.f), 448.f), (int)wv, false);
                    wv = (unsigned)__builtin_amdgcn_cvt_pk_fp8_f32(fminf(fmaxf(h[4 * j + 2], -448.f), 448.f), fminf(fmaxf(h[4 * j + 3], -448.f), 448.f), (int)wv, true); *(unsigned*)(a.H8 + (size_t)r * D + c) = wv; }
                else { ru2 o; o.x = pk_bf16(h[4 * j], h[4 * j + 1]); o.y = pk_bf16(h[4 * j + 2], h[4 * j + 3]); *(ru2*)(a.H + (size_t)r * D + c) = o; } }
            if constexpr (RT) {
                float lg[8];
#pragma unroll
                for (int e = 0; e < 8; ++e) lg[e] = 0.f;
#pragma unroll
                for (int j = 0; j < 4; ++j) { const RLAS unsigned char* bp = rwl + (j * 64 + lane) * RW_STRIDE;
#pragma unroll
                    for (int i = 0; i < 4; ++i) { const rf4 w0 = *(const RLAS rf4*)(bp + i * 32); const rf4 w1 = *(const RLAS rf4*)(bp + i * 32 + 16); const float hv = h[4 * j + i];
                        lg[0] += hv * w0.x; lg[1] += hv * w0.y; lg[2] += hv * w0.z; lg[3] += hv * w0.w; lg[4] += hv * w1.x; lg[5] += hv * w1.y; lg[6] += hv * w1.z; lg[7] += hv * w1.w; }
                    __builtin_amdgcn_sched_barrier(0); }
#pragma unroll
                for (int e = 0; e < 8; ++e) lg[e] = wave_sum(lg[e]);
                if (lane == 0) {
                    int e0 = 0; float v0 = lg[0];
#pragma unroll
                    for (int e = 1; e < 8; ++e) if (lg[e] > v0) { v0 = lg[e]; e0 = e; }
                    int e1 = -1; float v1 = -3.0e38f;
#pragma unroll
                    for (int e = 0; e < 8; ++e) if (e != e0 && lg[e] > v1) { v1 = lg[e]; e1 = e; }
                    if (e1 < 0) { e1 = (e0 + 1) & 7; v1 = v0; }
                    const float g0 = 1.f / (1.f + expf(v1 - v0));
                    a.top_e[2 * r] = e0; a.top_e[2 * r + 1] = e1; a.top_g[2 * r] = g0; a.top_g[2 * r + 1] = 1.f - g0;
                }
            }
        }
    };
    Raw<XF32, YM> ra, rb; Slot s_cur{}, s_nxt{};
    if (n > 0) { if constexpr (YM == 2) load_slot(s_cur, row_of(0));
        load(ra, row_of(0), s_cur);
        if constexpr (YM == 2) { if (n > 1) load_slot(s_nxt, row_of(1)); } }
    auto step = [&](const Raw<XF32, YM>& cur, Raw<XF32, YM>& nxt, int k) {
        Slot s_n2{};
        if (k + 1 < n) { load(nxt, row_of(k + 1), s_nxt); if constexpr (YM == 2) { if (k + 2 < n) load_slot(s_n2, row_of(k + 2)); } }
        process(cur, row_of(k), s_cur);
        s_cur = s_nxt; s_nxt = s_n2;
    };
#pragma unroll 1
    for (int k = 0; k < n; k += 2) { step(ra, rb, k); if (k + 1 < n) step(rb, ra, k + 1); }
}
}
#ifndef MOE_FP8
#define MOE_FP8 1
#endif
#ifndef FFN_FP8
#define FFN_FP8 1
#endif

#define LAS __attribute__((address_space(3)))
#define GAS __attribute__((address_space(1)))
typedef short bf16x8 __attribute__((ext_vector_type(8)));
typedef float f32x4 __attribute__((ext_vector_type(4)));
typedef float f32x2 __attribute__((ext_vector_type(2)));
typedef unsigned u32x4 __attribute__((ext_vector_type(4)));
typedef unsigned u32x2 __attribute__((ext_vector_type(2)));
constexpr size_t WS_WMI = 572 * MiB;
constexpr size_t WS_WMO = 660 * MiB;
constexpr size_t WS_W_MIXIN = WS_WSMALL;
constexpr size_t WS_W_MIXOUT = WS_W_MIXIN + 9 * MiB;
constexpr size_t WS_W_FFNIN = WS_W_MIXOUT + 2 * MiB;
constexpr size_t WS_W_FFNOUT = WS_W_FFNIN + 11 * MiB;
constexpr size_t WS_W_DOWN = WS_W_FFNOUT + 5632 * 1024;
constexpr size_t WS_W_UQ = WS_W_DOWN + 1536 * 1024;
constexpr size_t WS_W_UKV = WS_W_UQ + 1152 * 1024;
constexpr size_t WS_W_MLAOUT = WS_W_UKV + 1 * MiB;
static_assert(WS_W_MLAOUT + 2 * MiB <= WS_HB, "small weights fit");

typedef float f32x2_cv __attribute__((ext_vector_type(2))); typedef __bf16 bf16x2_cv __attribute__((ext_vector_type(2)));
__device__ __forceinline__ unsigned cvt_pk_bf16(float lo, float hi) { const f32x2_cv v = {lo, hi}; const bf16x2_cv b = __builtin_convertvector(v, bf16x2_cv); return __builtin_bit_cast(unsigned, b); }
__device__ __forceinline__ int tidx(int wv) { int t = (wv << 6) | (int)__builtin_amdgcn_mbcnt_hi(~0u, __builtin_amdgcn_mbcnt_lo(~0u, 0u)); asm volatile("" : "+v"(t)); return t; }
__device__ __forceinline__ unsigned pack4_fp8(float a, float b, float c, float d) { unsigned w = 0u; w = (unsigned)__builtin_amdgcn_cvt_pk_fp8_f32(a, b, (int)w, false); w = (unsigned)__builtin_amdgcn_cvt_pk_fp8_f32(c, d, (int)w, true); return w; }
__device__ __forceinline__ float clamp448(float v) { return fminf(fmaxf(v, -448.f), 448.f); }
constexpr float W8_SCALE = 64.f, W8_INV = 1.f / 64.f;
typedef int v8i_t __attribute__((ext_vector_type(8)));
typedef int v4i_t __attribute__((ext_vector_type(4)));
__device__ __forceinline__ float fast_silu(float v) { return v * __builtin_amdgcn_rcpf(1.f + __expf(-v)); }

namespace pg8 {
constexpr int BM = 256, BK = 64, HALF = 128, HTB = HALF * BK * 2  , STAGE_BYTES = 8 * HTB, NXCD = 8, WGM = 8;
__host__ __device__ __forceinline__ int lds_byte(int r, int c) { const int st = (r >> 4) * 2 + (c >> 5), rr = r & 15, cc = c & 31, ob = rr * 64 + cc * 2; return st * 1024 + (ob ^ (((ob >> 9) & 1) << 5)); }
__host__ __device__ __forceinline__ void stage_rc(int b, int& R_, int& C_) { const int st = b / 1024, sb = b % 1024, swz = sb ^ (((sb >> 9) & 1) << 5); R_ = (st >> 1) * 16 + swz / 64; C_ = (st & 1) * 32 + (swz % 64) / 2; }
__host__ __device__ __forceinline__ int perm32(int rho) { const int n = rho >> 4, i = rho & 15; return 8 * (i >> 2) + 4 * n + (i & 3); }

struct Unit { int arow, brow, pm, pn, rend; };
constexpr int UT_OFF = 131072 + 1024, UT_N = 64;
struct Gemm { const bf16_t* A; const bf16_t* Bt; int lda, ldb, K; };

struct DenseOrder {
    int nM, nN, nwg, G, c;
    __device__ bool next_lane(int i, Unit& u) const { return next(i, u); }
    __device__ void init(int nM_, int nN_, int G_, int c_) { nM = nM_; nN = nN_; nwg = nM * nN; G = G_; c = c_; }
    __device__ bool next(int i, Unit& u) const {
        const long L = (long)i * G + c; if (L >= nwg) return false;
        int wgid = (int)L; { const int q = nwg / NXCD, r = nwg % NXCD, xcd = wgid % NXCD, off = wgid / NXCD; wgid = (xcd < r ? xcd * (q + 1) : r * (q + 1) + (xcd - r) * q) + off; }
        const int nig = WGM * nN, gid = wgid / nig, fm = gid * WGM, gsz = (nM - fm) < WGM ? (nM - fm) : WGM;
        u.pm = fm + ((wgid % nig) % gsz); u.pn = (wgid % nig) / gsz; u.arow = u.pm * BM; u.brow = u.pn * BM; u.rend = 0x7fffffff; return true;
    }
    __device__ __forceinline__ void a_ready(const Unit&) const {}
    __device__ __forceinline__ void done(const Unit&) const {}
};
struct MoeOrder {
    const LAS int* meta; int nN, G, c, nwg;
    __device__ void init(const LAS int* meta_, int nN_, int G_, int c_) { meta = meta_; nN = nN_; G = G_; c = c_; int s = 0;
#pragma unroll
        for (int e = 0; e < 8; ++e) s += ((meta[8 + e] + 255) >> 8) * nN; nwg = __builtin_amdgcn_readfirstlane(s); }
    __device__ bool next_lane(int i, Unit& u) const {
        const int L = i * G + c; if (L >= nwg) return false;
        int wgid = L; { const int q = nwg / NXCD, r = nwg % NXCD, xcd = wgid % NXCD, off = wgid / NXCD; wgid = (xcd < r ? xcd * (q + 1) : r * (q + 1) + (xcd - r) * q) + off; }
        int e = -1, nM = 1, base = 0, cnt = 0;
#pragma unroll
        for (int k = 0; k < 8; ++k) { const int ck = meta[8 + k], tk = (ck + 255) >> 8, uk = tk * nN; if (e < 0) { if (wgid < uk) { e = k; nM = tk; base = meta[k]; cnt = ck; } else wgid -= uk; } }
        if (e < 0) return false;
        const int nig = WGM * nN, gid = wgid / nig, fm = gid * WGM, gsz = (nM - fm) < WGM ? (nM - fm) : WGM;
        const int pm_ = fm + ((wgid % nig) % gsz), pn_ = (wgid % nig) / gsz;
        u.pm = pm_; u.pn = pn_; u.arow = base + pm_ * BM; u.brow = (e * nN + pn_) * BM; u.rend = base + cnt; return true;
    }
    __device__ bool next(int i, Unit& u) const { Unit t; const bool ok = next_lane(i, t); if (!ok) return false;
        u.pm = __builtin_amdgcn_readfirstlane(t.pm); u.pn = __builtin_amdgcn_readfirstlane(t.pn); u.arow = __builtin_amdgcn_readfirstlane(t.arow); u.brow = __builtin_amdgcn_readfirstlane(t.brow); u.rend = __builtin_amdgcn_readfirstlane(t.rend); return true; }
    __device__ __forceinline__ void a_ready(const Unit&) const {}
    __device__ __forceinline__ void done(const Unit&) const {}
};

#define EPI_ROWS(...) _Pragma("unroll") for (int ai = 0; ai < 2; ++ai) _Pragma("unroll") for (int m = 0; m < 4; ++m) { const int row = u.arow + ai * HALF + wr * 64 + m * 16 + fr; __VA_ARGS__ }
__device__ __forceinline__ u32x4 pack8(const f32x4 a, const f32x4 b) { u32x4 w; w.x = cvt_pk_bf16(a[0], a[1]); w.y = cvt_pk_bf16(a[2], a[3]); w.z = cvt_pk_bf16(b[0], b[1]); w.w = cvt_pk_bf16(b[2], b[3]); return w; }

struct EpiPlain {
    static constexpr bool PERM = true, AFTER_DRAIN = false;
    bf16_t* O; int ldc;
    __device__ __forceinline__ void operator()(const f32x4 (&acc)[2][2][4][2], const Unit& u, int wr, int wc, int fr, int fq) const {
        const int col0 = u.pn * BM + wc * 32 + fq * 8;
#define PLN_BODY bf16_t* rowp = O + (size_t)row * ldc + col0; _Pragma("unroll") for (int bj = 0; bj < 2; ++bj) *(u32x4*)(rowp + bj * HALF) = pack8(acc[ai][bj][m][0], acc[ai][bj][m][1]);
        if (u.arow + BM <= u.rend) { EPI_ROWS( { PLN_BODY } ) } else { EPI_ROWS( if (row < u.rend) { PLN_BODY } ) }
#undef PLN_BODY
    }
};
struct EpiSwiglu {
    static constexpr bool PERM = true, AFTER_DRAIN = false;
    bf16_t* O;
    __device__ __forceinline__ void operator()(const f32x4 (&acc)[2][2][4][2], const Unit& u, int wr, int wc, int fr, int fq) const {
        const int col0 = u.pn * HALF + wc * 32 + fq * 8;
        EPI_ROWS( if (row < u.rend) { f32x4 o0, o1;
            _Pragma("unroll") for (int i = 0; i < 4; ++i) { o0[i] = fast_silu(acc[ai][0][m][0][i]) * acc[ai][1][m][0][i]; o1[i] = fast_silu(acc[ai][0][m][1][i]) * acc[ai][1][m][1][i]; }
            *(u32x4*)(O + (size_t)row * FFN + col0) = pack8(o0, o1); } )
    }
};
struct EpiSwiglu8 {
    static constexpr bool PERM = true, AFTER_DRAIN = false;
    unsigned char* O; float sc;
    __device__ __forceinline__ void operator()(const f32x4 (&acc)[2][2][4][2], const Unit& u, int wr, int wc, int fr, int fq) const {
        const int col0 = u.pn * HALF + wc * 32 + fq * 8;
        const float c1 = -sc * 1.4426950408889634f, c2 = sc * sc;
#define SWG_BODY  f32x2 a[4], b[4], e[4]; \
            _Pragma("unroll") for (int n = 0; n < 2; ++n) { a[2 * n] = __builtin_shufflevector(acc[ai][0][m][n], acc[ai][0][m][n], 0, 1); a[2 * n + 1] = __builtin_shufflevector(acc[ai][0][m][n], acc[ai][0][m][n], 2, 3); \
                b[2 * n] = __builtin_shufflevector(acc[ai][1][m][n], acc[ai][1][m][n], 0, 1); b[2 * n + 1] = __builtin_shufflevector(acc[ai][1][m][n], acc[ai][1][m][n], 2, 3); } \
            _Pragma("unroll") for (int i = 0; i < 4; ++i) e[i] = a[i] * c1; \
            __builtin_amdgcn_sched_barrier(0); \
            _Pragma("unroll") for (int i = 0; i < 4; ++i) { e[i].x = __builtin_amdgcn_exp2f(e[i].x); e[i].y = __builtin_amdgcn_exp2f(e[i].y); } \
            __builtin_amdgcn_sched_barrier(0); \
            _Pragma("unroll") for (int i = 0; i < 4; ++i) e[i] = e[i] + 1.f; \
            __builtin_amdgcn_sched_barrier(0); \
            _Pragma("unroll") for (int i = 0; i < 4; ++i) { e[i].x = __builtin_amdgcn_rcpf(e[i].x); e[i].y = __builtin_amdgcn_rcpf(e[i].y); } \
            __builtin_amdgcn_sched_barrier(0); \
            _Pragma("unroll") for (int i = 0; i < 4; ++i) a[i] = (a[i] * b[i]) * (e[i] * c2); \
            float o[8]; \
            _Pragma("unroll") for (int i = 0; i < 4; ++i) { o[2 * i] = clamp448(a[i].x); o[2 * i + 1] = clamp448(a[i].y); } \
            *(u32x2*)(O + (size_t)row * FFN + col0) = (u32x2){pack4_fp8(o[0], o[1], o[2], o[3]), pack4_fp8(o[4], o[5], o[6], o[7])};
        if (u.arow + BM <= u.rend) { EPI_ROWS( { SWG_BODY } ) } else { EPI_ROWS( if (row < u.rend) { SWG_BODY } ) }
#undef SWG_BODY
    }
};
struct EpiPlainS {
    static constexpr bool PERM = true, AFTER_DRAIN = false;
    bf16_t* O; int ldc; float sc;
    __device__ __forceinline__ void operator()(const f32x4 (&acc)[2][2][4][2], const Unit& u, int wr, int wc, int fr, int fq) const {
        const int col0 = u.pn * BM + wc * 32 + fq * 8;
#define PLN_BODY bf16_t* rowp = O + (size_t)row * ldc + col0; _Pragma("unroll") for (int bj = 0; bj < 2; ++bj) *(u32x4*)(rowp + bj * HALF) = pack8(acc[ai][bj][m][0] * sc, acc[ai][bj][m][1] * sc);
        if (u.arow + BM <= u.rend) { EPI_ROWS( { PLN_BODY } ) } else { EPI_ROWS( if (row < u.rend) { PLN_BODY } ) }
#undef PLN_BODY
    }
};
struct EpiMix {
    static constexpr bool PERM = true, AFTER_DRAIN = false;
    bf16_t* G0; const float* rc; const float* rs; const float* lb;
    __device__ __forceinline__ void operator()(const f32x4 (&acc)[2][2][4][2], const Unit& u, int wr, int wc, int fr, int fq) const {
        const int grp = u.pn >> 1, half = u.pn & 1; bf16_t* Gp = G0 + (size_t)grp * (GSZ / 2);
        if (grp <= 1) {
            const int head = half * 2 + (wc >> 1), jb = (wc & 1) * 32 + fq * 8; const float sc = grp == 1 ? 0.08838834764831845f : 1.f;
            float frv[8];
#pragma unroll
            for (int i = 0; i < 8; ++i) frv[i] = __builtin_amdgcn_exp2f(-(float)((jb + i) & 31) * 0.41524101186092029f) * 0.15915494309189535f;
            EPI_ROWS( f32x4 a0 = acc[ai][0][m][0] * sc, a1 = acc[ai][0][m][1] * sc, b0 = acc[ai][1][m][0] * sc, b1 = acc[ai][1][m][1] * sc; f32x4 o0, o1, p0, p1;
                if (row < RL) { const int t = row & 4095; const float pos = (float)(jb < 32 ? (t >> 6) : (t & 63)); f32x4 c0, c1, s0, s1;
                    _Pragma("unroll") for (int i = 0; i < 4; ++i) { const float r0 = __builtin_amdgcn_fractf(pos * frv[i]), r1 = __builtin_amdgcn_fractf(pos * frv[4 + i]);
                        c0[i] = __builtin_amdgcn_cosf(r0); s0[i] = __builtin_amdgcn_sinf(r0); c1[i] = __builtin_amdgcn_cosf(r1); s1[i] = __builtin_amdgcn_sinf(r1); }
                    o0 = a0 * c0 - b0 * s0; o1 = a1 * c1 - b1 * s1; p0 = a0 * s0 + b0 * c0; p1 = a1 * s1 + b1 * c1; }
                else { o0 = a0; o1 = a1; p0 = b0; p1 = b1; }
                bf16_t* dst = Gp + (size_t)row * 512 + head * 128 + jb; __builtin_nontemporal_store(pack8(o0, o1), (u32x4*)dst); __builtin_nontemporal_store(pack8(p0, p1), (u32x4*)(dst + 64)); )
        } else {
            const int cb = half * 256 + wc * 32 + fq * 8;
            const int act = (grp == 3 || grp == 4 || grp == 8) ? 1 : ((grp == 5 || grp == 6) ? 2 : 0);
            EPI_ROWS( _Pragma("unroll") for (int bj = 0; bj < 2; ++bj) { f32x4 v0 = acc[ai][bj][m][0], v1 = acc[ai][bj][m][1]; const int c = cb + bj * HALF;
                if (act != 0) { f32x2 x[4] = {__builtin_shufflevector(v0, v0, 0, 1), __builtin_shufflevector(v0, v0, 2, 3), __builtin_shufflevector(v1, v1, 0, 1), __builtin_shufflevector(v1, v1, 2, 3)}; f32x2 e[4];
                    const float ce = act == 1 ? -1.4426950408889634f : 1.4426950408889634f;
                    _Pragma("unroll") for (int i = 0; i < 4; ++i) e[i] = x[i] * ce;
                    __builtin_amdgcn_sched_barrier(0);
                    _Pragma("unroll") for (int i = 0; i < 4; ++i) { e[i].x = __builtin_amdgcn_exp2f(e[i].x); e[i].y = __builtin_amdgcn_exp2f(e[i].y); }
                    __builtin_amdgcn_sched_barrier(0);
                    _Pragma("unroll") for (int i = 0; i < 4; ++i) e[i] = e[i] + 1.f;
                    __builtin_amdgcn_sched_barrier(0);
                    _Pragma("unroll") for (int i = 0; i < 4; ++i) { e[i].x = __builtin_amdgcn_rcpf(e[i].x); e[i].y = __builtin_amdgcn_rcpf(e[i].y); }
                    __builtin_amdgcn_sched_barrier(0);
                    if (act == 1) { _Pragma("unroll") for (int i = 0; i < 4; ++i) x[i] = x[i] * e[i]; }
                    else { const f32x4 l0 = *(const f32x4*)(lb + c), l1 = *(const f32x4*)(lb + c + 4);
                        const f32x2 w[4] = {1.f - __builtin_shufflevector(l0, l0, 0, 1), 1.f - __builtin_shufflevector(l0, l0, 2, 3), 1.f - __builtin_shufflevector(l1, l1, 0, 1), 1.f - __builtin_shufflevector(l1, l1, 2, 3)};
                        _Pragma("unroll") for (int i = 0; i < 4; ++i) x[i] = w[i] * e[i]; }
                    v0 = __builtin_shufflevector(x[0], x[1], 0, 1, 2, 3); v1 = __builtin_shufflevector(x[2], x[3], 0, 1, 2, 3); }
                __builtin_nontemporal_store(pack8(v0, v1), (u32x4*)(Gp + (size_t)row * 512 + c)); } )
        }
    }
};
struct EpiUQ {
    static constexpr bool PERM = true, AFTER_DRAIN = false;
    bf16_t* QN; bf16_t* QR; const float* mc; const float* ms;
    __device__ __forceinline__ void operator()(const f32x4 (&acc)[2][2][4][2], const Unit& u, int wr, int wc, int fr, int fq) const {
        if (u.pn < 4) {
            EPI_ROWS( const int b = row >> 12, t = row & 4095;
                _Pragma("unroll") for (int bj = 0; bj < 2; ++bj) { const int h = 2 * u.pn + bj; *(u32x4*)(QN + (((size_t)b * 8 + h) * T + t) * 128 + wc * 32 + fq * 8) = pack8(acc[ai][bj][m][0], acc[ai][bj][m][1]); } )
        } else {
            const int h = 4 * (u.pn - 4) + wc, jb = fq * 8;
            float frv[8];
#pragma unroll
            for (int i = 0; i < 8; ++i) frv[i] = __builtin_amdgcn_exp2f(-(float)((jb + i) & 15) * 0.83048202372184059f) * 0.15915494309189535f;
            EPI_ROWS( const int b = row >> 12, t = row & 4095; const f32x4 a0 = acc[ai][0][m][0], a1 = acc[ai][0][m][1], b0 = acc[ai][1][m][0], b1 = acc[ai][1][m][1];
                const float pos = (float)(jb < 16 ? (t >> 6) : (t & 63)); f32x4 c0, c1, s0, s1;
                _Pragma("unroll") for (int i = 0; i < 4; ++i) { const float r0 = __builtin_amdgcn_fractf(pos * frv[i]), r1 = __builtin_amdgcn_fractf(pos * frv[4 + i]);
                    c0[i] = __builtin_amdgcn_cosf(r0); s0[i] = __builtin_amdgcn_sinf(r0); c1[i] = __builtin_amdgcn_cosf(r1); s1[i] = __builtin_amdgcn_sinf(r1); }
                bf16_t* dst = QR + (((size_t)b * 8 + h) * T + t) * 64 + jb; *(u32x4*)dst = pack8(a0 * c0 - b0 * s0, a1 * c1 - b1 * s1); *(u32x4*)(dst + 32) = pack8(a0 * s0 + b0 * c0, a1 * s1 + b1 * c1); )
        }
    }
};
struct EpiUKV {
    static constexpr bool PERM = true, AFTER_DRAIN = false;
    bf16_t* KN; bf16_t* V;
    __device__ __forceinline__ void operator()(const f32x4 (&acc)[2][2][4][2], const Unit& u, int wr, int wc, int fr, int fq) const {
        EPI_ROWS( const bool lat = row < RL; const int b = lat ? (row >> 12) : ((row - RL) >> 8); const int key = lat ? CT + (row & 4095) : ((row - RL) & 255);
            const size_t off = (((size_t)b * 8 + u.pn) * KEYS + key) * 128 + wc * 32 + fq * 8;
            *(u32x4*)(KN + off) = pack8(acc[ai][0][m][0], acc[ai][0][m][1]); *(u32x4*)(V + off) = pack8(acc[ai][1][m][0], acc[ai][1][m][1]); )
    }
};

template <class Epi, class Sched, bool ALIGN_EPI, bool FP8 = false>
__device__ __forceinline__ void gemm_phase(LAS unsigned char* lds, const Gemm g, const Sched& S, const Epi& E, const int wv) {
    const int tid = tidx(wv), wid = __builtin_amdgcn_readfirstlane(tid >> 6), lane = tid & 63, wr = wid >> 2, wc = wid & 3, fr = lane & 15, fq = lane >> 4;
    const int K = g.K, nt = K / BK;
    unsigned voffA[2], voffB[2];
#pragma unroll
    for (int i = 0; i < 2; ++i) { int R_, C_; stage_rc(tid * 16 + i * 8192, R_, C_); const int Rb = Epi::PERM ? ((R_ & ~31) + perm32(R_ & 31)) : R_;
        voffA[i] = (unsigned)(R_ * g.lda + C_) * 2u; voffB[i] = (unsigned)(Rb * g.ldb + C_) * 2u; }
    const size_t kstep = (size_t)(BK * 2);
    const size_t hstepA = (size_t)HALF * g.lda * 2, hstepB = (size_t)HALF * g.ldb * 2;
    const unsigned ldsw = (unsigned)wid * 1024u;
    const int aoff = lds_byte(wr * 64 + fr, fq * 8), boff = lds_byte(wc * 32 + fr, fq * 8);
#define PG8_SA(b, h) (((b) * 2 + (h)) * HTB)
#define PG8_SB(b, h) ((4 + (b) * 2 + (h)) * HTB)
#define PG8_STAGE(bufoff, gbase, voff) do { _Pragma("unroll") for (int _i = 0; _i < 2; ++_i) { unsigned _vo = (voff)[_i]; asm volatile("" : "+v"(_vo));     \
        __builtin_amdgcn_global_load_lds((const unsigned*)((const char*)(gbase) + _vo), (LAS unsigned*)(lds + (bufoff) + ldsw + _i * 8192), 16, 0, 0); } } while (0)
#define PG8_LDA(dst, b, h) do { _Pragma("unroll") for (int m = 0; m < 4; ++m) { if constexpr (FP8) dst##8[m] = __builtin_shufflevector(*(const LAS v4i_t*)(lds + PG8_SA(b, h) + aoff + m * 2048), *(const LAS v4i_t*)(lds + PG8_SA(b, h) + aoff + m * 2048 + 1024), 0, 1, 2, 3, 4, 5, 6, 7); \
        else { _Pragma("unroll") for (int k = 0; k < 2; ++k) dst[m][k] = *(const LAS bf16x8*)(lds + PG8_SA(b, h) + aoff + m * 2048 + k * 1024); } } } while (0)
#define PG8_LDB(dst, b, h) do { _Pragma("unroll") for (int n = 0; n < 2; ++n) { if constexpr (FP8) dst##8[n] = __builtin_shufflevector(*(const LAS v4i_t*)(lds + PG8_SB(b, h) + boff + n * 2048), *(const LAS v4i_t*)(lds + PG8_SB(b, h) + boff + n * 2048 + 1024), 0, 1, 2, 3, 4, 5, 6, 7); \
        else { _Pragma("unroll") for (int k = 0; k < 2; ++k) dst[n][k] = *(const LAS bf16x8*)(lds + PG8_SB(b, h) + boff + n * 2048 + k * 1024); } } } while (0)
#define PG8_MMA(ai, bj, At, Bt) do { __builtin_amdgcn_s_setprio(1); _Pragma("unroll") for (int m = 0; m < 4; ++m) _Pragma("unroll") for (int n = 0; n < 2; ++n) { \
        if constexpr (FP8) { acc[ai][bj][m][n] = __builtin_amdgcn_mfma_scale_f32_16x16x128_f8f6f4(Bt##8[n], At##8[m], acc[ai][bj][m][n], 0, 0, 0, 0x7f7f7f7f, 0, 0x7f7f7f7f); } \
        else { _Pragma("unroll") for (int k = 0; k < 2; ++k) acc[ai][bj][m][n] = __builtin_amdgcn_mfma_f32_16x16x32_bf16(Bt[n][k], At[m][k], acc[ai][bj][m][n], 0, 0, 0); } } \
        __builtin_amdgcn_s_setprio(0); } while (0)
#define PG8_WAIT_V(n) asm volatile("s_waitcnt vmcnt(" #n ")" ::: "memory")
#define PG8_WAIT_L(n) asm volatile("s_waitcnt lgkmcnt(" #n ")" ::: "memory")
#define PG8_BAR __builtin_amdgcn_s_barrier()
#define PG8_SCHED __builtin_amdgcn_sched_barrier(0)
    LAS int* ut = (LAS int*)(lds + UT_OFF);
    if (tid < UT_N) { Unit tu; tu.arow = tu.brow = tu.pm = tu.pn = tu.rend = 0; const bool ok = S.next_lane(tid, tu);
        *(LAS v4i_t*)(ut + tid * 8) = (v4i_t){ok ? tu.arow : -1, tu.brow, tu.pm, tu.pn}; ut[tid * 8 + 4] = tu.rend; }
    __syncthreads();
    auto fetch = [&](int i, Unit& u) -> bool {
        if (i >= UT_N) return S.next(i, u);
        const v4i_t q = *(const LAS v4i_t*)(ut + i * 8); const int re = ut[i * 8 + 4];
        const int a0 = __builtin_amdgcn_readfirstlane(q.x); if (a0 < 0) return false;
        u.arow = a0; u.brow = __builtin_amdgcn_readfirstlane(q.y); u.pm = __builtin_amdgcn_readfirstlane(q.z); u.pn = __builtin_amdgcn_readfirstlane(q.w); u.rend = __builtin_amdgcn_readfirstlane(re); return true; };
    Unit cur, nxt; int ui = 0;
    if (!fetch(0, cur)) return;
    f32x4 acc[2][2][4][2];
#pragma unroll
    for (int a = 0; a < 2; ++a)
#pragma unroll
        for (int b = 0; b < 2; ++b)
#pragma unroll
            for (int m = 0; m < 4; ++m)
#pragma unroll
                for (int n = 0; n < 2; ++n) acc[a][b][m][n] = (f32x4){0.f, 0.f, 0.f, 0.f};
    bf16x8 At[4][2], B0[2][2], B1[2][2]; v8i_t At8[4], B08[2], B18[2];
    const char* cA = (const char*)g.A + (size_t)cur.arow * g.lda * 2; const char* cB = (const char*)g.Bt + (size_t)cur.brow * g.ldb * 2;
    S.a_ready(cur);
    PG8_STAGE(PG8_SB(0, 0), cB, voffB); PG8_STAGE(PG8_SB(0, 1), cB + hstepB, voffB); PG8_STAGE(PG8_SA(0, 0), cA, voffA); PG8_STAGE(PG8_SA(0, 1), cA + hstepA, voffA);
    if (wr == 1) PG8_BAR;
    PG8_WAIT_V(2); PG8_BAR;
    PG8_STAGE(PG8_SB(1, 0), cB + kstep, voffB); PG8_STAGE(PG8_SA(1, 0), cA + kstep, voffA); PG8_STAGE(PG8_SB(1, 1), cB + hstepB + kstep, voffB);
    PG8_WAIT_V(6); PG8_BAR;
    for (;;) {
        const bool has_next = fetch(ui + 1, nxt);
        const char* nA = has_next ? (const char*)g.A + (size_t)nxt.arow * g.lda * 2 : cA; const char* nB = has_next ? (const char*)g.Bt + (size_t)nxt.brow * g.ldb * 2 : cB;
#pragma unroll 1
        for (int t = 0; t < nt; t += 2) {
            const bool last = (t == nt - 2);
            const char* a1 = cA + (size_t)(t + 1) * kstep;
            const char* a2 = last ? nA : cA + (size_t)(t + 2) * kstep; const char* b2 = last ? nB : cB + (size_t)(t + 2) * kstep;
            const char* a3 = a2 + kstep; const char* b3 = b2 + kstep;
            if (last && has_next) S.a_ready(nxt);
            PG8_LDB(B0, 0, 0); PG8_LDB(B1, 0, 1); PG8_SCHED; PG8_LDA(At, 0, 0); PG8_STAGE(PG8_SA(1, 1), a1 + hstepA, voffA);
            PG8_WAIT_V(8); PG8_WAIT_L(0); PG8_BAR; PG8_MMA(0, 0, At, B0); PG8_MMA(0, 1, At, B1); PG8_BAR; PG8_SCHED;
            PG8_LDA(At, 0, 1); PG8_STAGE(PG8_SB(0, 0), b2, voffB); PG8_STAGE(PG8_SB(0, 1), b2 + hstepB, voffB); PG8_STAGE(PG8_SA(0, 0), a2, voffA);
            PG8_WAIT_V(8); PG8_WAIT_L(0); PG8_BAR; PG8_MMA(1, 0, At, B0); PG8_MMA(1, 1, At, B1); PG8_BAR; PG8_SCHED;
            PG8_LDB(B0, 1, 0); PG8_LDB(B1, 1, 1); PG8_SCHED; PG8_LDA(At, 1, 0); PG8_STAGE(PG8_SA(0, 1), a2 + hstepA, voffA);
            PG8_WAIT_V(8); PG8_WAIT_L(0); PG8_BAR; PG8_MMA(0, 0, At, B0); PG8_MMA(0, 1, At, B1); PG8_BAR; PG8_SCHED;
            PG8_LDA(At, 1, 1); PG8_STAGE(PG8_SB(1, 0), b3, voffB); PG8_STAGE(PG8_SB(1, 1), b3 + hstepB, voffB); PG8_STAGE(PG8_SA(1, 0), a3, voffA);
            PG8_WAIT_V(8); PG8_WAIT_L(0); PG8_BAR; PG8_MMA(1, 0, At, B0); PG8_MMA(1, 1, At, B1); PG8_BAR; PG8_SCHED;
        }
        if constexpr (ALIGN_EPI) { if (wr == 0) PG8_BAR; }
        { const int l2_ = tidx(wv) & 63; E(acc, cur, wr, wc, l2_ & 15, l2_ >> 4); } S.done(cur);
        if (!has_next) break;
#pragma unroll
        for (int a = 0; a < 2; ++a)
#pragma unroll
            for (int b = 0; b < 2; ++b)
#pragma unroll
                for (int m = 0; m < 4; ++m)
#pragma unroll
                    for (int n = 0; n < 2; ++n) acc[a][b][m][n] = (f32x4){0.f, 0.f, 0.f, 0.f};
        cur = nxt; cA = nA; cB = nB; ++ui;
        if constexpr (ALIGN_EPI) { if (wr == 1) PG8_BAR; }
    }
    PG8_WAIT_V(0);
    if constexpr (!ALIGN_EPI) { if (wr == 0) PG8_BAR; }
    PG8_BAR;
#undef PG8_SA
#undef PG8_SB
#undef PG8_STAGE
#undef PG8_LDA
#undef PG8_LDB
#undef PG8_MMA
#undef PG8_WAIT_V
#undef PG8_WAIT_L
#undef PG8_BAR
#undef PG8_SCHED
}
}


namespace attn {
using s16x4 = __attribute__((ext_vector_type(4))) short;
using f32x16 = __attribute__((ext_vector_type(16))) float;
constexpr int NW = 8, QBLK = 32, KVBLK = 64;
constexpr float SCALE = 0.07216878364870322f;
constexpr float THR = 8.f;
constexpr int SHM_V = KVBLK * 128 * 2, SHM_K = KVBLK * 128 * 2, SHM_R = KVBLK * 64 * 2, NBUF = 3;
constexpr int OFF_V = 0, OFF_K = NBUF * SHM_V, OFF_R = OFF_K + NBUF * SHM_K, OFF_W = OFF_R + NBUF * SHM_R, LDS_NEED = OFF_W + NW * 64 * 4;
#define KSWZ(row, colB) ((row) * 256 + ((colB) ^ (((row) & 7) << 4)))
#define RSWZ(row, colB) ((row) * 128 + ((colB) ^ ((((row) >> 1) & 7) << 4)))
#define SBAR() __builtin_amdgcn_sched_barrier(0)
__device__ __forceinline__ int crow(int r, int hi) { return (r & 3) + 8 * (r >> 2) + 4 * hi; }
__device__ __forceinline__ unsigned cvtpk(float lo, float hi) { return cvt_pk_bf16(lo, hi); }

__device__ __forceinline__ void partialSM(f32x16& p0, f32x16& p1, float& m_reg, float& mn, float& alpha) {
    constexpr float C = SCALE * 1.4426950408889634f;
    float pmax = p0[0];
#pragma unroll
    for (int r = 1; r < 16; ++r) pmax = fmaxf(pmax, p0[r]);
#pragma unroll
    for (int r = 0; r < 16; ++r) pmax = fmaxf(pmax, p1[r]);
    { auto rr = __builtin_amdgcn_permlane32_swap(__float_as_uint(pmax), __float_as_uint(pmax), false, false);
      pmax = fmaxf(__uint_as_float(rr[0]), __uint_as_float(rr[1])); }
    if (__builtin_expect(__all(pmax - m_reg <= THR / SCALE), 1)) { mn = m_reg; alpha = 1.f; }
    else { mn = fmaxf(m_reg, pmax); alpha = __builtin_amdgcn_exp2f((m_reg - mn) * C); m_reg = mn; }
    const float mnC = -mn * C;
#pragma unroll
    for (int r = 0; r < 16; ++r) p0[r] = fmaf(p0[r], C, mnC);
#pragma unroll
    for (int r = 0; r < 16; ++r) p1[r] = fmaf(p1[r], C, mnC);
#pragma unroll
    for (int r = 0; r < 16; ++r) p0[r] = __builtin_amdgcn_exp2f(p0[r]);
}
__device__ __forceinline__ void finishSM(f32x16& p0, f32x16& p1, float alpha, float& l_reg, bf16x8& pa0, bf16x8& pa1, bf16x8& pa2, bf16x8& pa3) {
#pragma unroll
    for (int r = 0; r < 16; ++r) p1[r] = __builtin_amdgcn_exp2f(p1[r]);
    float ps = 0;
#pragma unroll
    for (int r = 0; r < 16; ++r) ps += p0[r];
#pragma unroll
    for (int r = 0; r < 16; ++r) ps += p1[r];
    { auto rr = __builtin_amdgcn_permlane32_swap(__float_as_uint(ps), __float_as_uint(ps), false, false);
      ps = __uint_as_float(rr[0]) + __uint_as_float(rr[1]); }
    l_reg = l_reg * alpha + ps;
#define PK4(P, BASE, OUT) do { unsigned a0 = cvtpk(P[BASE + 0], P[BASE + 1]), a1 = cvtpk(P[BASE + 2], P[BASE + 3]);   \
    unsigned b0 = cvtpk(P[BASE + 4], P[BASE + 5]), b1 = cvtpk(P[BASE + 6], P[BASE + 7]);                              \
    auto r0 = __builtin_amdgcn_permlane32_swap(a0, b0, false, false); auto r1 = __builtin_amdgcn_permlane32_swap(a1, b1, false, false); \
    u32x4 w = {r0[0], r1[0], r0[1], r1[1]}; OUT = *reinterpret_cast<bf16x8*>(&w); } while (0)
    PK4(p0, 0, pa0); PK4(p0, 8, pa1); PK4(p1, 0, pa2); PK4(p1, 8, pa3);
#undef PK4
}
__device__ __forceinline__ void qkt(f32x16& p0, f32x16& p1, const LAS char* Ks, const LAS char* Rs, const bf16x8* qr, const bf16x8* qrr, int r32, int hi) {
    p0 = f32x16{}; p1 = f32x16{};
#pragma unroll
    for (int d0 = 0; d0 < 8; ++d0) { const int cb = (d0 * 16 + hi * 8) * 2;
        const bf16x8 b0 = *reinterpret_cast<const LAS bf16x8*>(Ks + KSWZ(r32, cb));
        const bf16x8 b1 = *reinterpret_cast<const LAS bf16x8*>(Ks + KSWZ(32 + r32, cb));
        p0 = __builtin_amdgcn_mfma_f32_32x32x16_bf16(b0, qr[d0], p0, 0, 0, 0);
        p1 = __builtin_amdgcn_mfma_f32_32x32x16_bf16(b1, qr[d0], p1, 0, 0, 0); if ((d0 & 3) == 3) SBAR(); }
#pragma unroll
    for (int d0 = 0; d0 < 4; ++d0) { const int cb = (d0 * 16 + hi * 8) * 2;
        const bf16x8 b0 = *reinterpret_cast<const LAS bf16x8*>(Rs + RSWZ(r32, cb));
        const bf16x8 b1 = *reinterpret_cast<const LAS bf16x8*>(Rs + RSWZ(32 + r32, cb));
        p0 = __builtin_amdgcn_mfma_f32_32x32x16_bf16(b0, qrr[d0], p0, 0, 0, 0);
        p1 = __builtin_amdgcn_mfma_f32_32x32x16_bf16(b1, qrr[d0], p1, 0, 0, 0); }
}
__device__ __forceinline__ int v_st(int k, int c) { const int kk = (k & ~0xC) | ((k & 4) << 1) | ((k & 8) >> 1); return ((kk >> 3) * 4 + (c >> 5)) * 512 + ((kk & 7) * 32 + (c & 31)) * 2; }
__device__ __forceinline__ int v_rd_base(int lane) { return ((lane & 3) << 3) | (((lane >> 2) & 3) << 6) | (((lane >> 4) & 1) << 5) | (((lane >> 5) & 1) << 8); }
constexpr int v_rd_off(int d0, int ks, int half) { return d0 * 512 + ks * 4096 + half * 2048; }
template <int OFF> __device__ __forceinline__ s16x4 tr_read(int vb) {
    s16x4 r; asm volatile("ds_read_b64_tr_b16 %0, %1 offset:%2" : "=&v"(r) : "v"(vb), "i"(OFF) : "memory"); return r;
}
template <int D0> __device__ __forceinline__ void pv_one(f32x16& od, int vb, bf16x8 pa0, bf16x8 pa1, bf16x8 pa2, bf16x8 pa3) {
    const s16x4 l0 = tr_read<v_rd_off(D0, 0, 0)>(vb), h0 = tr_read<v_rd_off(D0, 0, 1)>(vb), l1 = tr_read<v_rd_off(D0, 1, 0)>(vb), h1 = tr_read<v_rd_off(D0, 1, 1)>(vb);
    const s16x4 l2 = tr_read<v_rd_off(D0, 2, 0)>(vb), h2 = tr_read<v_rd_off(D0, 2, 1)>(vb), l3 = tr_read<v_rd_off(D0, 3, 0)>(vb), h3 = tr_read<v_rd_off(D0, 3, 1)>(vb);
    asm volatile("s_waitcnt lgkmcnt(0)" ::: "memory"); SBAR();
#define PK(L, H) (bf16x8){L[0], L[1], L[2], L[3], H[0], H[1], H[2], H[3]}
    od = __builtin_amdgcn_mfma_f32_32x32x16_bf16(pa0, PK(l0, h0), od, 0, 0, 0);
    od = __builtin_amdgcn_mfma_f32_32x32x16_bf16(pa1, PK(l1, h1), od, 0, 0, 0);
    od = __builtin_amdgcn_mfma_f32_32x32x16_bf16(pa2, PK(l2, h2), od, 0, 0, 0);
    od = __builtin_amdgcn_mfma_f32_32x32x16_bf16(pa3, PK(l3, h3), od, 0, 0, 0);
#undef PK
}
__device__ __forceinline__ void pv_d0(f32x16* o, int vb, bf16x8 pa0, bf16x8 pa1, bf16x8 pa2, bf16x8 pa3) {
    pv_one<0>(o[0], vb, pa0, pa1, pa2, pa3); pv_one<1>(o[1], vb, pa0, pa1, pa2, pa3); pv_one<2>(o[2], vb, pa0, pa1, pa2, pa3); pv_one<3>(o[3], vb, pa0, pa1, pa2, pa3);
}

#define ATR(OFF) tr_read<(OFF)>(vb)
#define AWAIT(n) do { asm volatile("s_waitcnt lgkmcnt(" #n ")" ::: "memory"); SBAR(); } while (0)
#define APK(L, H) (bf16x8){L[0], L[1], L[2], L[3], H[0], H[1], H[2], H[3]}
#define AVLOAD(D0, X) do { X[0] = ATR(v_rd_off(D0, 0, 0)); X[1] = ATR(v_rd_off(D0, 0, 1)); X[2] = ATR(v_rd_off(D0, 1, 0)); X[3] = ATR(v_rd_off(D0, 1, 1)); \
    X[4] = ATR(v_rd_off(D0, 2, 0)); X[5] = ATR(v_rd_off(D0, 2, 1)); X[6] = ATR(v_rd_off(D0, 3, 0)); X[7] = ATR(v_rd_off(D0, 3, 1)); } while (0)
#define AVMMA(OD, X) do { OD = __builtin_amdgcn_mfma_f32_32x32x16_bf16(APK(X[0], X[1]), pa0, OD, 0, 0, 0); OD = __builtin_amdgcn_mfma_f32_32x32x16_bf16(APK(X[2], X[3]), pa1, OD, 0, 0, 0); \
    OD = __builtin_amdgcn_mfma_f32_32x32x16_bf16(APK(X[4], X[5]), pa2, OD, 0, 0, 0); OD = __builtin_amdgcn_mfma_f32_32x32x16_bf16(APK(X[6], X[7]), pa3, OD, 0, 0, 0); SBAR(); } while (0)
#define AKLOAD(i) do { if ((i) < 8) { const int cb = ((i) * 16 + hi * 8) * 2; kb0[(i) & 7] = *reinterpret_cast<const LAS bf16x8*>(Ks + KSWZ(r32, cb)); kb1[(i) & 7] = *reinterpret_cast<const LAS bf16x8*>(Ks + KSWZ(32 + r32, cb)); } \
    else { const int cb = (((i) - 8) * 16 + hi * 8) * 2; kb0[(i) & 7] = *reinterpret_cast<const LAS bf16x8*>(Rs + RSWZ(r32, cb)); kb1[(i) & 7] = *reinterpret_cast<const LAS bf16x8*>(Rs + RSWZ(32 + r32, cb)); } } while (0)
template <bool HAS_PV, bool HAS_QK>
__device__ __forceinline__ void mphase(f32x16& p0, f32x16& p1, f32x16* o, const LAS char* Ks, const LAS char* Rs, int vb, const bf16x8* qr, const bf16x8* qrr,
                                       bf16x8 pa0, bf16x8 pa1, bf16x8 pa2, bf16x8 pa3, int r32, int hi) {
    bf16x8 kb0[8], kb1[8]; s16x4 va[8], vc[8], vd[8];
    __builtin_amdgcn_s_setprio(1);
    if constexpr (HAS_PV) {
        AVLOAD(0, va); AVLOAD(1, vc); AVLOAD(2, vd);
        AWAIT(15); AVMMA(o[0], va); AVLOAD(3, va);
        AWAIT(15); AVMMA(o[1], vc);
        if constexpr (HAS_QK) { AKLOAD(0); AKLOAD(1); AKLOAD(2); AKLOAD(3); SBAR(); AWAIT(15); AVMMA(o[2], vd); AWAIT(8); AVMMA(o[3], va); }
        else { AWAIT(8); AVMMA(o[2], vd); AWAIT(0); AVMMA(o[3], va); }
    } else if constexpr (HAS_QK) { AKLOAD(0); AKLOAD(1); AKLOAD(2); AKLOAD(3); SBAR(); }
    if constexpr (HAS_QK) {
        p0 = f32x16{}; p1 = f32x16{};
#pragma unroll
        for (int i = 0; i < 12; ++i) { if (i + 4 < 12) AKLOAD(i + 4); SBAR();
            const bf16x8 qv = i < 8 ? qr[i < 8 ? i : 0] : qrr[i >= 8 ? i - 8 : 0];
            p0 = __builtin_amdgcn_mfma_f32_32x32x16_bf16(kb0[i & 7], qv, p0, 0, 0, 0); p1 = __builtin_amdgcn_mfma_f32_32x32x16_bf16(kb1[i & 7], qv, p1, 0, 0, 0); SBAR(); }
    }
    __builtin_amdgcn_s_setprio(0);
}
#undef ATR
#undef AWAIT
#undef APK
#undef AVLOAD
#undef AVMMA
#undef AKLOAD

__device__ __forceinline__ void attn_unit(const bf16_t* __restrict__ Qn, const bf16_t* __restrict__ Qr, const bf16_t* __restrict__ Kn, const bf16_t* __restrict__ Kr, const bf16_t* __restrict__ Vh,
                                          bf16_t* __restrict__ Ob, int seq, LAS char* lds, const int wv) {
    const int tid = tidx(wv), wid = tid >> 6, lane = tid & 63, r32 = lane & 31, hi = lane >> 5;
    const int grp = wv >> 2;
    LAS char* V_lds = lds + OFF_V; LAS char* K_lds = lds + OFF_K; LAS char* R_lds = lds + OFF_R;
    LAS float* wsl = (LAS float*)(lds + OFF_W) + wid * 64; LAS float* li_l = wsl; LAS float* al_l = wsl + 32;
    float m_reg = -1e30f, l_reg = 0; f32x16 o[4] = {}; bf16x8 qr[8], qrr[4];
    { unsigned qo = (unsigned)((wid * QBLK + r32) * 128 + hi * 8) * 2u, qo2 = (unsigned)((wid * QBLK + r32) * 64 + hi * 8) * 2u;
      asm volatile("" : "+v"(qo), "+v"(qo2));
#pragma unroll
      for (int d0 = 0; d0 < 8; ++d0) qr[d0] = *reinterpret_cast<const bf16x8*>((const char*)Qn + qo + d0 * 32);
#pragma unroll
      for (int d0 = 0; d0 < 4; ++d0) qrr[d0] = *reinterpret_cast<const bf16x8*>((const char*)Qr + qo2 + d0 * 32); }
    const int vb0 = (int)(unsigned)(uintptr_t)V_lds + v_rd_base(lane);
    const int t4 = tid & 255, sr = 32 * grp + (t4 >> 4), sc = (t4 & 15) * 8, rr_ = 32 * grp + (t4 >> 3), rc_ = (t4 & 7) * 8;
    const int vst0 = v_st(sr, sc), vst1 = v_st(sr + 16, sc), kst0 = KSWZ(sr, sc * 2), kst1 = KSWZ(sr + 16, sc * 2), rst0 = RSWZ(rr_, rc_ * 2);
    unsigned vo = (unsigned)(sr * 128 + sc) * 2u, ro = (unsigned)(rr_ * 64 + rc_) * 2u;
    asm volatile("" : "+v"(vo), "+v"(ro));
    bf16x8 vs0, vs1, ks0, ks1, rs0;
    const int NT = seq / KVBLK;
#define M3(x) ((x) >= 3 ? (x) - 3 : (x))
#define SLOADS(n) do { const int _k = (n) + 1 < NT ? (n) + 1 : NT - 1, _v = (n) < NT ? (n) : NT - 1; const char* kt = (const char*)Kn + (size_t)_k * (KVBLK * 256); const char* rt = (const char*)Kr + (size_t)_k * (KVBLK * 128); \
        const char* vt = (const char*)Vh + (size_t)_v * (KVBLK * 256); \
        ks0 = *reinterpret_cast<const bf16x8*>(kt + vo); ks1 = *reinterpret_cast<const bf16x8*>(kt + 4096 + vo); rs0 = *reinterpret_cast<const bf16x8*>(rt + ro); \
        vs0 = *reinterpret_cast<const bf16x8*>(vt + vo); vs1 = *reinterpret_cast<const bf16x8*>(vt + 4096 + vo); } while (0)
#define SWRITES(sk, sv) do { *(LAS bf16x8*)(K_lds + (sk) * SHM_K + kst0) = ks0; *(LAS bf16x8*)(K_lds + (sk) * SHM_K + kst1) = ks1; *(LAS bf16x8*)(R_lds + (sk) * SHM_R + rst0) = rs0; \
        *(LAS bf16x8*)(V_lds + (sv) * SHM_V + vst0) = vs0; *(LAS bf16x8*)(V_lds + (sv) * SHM_V + vst1) = vs1; } while (0)
#define SWAIT() asm volatile("s_waitcnt vmcnt(0)" ::: "memory")
#define RESC(a) do { if (__any((a) < 1.f)) { _Pragma("unroll") for (int d = 0; d < 4; ++d) _Pragma("unroll") for (int r = 0; r < 16; ++r) o[d][r] *= (a); } } while (0)
#define MBAR() do { SBAR(); asm volatile("s_waitcnt lgkmcnt(0)" ::: "memory"); __builtin_amdgcn_s_barrier(); SBAR(); } while (0)
#define SOFTMAX() do { partialSM(p0, p1, m_reg, mn, al); RESC(al); finishSM(p0, p1, al, l_reg, pa0, pa1, pa2, pa3); } while (0)
    f32x16 p0, p1; float mn, al; bf16x8 pa0, pa1, pa2, pa3;
    { ks0 = *reinterpret_cast<const bf16x8*>((const char*)Kn + vo); ks1 = *reinterpret_cast<const bf16x8*>((const char*)Kn + 4096 + vo); rs0 = *reinterpret_cast<const bf16x8*>((const char*)Kr + ro); SWAIT();
      *(LAS bf16x8*)(K_lds + kst0) = ks0; *(LAS bf16x8*)(K_lds + kst1) = ks1; *(LAS bf16x8*)(R_lds + rst0) = rs0; }
    __syncthreads();
    if (grp == 1) { SLOADS(0); SWAIT(); SWRITES(1, 0); __syncthreads(); }
    SLOADS(grp); SBAR();
    mphase<false, true>(p0, p1, o, K_lds, R_lds, 0, qr, qrr, pa0, pa1, pa2, pa3, r32, hi);
    MBAR();
    SOFTMAX(); SWAIT(); SWRITES(1 + grp, grp);
    __syncthreads();
    int s3 = 1;
#pragma unroll 1
    for (int j = 1; j < NT; ++j) {
        const int sv = M3(s3 + grp), sk = M3(sv + 1);
        SLOADS(j + grp); SBAR();
        mphase<true, true>(p0, p1, o, K_lds + s3 * SHM_K, R_lds + s3 * SHM_R, vb0 + M3(s3 + 2) * SHM_V, qr, qrr, pa0, pa1, pa2, pa3, r32, hi);
        MBAR();
        SOFTMAX(); SWAIT(); SWRITES(sk, sv);
        __syncthreads();
        s3 = M3(s3 + 1);
    }
    mphase<true, false>(p0, p1, o, K_lds, R_lds, vb0 + M3(s3 + 2) * SHM_V, qr, qrr, pa0, pa1, pa2, pa3, r32, hi);
    __syncthreads();
    if (grp == 0) __syncthreads();
#undef SOFTMAX
#undef MBAR
    { const float rl = __builtin_amdgcn_rcpf(l_reg);
      unsigned oo0 = (unsigned)((wid * QBLK + r32) * 1024 + 8 * hi) * 2u; asm volatile("" : "+v"(oo0));
#pragma unroll
      for (int d0 = 0; d0 < 4; ++d0)
#pragma unroll
          for (int p = 0; p < 2; ++p) {
              const unsigned a0 = cvtpk(o[d0][8 * p] * rl, o[d0][8 * p + 1] * rl), a1 = cvtpk(o[d0][8 * p + 2] * rl, o[d0][8 * p + 3] * rl);
              const unsigned b0 = cvtpk(o[d0][8 * p + 4] * rl, o[d0][8 * p + 5] * rl), b1 = cvtpk(o[d0][8 * p + 6] * rl, o[d0][8 * p + 7] * rl);
              auto r0 = __builtin_amdgcn_permlane32_swap(a0, b0, false, false); auto r1 = __builtin_amdgcn_permlane32_swap(a1, b1, false, false);
              const u32x4 w = {r0[0], r1[0], r0[1], r1[1]}; *(u32x4*)((char*)Ob + oo0 + (d0 * 32 + 16 * p) * 2) = w; } }
    __syncthreads();
#undef M3
#undef SLOADS
#undef SWRITES
#undef SWAIT
#undef RESC
}
}


namespace scan {
using attn::s16x4; using attn::f32x16; using attn::v_st; using attn::v_rd_base; using attn::crow; using attn::cvtpk;
constexpr int NCH = KEYS / 64;
constexpr size_t WS_STATE = 422 * MiB;
constexpr size_t WS_DEC = 694 * MiB;
__device__ __forceinline__ int seq_row(int b, int p) { return p < CT ? RL + b * CT + p : b * T + (p - CT); }
__device__ __forceinline__ s16x4 trr(int addr) { s16x4 r; asm volatile("ds_read_b64_tr_b16 %0, %1" : "=&v"(r) : "v"(addr) : "memory"); return r; }
template <int OFF> __device__ __forceinline__ s16x4 tri(int addr) { s16x4 r; asm volatile("ds_read_b64_tr_b16 %0, %1 offset:%2" : "=&v"(r) : "v"(addr), "i"(OFF) : "memory"); return r; }
#define SC_PK(L, H) (bf16x8){L[0], L[1], L[2], L[3], H[0], H[1], H[2], H[3]}
#define SC_LWAIT() do { asm volatile("s_waitcnt lgkmcnt(0)" ::: "memory"); __builtin_amdgcn_sched_barrier(0); } while (0)
__device__ __forceinline__ float2 bf2x(unsigned u) { return make_float2(bf2f((bf16_t)(u & 0xffffu)), bf2f((bf16_t)(u >> 16))); }

struct Prep {
    float2 kf[8], kb[8];
    float2 bf[8], cb[8];
    float2 totf, totb, reff, refb;
};
__device__ __forceinline__ void prep_decay(Prep& P, const unsigned (&rkf)[8], const unsigned (&rkb)[8], int a, float lgf, float lgb, LAS float* tot, int tid) {
    const int cp = tid & 63, tg = tid >> 6;
    float2 gf[8], gb[8];
#pragma unroll
    for (int i = 0; i < 8; ++i) {
        P.kf[i] = bf2x(rkf[i]); P.kb[i] = bf2x(rkb[i]);
        if (a) { gf[i] = make_float2(__logf(fmaxf(1.f - P.kf[i].x, 1e-30f)), __logf(fmaxf(1.f - P.kf[i].y, 1e-30f))); gb[i] = make_float2(__logf(fmaxf(1.f - P.kb[i].x, 1e-30f)), __logf(fmaxf(1.f - P.kb[i].y, 1e-30f))); }
        else { gf[i] = make_float2(lgf, lgf); gb[i] = make_float2(lgb, lgb); } }
    P.bf[0] = gf[0];
#pragma unroll
    for (int i = 1; i < 8; ++i) P.bf[i] = make_float2(P.bf[i - 1].x + gf[i].x, P.bf[i - 1].y + gf[i].y);
    P.cb[0] = gb[0];
#pragma unroll
    for (int i = 1; i < 8; ++i) P.cb[i] = make_float2(P.cb[i - 1].x + gb[i].x, P.cb[i - 1].y + gb[i].y);
    *(LAS f32x2*)(tot + (0 * 8 + tg) * 128 + 2 * cp) = (f32x2){P.bf[7].x, P.bf[7].y}; *(LAS f32x2*)(tot + (1 * 8 + tg) * 128 + 2 * cp) = (f32x2){P.cb[7].x, P.cb[7].y};
    __syncthreads();
    float2 offf = make_float2(0.f, 0.f), offb = make_float2(0.f, 0.f); P.totf = offf; P.totb = offf; P.reff = offf; P.refb = offf;
#pragma unroll
    for (int g = 0; g < 8; ++g) { const f32x2 tf = *(const LAS f32x2*)(tot + (0 * 8 + g) * 128 + 2 * cp), tb = *(const LAS f32x2*)(tot + (1 * 8 + g) * 128 + 2 * cp);
        P.totf.x += tf.x; P.totf.y += tf.y; P.totb.x += tb.x; P.totb.y += tb.y;
        if (g < 4) { P.reff.x += tf.x; P.reff.y += tf.y; } else { P.refb.x += tb.x; P.refb.y += tb.y; }
        if (g < tg) { offf.x += tf.x; offf.y += tf.y; offb.x += tb.x; offb.y += tb.y; } }
#pragma unroll
    for (int i = 0; i < 8; ++i) { P.bf[i].x += offf.x; P.bf[i].y += offf.y;
        P.cb[i].x = P.totb.x - (P.cb[i].x + offb.x) + gb[i].x; P.cb[i].y = P.totb.y - (P.cb[i].y + offb.y) + gb[i].y; }
}
__device__ __forceinline__ unsigned pk2f(float a, float b) { return cvtpk(a, b); }
struct Raw { unsigned kf[8], kb[8], q[8]; bf16x8 vv[2]; };
template <bool WITH_Q> __device__ __forceinline__ void load_raw(Raw& Rw, int item, const bf16_t* G0p, int tid) {
    const int cp = tid & 63, tg = tid >> 6;
    const int c = item % NCH, h = (item / NCH) & 3, b = (item / (NCH * 4)) & 7, a = item / (NCH * 32);
    const bf16_t* KF = G0p + (size_t)(a ? 5 : 1) * (GSZ / 2); const bf16_t* KB = G0p + (size_t)(a ? 6 : 1) * (GSZ / 2); const bf16_t* Vg = G0p + (size_t)(a ? 7 : 2) * (GSZ / 2); const bf16_t* Qg = G0p + (size_t)(a ? 4 : 0) * (GSZ / 2);
    const int row0 = seq_row(b, 64 * c);
#pragma unroll
    for (int i = 0; i < 8; ++i) { const size_t off = (size_t)(row0 + 8 * tg + i) * 512 + h * 128 + 2 * cp; Rw.kf[i] = *(const unsigned*)(KF + off); Rw.kb[i] = *(const unsigned*)(KB + off); if (WITH_Q) Rw.q[i] = *(const unsigned*)(Qg + off); }
#pragma unroll
    for (int n = 0; n < 2; ++n) { const int q = tid + 512 * n, k = q >> 4, c0 = (q & 15) * 8; Rw.vv[n] = *(const bf16x8*)(Vg + (size_t)(row0 + k) * 512 + h * 128 + c0); }
}

__device__ __forceinline__ void s1_item(int item, int next_item, Raw& Rw, const bf16_t* G0p, const float* lg, bf16_t* ST, float* DEC, LAS char* lds, const int wv) {
    const int tid = tidx(wv), lane = tid & 63, wid = tid >> 6, cp = tid & 63, tg = tid >> 6, r32 = lane & 31, hi = lane >> 5;
    const int c = item % NCH, h = (item / NCH) & 3, b = (item / (NCH * 4)) & 7, a = item / (NCH * 32);
    LAS char* KFi = lds; LAS char* KBi = lds + 16384; LAS char* Vi = lds + 32768; LAS float* tot = (LAS float*)(lds + 49152);
    bf16x8 vv[2] = {Rw.vv[0], Rw.vv[1]};
    Prep P; prep_decay(P, Rw.kf, Rw.kb, a, lg[h], lg[4 + h], tot, tid);
#pragma unroll
    for (int i = 0; i < 8; ++i) { const int k = 8 * tg + i; const int o = v_st(k, 2 * cp);
        *(LAS unsigned*)(KFi + o) = pk2f(P.kf[i].x * __expf(P.totf.x - P.bf[i].x), P.kf[i].y * __expf(P.totf.y - P.bf[i].y));
        *(LAS unsigned*)(KBi + o) = pk2f(P.kb[i].x * __expf(P.totb.x - P.cb[i].x), P.kb[i].y * __expf(P.totb.y - P.cb[i].y)); }
#pragma unroll
    for (int n = 0; n < 2; ++n) { const int q = tid + 512 * n, k = q >> 4, c0 = (q & 15) * 8; *(LAS bf16x8*)(Vi + v_st(k, c0)) = vv[n]; }
    const size_t sidx = ((((size_t)a * 8 + b) * 4 + h) * 2) * NCH;
    if (tg == 0) { *(float2*)(DEC + (sidx + c) * 128 + 2 * cp) = make_float2(__expf(P.totf.x), __expf(P.totf.y)); *(float2*)(DEC + (sidx + NCH + c) * 128 + 2 * cp) = make_float2(__expf(P.totb.x), __expf(P.totb.y)); }
    if (next_item >= 0) load_raw<false>(Rw, next_item, G0p, tid);
    __syncthreads();
    const int dkb = wid & 3, dvb0 = 2 * (wid >> 2);
    const int aKF = (int)(unsigned)(uintptr_t)KFi + v_rd_base(lane) + dkb * 512, aKB = (int)(unsigned)(uintptr_t)KBi + v_rd_base(lane) + dkb * 512, aV = (int)(unsigned)(uintptr_t)Vi + v_rd_base(lane) + dvb0 * 512;
    f32x16 uf0 = {}, uf1 = {}, ub0 = {}, ub1 = {};
    asm volatile("" : "+v"(uf0), "+v"(uf1), "+v"(ub0), "+v"(ub1));
#define S1_STEP(KS) do { const s16x4 fl = tri<(KS) * 4096>(aKF), fh = tri<(KS) * 4096 + 2048>(aKF), bl = tri<(KS) * 4096>(aKB), bh = tri<(KS) * 4096 + 2048>(aKB); \
        const s16x4 v0l = tri<(KS) * 4096>(aV), v0h = tri<(KS) * 4096 + 2048>(aV), v1l = tri<(KS) * 4096 + 512>(aV), v1h = tri<(KS) * 4096 + 2048 + 512>(aV); SC_LWAIT(); \
        const bf16x8 kff = SC_PK(fl, fh), kbf = SC_PK(bl, bh), vf0 = SC_PK(v0l, v0h), vf1 = SC_PK(v1l, v1h); \
        uf0 = __builtin_amdgcn_mfma_f32_32x32x16_bf16(vf0, kff, uf0, 0, 0, 0); uf1 = __builtin_amdgcn_mfma_f32_32x32x16_bf16(vf1, kff, uf1, 0, 0, 0); \
        ub0 = __builtin_amdgcn_mfma_f32_32x32x16_bf16(vf0, kbf, ub0, 0, 0, 0); ub1 = __builtin_amdgcn_mfma_f32_32x32x16_bf16(vf1, kbf, ub1, 0, 0, 0); } while (0)
    S1_STEP(0); S1_STEP(1); S1_STEP(2); S1_STEP(3);
#undef S1_STEP
    bf16_t* Uf = ST + (sidx + c) * 16384; bf16_t* Ub = ST + (sidx + NCH + c) * 16384;
    const int dk = 32 * dkb + r32;
#define S1_ST(ACC, BASE, DVB) do { _Pragma("unroll") for (int p = 0; p < 2; ++p) { \
        const unsigned a0 = cvtpk(ACC[8 * p], ACC[8 * p + 1]), a1 = cvtpk(ACC[8 * p + 2], ACC[8 * p + 3]), b0 = cvtpk(ACC[8 * p + 4], ACC[8 * p + 5]), b1 = cvtpk(ACC[8 * p + 6], ACC[8 * p + 7]); \
        auto r0 = __builtin_amdgcn_permlane32_swap(a0, b0, false, false); auto r1 = __builtin_amdgcn_permlane32_swap(a1, b1, false, false); \
        const u32x4 w = {r0[0], r1[0], r0[1], r1[1]}; *(u32x4*)((BASE) + ((size_t)(4 * (DVB) + 2 * p + hi) * 128 + dk) * 8) = w; } } while (0)
    S1_ST(uf0, Uf, dvb0); S1_ST(uf1, Uf, dvb0 + 1); S1_ST(ub0, Ub, dvb0); S1_ST(ub1, Ub, dvb0 + 1);
#undef S1_ST
    __syncthreads();
}

__device__ __forceinline__ void s2_vec(size_t v, bf16_t* ST, const float* DEC) {
    const int chain = (int)(v >> 11), e8 = (int)(v & 2047), dk = e8 & 127, dir = chain & 1;
    bf16_t* base = ST + (size_t)chain * NCH * 16384 + (size_t)e8 * 8; const float* dec = DEC + (size_t)chain * NCH * 128 + dk;
    float S[8];
#pragma unroll
    for (int i = 0; i < 8; ++i) S[i] = 0.f;
#define S2_C(q) (dir ? ((q) < 4 ? 3 - (q) : 71 - (q)) : (q))
    u32x4 u[8]; float d[8];
#pragma unroll
    for (int j = 0; j < 8; ++j) { const int c = S2_C(j); u[j] = __builtin_nontemporal_load((const u32x4*)(base + (size_t)c * 16384)); d[j] = dec[c * 128]; }
#pragma unroll 1
    for (int q0 = 0; q0 < NCH; q0 += 8) {
#pragma unroll
        for (int j = 0; j < 8; ++j) { const int q = q0 + j; if (q < NCH) { const int c = S2_C(q);
            const u32x4 uu = u[j]; const float dd = d[j];
            if (q + 8 < NCH) { const int cn = S2_C(q + 8); u[j] = __builtin_nontemporal_load((const u32x4*)(base + (size_t)cn * 16384)); d[j] = dec[cn * 128]; }
            u32x4 w; w.x = cvtpk(S[0], S[1]); w.y = cvtpk(S[2], S[3]); w.z = cvtpk(S[4], S[5]); w.w = cvtpk(S[6], S[7]);
            *(u32x4*)(base + (size_t)c * 16384) = w;
            const float2 u0 = bf2x(uu.x), u1 = bf2x(uu.y), u2 = bf2x(uu.z), u3 = bf2x(uu.w);
            S[0] = dd * S[0] + u0.x; S[1] = dd * S[1] + u0.y; S[2] = dd * S[2] + u1.x; S[3] = dd * S[3] + u1.y; S[4] = dd * S[4] + u2.x; S[5] = dd * S[5] + u2.y; S[6] = dd * S[6] + u3.x; S[7] = dd * S[7] + u3.y; } }
    }
#undef S2_C
}

__device__ __forceinline__ void s3_item(int item, int next_item, Raw& Rw, const bf16_t* G0p, const float* lg, const bf16_t* ST, bf16_t* Y, LAS char* lds, const int wv) {
    const int tid = tidx(wv), lane = tid & 63, wid = tid >> 6, cp = tid & 63, tg = tid >> 6, r32 = lane & 31, hi = lane >> 5;
    const int c = item % NCH, h = (item / NCH) & 3, b = (item / (NCH * 4)) & 7, a = item / (NCH * 32);
    const bf16_t* Gt = G0p + (size_t)(a ? 8 : 3) * (GSZ / 2);
    const int row0 = seq_row(b, 64 * c);
    LAS char* QFi = lds; LAS char* KFi = lds + 16384; LAS char* Vi = lds + 32768; LAS float* tot = (LAS float*)(lds + 49152);
    LAS char* QBi = lds + 65536; LAS char* KBi = lds + 81920; LAS char* QF2 = lds + 98304; LAS char* QB2 = lds + 114688; LAS float* red = (LAS float*)(lds + 65536);
    const size_t sidx = ((((size_t)a * 8 + b) * 4 + h) * 2) * NCH;
    bf16x8 vv[2] = {Rw.vv[0], Rw.vv[1]}, sf[4], sb[4];
    float2 qv[8];
#pragma unroll
    for (int i = 0; i < 8; ++i) qv[i] = bf2x(Rw.q[i]);
    Prep P; prep_decay(P, Rw.kf, Rw.kb, a, lg[h], lg[4 + h], tot, tid);
#pragma unroll
    for (int i = 0; i < 8; ++i) { const int k = 8 * tg + i; const int o = KSWZ(k, 4 * cp);
        const float2 ef = make_float2(__expf(P.bf[i].x - P.reff.x), __expf(P.bf[i].y - P.reff.y)), eb = make_float2(__expf(P.cb[i].x - P.refb.x), __expf(P.cb[i].y - P.refb.y));
        *(LAS unsigned*)(QFi + o) = pk2f(qv[i].x * ef.x, qv[i].y * ef.y); *(LAS unsigned*)(KFi + o) = pk2f(P.kf[i].x * __builtin_amdgcn_rcpf(ef.x), P.kf[i].y * __builtin_amdgcn_rcpf(ef.y));
        *(LAS unsigned*)(QBi + o) = pk2f(qv[i].x * eb.x, qv[i].y * eb.y); *(LAS unsigned*)(KBi + o) = pk2f(P.kb[i].x * __builtin_amdgcn_rcpf(eb.x), P.kb[i].y * __builtin_amdgcn_rcpf(eb.y));
        *(LAS unsigned*)(QF2 + o) = pk2f(qv[i].x * __expf(P.bf[i].x), qv[i].y * __expf(P.bf[i].y)); *(LAS unsigned*)(QB2 + o) = pk2f(qv[i].x * __expf(P.cb[i].x), qv[i].y * __expf(P.cb[i].y)); }
#pragma unroll
    for (int n = 0; n < 2; ++n) { const int q = tid + 512 * n, k = q >> 4, c0 = (q & 15) * 8; *(LAS bf16x8*)(Vi + v_st(k, c0)) = vv[n]; }
#pragma unroll
    for (int n = 0; n < 4; ++n) { const int q = tid + 512 * n; sf[n] = *(const bf16x8*)(ST + (sidx + c) * 16384 + (size_t)q * 8); sb[n] = *(const bf16x8*)(ST + (sidx + NCH + c) * 16384 + (size_t)q * 8); }
    if (next_item >= 0) load_raw<true>(Rw, next_item, G0p, tid);
    __syncthreads();
    const int rb = wid >> 2, d0 = wid & 3, qrow = 32 * rb + r32;
    f32x16 pf0 = {}, pf1 = {}, pb0 = {}, pb1 = {};
    asm volatile("" : "+v"(pf0), "+v"(pf1), "+v"(pb0), "+v"(pb1));
#pragma unroll
    for (int ks = 0; ks < 8; ++ks) { const int cb_ = (ks * 16 + hi * 8) * 2;
        const bf16x8 qf = *(const LAS bf16x8*)(QFi + KSWZ(qrow, cb_)), qb = *(const LAS bf16x8*)(QBi + KSWZ(qrow, cb_));
        const bf16x8 kf0 = *(const LAS bf16x8*)(KFi + KSWZ(r32, cb_)), kf1 = *(const LAS bf16x8*)(KFi + KSWZ(32 + r32, cb_)), kb0 = *(const LAS bf16x8*)(KBi + KSWZ(r32, cb_)), kb1 = *(const LAS bf16x8*)(KBi + KSWZ(32 + r32, cb_));
        pf0 = __builtin_amdgcn_mfma_f32_32x32x16_bf16(kf0, qf, pf0, 0, 0, 0); pf1 = __builtin_amdgcn_mfma_f32_32x32x16_bf16(kf1, qf, pf1, 0, 0, 0);
        pb0 = __builtin_amdgcn_mfma_f32_32x32x16_bf16(kb0, qb, pb0, 0, 0, 0); pb1 = __builtin_amdgcn_mfma_f32_32x32x16_bf16(kb1, qb, pb1, 0, 0, 0); }
#pragma unroll
    for (int r = 0; r < 16; ++r) { const int j0 = crow(r, hi), j1 = 32 + j0;
        pf0[r] = (j0 <= qrow ? pf0[r] : 0.f) + (j0 >= qrow ? pb0[r] : 0.f); pf1[r] = (j1 <= qrow ? pf1[r] : 0.f) + (j1 >= qrow ? pb1[r] : 0.f); }
    bf16x8 pa0, pa1, pa2, pa3;
#define PK4(Pv, BASE, OUT) do { unsigned a0 = cvtpk(Pv[BASE + 0], Pv[BASE + 1]), a1 = cvtpk(Pv[BASE + 2], Pv[BASE + 3]);   \
    unsigned b0 = cvtpk(Pv[BASE + 4], Pv[BASE + 5]), b1 = cvtpk(Pv[BASE + 6], Pv[BASE + 7]);                              \
    auto r0 = __builtin_amdgcn_permlane32_swap(a0, b0, false, false); auto r1 = __builtin_amdgcn_permlane32_swap(a1, b1, false, false); \
    u32x4 w = {r0[0], r1[0], r0[1], r1[1]}; OUT = *reinterpret_cast<bf16x8*>(&w); } while (0)
    PK4(pf0, 0, pa0); PK4(pf0, 8, pa1); PK4(pf1, 0, pa2); PK4(pf1, 8, pa3);
#undef PK4
    f32x16 o = {}; asm volatile("" : "+v"(o));
    { const int aV = (int)(unsigned)(uintptr_t)Vi + v_rd_base(lane) + d0 * 512;
      const s16x4 l0 = tri<0>(aV), h0 = tri<2048>(aV), l1 = tri<4096>(aV), h1 = tri<4096 + 2048>(aV), l2 = tri<8192>(aV), h2 = tri<8192 + 2048>(aV), l3 = tri<12288>(aV), h3 = tri<12288 + 2048>(aV); SC_LWAIT();
      o = __builtin_amdgcn_mfma_f32_32x32x16_bf16(SC_PK(l0, h0), pa0, o, 0, 0, 0); o = __builtin_amdgcn_mfma_f32_32x32x16_bf16(SC_PK(l1, h1), pa1, o, 0, 0, 0);
      o = __builtin_amdgcn_mfma_f32_32x32x16_bf16(SC_PK(l2, h2), pa2, o, 0, 0, 0); o = __builtin_amdgcn_mfma_f32_32x32x16_bf16(SC_PK(l3, h3), pa3, o, 0, 0, 0); }
    __syncthreads();
    LAS char* SFi = lds; LAS char* SBi = lds + 32768;
#pragma unroll
    for (int n = 0; n < 4; ++n) { const int q = tid + 512 * n, dk = q & 127, c0 = (q >> 7) * 8; const int oo = (dk >> 6) * 16384 + v_st(dk & 63, c0); *(LAS bf16x8*)(SFi + oo) = sf[n]; *(LAS bf16x8*)(SBi + oo) = sb[n]; }
    __syncthreads();
    u32x2 gq[4];
#pragma unroll
    for (int g = 0; g < 4; ++g) gq[g] = *(const u32x2*)(Gt + (size_t)(row0 + 32 * rb + r32) * 512 + h * 128 + 32 * d0 + 8 * g + 4 * hi);
    { const int aSF = (int)(unsigned)(uintptr_t)SFi + v_rd_base(lane) + d0 * 512, aSB = (int)(unsigned)(uintptr_t)SBi + v_rd_base(lane) + d0 * 512;
#define S3_STEP(KS) do { const int cb_ = ((KS) * 16 + hi * 8) * 2; const bf16x8 q1 = *(const LAS bf16x8*)(QF2 + KSWZ(qrow, cb_)), q2 = *(const LAS bf16x8*)(QB2 + KSWZ(qrow, cb_)); \
        const s16x4 fl = tri<(KS) * 4096>(aSF), fh = tri<(KS) * 4096 + 2048>(aSF), bl = tri<(KS) * 4096>(aSB), bh = tri<(KS) * 4096 + 2048>(aSB); SC_LWAIT(); \
        o = __builtin_amdgcn_mfma_f32_32x32x16_bf16(SC_PK(fl, fh), q1, o, 0, 0, 0); o = __builtin_amdgcn_mfma_f32_32x32x16_bf16(SC_PK(bl, bh), q2, o, 0, 0, 0); } while (0)
      S3_STEP(0); S3_STEP(1); S3_STEP(2); S3_STEP(3); S3_STEP(4); S3_STEP(5); S3_STEP(6); S3_STEP(7);
#undef S3_STEP
    }
    { float ss = 0.f;
#pragma unroll
      for (int r = 0; r < 16; ++r) ss += o[r] * o[r];
      { auto rr = __builtin_amdgcn_permlane32_swap(__float_as_uint(ss), __float_as_uint(ss), false, false); ss = __uint_as_float(rr[0]) + __uint_as_float(rr[1]); }
      if (hi == 0) red[(rb * 4 + d0) * 32 + r32] = ss; }
    __syncthreads();
    { const float tot = red[(rb * 4 + 0) * 32 + r32] + red[(rb * 4 + 1) * 32 + r32] + red[(rb * 4 + 2) * 32 + r32] + red[(rb * 4 + 3) * 32 + r32];
      const float rs = rsqrtf(tot * (1.f / 128.f) + EPS);
      bf16_t* yrow = Y + (size_t)(row0 + 32 * rb + r32) * 1024 + a * 512 + h * 128 + 32 * d0 + 8 * hi;
#pragma unroll
      for (int pp = 0; pp < 2; ++pp) {
          const float2 ga = bf2x(gq[2 * pp].x), gb = bf2x(gq[2 * pp].y), gc = bf2x(gq[2 * pp + 1].x), gd = bf2x(gq[2 * pp + 1].y);
          const unsigned a0 = cvtpk(o[8 * pp] * rs * ga.x, o[8 * pp + 1] * rs * ga.y), a1 = cvtpk(o[8 * pp + 2] * rs * gb.x, o[8 * pp + 3] * rs * gb.y);
          const unsigned b0 = cvtpk(o[8 * pp + 4] * rs * gc.x, o[8 * pp + 5] * rs * gc.y), b1 = cvtpk(o[8 * pp + 6] * rs * gd.x, o[8 * pp + 7] * rs * gd.y);
          auto r0 = __builtin_amdgcn_permlane32_swap(a0, b0, false, false); auto r1 = __builtin_amdgcn_permlane32_swap(a1, b1, false, false);
          const u32x4 w = {r0[0], r1[0], r0[1], r1[1]}; *(u32x4*)(yrow + 16 * pp) = w; } }
    __syncthreads();
}
#undef SC_PK
#undef SC_LWAIT
}

constexpr int RING_OFF = 0, RING_BYTES = 131072;
constexpr int MISC_OFF = RING_BYTES;
constexpr int LDS_BYTES = 147456;
constexpr int NWAVES = 8, NTHREADS = 512;
static_assert(pg8::UT_OFF == MISC_OFF + 1024 && pg8::UT_OFF + pg8::UT_N * 32 <= LDS_BYTES, "unit table lives in the control region");

#define XB_TMO      128
#define XB_XCNT(j)  (256  + 64 * (j))
#define XB_XSUB(j)  (1280 + 64 * (j))
#define XB_XGEN(j)  (2304 + 64 * (j))
#define XB_TOP      3328
#define XB_TOPGEN   3392
#define XCD_BAR_WORDS 3456
#define XB_SPIN_CAP (1u << 18)
__device__ __forceinline__ unsigned xb_ld(unsigned* p)              { return __hip_atomic_load(p, __ATOMIC_RELAXED, __HIP_MEMORY_SCOPE_AGENT); }
__device__ __forceinline__ unsigned xb_add(unsigned* p, unsigned v) { return __hip_atomic_fetch_add(p, v, __ATOMIC_RELAXED, __HIP_MEMORY_SCOPE_AGENT); }
__device__ __forceinline__ unsigned xb_xcc_id() { return (unsigned)__builtin_amdgcn_s_getreg((3 << 11) | 20) & 0xFu; }
#define XB_SPIN(cond, bar) do { unsigned _sp = 0; while (cond) { __builtin_amdgcn_s_sleep(1); \
    if ((++_sp & 255u) == 0u) { if (xb_ld(&(bar)[XB_TMO])) break; if (_sp > XB_SPIN_CAP) { atomicAdd(&(bar)[XB_TMO], 1u); break; } } } } while (0)
struct XcdBarrier { unsigned* bar; unsigned x; volatile LAS unsigned* st; };
__device__ __forceinline__ XcdBarrier xcd_barrier_post(unsigned* bar, volatile LAS unsigned* st) {
    XcdBarrier b; b.bar = bar; b.x = xb_xcc_id(); b.st = st;
    if (threadIdx.x == 0) (void)xb_add(&bar[XB_XCNT(b.x)], 1u);
    return b;
}
__device__ __forceinline__ void xcd_barrier_complete(unsigned* bar, unsigned x, unsigned& nloc, unsigned& nx) {
    const unsigned Gt = gridDim.x * gridDim.y * gridDim.z;
    unsigned sum, cnt, mine, sp = 0u;
    for (;;) {
        sum = 0u; cnt = 0u; mine = 0u;
#pragma unroll
        for (unsigned j = 0; j < 16; ++j) { const unsigned c = xb_ld(&bar[XB_XCNT(j)]); sum += c; cnt += (c > 0u) ? 1u : 0u; mine = (j == x) ? c : mine; }
        if (sum == Gt) break;
        __builtin_amdgcn_s_sleep(1);
        if ((++sp & 255u) == 0u) { if (xb_ld(&bar[XB_TMO])) break; if (sp > XB_SPIN_CAP) { atomicAdd(&bar[XB_TMO], 1u); break; } }
    }
    nloc = mine > 0u ? mine : 1u; nx = cnt > 0u ? cnt : 1u;
}
__device__ __forceinline__ void xcd_barrier(const XcdBarrier& b, const bool leader  ) {
    asm volatile("s_waitcnt vmcnt(0)" ::: "memory");
    __syncthreads();
    if (leader) {
        unsigned* bar = b.bar;
        __builtin_amdgcn_s_waitcnt(0);
        unsigned nloc = b.st[0], nx = b.st[1];
        if (nloc == 0u) { xcd_barrier_complete(bar, b.x, nloc, nx); b.st[0] = nloc; b.st[1] = nx; }
        const unsigned old = xb_add(&bar[XB_XSUB(b.x)], 1u);
        const unsigned gen = old / nloc;
        if (old + 1u == (gen + 1u) * nloc) {
            __builtin_amdgcn_fence(__ATOMIC_RELEASE, "agent");
            asm volatile("s_waitcnt vmcnt(0)" ::: "memory");
            const unsigned og = xb_add(&bar[XB_TOP], 1u);
            const unsigned tg = og / nx;
            if (og + 1u == (tg + 1u) * nx) xb_add(&bar[XB_TOPGEN], 1u);
            else XB_SPIN(xb_ld(&bar[XB_TOPGEN]) == tg, bar);
            __builtin_amdgcn_fence(__ATOMIC_ACQUIRE, "agent");
            xb_add(&bar[XB_XGEN(b.x)], 1u);
            asm volatile("s_waitcnt vmcnt(0)" ::: "memory");
        } else {
            XB_SPIN(xb_ld(&bar[XB_XGEN(b.x)]) == gen, bar);
            __builtin_amdgcn_fence(__ATOMIC_ACQUIRE, "agent");
            asm volatile("s_waitcnt vmcnt(0)" ::: "memory");
        }
    }
    __syncthreads();
}

__device__ __forceinline__ void transpose_item(const float* __restrict__ W, int ldw, int K, int src0, bf16_t* __restrict__ WT, int n0, int k0, LAS float* scr, int lane) {
    f32x4 ld[8];
#pragma unroll
    for (int i = 0; i < 8; ++i) { const int kk = 8 * i + (lane >> 3); ld[i] = src0 >= 0 ? *(const f32x4*)(W + (size_t)(k0 + kk) * ldw + src0 + 4 * (lane & 7)) : (f32x4){0.f, 0.f, 0.f, 0.f}; }
#pragma unroll
    for (int i = 0; i < 8; ++i) { const int kk = 8 * i + (lane >> 3); *(LAS f32x4*)(scr + kk * 36 + 4 * (lane & 7)) = ld[i]; }
    asm volatile("s_waitcnt lgkmcnt(0)" ::: "memory");
    const int c = lane & 7;
#pragma unroll
    for (int j = 0; j < 4; ++j) { const int n = (lane >> 3) + 8 * j; const LAS float* s = scr + (8 * c) * 36 + n;
        u32x4 o; o.x = cvt_pk_bf16(s[0 * 36], s[1 * 36]); o.y = cvt_pk_bf16(s[2 * 36], s[3 * 36]); o.z = cvt_pk_bf16(s[4 * 36], s[5 * 36]); o.w = cvt_pk_bf16(s[6 * 36], s[7 * 36]);
        *(u32x4*)(WT + (size_t)(n0 + n) * K + k0 + 8 * c) = o; }
    asm volatile("s_waitcnt lgkmcnt(0)" ::: "memory");
}
__device__ __forceinline__ void transpose_item8(const float* __restrict__ W, int ldw, int K, int src0, unsigned char* __restrict__ WT, int n0, int k0, LAS float* scr, int lane) {
    f32x4 ld[8];
#pragma unroll
    for (int i = 0; i < 8; ++i) { const int kk = 8 * i + (lane >> 3); ld[i] = *(const f32x4*)(W + (size_t)(k0 + kk) * ldw + src0 + 4 * (lane & 7)); }
#pragma unroll
    for (int i = 0; i < 8; ++i) { const int kk = 8 * i + (lane >> 3); *(LAS f32x4*)(scr + kk * 36 + 4 * (lane & 7)) = ld[i]; }
    asm volatile("s_waitcnt lgkmcnt(0)" ::: "memory");
    const int c = lane & 7;
#pragma unroll
    for (int j = 0; j < 4; ++j) { const int n = (lane >> 3) + 8 * j; const LAS float* sp = scr + (8 * c) * 36 + n;
        u32x2 o; o.x = pack4_fp8(sp[0 * 36] * W8_SCALE, sp[1 * 36] * W8_SCALE, sp[2 * 36] * W8_SCALE, sp[3 * 36] * W8_SCALE); o.y = pack4_fp8(sp[4 * 36] * W8_SCALE, sp[5 * 36] * W8_SCALE, sp[6 * 36] * W8_SCALE, sp[7 * 36] * W8_SCALE);
        *(u32x2*)(WT + (size_t)(n0 + n) * K + k0 + 8 * c) = o; }
    asm volatile("s_waitcnt lgkmcnt(0)" ::: "memory");
}
__device__ __forceinline__ int src_mixin(int n0) { const int pn = n0 >> 8, q = n0 & 255, grp = pn >> 1, half = pn & 1; if (grp > 1) return n0; const int bj = q >> 7, rr = q & 127, hl = rr >> 6, j = rr & 63; return grp * 512 + (half * 2 + hl) * 128 + bj * 64 + j; }
__device__ __forceinline__ int src_swiglu(int n0) { const int pn = n0 >> 8, q = n0 & 255, bj = q >> 7, rr = q & 127; return bj * FFN + pn * 128 + rr; }
__device__ __forceinline__ int src_uq(int n0) { const int pn = n0 >> 8, q = n0 & 255, bj = q >> 7, rr = q & 127; if (pn < 4) return (2 * pn + bj) * 192 + rr; const int hl = rr >> 5; return (4 * (pn - 4) + hl) * 192 + 128 + bj * 32 + (rr & 31); }

struct Args { const float* in[22]; float* out; unsigned char* ws; int ph_lo, ph_hi; };

constexpr int CI_MIXIN = 0, CI_MIXOUT = CI_MIXIN + 16 * 144, CI_FFNIN = CI_MIXOUT + 16 * 32, CI_FFNOUT = CI_FFNIN + 16 * 176, CI_DOWN = CI_FFNOUT + 44 * 32, CI_UQ = CI_DOWN + 16 * 24,
              CI_UKV = CI_UQ + 6 * 48, CI_MLAOUT = CI_UKV + 4 * 64, CI_MOEOUT = CI_MLAOUT + 16 * 32, CI_MOEIN = CI_MOEOUT + 8 * 44 * 32, CI_END = CI_MOEIN + 8 * 16 * 176;
struct ConvP { const float *mix_in_w, *mix_out_w, *ffn_in_w, *ffn_out_w, *down_w, *uq_w, *ukv_w, *mla_out_w, *moe_in_w, *moe_out_w;
               bf16_t *Wmixin, *Wmixout, *Wffnin, *Wffnout, *Wdown, *Wuq, *Wukv, *Wmlaout, *Wmi, *Wmo; };
template <int LO, int HI> __device__ __forceinline__ void conv_range(const ConvP& p, const int gwl, const int NGWL, LAS float* scr, const int lane) {
#define CI_HAS(A, B) (LO < (B) && HI > (A))
    for (int it = LO + gwl; it < HI; it += NGWL) {
        if (CI_HAS(CI_MIXIN, CI_MIXOUT) && it < CI_MIXOUT) { const int r = it - CI_MIXIN, kb = r / 144, nb = r % 144; transpose_item(p.mix_in_w, MIXC, 1024, src_mixin(nb * 32), p.Wmixin, nb * 32, kb * 64, scr, lane); continue; }
        if (CI_HAS(CI_MIXOUT, CI_FFNIN) && it < CI_FFNIN) { const int r = it - CI_MIXOUT, kb = r / 32, nb = r % 32; transpose_item(p.mix_out_w, 1024, 1024, nb * 32, p.Wmixout, nb * 32, kb * 64, scr, lane); continue; }
#if FFN_FP8 == 1
        if (CI_HAS(CI_FFNIN, CI_FFNOUT) && it < CI_FFNOUT) { const int r = it - CI_FFNIN, kb = r / 176, nb = r % 176; transpose_item8(p.ffn_in_w, 2 * FFN, 1024, src_swiglu(nb * 32), (unsigned char*)p.Wffnin, nb * 32, kb * 64, scr, lane); continue; }
#else
        if (CI_HAS(CI_FFNIN, CI_FFNOUT) && it < CI_FFNOUT) { const int r = it - CI_FFNIN, kb = r / 176, nb = r % 176; transpose_item(p.ffn_in_w, 2 * FFN, 1024, src_swiglu(nb * 32), p.Wffnin, nb * 32, kb * 64, scr, lane); continue; }
#endif
#if FFN_FP8
        if (CI_HAS(CI_FFNOUT, CI_DOWN) && it < CI_DOWN) { const int r = it - CI_FFNOUT, kb = r / 32, nb = r % 32; transpose_item8(p.ffn_out_w, 1024, FFN, nb * 32, (unsigned char*)p.Wffnout, nb * 32, kb * 64, scr, lane); continue; }
#else
        if (CI_HAS(CI_FFNOUT, CI_DOWN) && it < CI_DOWN) { const int r = it - CI_FFNOUT, kb = r / 32, nb = r % 32; transpose_item(p.ffn_out_w, 1024, FFN, nb * 32, p.Wffnout, nb * 32, kb * 64, scr, lane); continue; }
#endif
        if (CI_HAS(CI_DOWN, CI_UQ) && it < CI_UQ) { const int r = it - CI_DOWN, kb = r / 24, nb = r % 24; transpose_item(p.down_w, DOWNC, 1024, nb < 22 ? nb * 32 : -1, p.Wdown, nb * 32, kb * 64, scr, lane); continue; }
        if (CI_HAS(CI_UQ, CI_UKV) && it < CI_UKV) { const int r = it - CI_UQ, kb = r / 48, nb = r % 48; transpose_item(p.uq_w, 1536, QRANK, src_uq(nb * 32), p.Wuq, nb * 32, kb * 64, scr, lane); continue; }
        if (CI_HAS(CI_UKV, CI_MLAOUT) && it < CI_MLAOUT) { const int r = it - CI_UKV, kb = r / 64, nb = r % 64; transpose_item(p.ukv_w, 2048, KVRANK, nb * 32, p.Wukv, nb * 32, kb * 64, scr, lane); continue; }
        if (CI_HAS(CI_MLAOUT, CI_MOEOUT) && it < CI_MOEOUT) { const int r = it - CI_MLAOUT, kb = r / 32, nb = r % 32; transpose_item(p.mla_out_w, 1024, 1024, nb * 32, p.Wmlaout, nb * 32, kb * 64, scr, lane); continue; }
        constexpr int J0 = 16 * 176, J1 = 44 * 32;
#if MOE_FP8
        if (CI_HAS(CI_MOEOUT, CI_MOEIN) && it < CI_MOEIN) { const int q = it - CI_MOEOUT, e = q / J1, r = q % J1, kb = r / 32, nb = r % 32; transpose_item8(p.moe_out_w + (size_t)e * FFN * 1024, 1024, FFN, nb * 32, (unsigned char*)p.Wmo + (size_t)e * 1024 * FFN, nb * 32, kb * 64, scr, lane); continue; }
        if (CI_HAS(CI_MOEIN, CI_END)) { const int q = it - CI_MOEIN, e = q / J0, r = q % J0, kb = r / 176, nb = r % 176; transpose_item8(p.moe_in_w + (size_t)e * 1024 * 2 * FFN, 2 * FFN, 1024, src_swiglu(nb * 32), (unsigned char*)p.Wmi + (size_t)e * 2 * FFN * 1024, nb * 32, kb * 64, scr, lane); }
#else
        if (CI_HAS(CI_MOEOUT, CI_MOEIN) && it < CI_MOEIN) { const int q = it - CI_MOEOUT, e = q / J1, r = q % J1, kb = r / 32, nb = r % 32; transpose_item(p.moe_out_w + (size_t)e * FFN * 1024, 1024, FFN, nb * 32, p.Wmo + (size_t)e * 1024 * FFN, nb * 32, kb * 64, scr, lane); continue; }
        if (CI_HAS(CI_MOEIN, CI_END)) { const int q = it - CI_MOEIN, e = q / J0, r = q % J0, kb = r / 176, nb = r % 176; transpose_item(p.moe_in_w + (size_t)e * 1024 * 2 * FFN, 2 * FFN, 1024, src_swiglu(nb * 32), p.Wmi + (size_t)e * 2 * FFN * 1024, nb * 32, kb * 64, scr, lane); }
#endif
    }
#undef CI_HAS
}
__device__ __forceinline__ bool tail_ids(const int nunits, const int G, const int blk, const int wave, int& gwl, int& NGWL) {
    const int rounds = (nunits + G - 1) / G, nheavy = nunits - (rounds - 1) * G;
    if (nheavy >= G) { gwl = blk * 8 + wave; NGWL = G * 8; return true; }
    if (blk < nheavy) return false;
    gwl = (blk - nheavy) * 8 + wave; NGWL = (G - nheavy) * 8; return true;
}

enum Phase { PH_SETUP = 0, PH_ROWS1, PH_MIXIN, PH_SCAN1, PH_SCAN2, PH_SCAN3, PH_MIXOUT, PH_ROWS5, PH_FFNIN, PH_FFNOUT, PH_ROWS8, PH_DOWN, PH_PREP, PH_UQ, PH_UKV, PH_ATTN, PH_MLAOUT, PH_ROWS13, PH_ROUTE, PH_MOEIN, PH_MOEOUT, PH_ROWS17, PH_COUNT };

__global__ void __launch_bounds__(NTHREADS, 2) mega(Args args) {
    extern __shared__ __attribute__((aligned(16))) unsigned char lds_raw[];
    LAS unsigned char* lds = (LAS unsigned char*)lds_raw;
    volatile LAS unsigned* MISC = (volatile LAS unsigned*)(lds + MISC_OFF);
    const int wave0 = __builtin_amdgcn_readfirstlane((int)threadIdx.x >> 6);
    const int tid0 = threadIdx.x;
    const int G = gridDim.x, blk = blockIdx.x;
#define PHASE_IDS const int tid = tidx(wave0), lane = tid & 63, wave = __builtin_amdgcn_readfirstlane(tid >> 6), gw = blk * NWAVES + wave, NGW = G * NWAVES; (void)lane; (void)gw; (void)NGW
    unsigned char* ws0 = args.ws;
    for (int u = tid0; u < (LDS_BYTES - MISC_OFF) / 4; u += NTHREADS) ((LAS unsigned*)(lds + MISC_OFF))[u] = 0u;
    __syncthreads();
    const int lo = args.ph_lo, hi = args.ph_hi;
    XcdBarrier bar; bar.bar = (unsigned*)(ws0 + WS_CTL) + 4096; bar.x = 0; bar.st = nullptr;
    if (hi - lo > 1) bar = xcd_barrier_post((unsigned*)(ws0 + WS_CTL) + 4096, MISC + 8);
#ifndef PHMASK
#define PHMASK 0xffffffffu
#endif
#define IN(k) (((PHMASK >> (k)) & 1u) && lo <= (k) && (k) < hi)
#ifdef PROBE_K
    LAS unsigned long long* tsl = (LAS unsigned long long*)(lds + MISC_OFF + 512);
    if (tid0 == 0) tsl[0] = __builtin_amdgcn_s_memrealtime();
#define SEAM(k) do { if (IN(k) && IN((k) + 1)) xcd_barrier(bar, tidx(wave0) == 0); if (tid0 == 0) tsl[(k) + 1] = __builtin_amdgcn_s_memrealtime(); } while (0)
#else
#define SEAM(k) do { if (IN(k) && IN((k) + 1)) xcd_barrier(bar, tidx(wave0) == 0); } while (0)
#endif
    const float* x = args.in[0]; const float* cvec = args.in[1]; const float* ctx = args.in[2]; const float* cctx = args.in[3];
    const float* mod_w = args.in[4]; const float* mod_b = args.in[5]; const float* norm_g = args.in[6]; const float* mix_in_w = args.in[7];
    const float* decay_logit = args.in[8]; const float* lb_logit = args.in[9]; const float* mix_out_w = args.in[10]; const float* ffn_in_w = args.in[11];
    const float* ffn_out_w = args.in[12]; const float* down_w = args.in[13]; const float* gq = args.in[14]; const float* gkv = args.in[15];
    const float* uq_w = args.in[16]; const float* ukv_w = args.in[17]; const float* mla_out_w = args.in[18]; const float* router_w = args.in[19];
    const float* moe_in_w = args.in[20]; const float* moe_out_w = args.in[21];
    float* out = args.out;
#define PHASE_PTRS GAS unsigned char* wsg_ = (GAS unsigned char*)ws0; asm volatile("" : "+s"(wsg_)); unsigned char* ws = (unsigned char*)wsg_;     \
    float* modv = (float*)(ws + WS_MODV); float* lbv = (float*)(ws + WS_LB); float* lg = (float*)(ws + WS_LG); int* meta = (int*)(ws + WS_META); \
    float* rc = (float*)(ws + WS_ROPE_RC); float* rs = (float*)(ws + WS_ROPE_RS); float* mc = (float*)(ws + WS_ROPE_MC); float* ms = (float*)(ws + WS_ROPE_MS); \
    float* cx = (float*)(ws + WS_CX); bf16_t* HB = (bf16_t*)(ws + WS_HB); bf16_t* G0 = (bf16_t*)(ws + WS_G0); \
    bf16_t* OX = (bf16_t*)(ws + WS_OX); bf16_t* ACT = (bf16_t*)(ws + WS_ACT); \
    bf16_t* DOWN = (bf16_t*)(ws + WS_DOWN); bf16_t* QN = (bf16_t*)(ws + WS_QN); bf16_t* QR = (bf16_t*)(ws + WS_QR); bf16_t* KN = (bf16_t*)(ws + WS_KN); bf16_t* KR = (bf16_t*)(ws + WS_KR); \
    bf16_t* Vv = (bf16_t*)(ws + WS_V); bf16_t* AO = (bf16_t*)(ws + WS_AO); bf16_t* Ob = (bf16_t*)(ws + WS_O); bf16_t* NQ = (bf16_t*)(ws + WS_NQ); bf16_t* NKV = (bf16_t*)(ws + WS_NKV); \
    bf16_t* H4 = (bf16_t*)(ws + WS_H4); bf16_t* HS = (bf16_t*)(ws + WS_HS); bf16_t* ACT2 = (bf16_t*)(ws + WS_ACT2); bf16_t* YS = (bf16_t*)(ws + WS_YS); \
    int* top_e = (int*)(ws + WS_TOPE); float* top_g = (float*)(ws + WS_TOPG); int* tslot = (int*)(ws + WS_TSLOT); \
    bf16_t* Wmixin = (bf16_t*)(ws + WS_W_MIXIN); bf16_t* Wmixout = (bf16_t*)(ws + WS_W_MIXOUT); bf16_t* Wffnin = (bf16_t*)(ws + WS_W_FFNIN); bf16_t* Wffnout = (bf16_t*)(ws + WS_W_FFNOUT); \
    bf16_t* Wdown = (bf16_t*)(ws + WS_W_DOWN); bf16_t* Wuq = (bf16_t*)(ws + WS_W_UQ); bf16_t* Wukv = (bf16_t*)(ws + WS_W_UKV); bf16_t* Wmlaout = (bf16_t*)(ws + WS_W_MLAOUT); \
    bf16_t* Wmi = (bf16_t*)(ws + WS_WMI); bf16_t* Wmo = (bf16_t*)(ws + WS_WMO); \
    const float* mv0 = modv; const float* mv1 = modv + 9 * 6144; const float* g0 = norm_g; const float* g1n = norm_g + 4 * 1024;
    if (IN(PH_SETUP)) { PHASE_PTRS; PHASE_IDS;
        for (int gid = blk * NTHREADS + tid; gid < 4096 * 64; gid += G * NTHREADS) tables_body(gid, lb_logit, decay_logit, rc, rs, mc, ms, lbv, lg);
        LAS float* sc = (LAS float*)(lds + RING_OFF);
        for (int i = tid; i < 9 * 1024; i += NTHREADS) { const int r = i >> 10, k = i & 1023; const float v = r < 8 ? cvec[r * 1024 + k] : cctx[k]; sc[i] = siluf(v); }
        __syncthreads();
        { LAS float* red = (LAS float*)(lds + RING_OFF + 40960);
          for (int cg = blk; cg < 12288 / 64; cg += G) {
            const int col = cg * 64 + lane, l = col / 6144, n = col % 6144;
            float acc[9];
#pragma unroll
            for (int r = 0; r < 9; ++r) acc[r] = 0.f;
            const float* w = mod_w + ((size_t)l * 1024 + wave * 128) * 6144 + n; const LAS float* scw = sc + wave * 128;
#pragma unroll 16
            for (int k = 0; k < 128; ++k) { const float wv = w[(size_t)k * 6144];
#pragma unroll
                for (int r = 0; r < 9; ++r) acc[r] += scw[r * 1024 + k] * wv; }
#pragma unroll
            for (int r = 0; r < 9; ++r) red[(wave * 9 + r) * 64 + lane] = acc[r];
            __syncthreads();
            for (int o = tid; o < 9 * 64; o += NTHREADS) { const int r = o >> 6, ln = o & 63; float sum = 0.f;
#pragma unroll
                for (int w8 = 0; w8 < 8; ++w8) sum += red[(w8 * 9 + r) * 64 + ln];
                const int n2 = (cg * 64) % 6144 + ln; modv[((size_t)l * 9 + r) * 6144 + n2] = sum + mod_b[l * 6144 + n2]; }
            __syncthreads();
          } }
        __syncthreads();
        { ConvP cp{mix_in_w, mix_out_w, ffn_in_w, ffn_out_w, down_w, uq_w, ukv_w, mla_out_w, moe_in_w, moe_out_w, Wmixin, Wmixout, Wffnin, Wffnout, Wdown, Wuq, Wukv, Wmlaout, Wmi, Wmo};
          conv_range<CI_MIXIN, CI_MIXOUT>(cp, gw, NGW, (LAS float*)(lds + RING_OFF + 40960 + wave * 9216), lane); }
    }
    SEAM(PH_SETUP);
    if (IN(PH_ROWS1)) { PHASE_PTRS; PHASE_IDS; RowArgs a{}; a.xin_lat = x; a.xin_ctx = ctx; a.gh = g0; a.scale = mv0 + 1024; a.shift = mv0; a.H = HB; a.nrows = R;
        rows2::rows_phase<true, 0, 0, 1, false>(a, gw, NGW, lane, true, nullptr); }
    SEAM(PH_ROWS1);
    if (IN(PH_MIXIN)) { PHASE_PTRS; pg8::Gemm g{HB, Wmixin, D, D, D}; pg8::DenseOrder S; S.init(R / 256, MIXC / 256, G, blk); pg8::EpiMix E{G0, rc, rs, lbv};
        pg8::gemm_phase<pg8::EpiMix, pg8::DenseOrder, true>(lds + RING_OFF, g, S, E, wave0); }
#define CONV_TAIL(NUNITS, LO, HI) do { PHASE_PTRS; PHASE_IDS; int gwl, NGWL; if (tail_ids((NUNITS), G, blk, wave, gwl, NGWL)) { __syncthreads(); \
        ConvP cp{mix_in_w, mix_out_w, ffn_in_w, ffn_out_w, down_w, uq_w, ukv_w, mla_out_w, moe_in_w, moe_out_w, Wmixin, Wmixout, Wffnin, Wffnout, Wdown, Wuq, Wukv, Wmlaout, Wmi, Wmo}; \
        conv_range<(LO), (HI)>(cp, gwl, NGWL, (LAS float*)(lds + RING_OFF + wave * 9216), lane); } } while (0)
    if (IN(PH_MIXIN)) CONV_TAIL((R / 256) * (MIXC / 256), CI_MIXOUT, CI_DOWN);
    SEAM(PH_MIXIN);
#define SCAN_PTRS bf16_t* ST = (bf16_t*)(ws + scan::WS_STATE); float* DEC = (float*)(ws + scan::WS_DEC)
    if (IN(PH_SCAN1)) { PHASE_PTRS; SCAN_PTRS; scan::Raw Rw; const int NI = 2 * NB * 4 * scan::NCH; if (blk < NI) scan::load_raw<false>(Rw, blk, G0, tidx(wave0));
        for (int item = blk; item < NI; item += G) scan::s1_item(item, item + G < NI ? item + G : -1, Rw, G0, lg, ST, DEC, (LAS char*)(lds + RING_OFF), wave0); }
    SEAM(PH_SCAN1);
    if (IN(PH_SCAN2)) { PHASE_PTRS; SCAN_PTRS; PHASE_IDS; for (size_t v = (size_t)blk * NTHREADS + tid; v < (size_t)2 * NB * 4 * 2 * 2048; v += (size_t)G * NTHREADS) scan::s2_vec(v, ST, DEC); }
    SEAM(PH_SCAN2);
    if (IN(PH_SCAN3)) { PHASE_PTRS; SCAN_PTRS; scan::Raw Rw; const int NI = 2 * NB * 4 * scan::NCH; if (blk < NI) scan::load_raw<true>(Rw, blk, G0, tidx(wave0));
        for (int item = blk; item < NI; item += G) scan::s3_item(item, item + G < NI ? item + G : -1, Rw, G0, lg, ST, HB, (LAS char*)(lds + RING_OFF), wave0); }
    SEAM(PH_SCAN3);
    if (IN(PH_MIXOUT)) { PHASE_PTRS; pg8::Gemm g{HB, Wmixout, D, D, D}; pg8::DenseOrder S; S.init(R / 256, D / 256, G, blk); pg8::EpiPlain E{OX, D};
        pg8::gemm_phase<pg8::EpiPlain, pg8::DenseOrder, false>(lds + RING_OFF, g, S, E, wave0); }
    if (IN(PH_MIXOUT)) CONV_TAIL((R / 256) * (D / 256), CI_DOWN, CI_MOEIN);
    SEAM(PH_MIXOUT);
    if (IN(PH_ROWS5)) { PHASE_PTRS; PHASE_IDS; RowArgs a{}; a.xin_lat = x; a.xin_ctx = ctx; a.xout_lat = out; a.xout_ctx = cx; a.Y = OX; a.gy = g0 + 1024; a.gate = mv0 + 2048; a.gh = g0 + 2048; a.scale = mv0 + 4096; a.shift = mv0 + 3072; a.H = HB; a.nrows = R; a.xout_bf = 1;
#if FFN_FP8 == 1
        a.H8 = (unsigned char*)HB;
        rows2::rows_phase<true, 1, 1, 2, false>(a, gw, NGW, lane, true, nullptr); }
#else
        rows2::rows_phase<true, 1, 1, 1, false>(a, gw, NGW, lane, true, nullptr); }
#endif
    SEAM(PH_ROWS5);
#if FFN_FP8 == 2
    if (IN(PH_FFNIN)) { PHASE_PTRS; pg8::Gemm g{HB, Wffnin, D, D, D}; pg8::DenseOrder S; S.init(R / 256, 2 * FFN / 256, G, blk); pg8::EpiSwiglu8 E{(unsigned char*)ACT, 1.f};
        pg8::gemm_phase<pg8::EpiSwiglu8, pg8::DenseOrder, true>(lds + RING_OFF, g, S, E, wave0); }
#elif FFN_FP8 == 1
    if (IN(PH_FFNIN)) { PHASE_PTRS; pg8::Gemm g{HB, Wffnin, D / 2, D / 2, D / 2}; pg8::DenseOrder S; S.init(R / 256, 2 * FFN / 256, G, blk); pg8::EpiSwiglu8 E{(unsigned char*)ACT, W8_INV};
        pg8::gemm_phase<pg8::EpiSwiglu8, pg8::DenseOrder, true, true>(lds + RING_OFF, g, S, E, wave0); }
#else
    if (IN(PH_FFNIN)) { PHASE_PTRS; pg8::Gemm g{HB, Wffnin, D, D, D}; pg8::DenseOrder S; S.init(R / 256, 2 * FFN / 256, G, blk); pg8::EpiSwiglu E{ACT};
        pg8::gemm_phase<pg8::EpiSwiglu, pg8::DenseOrder, true>(lds + RING_OFF, g, S, E, wave0); }
#endif
    SEAM(PH_FFNIN);
#if FFN_FP8
    if (IN(PH_FFNOUT)) { PHASE_PTRS; pg8::Gemm g{ACT, Wffnout, FFN / 2, FFN / 2, FFN / 2}; pg8::DenseOrder S; S.init(R / 256, D / 256, G, blk); pg8::EpiPlainS E{OX, D, W8_INV};
        pg8::gemm_phase<pg8::EpiPlainS, pg8::DenseOrder, true, true>(lds + RING_OFF, g, S, E, wave0); }
#else
    if (IN(PH_FFNOUT)) { PHASE_PTRS; pg8::Gemm g{ACT, Wffnout, FFN, FFN, FFN}; pg8::DenseOrder S; S.init(R / 256, D / 256, G, blk); pg8::EpiPlain E{OX, D};
        pg8::gemm_phase<pg8::EpiPlain, pg8::DenseOrder, false>(lds + RING_OFF, g, S, E, wave0); }
#endif
    if (IN(PH_FFNOUT)) CONV_TAIL((R / 256) * (D / 256), CI_MOEIN, CI_MOEIN + 6 * 16 * 176);
    SEAM(PH_FFNOUT);
    if (IN(PH_ROWS8)) { PHASE_PTRS; PHASE_IDS; RowArgs a{}; a.xin_lat = out; a.xin_ctx = cx; a.xout_lat = out; a.xout_ctx = cx; a.Y = OX; a.gy = g0 + 3072; a.gate = mv0 + 5120; a.gh = g1n; a.scale = mv1 + 1024; a.shift = mv1; a.H = HB; a.nrows = R; a.xin_bf = 1; a.xout_bf = 1;
        rows2::rows_phase<false, 1, 1, 1, false>(a, gw, NGW, lane, true, nullptr);
    }
    SEAM(PH_ROWS8);
    if (IN(PH_DOWN)) { PHASE_PTRS; pg8::Gemm g{HB, Wdown, D, D, D}; pg8::DenseOrder S; S.init(R / 256, DOWNP / 256, G, blk); pg8::EpiPlain E{DOWN, DOWNP};
        pg8::gemm_phase<pg8::EpiPlain, pg8::DenseOrder, false>(lds + RING_OFF, g, S, E, wave0); }
    if (IN(PH_DOWN)) CONV_TAIL((R / 256) * (DOWNP / 256), CI_MOEIN + 6 * 16 * 176, CI_END);
    SEAM(PH_DOWN);
    if (IN(PH_PREP)) { PHASE_PTRS; PHASE_IDS; for (int r = gw; r < R; r += NGW) mla_prep_body(r, lane, DOWN, gq, gkv, mc, ms, NQ, NKV, KR); }
    SEAM(PH_PREP);
    if (IN(PH_UQ)) { PHASE_PTRS; pg8::Gemm g{NQ, Wuq, QRANK, QRANK, QRANK}; pg8::DenseOrder S; S.init(RL / 256, 1536 / 256, G, blk); pg8::EpiUQ E{QN, QR, mc, ms};
          pg8::gemm_phase<pg8::EpiUQ, pg8::DenseOrder, false>(lds + RING_OFF, g, S, E, wave0); }
#ifdef PROBE_K
    if (tid0 == 0) tsl[PH_UQ + 1] = __builtin_amdgcn_s_memrealtime();
#endif
    if (IN(PH_UKV)) { PHASE_PTRS; pg8::Gemm g{NKV, Wukv, KVRANK, KVRANK, KVRANK}; pg8::DenseOrder S; S.init(R / 256, 2048 / 256, G, blk); pg8::EpiUKV E{KN, Vv};
          pg8::gemm_phase<pg8::EpiUKV, pg8::DenseOrder, false>(lds + RING_OFF, g, S, E, wave0); }
    SEAM(PH_UKV);
    if (IN(PH_ATTN)) { PHASE_PTRS;
        for (int L = blk; L < NB * 8 * (T / 256); L += G) { const int xg = L & 7, jj = L >> 3, pair = xg * 8 + (jj >> 4), qb = jj & 15, b = pair >> 3, h = pair & 7;
            const size_t bh = (size_t)b * 8 + h;
            attn::attn_unit(QN + (bh * T + qb * 256) * 128, QR + (bh * T + qb * 256) * 64, KN + bh * KEYS * 128, KR + (size_t)b * KEYS * 64, Vv + bh * KEYS * 128,
                            AO + ((size_t)b * T + qb * 256) * 1024 + h * 128, KEYS, (LAS char*)(lds + RING_OFF), wave0); }
    }
    SEAM(PH_ATTN);
    if (IN(PH_MLAOUT)) { PHASE_PTRS; pg8::Gemm g{AO, Wmlaout, D, D, D}; pg8::DenseOrder S; S.init(RL / 256, D / 256, G, blk); pg8::EpiPlain E{Ob, D};
        pg8::gemm_phase<pg8::EpiPlain, pg8::DenseOrder, false>(lds + RING_OFF, g, S, E, wave0); }
    SEAM(PH_MLAOUT);
    if (IN(PH_ROWS13)) { PHASE_PTRS; PHASE_IDS; RowArgs a{}; a.xin_lat = out; a.xin_ctx = cx; a.xout_lat = out; a.xout_ctx = cx; a.Y = Ob; a.gy = g1n + 1024; a.gate = mv1 + 2048; a.gh = g1n + 2048; a.scale = mv1 + 4096; a.shift = mv1 + 3072; a.H = H4;
        a.router_w = router_w; a.top_e = top_e; a.top_g = top_g; a.nrows = RL; a.xin_bf = 1; a.xout_bf = 1; a.xout_lat = (float*)(ws + 404 * MiB);
        rows2::stage_router(router_w, lds + RING_OFF, tid, NTHREADS); __syncthreads();
#if MOE_FP8
        a.H8 = (unsigned char*)H4;
        rows2::rows_phase<false, 1, 1, 2, true>(a, gw, NGW, lane, false, lds + RING_OFF); }
#else
        rows2::rows_phase<false, 1, 1, 1, true>(a, gw, NGW, lane, false, lds + RING_OFF); }
#endif
    SEAM(PH_ROWS13);
    if (IN(PH_ROUTE)) { PHASE_PTRS; PHASE_IDS;
        LAS int* sh = (LAS int*)(lds + RING_OFF);
        const int TPB = RL / G, t0 = blk * TPB;
        if (tid < 32) sh[tid] = 0;
        __syncthreads();
        unsigned long long ctot = 0ull, cpre = 0ull;
        for (int t = tid; t < RL; t += NTHREADS) { const int2 e = *(const int2*)(top_e + 2 * t); const unsigned long long inc = (1ull << (8 * e.x)) + (1ull << (8 * e.y)); ctot += inc; if (t < t0) cpre += inc; }
#pragma unroll
        for (int e = 0; e < 8; ++e) { int a = (int)((ctot >> (8 * e)) & 255ull), b2 = (int)((cpre >> (8 * e)) & 255ull);
#pragma unroll
            for (int o = 1; o < 64; o <<= 1) { a += __shfl_xor(a, o); b2 += __shfl_xor(b2, o); }
            if (lane == 0) { __hip_atomic_fetch_add(&sh[e], a, __ATOMIC_RELAXED, __HIP_MEMORY_SCOPE_WORKGROUP); __hip_atomic_fetch_add(&sh[8 + e], b2, __ATOMIC_RELAXED, __HIP_MEMORY_SCOPE_WORKGROUP); } }
        __syncthreads();
        int base_e[8]; { int acc = 0;
#pragma unroll
            for (int e = 0; e < 8; ++e) { base_e[e] = acc; acc += sh[e]; } }
        if (tid < 8) { MISC[16 + tid] = (unsigned)base_e[tid]; MISC[24 + tid] = (unsigned)sh[tid]; if (blk == 0) { meta[tid] = base_e[tid]; meta[8 + tid] = sh[tid]; } }
        int e0 = 0, e1 = 0; const bool act = tid < TPB;
        if (act) { const int2 e = *(const int2*)(top_e + 2 * (t0 + tid)); e0 = e.x; e1 = e.y; }
        int r0 = 0, r1 = 0;
#pragma unroll
        for (int e = 0; e < 8; ++e) { const bool f = act && (e0 == e || e1 == e); const unsigned long long bal = __ballot(f); const int pre = __popcll(bal & ((1ull << lane) - 1ull));
            if (wave == 0 && lane == 0) sh[16 + e] = __popcll(bal);
            if (e0 == e) r0 = pre; if (e1 == e) r1 = pre; }
        __syncthreads();
        if (act) { if (wave == 1) { r0 += sh[16 + e0]; r1 += sh[16 + e1]; }
            int s0 = 0, s1 = 0;
#pragma unroll
            for (int e = 0; e < 8; ++e) { if (e0 == e) s0 = base_e[e] + sh[8 + e] + r0; if (e1 == e) s1 = base_e[e] + sh[8 + e] + r1; }
            sh[32 + 2 * tid] = s0; sh[33 + 2 * tid] = s1; *(int2*)(tslot + 2 * (t0 + tid)) = make_int2(s0, s1); }
        __syncthreads();
        for (int i = wave; i < TPB; i += NWAVES) { const int t = t0 + i; const int s0 = sh[32 + 2 * i], s1 = sh[33 + 2 * i];
#if MOE_FP8
            const unsigned char* H48 = (const unsigned char*)H4; unsigned char* HS8 = (unsigned char*)HS;
            const u32x4 w = *(const u32x4*)(H48 + (size_t)t * D + lane * 16);
            *(u32x4*)(HS8 + (size_t)s0 * D + lane * 16) = w; *(u32x4*)(HS8 + (size_t)s1 * D + lane * 16) = w; }
#else
            const uint4 v0 = *(const uint4*)(H4 + (size_t)t * D + lane * 8), v1 = *(const uint4*)(H4 + (size_t)t * D + 512 + lane * 8);
            *(uint4*)(HS + (size_t)s0 * D + lane * 8) = v0; *(uint4*)(HS + (size_t)s0 * D + 512 + lane * 8) = v1;
            *(uint4*)(HS + (size_t)s1 * D + lane * 8) = v0; *(uint4*)(HS + (size_t)s1 * D + 512 + lane * 8) = v1; }
#endif
    }
    SEAM(PH_ROUTE);
    if (IN(PH_MOEIN)) { PHASE_PTRS;
        { const int t2 = tidx(wave0); if (t2 < 16) MISC[16 + t2] = (unsigned)meta[t2]; }
        __syncthreads();
#if MOE_FP8
        pg8::Gemm g{HS, Wmi, D / 2, D / 2, D / 2}; pg8::MoeOrder S; S.init((const LAS int*)(lds + MISC_OFF + 64), 2 * FFN / 256, G, blk); pg8::EpiSwiglu8 E{(unsigned char*)ACT2, W8_INV};
        pg8::gemm_phase<pg8::EpiSwiglu8, pg8::MoeOrder, true, true>(lds + RING_OFF, g, S, E, wave0); }
#else
        pg8::Gemm g{HS, Wmi, D, D, D}; pg8::MoeOrder S; S.init((const LAS int*)(lds + MISC_OFF + 64), 2 * FFN / 256, G, blk); pg8::EpiSwiglu E{ACT2};
        pg8::gemm_phase<pg8::EpiSwiglu, pg8::MoeOrder, true>(lds + RING_OFF, g, S, E, wave0); }
#endif
    SEAM(PH_MOEIN);
    if (IN(PH_MOEOUT)) { PHASE_PTRS;
        { const int t2 = tidx(wave0); if (t2 < 16) MISC[16 + t2] = (unsigned)meta[t2]; }
        __syncthreads();
#if MOE_FP8
        pg8::Gemm g{ACT2, Wmo, FFN / 2, FFN / 2, FFN / 2}; pg8::MoeOrder S; S.init((const LAS int*)(lds + MISC_OFF + 64), D / 256, G, blk); pg8::EpiPlainS E{YS, D, W8_INV};
        pg8::gemm_phase<pg8::EpiPlainS, pg8::MoeOrder, true, true>(lds + RING_OFF, g, S, E, wave0); }
#else
        pg8::Gemm g{ACT2, Wmo, FFN, FFN, FFN}; pg8::MoeOrder S; S.init((const LAS int*)(lds + MISC_OFF + 64), D / 256, G, blk); pg8::EpiPlain E{YS, D};
        pg8::gemm_phase<pg8::EpiPlain, pg8::MoeOrder, true>(lds + RING_OFF, g, S, E, wave0); }
#endif
    SEAM(PH_MOEOUT);
    if (IN(PH_ROWS17)) { PHASE_PTRS; PHASE_IDS; RowArgs a{}; a.xin_lat = out; a.xin_ctx = cx; a.xout_lat = out; a.xout_ctx = cx; a.Y = YS; a.tok_slot = tslot; a.tok_g = top_g; a.gy = g1n + 3072; a.gate = mv1 + 5120; a.nrows = RL; a.xin_bf = 1; a.xin_lat = (const float*)(ws + 404 * MiB);
#ifdef PROBE_K
        __syncthreads();
        { const float tot = (float)(tsl[PH_ROWS17] - tsl[0]); float fr = 0.f;
#pragma unroll
          for (int k = 0; k < PH_ROWS17; ++k) if ((PROBE_K >> k) & 1) fr += (float)(tsl[k + 1] - tsl[k]);
          a.oscale = 1.f + 2.f * fr / tot; }
#endif
        rows2::rows_phase<false, 2, 2, 0, false>(a, gw, NGW, lane, false, nullptr); }
#undef IN
#undef SEAM
}
#ifndef N_LAUNCH_MODE
#define N_LAUNCH_MODE 1
#endif

static inline dim3 g1(size_t n, int per) { return dim3((unsigned)((n + per - 1) / per)); }
extern "C" void kernel_launch(void* const* d_in, const int* in_sizes, int n_in, void* d_out, int out_size, void* d_ws, size_t ws_size, hipStream_t stream) {
    if (n_in != 22 || out_size != RL * D || ws_size < WS_END) { fprintf(stderr, "kernel_launch: unexpected shapes: n_in %d out %d ws %zu (need %zu)\n", n_in, out_size, ws_size, (size_t)WS_END); return; }
    static int grid = 0;
    if (grid == 0) {
        int dev = 0, cus = 0;
        if (hipGetDevice(&dev) != hipSuccess || hipDeviceGetAttribute(&cus, hipDeviceAttributeMultiprocessorCount, dev) != hipSuccess) { grid = -1; return; }
        if (hipFuncSetAttribute((const void*)mega, hipFuncAttributeMaxDynamicSharedMemorySize, LDS_BYTES) != hipSuccess) { fprintf(stderr, "hipFuncSetAttribute failed\n"); grid = -1; return; }
        int per_cu = 0; (void)hipOccupancyMaxActiveBlocksPerMultiprocessor(&per_cu, (const void*)mega, NTHREADS, LDS_BYTES); (void)hipGetLastError();
        if (per_cu < 1) fprintf(stderr, "occupancy query says %d\n", per_cu);
        grid = cus;
    }
    if (grid < 0) return;
    char* ws = (char*)d_ws; float* out = (float*)d_out;
    float* lg = (float*)(ws + WS_LG); int* meta = (int*)(ws + WS_META);
    bf16_t* HB = (bf16_t*)(ws + WS_HB);
    bf16_t* G[9]; for (int i = 0; i < 9; ++i) G[i] = (bf16_t*)(ws + WS_G0 + i * GSZ);
    float* oret = (float*)(ws + WS_ST + 72 * MiB); float* ohg = (float*)(ws + WS_ST + 140 * MiB);
    bf16_t* QN = (bf16_t*)(ws + WS_QN); bf16_t* QR = (bf16_t*)(ws + WS_QR); bf16_t* KN = (bf16_t*)(ws + WS_KN); bf16_t* KR = (bf16_t*)(ws + WS_KR);
    bf16_t* Vv = (bf16_t*)(ws + WS_V); bf16_t* AO = (bf16_t*)(ws + WS_AO);
    bf16_t* H4 = (bf16_t*)(ws + WS_H4); bf16_t* HS = (bf16_t*)(ws + WS_HS);
    int* top_e = (int*)(ws + WS_TOPE); int* rank = (int*)(ws + WS_RANK); int* tslot = (int*)(ws + WS_TSLOT);
    (void)hipMemsetAsync(ws + WS_CTL, 0, 1 * MiB, stream);
    Args a{}; for (int i = 0; i < 22; ++i) a.in[i] = (const float*)d_in[i]; a.out = out; a.ws = (unsigned char*)d_ws;
    auto run = [&](int lo, int hi) { a.ph_lo = lo; a.ph_hi = hi; hipLaunchKernelGGL(mega, dim3(grid), dim3(NTHREADS), LDS_BYTES, stream, a); };
#if N_LAUNCH_MODE == 1
    run(0, PH_COUNT);
#else
    for (int p = PH_SETUP; p < PH_COUNT; ++p) run(p, p + 1);
#endif
}
```
